# Optimizing an MI355X kernel written in HIP

```python
import jax, jax.numpy as jnp
from jax import lax
import numpy as np

D_MODEL = 1024
BATCH = 16
SEQ = 256
DEPTH = 2
DEC_BATCH = 4
DEC_SEQ = 1024
PAST_LEN = 512

F32 = jnp.float32
GRID_W = 64
N_MIXERS = 4
W_GRP = D_MODEL // N_MIXERS
N_HEADS = 4
HEAD_V = W_GRP // N_HEADS
HGRN_DK = HEAD_V
GLA_DK = HEAD_V // 2
GLA_RANK = 16
GLA_NORMALIZER = 16.0
RG_BLOCKS = N_HEADS
RG_BLOCK = W_GRP // RG_BLOCKS
RG_CONV = 4
RG_C = 8.0
SCONV_W = 3
D_FF = 4 * D_MODEL
CHUNK = 32
EPS = 1e-6
F_FLOOR = 1e-20
SPLIT_SIZES = (
    N_HEADS * HGRN_DK, N_HEADS * HEAD_V, N_HEADS * HGRN_DK, N_HEADS * HGRN_DK, W_GRP,
    N_HEADS * GLA_DK, N_HEADS * GLA_DK, W_GRP, W_GRP, GLA_RANK, GLA_RANK,
    W_GRP, W_GRP,
    W_GRP, W_GRP, W_GRP,
)
PROJ_W = sum(SPLIT_SIZES)

kernel_name = 'hybrid_parallel_heads_diffusion_step'


def rmsnorm(x, g):
    xf = x.astype(F32)
    y = xf * lax.rsqrt(jnp.mean(xf * xf, axis=-1, keepdims=True) + EPS)
    return (y * g.astype(F32)).astype(x.dtype)


def to_heads(t):
    b, l, _ = t.shape
    return t.reshape(b, l, N_HEADS, -1).transpose(0, 2, 1, 3)


def head_norm_gate(o, g, gain):
    b, h, l, dv = o.shape
    o = o.transpose(0, 2, 1, 3)
    o = o * lax.rsqrt(jnp.mean(o * o, axis=-1, keepdims=True) + EPS)
    o = o.reshape(b, l, h * dv) * gain.astype(F32)
    return (o * jax.nn.silu(g.astype(F32))).astype(g.dtype)


def chunk_gla(q, k, v, log_a, s0):
    b, h, l, dk = q.shape
    dv = v.shape[-1]
    n = l // CHUNK
    q = q.reshape(b, h, n, CHUNK, dk)
    k = k.reshape(b, h, n, CHUNK, dk)
    v = v.reshape(b, h, n, CHUNK, dv)
    cum = jnp.cumsum(log_a.reshape(b, h, n, CHUNK, dk), axis=3)
    last = cum[:, :, :, -1:, :]
    causal = jnp.tril(jnp.ones((CHUNK, CHUNK), dtype=bool))[:, :, None]
    diff = cum[:, :, :, :, None, :] - cum[:, :, :, None, :, :]
    decay = jnp.where(causal, jnp.exp(jnp.minimum(diff, 0.0)), 0.0)
    scores = jnp.einsum('bhntd,bhnsd,bhntsd->bhnts', q, k, decay)
    o_intra = jnp.einsum('bhnts,bhnse->bhnte', scores, v)
    ds = jnp.einsum('bhncd,bhnce->bhnde', k * jnp.exp(last - cum), v)
    a_chunk = jnp.exp(last[:, :, :, 0, :])

    def step(s, inp):
        a_n, ds_n = inp
        return a_n[..., None] * s + ds_n, s

    s_final, s_in = lax.scan(step, s0, (jnp.moveaxis(a_chunk, 2, 0), jnp.moveaxis(ds, 2, 0)))
    s_in = jnp.moveaxis(s_in, 0, 2)
    o_inter = jnp.einsum('bhntd,bhnde->bhnte', q * jnp.exp(cum), s_in)
    return (o_intra + o_inter).reshape(b, h, l, dv), s_final


def bidirectional_gla(q, v, ks, log_as, s0):
    outs, finals = [], []
    for d in range(2):
        qd, kd, vd, ad = q, ks[d], v, log_as[d]
        if d == 1:
            qd, kd, vd, ad = (jnp.flip(t, axis=2) for t in (qd, kd, vd, ad))
        o, sf = chunk_gla(qd, kd, vd, ad, s0[:, d].astype(F32))
        outs.append(jnp.flip(o, axis=2) if d == 1 else o)
        finals.append(sf)
    return outs[0] + outs[1], jnp.stack(finals, axis=1)


def hgrn2_mixer(q, i, f_fwd, f_bwd, g, lb, norm_g, s0):
    qh = to_heads(q.astype(F32))
    vh = to_heads(i.astype(F32))
    lb = lb.astype(F32)
    ks, las = [], []
    for d, fl in enumerate((f_fwd, f_bwd)):
        f = lb[d] + (1.0 - lb[d]) * jax.nn.sigmoid(fl.astype(F32))
        log_f = jnp.log(jnp.maximum(f, F_FLOOR))
        ks.append(to_heads(1.0 - f))
        las.append(to_heads(log_f))
    o, sf = bidirectional_gla(qh, vh, ks, las, s0)
    return head_norm_gate(o, g, norm_g), sf


def gla_mixer(q, k, v, g, a_fwd, a_bwd, wa2, ba2, norm_g, s0):
    qh = to_heads(q.astype(F32)) * (GLA_DK ** -0.5)
    kh = to_heads(k.astype(F32))
    vh = to_heads(v.astype(F32))
    las = [to_heads(jax.nn.log_sigmoid((a @ wa2[d] + ba2[d]).astype(F32)) / GLA_NORMALIZER)
           for d, a in enumerate((a_fwd, a_bwd))]
    o, sf = bidirectional_gla(qh, vh, [kh, kh], las, s0)
    return head_norm_gate(o, g, norm_g), sf


def causal_conv(u, w, bias):
    l = u.shape[1]
    kw = w.shape[0]
    up = jnp.pad(u, ((0, 0), (kw - 1, 0), (0, 0)))
    out = bias
    for j in range(kw):
        out = out + up[:, j:j + l] * w[j]
    return out


def block_diag(x, w, bias):
    b, l, _ = x.shape
    y = jnp.einsum('blnc,ncd->blnd', x.reshape(b, l, RG_BLOCKS, RG_BLOCK), w.astype(F32))
    return y.reshape(b, l, W_GRP) + bias.astype(F32)


def rglru_scan(x, r, ig, lam, h0):
    log_a = -RG_C * r * jax.nn.softplus(-lam)
    a = jnp.exp(log_a)
    bx = jnp.sqrt(-jnp.expm1(2.0 * log_a)) * (ig * x)
    bx = bx.at[:, 0].add(a[:, 0] * h0)

    def combine(e1, e2):
        a1, b1 = e1
        a2, b2 = e2
        return a1 * a2, a2 * b1 + b2

    _, h = lax.associative_scan(combine, (a, bx), axis=1)
    return h, h[:, -1]


def rglru_mixer(u, gate, conv_w, conv_b, w_r, b_r, w_i, b_i, lam, h0):
    u = u.astype(F32)
    outs, finals = [], []
    for d in range(2):
        ud = jnp.flip(u, axis=1) if d == 1 else u
        xc = causal_conv(ud, conv_w[d].astype(F32), conv_b[d].astype(F32))
        r = jax.nn.sigmoid(block_diag(xc, w_r[d], b_r[d]))
        ig = jax.nn.sigmoid(block_diag(xc, w_i[d], b_i[d]))
        h, hf = rglru_scan(xc, r, ig, lam[d].astype(F32), h0[:, d].astype(F32))
        outs.append(jnp.flip(h, axis=1) if d == 1 else h)
        finals.append(hf)
    y = (outs[0] + outs[1]) * jax.nn.gelu(gate.astype(F32))
    return y.astype(gate.dtype), jnp.stack(finals, axis=1)


def short_conv_mixer(bg, cg, v, w, rows):
    u = cg * v
    b, l, ch = u.shape
    u = u.reshape(b, rows, l // rows, ch)
    pad = SCONV_W // 2
    up = jnp.pad(u, ((0, 0), (0, 0), (pad, pad), (0, 0)))
    seg = l // rows
    y = up[:, :, 0:seg] * w[0]
    for j in range(1, SCONV_W):
        y = y + up[:, :, j:j + seg] * w[j]
    return bg * y.reshape(b, l, ch)


def trunk_layer(x, mod, rows, s_hgrn, s_gla, s_rg, lb, norm1_g, norm2_g, w_in, w_out,
                hgrn_norm_g, gla_wa2, gla_ba2, gla_norm_g, rg_conv_w, rg_conv_b,
                rg_w_r, rg_b_r, rg_w_i, rg_b_i, rg_lambda, sconv_w, mlp_w1, mlp_w2):
    shift1, scale1, gate1, shift2, scale2, gate2 = jnp.split(mod[:, None, :], 6, axis=-1)
    h = rmsnorm(x, norm1_g) * (1 + scale1) + shift1
    proj = h @ w_in
    points = np.cumsum(SPLIT_SIZES)[:-1].tolist()
    (a_q, a_i, a_ff, a_fb, a_g, b_q, b_k, b_v, b_g, b_af, b_ab,
     c_x, c_g, d_b, d_c, d_v) = jnp.split(proj, points, axis=-1)
    o_a, sf_a = hgrn2_mixer(a_q, a_i, a_ff, a_fb, a_g, lb, hgrn_norm_g, s_hgrn)
    o_b, sf_b = gla_mixer(b_q, b_k, b_v, b_g, b_af, b_ab, gla_wa2, gla_ba2, gla_norm_g, s_gla)
    o_c, sf_c = rglru_mixer(c_x, c_g, rg_conv_w, rg_conv_b, rg_w_r, rg_b_r, rg_w_i, rg_b_i,
                            rg_lambda, s_rg)
    o_d = short_conv_mixer(d_b, d_c, d_v, sconv_w, rows)
    mix = jnp.concatenate([o_a, o_b, o_c, o_d], axis=-1) @ w_out
    x = x + gate1 * mix
    h2 = rmsnorm(x, norm2_g) * (1 + scale2) + shift2
    ff = jnp.square(jax.nn.relu(h2 @ mlp_w1)) @ mlp_w2
    x = x + gate2 * ff
    return x, sf_a, sf_b, sf_c


def setup_inputs(seed: int = 0) -> dict:
    key = jax.random.key(seed)
    ks = jax.random.split(key, 32)
    D = D_MODEL

    def nrm(k, shape, s):
        return jax.random.normal(k, shape, F32) * s

    def gain(k, shape):
        return 1.0 + 0.1 * jax.random.normal(k, shape, F32)

    u = jax.random.uniform(ks[29], (DEPTH, 2, W_GRP), F32, 0.9, 0.999)
    p_a = u ** (1.0 / RG_C)
    rg_lambda = jnp.log(p_a) - jnp.log1p(-p_a)
    return {
        'x_prompt': nrm(ks[0], (BATCH, SEQ, D), 1.0),
        'x_sample': nrm(ks[1], (DEC_BATCH, DEC_SEQ, D), 1.0),
        'state_hgrn': nrm(ks[2], (DEC_BATCH, DEPTH, 2, N_HEADS, HGRN_DK, HEAD_V), 0.5),
        'state_gla': nrm(ks[3], (DEC_BATCH, DEPTH, 2, N_HEADS, GLA_DK, HEAD_V), 0.5),
        'state_rglru': nrm(ks[4], (DEC_BATCH, DEPTH, 2, W_GRP), 0.5),
        'c': nrm(ks[5], (DEC_BATCH, D), 1.0),
        'c_ctx': nrm(ks[6], (D,), 1.0),
        'norm1_g': gain(ks[7], (DEPTH, D)),
        'norm2_g': gain(ks[8], (DEPTH, D)),
        'ada_w': nrm(ks[9], (DEPTH, D, 6 * D), 0.3 * D ** -0.5),
        'ada_b': nrm(ks[10], (DEPTH, 6 * D), 0.02),
        'w_in': nrm(ks[11], (DEPTH, D, PROJ_W), D ** -0.5),
        'w_out': nrm(ks[12], (DEPTH, D, D), D ** -0.5),
        'hgrn_lb_logits': nrm(ks[13], (DEPTH, 2, W_GRP), 1.0),
        'hgrn_norm_g': gain(ks[14], (DEPTH, W_GRP)),
        'gla_wa2': nrm(ks[15], (DEPTH, 2, GLA_RANK, N_HEADS * GLA_DK), GLA_RANK ** -0.5),
        'gla_ba2': nrm(ks[16], (DEPTH, 2, N_HEADS * GLA_DK), 0.1),
        'gla_norm_g': gain(ks[17], (DEPTH, W_GRP)),
        'rg_conv_w': nrm(ks[18], (DEPTH, 2, RG_CONV, W_GRP), RG_CONV ** -0.5),
        'rg_conv_b': nrm(ks[19], (DEPTH, 2, W_GRP), 0.02),
        'rg_w_r': nrm(ks[20], (DEPTH, 2, RG_BLOCKS, RG_BLOCK, RG_BLOCK), RG_BLOCK ** -0.5),
        'rg_b_r': nrm(ks[21], (DEPTH, 2, W_GRP), 0.02),
        'rg_w_i': nrm(ks[22], (DEPTH, 2, RG_BLOCKS, RG_BLOCK, RG_BLOCK), RG_BLOCK ** -0.5),
        'rg_b_i': nrm(ks[23], (DEPTH, 2, W_GRP), 0.02),
        'rg_lambda': rg_lambda,
        'sconv_w': nrm(ks[24], (DEPTH, SCONV_W, W_GRP), SCONV_W ** -0.5),
        'mlp_w1': nrm(ks[25], (DEPTH, D, D_FF), D ** -0.5),
        'mlp_w2': nrm(ks[26], (DEPTH, D_FF, D), D_FF ** -0.5),
        'final_norm_g': gain(ks[27], (D,)),
    }


def reference(x_prompt, x_sample, state_hgrn, state_gla, state_rglru, c, c_ctx,
              norm1_g, norm2_g, ada_w, ada_b, w_in, w_out, hgrn_lb_logits, hgrn_norm_g,
              gla_wa2, gla_ba2, gla_norm_g, rg_conv_w, rg_conv_b, rg_w_r, rg_b_r,
              rg_w_i, rg_b_i, rg_lambda, sconv_w, mlp_w1, mlp_w2, final_norm_g):
    sm = jax.nn.softmax(hgrn_lb_logits.astype(F32), axis=0)
    lower_bounds = jnp.cumsum(sm, axis=0) - sm[0]
    b_ctx = x_prompt.shape[0]
    rows = x_sample.shape[1] // GRID_W
    zero_h = jnp.zeros((b_ctx, 2, N_HEADS, HGRN_DK, HEAD_V), F32)
    zero_g = jnp.zeros((b_ctx, 2, N_HEADS, GLA_DK, HEAD_V), F32)
    zero_r = jnp.zeros((b_ctx, 2, W_GRP), F32)
    xp, xs = x_prompt, x_sample
    new_h, new_g, new_r = [], [], []
    for l in range(DEPTH):
        lw = (norm1_g[l], norm2_g[l], w_in[l], w_out[l], hgrn_norm_g[l], gla_wa2[l], gla_ba2[l],
              gla_norm_g[l], rg_conv_w[l], rg_conv_b[l], rg_w_r[l], rg_b_r[l], rg_w_i[l],
              rg_b_i[l], rg_lambda[l], sconv_w[l], mlp_w1[l], mlp_w2[l])
        mod_ctx = (jax.nn.silu(c_ctx) @ ada_w[l] + ada_b[l])[None, :]
        mod_lat = jax.nn.silu(c) @ ada_w[l] + ada_b[l]
        xp, sh, sg, sr = trunk_layer(xp, mod_ctx, 1, zero_h, zero_g, zero_r, lower_bounds[l], *lw)
        xs, _, _, _ = trunk_layer(xs, mod_lat, rows, state_hgrn[:, l], state_gla[:, l],
                                  state_rglru[:, l], lower_bounds[l], *lw)
        new_h.append(sh)
        new_g.append(sg)
        new_r.append(sr)
    y_prompt = rmsnorm(xp, final_norm_g)
    y_sample = rmsnorm(xs, final_norm_g)
    new_state_hgrn = jnp.stack(new_h, axis=1).astype(x_prompt.dtype)
    new_state_gla = jnp.stack(new_g, axis=1).astype(x_prompt.dtype)
    new_state_rglru = jnp.stack(new_r, axis=1).astype(x_prompt.dtype)
    return (y_prompt, y_sample, new_state_hgrn, new_state_gla, new_state_rglru)
```

```cpp
#include <hip/hip_runtime.h>
#include <hip/hip_cooperative_groups.h>
#include <cstdio>
#include <cstdint>
namespace cg = cooperative_groups;

#ifndef MEGA
#define MEGA 1
#endif

#define DI __device__ __forceinline__
#define LAS __attribute__((address_space(3)))
typedef unsigned short bf16_t;
typedef short bf16x8 __attribute__((ext_vector_type(8)));
typedef float f32x4 __attribute__((ext_vector_type(4)));
typedef float f32x16 __attribute__((ext_vector_type(16)));
typedef unsigned u32x4 __attribute__((ext_vector_type(4)));
typedef unsigned u32x2 __attribute__((ext_vector_type(2)));
typedef __bf16 bf16x2_t __attribute__((ext_vector_type(2)));
typedef float f32x2_t __attribute__((ext_vector_type(2)));

constexpr int NTOK = 8192, DM = 1024, NP = 3584, DFF = 4096;
constexpr int A_Q = 0, A_I = 256, A_FF = 512, A_FB = 768, A_G = 1024, B_Q = 1280, B_K = 1408, B_V = 1536, B_G = 1792, B_AF = 2048, B_AB = 2064,
              C_X = 2080, C_G = 2336, D_B = 2592, D_C = 2848, D_V = 3104, PW = 3360;
constexpr size_t MiB = 1u << 20;
constexpr size_t WS_WIN = 0, WS_WOUT = 14 * MiB, WS_W1 = 18 * MiB, WS_W2 = 34 * MiB, WS_MOD = 50 * MiB, WS_HM = 51 * MiB, WS_BIG = 67 * MiB,
                 WS_OI = 131 * MiB, WS_DSA = 147 * MiB, WS_DSB = 179 * MiB, WS_QHA = 195 * MiB, WS_QHB = 203 * MiB, WS_HL = 207 * MiB, WS_CP = 223 * MiB,
                 WS_ACHA = 239 * MiB, WS_ACHB = 239 * MiB + 512 * 1024, WS_RAGA = 240 * MiB, WS_RAGH = 240 * MiB + 512 * 1024, WS_END = 241 * MiB;
constexpr int OUT_SH = 8388608, OUT_SG = OUT_SH + 1048576, OUT_SR = OUT_SG + 524288;
constexpr int LDS_BYTES = 147456;

struct Params { const float* in[29]; float* out; unsigned char* ws; size_t zo; int ph_lo, ph_hi;
    DI const float* IN(int i) const { return in[i] + zo; } };

DI float bf2f(bf16_t u) { return __uint_as_float(((unsigned)u) << 16); }
DI unsigned pk2(float lo, float hi) { f32x2_t v = {lo, hi}; bf16x2_t b = __builtin_convertvector(v, bf16x2_t); return __builtin_bit_cast(unsigned, b); }
DI bf16_t f2bf(float x) { return (bf16_t)(pk2(x, 0.f) & 0xffffu); }
DI bf16x8 pack8(const float* v) { u32x4 p; p.x = pk2(v[0], v[1]); p.y = pk2(v[2], v[3]); p.z = pk2(v[4], v[5]); p.w = pk2(v[6], v[7]); return __builtin_bit_cast(bf16x8, p); }
DI float sigmoidf_(float x) { return 1.f / (1.f + __expf(-x)); }
DI float siluf_(float x) { return x / (1.f + __expf(-x)); }
DI int crow(int reg, int h) { return (reg & 3) + 8 * (reg >> 2) + 4 * h; }
#define MFMA32(a, b, c) __builtin_amdgcn_mfma_f32_32x32x16_bf16((a), (b), (c), 0, 0, 0)
DI f32x16 zero16() { f32x16 z; for (int i = 0; i < 16; ++i) z[i] = 0.f; return z; }
DI float shx(float v, int lane, int m) { return __int_as_float(__builtin_amdgcn_ds_bpermute((lane ^ m) << 2, __float_as_int(v))); }
DI int modrow_of(int row) { return row < 4096 ? 0 : 1 + ((row - 4096) >> 10); }

namespace pg8 {
constexpr int BM = 256, BK = 64, HALF = 128, HTB = HALF * BK * 2, NXCD = 8, WGM = 8;
__host__ __device__ __forceinline__ int lds_byte(int r, int c) { const int st = (r >> 4) * 2 + (c >> 5), rr = r & 15, cc = c & 31, ob = rr * 64 + cc * 2; return st * 1024 + (ob ^ (((ob >> 9) & 1) << 5)); }
__host__ __device__ __forceinline__ void stage_rc(int b, int& R, int& C) { const int st = b / 1024, sb = b % 1024, swz = sb ^ (((sb >> 9) & 1) << 5); R = (st >> 1) * 16 + swz / 64; C = (st & 1) * 32 + (swz % 64) / 2; }
__host__ __device__ __forceinline__ int perm32(int rho) { const int n = rho >> 4, i = rho & 15; return 8 * (i >> 2) + 4 * n + (i & 3); }
struct Unit { int pm, pn; };
struct Gemm { const bf16_t* A; const bf16_t* Bt; int M, N, K; };
struct StaticOrder {
    int nM, nN, nwg, G, c;
    __host__ __device__ void init(int M, int N, int G_, int c_) { nM = M / BM; nN = N / BM; nwg = nM * nN; G = G_; c = c_; }
    __host__ __device__ bool next(int i, Unit& u) const {
        const long L = (long)i * G + c; if (L >= nwg) return false;
        int wgid = (int)L; { const int q = nwg / NXCD, r = nwg % NXCD, xcd = wgid % NXCD, off = wgid / NXCD; wgid = (xcd < r ? xcd * (q + 1) : r * (q + 1) + (xcd - r) * q) + off; }
        const int nig = WGM * nN, gid = wgid / nig, fm = gid * WGM, gsz = (nM - fm) < WGM ? (nM - fm) : WGM;
        u.pm = fm + ((wgid % nig) % gsz); u.pn = (wgid % nig) / gsz; return true;
    }
};
template <class Epi>
__device__ __forceinline__ void gemm_phase(LAS unsigned char* lds, const Gemm g, const StaticOrder& S, const Epi& E, const int tid) {
    const int wid = __builtin_amdgcn_readfirstlane(tid >> 6), lane = tid & 63, wr = wid >> 2, wc = wid & 3, fr = lane & 15, fq = lane >> 4;
    const int K = g.K, nt = K / BK;
    unsigned voffA[2], voffB[2];
#pragma unroll
    for (int i = 0; i < 2; ++i) { int R, C; stage_rc(tid * 16 + i * 8192, R, C); const int Rb = (R & ~31) + perm32(R & 31);
        voffA[i] = (unsigned)(R * K + C) * 2u; voffB[i] = (unsigned)(Rb * K + C) * 2u; }
    const size_t kstep = (size_t)(BK * 2);
    const size_t hstep = (size_t)HALF * K * 2;
    const size_t tstep = 2 * hstep;
    const unsigned ldsw = (unsigned)wid * 1024u;
    const int aoff = lds_byte(wr * 64 + fr, fq * 8), boff = lds_byte(wc * 32 + fr, fq * 8);
#define PG8_SA(b, h) (((b) * 2 + (h)) * HTB)
#define PG8_SB(b, h) ((4 + (b) * 2 + (h)) * HTB)
#define PG8_STAGE(bufoff, gbase, voff) do { _Pragma("unroll") for (int _i = 0; _i < 2; ++_i) \
        __builtin_amdgcn_global_load_lds((const unsigned*)((const char*)(gbase) + (voff)[_i]), (LAS unsigned*)(lds + (bufoff) + ldsw + _i * 8192), 16, 0, 0); } while (0)
#define PG8_LDA(dst, b, h) do { _Pragma("unroll") for (int m = 0; m < 4; ++m) _Pragma("unroll") for (int k = 0; k < 2; ++k) dst[m][k] = *(const LAS bf16x8*)(lds + PG8_SA(b, h) + aoff + m * 2048 + k * 1024); } while (0)
#define PG8_LDB(dst, b, h) do { _Pragma("unroll") for (int n = 0; n < 2; ++n) _Pragma("unroll") for (int k = 0; k < 2; ++k) dst[n][k] = *(const LAS bf16x8*)(lds + PG8_SB(b, h) + boff + n * 2048 + k * 1024); } while (0)
#define PG8_MMA(ai, bj, At, Bt) do { __builtin_amdgcn_s_setprio(1); _Pragma("unroll") for (int m = 0; m < 4; ++m) _Pragma("unroll") for (int n = 0; n < 2; ++n) _Pragma("unroll") for (int k = 0; k < 2; ++k) \
        acc[ai][bj][m][n] = __builtin_amdgcn_mfma_f32_16x16x32_bf16(Bt[n][k], At[m][k], acc[ai][bj][m][n], 0, 0, 0); __builtin_amdgcn_s_setprio(0); } while (0)
#define PG8_WAIT_V(n) asm volatile("s_waitcnt vmcnt(" #n ")" ::: "memory")
#define PG8_WAIT_L(n) asm volatile("s_waitcnt lgkmcnt(" #n ")" ::: "memory")
#define PG8_BAR __builtin_amdgcn_s_barrier()
#define PG8_SCHED __builtin_amdgcn_sched_barrier(0)
    Unit cur, nxt; int ui = 0;
    if (!S.next(0, cur)) return;
    f32x4 acc[2][2][4][2];
#pragma unroll
    for (int a = 0; a < 2; ++a)
#pragma unroll
        for (int b = 0; b < 2; ++b)
#pragma unroll
            for (int m = 0; m < 4; ++m)
#pragma unroll
                for (int n = 0; n < 2; ++n) acc[a][b][m][n] = (f32x4){0.f, 0.f, 0.f, 0.f};
    bf16x8 At[4][2], B0[2][2], B1[2][2];
    const char* cA = (const char*)g.A + (size_t)cur.pm * tstep; const char* cB = (const char*)g.Bt + (size_t)cur.pn * tstep;
    PG8_STAGE(PG8_SB(0, 0), cB, voffB); PG8_STAGE(PG8_SA(0, 0), cA, voffA); PG8_STAGE(PG8_SB(0, 1), cB + hstep, voffB); PG8_STAGE(PG8_SA(0, 1), cA + hstep, voffA);
    if (wr == 1) PG8_BAR;
    PG8_WAIT_V(4); PG8_BAR;
    PG8_STAGE(PG8_SB(1, 0), cB + kstep, voffB); PG8_STAGE(PG8_SA(1, 0), cA + kstep, voffA); PG8_STAGE(PG8_SB(1, 1), cB + hstep + kstep, voffB);
    PG8_WAIT_V(6); PG8_BAR;
    for (;;) {
        const bool has_next = S.next(ui + 1, nxt);
        const char* nA = has_next ? (const char*)g.A + (size_t)nxt.pm * tstep : cA; const char* nB = has_next ? (const char*)g.Bt + (size_t)nxt.pn * tstep : cB;
        for (int t = 0; t < nt; t += 2) {
            const bool last = (t == nt - 2);
            const char* a1 = cA + (size_t)(t + 1) * kstep;
            const char* a2 = last ? nA : cA + (size_t)(t + 2) * kstep; const char* b2 = last ? nB : cB + (size_t)(t + 2) * kstep;
            const char* a3 = a2 + kstep; const char* b3 = b2 + kstep;
            PG8_LDB(B0, 0, 0); PG8_SCHED; PG8_LDA(At, 0, 0); PG8_STAGE(PG8_SA(1, 1), a1 + hstep, voffA);
            PG8_WAIT_L(8); PG8_BAR; PG8_WAIT_L(0); PG8_MMA(0, 0, At, B0); PG8_BAR; PG8_SCHED;
            PG8_LDB(B1, 0, 1); PG8_STAGE(PG8_SB(0, 0), b2, voffB);
            PG8_BAR; PG8_WAIT_L(0); PG8_MMA(0, 1, At, B1); PG8_BAR;
            PG8_LDA(At, 0, 1); PG8_STAGE(PG8_SA(0, 0), a2, voffA);
            PG8_BAR; PG8_WAIT_L(0); PG8_MMA(1, 0, At, B0); PG8_BAR; PG8_SCHED;
            PG8_STAGE(PG8_SB(0, 1), b2 + hstep, voffB);
            PG8_WAIT_V(6); PG8_BAR; PG8_MMA(1, 1, At, B1); PG8_BAR;
            PG8_LDB(B0, 1, 0); PG8_SCHED; PG8_LDA(At, 1, 0); PG8_STAGE(PG8_SA(0, 1), a2 + hstep, voffA);
            PG8_WAIT_L(8); PG8_BAR; PG8_WAIT_L(0); PG8_MMA(0, 0, At, B0); PG8_BAR; PG8_SCHED;
            PG8_LDB(B1, 1, 1); PG8_STAGE(PG8_SB(1, 0), b3, voffB);
            PG8_BAR; PG8_WAIT_L(0); PG8_MMA(0, 1, At, B1); PG8_BAR;
            PG8_LDA(At, 1, 1); PG8_STAGE(PG8_SA(1, 0), a3, voffA);
            PG8_BAR; PG8_WAIT_L(0); PG8_MMA(1, 0, At, B0); PG8_BAR; PG8_SCHED;
            PG8_STAGE(PG8_SB(1, 1), b3 + hstep, voffB);
            PG8_WAIT_V(6); PG8_BAR; PG8_MMA(1, 1, At, B1); PG8_BAR;
        }
        E(acc, cur, wr, wc, fr, fq);
        if (!has_next) break;
#pragma unroll
        for (int a = 0; a < 2; ++a)
#pragma unroll
            for (int b = 0; b < 2; ++b)
#pragma unroll
                for (int m = 0; m < 4; ++m)
#pragma unroll
                    for (int n = 0; n < 2; ++n) acc[a][b][m][n] = (f32x4){0.f, 0.f, 0.f, 0.f};
        cur = nxt; cA = nA; cB = nB; ++ui;
    }
    PG8_WAIT_V(0);
    if (wr == 0) PG8_BAR;
    PG8_BAR;
#undef PG8_SA
#undef PG8_SB
#undef PG8_STAGE
#undef PG8_LDA
#undef PG8_LDB
#undef PG8_MMA
#undef PG8_WAIT_V
#undef PG8_WAIT_L
#undef PG8_BAR
#undef PG8_SCHED
}

template <int ACT> struct EpiBf16 {
    bf16_t* O; int ldc;
    __device__ __forceinline__ void operator()(const f32x4 (&acc)[2][2][4][2], const Unit& u, int wr, int wc, int fr, int fq) const {
        const int row0 = u.pm * BM + wr * 64 + fr, col0 = u.pn * BM + wc * 32 + 8 * fq;
#pragma unroll
        for (int ai = 0; ai < 2; ++ai)
#pragma unroll
            for (int m = 0; m < 4; ++m) { bf16_t* rowp = O + (size_t)(row0 + ai * HALF + m * 16) * ldc + col0;
#pragma unroll
                for (int bj = 0; bj < 2; ++bj) { f32x4 v0 = acc[ai][bj][m][0], v1 = acc[ai][bj][m][1];
                    if (ACT == 1) {
#pragma unroll
                        for (int q = 0; q < 4; ++q) { float a = fmaxf(v0[q], 0.f), b = fmaxf(v1[q], 0.f); v0[q] = a * a; v1[q] = b * b; } }
                    u32x4 w; w.x = pk2(v0[0], v0[1]); w.y = pk2(v0[2], v0[3]); w.z = pk2(v1[0], v1[1]); w.w = pk2(v1[2], v1[3]);
                    *(u32x4*)(rowp + bj * HALF) = w; } }
    }
};
struct EpiResid {
    const float* xin_lo; const float* xin_hi; float* xout; const float* gate;
    __device__ __forceinline__ void operator()(const f32x4 (&acc)[2][2][4][2], const Unit& u, int wr, int wc, int fr, int fq) const {
        const int rowb = u.pm * BM; const float* xin = rowb < 4096 ? xin_lo : xin_hi; const float* gp = gate + modrow_of(rowb) * 6144;
        const int row0 = rowb + wr * 64 + fr, col0 = u.pn * BM + wc * 32 + 8 * fq;
        f32x4 gv[2][2];
#pragma unroll
        for (int bj = 0; bj < 2; ++bj)
#pragma unroll
            for (int n = 0; n < 2; ++n) gv[bj][n] = *(const f32x4*)(gp + col0 + bj * HALF + 4 * n);
#pragma unroll
        for (int ai = 0; ai < 2; ++ai)
#pragma unroll
            for (int m = 0; m < 4; ++m) { const size_t ro = (size_t)(row0 + ai * HALF + m * 16) * 1024 + col0;
#pragma unroll
                for (int bj = 0; bj < 2; ++bj)
#pragma unroll
                    for (int n = 0; n < 2; ++n) { const f32x4 xi = *(const f32x4*)(xin + ro + bj * HALF + 4 * n);
                        *(f32x4*)(xout + ro + bj * HALF + 4 * n) = xi + gv[bj][n] * acc[ai][bj][m][n]; } }
    }
};
}

DI void transpose_unit(const float* __restrict__ W, int K, int N, int Npad, bf16_t* WT, int unit, int lane) {
    const int nblk = Npad / 64, kb = unit / nblk, nb = unit % nblk, n = nb * 64 + lane, k0 = kb * 64;
    u32x4 o[8];
    if (n < N) {
        float v[64];
#pragma unroll
        for (int kk = 0; kk < 64; ++kk) v[kk] = W[(size_t)(k0 + kk) * N + n];
#pragma unroll
        for (int q = 0; q < 8; ++q) { o[q].x = pk2(v[8 * q], v[8 * q + 1]); o[q].y = pk2(v[8 * q + 2], v[8 * q + 3]); o[q].z = pk2(v[8 * q + 4], v[8 * q + 5]); o[q].w = pk2(v[8 * q + 6], v[8 * q + 7]); }
    } else {
#pragma unroll
        for (int q = 0; q < 8; ++q) o[q] = (u32x4){0u, 0u, 0u, 0u};
    }
    u32x4* dst = (u32x4*)(WT + (size_t)n * K + k0);
#pragma unroll
    for (int q = 0; q < 8; ++q) dst[q] = o[q];
}

DI void phase_p0(const Params& p, LAS unsigned char* lds, const int tid) {
    const int lane = tid & 63, wid = tid >> 6, G = gridDim.x, bid = blockIdx.x;
    const float* c = p.IN(5); const float* c_ctx = p.IN(6); const float* ada_w = p.IN(9); const float* ada_b = p.IN(10);
    float* mod = (float*)(p.ws + WS_MOD);
    LAS float* st = (LAS float*)lds + wid * 640;
    LAS float* red = (LAS float*)(lds + 32768);
    for (int bu = bid; bu < 192; bu += G) {
        const int l = bu / 96, cgp = bu % 96, col = cgp * 64 + lane;
        for (int i = lane; i < 640; i += 64) { const int row = i / 128, k = wid * 128 + (i % 128); const float cv = row == 0 ? c_ctx[k] : c[(row - 1) * 1024 + k]; st[i] = siluf_(cv); }
        __syncthreads();
        float acc[5] = {0.f, 0.f, 0.f, 0.f, 0.f};
        const float* W = ada_w + (size_t)l * 1024 * 6144 + (size_t)(wid * 128) * 6144 + col;
#pragma unroll 16
        for (int kk = 0; kk < 128; ++kk) { const float w = W[(size_t)kk * 6144];
#pragma unroll
            for (int row = 0; row < 5; ++row) acc[row] += st[row * 128 + kk] * w; }
#pragma unroll
        for (int row = 0; row < 5; ++row) red[(wid * 5 + row) * 64 + lane] = acc[row];
        __syncthreads();
        if (tid < 320) { const int row = tid / 64, ln = tid % 64; float s = 0.f;
#pragma unroll
            for (int w = 0; w < 8; ++w) s += red[(w * 5 + row) * 64 + ln];
            const int cc = cgp * 64 + ln; mod[(l * 5 + row) * 6144 + cc] = s + ada_b[l * 6144 + cc]; }
        __syncthreads();
    }
    const int gw = bid * 8 + wid, GW = G * 8;
    for (int u = gw; u < 6400; u += GW) {
        const int l = u / 3200; int r = u % 3200;
        if (r < 896) transpose_unit(p.IN(11) + (size_t)l * 1024 * PW, 1024, PW, NP, (bf16_t*)(p.ws + WS_WIN) + (size_t)l * NP * 1024, r, lane);
        else if (r < 1152) transpose_unit(p.IN(12) + (size_t)l * 1024 * 1024, 1024, 1024, 1024, (bf16_t*)(p.ws + WS_WOUT) + (size_t)l * 1024 * 1024, r - 896, lane);
        else if (r < 2176) transpose_unit(p.IN(26) + (size_t)l * 1024 * 4096, 1024, 4096, 4096, (bf16_t*)(p.ws + WS_W1) + (size_t)l * 4096 * 1024, r - 1152, lane);
        else transpose_unit(p.IN(27) + (size_t)l * 4096 * 1024, 4096, 1024, 1024, (bf16_t*)(p.ws + WS_W2) + (size_t)l * 1024 * 4096, r - 2176, lane);
    }
}

DI void phase_norm(const Params& p, int l, int which, const int tid) {
    const int lane = tid & 63, wid = tid >> 6, gw = blockIdx.x * 8 + wid, GW = gridDim.x * 8;
    const float* mod = (const float*)(p.ws + WS_MOD);
    bf16_t* hm = (bf16_t*)(p.ws + WS_HM);
    const float* g = which == 0 ? p.IN(7) + l * 1024 : (which == 1 ? p.IN(8) + l * 1024 : p.IN(28));
    f32x4 gv[4];
#pragma unroll
    for (int j = 0; j < 4; ++j) gv[j] = ((const f32x4*)g)[lane + 64 * j];
    for (int row = gw; row < NTOK; row += GW) {
        const float* xr = (which == 0 && l == 0) ? (row < 4096 ? p.IN(0) + (size_t)row * 1024 : p.IN(1) + (size_t)(row - 4096) * 1024) : p.out + (size_t)row * 1024;
        f32x4 v[4]; float ss = 0.f;
#pragma unroll
        for (int j = 0; j < 4; ++j) { v[j] = ((const f32x4*)xr)[lane + 64 * j]; ss += (v[j].x * v[j].x + v[j].y * v[j].y) + (v[j].z * v[j].z + v[j].w * v[j].w); }
#pragma unroll
        for (int o = 1; o < 64; o <<= 1) ss += shx(ss, lane, o);
        const float rstd = rsqrtf(ss * (1.f / 1024.f) + 1e-6f);
        if (which == 2) {
            float* yo = p.out + (size_t)row * 1024;
#pragma unroll
            for (int j = 0; j < 4; ++j) ((f32x4*)yo)[lane + 64 * j] = v[j] * rstd * gv[j];
        } else {
            const float* mr = mod + (size_t)(l * 5 + modrow_of(row)) * 6144 + (which == 0 ? 0 : 3072);
#pragma unroll
            for (int j = 0; j < 4; ++j) { const f32x4 sh = ((const f32x4*)mr)[lane + 64 * j], sc = ((const f32x4*)(mr + 1024))[lane + 64 * j];
                const f32x4 hv = v[j] * rstd * gv[j] * (sc + 1.f) + sh;
                u32x2 o; o.x = pk2(hv.x, hv.y); o.y = pk2(hv.z, hv.w);
                ((u32x2*)(hm + (size_t)row * 1024))[lane + 64 * j] = o; }
        }
    }
}

template <int MIX>
DI void m1_gla_unit(const Params& p, int l, int c, int hd, LAS unsigned char* wl, int lane) {
    constexpr int DK = MIX == 0 ? 64 : 32, NT = DK / 32, PITCH = DK + 8;
    const int r = lane & 31, hh = lane >> 5, tok0 = c * 32;
    const char* proj = (const char*)(p.ws + WS_BIG);
    LAS bf16_t* Qt = (LAS bf16_t*)wl; LAS bf16_t* Kt = Qt + 32 * PITCH;
    char* DS = (char*)(p.ws + (MIX == 0 ? WS_DSA : WS_DSB));
    float* ACH = (float*)(p.ws + (MIX == 0 ? WS_ACHA : WS_ACHB));
    char* QH = (char*)(p.ws + (MIX == 0 ? WS_QHA : WS_QHB));
    float* OI = (float*)(p.ws + WS_OI);
    const unsigned voa0 = (unsigned)((tok0 + 4 * hh) * NP) * 2u, vob0 = voa0 + (unsigned)r * 2u;
    unsigned voa = voa0, vob = vob0;
#define PROWB(li) ((unsigned)((8 * ((li) >> 2) + ((li) & 3)) * NP * 2))
#define LD16(off) (*(const bf16_t*)(proj + (off)))
    const unsigned vcolb = (unsigned)((MIX == 0 ? A_I : B_V) + hd * 64) * 2u;
    bf16x8 vf[2][2];
#pragma unroll
    for (int n = 0; n < 2; ++n)
#pragma unroll
        for (int st = 0; st < 2; ++st) {
#pragma unroll
            for (int j = 0; j < 8; ++j) vf[n][st][j] = (short)LD16(vob + PROWB(8 * st + j) + vcolb + 64u * n);
            __builtin_amdgcn_sched_barrier(0);
        }
    const unsigned qcolb = (unsigned)((MIX == 0 ? A_Q : B_Q) + hd * DK) * 2u;
    f32x16 PT = zero16();
#pragma unroll 1
    for (int dir = 0; dir < 2; ++dir) {
#pragma unroll 1
        for (int m = 0; m < NT; ++m) {
            voa = voa0; vob = vob0; asm volatile("" : "+v"(voa), "+v"(vob));
            float la[16], kk[16];
            if (MIX == 0) {
                const unsigned zcolb = (unsigned)((dir == 0 ? A_FF : A_FB) + hd * 64 + 32 * m) * 2u;
                const float* lbl = p.IN(13);
                float lb = 0.f;
                if (l == 1) { const int ch = hd * 64 + 32 * m + r; const float l0 = lbl[(0 * 2 + dir) * 256 + ch], l1 = lbl[(1 * 2 + dir) * 256 + ch]; lb = 1.f / (1.f + __expf(l0 - l1)); }
#pragma unroll
                for (int li = 0; li < 16; ++li) { const float z = bf2f(LD16(vob + PROWB(li) + zcolb));
                    const float e = __expf(-z), sg = 1.f / (1.f + e), omsg = e * sg;
                    const float f = lb + (1.f - lb) * sg; kk[li] = (1.f - lb) * omsg; la[li] = __logf(fmaxf(f, 1e-20f)); }
            } else {
                const unsigned kcolb = (unsigned)(B_K + hd * 32) * 2u, acolb = (unsigned)(dir == 0 ? B_AF : B_AB) * 2u;
                float w2[16];
#pragma unroll
                for (int rho = 0; rho < 16; ++rho) w2[rho] = p.IN(15)[((l * 2 + dir) * 16 + rho) * 128 + hd * 32 + r];
                const float ba = p.IN(16)[(l * 2 + dir) * 128 + hd * 32 + r];
#pragma unroll
                for (int li = 0; li < 16; ++li) {
                    if ((li & 3) == 0 && li) __builtin_amdgcn_sched_barrier(0);
                    const u32x4 a0 = *(const u32x4*)(proj + (voa + PROWB(li) + acolb)), a1 = *(const u32x4*)(proj + (voa + PROWB(li) + acolb + 16u));
                    float w = ba;
#pragma unroll
                    for (int qd = 0; qd < 4; ++qd) { w += __uint_as_float(a0[qd] << 16) * w2[2 * qd] + __uint_as_float(a0[qd] & 0xffff0000u) * w2[2 * qd + 1];
                        w += __uint_as_float(a1[qd] << 16) * w2[8 + 2 * qd] + __uint_as_float(a1[qd] & 0xffff0000u) * w2[8 + 2 * qd + 1]; }
                    const float ls = fminf(w, 0.f) - log1pf(__expf(-fabsf(w)));
                    la[li] = ls * (1.f / 16.f);
                    kk[li] = bf2f(LD16(vob + PROWB(li) + kcolb));
                }
            }
            float gs[4], pgs[4];
#pragma unroll
            for (int g = 0; g < 4; ++g) { gs[g] = (la[4 * g] + la[4 * g + 1]) + (la[4 * g + 2] + la[4 * g + 3]); pgs[g] = shx(gs[g], lane, 32); }
            float run = 0.f, half = 0.f; float cum[16];
#pragma unroll
            for (int g = 0; g < 4; ++g) { float b = run + (hh ? pgs[g] : 0.f); run += gs[g] + pgs[g]; if (g == 1) half = run;
#pragma unroll
                for (int i = 0; i < 4; ++i) { b += la[4 * g + i]; cum[4 * g + i] = b; } }
            const float total = run;
            const float ref = dir == 0 ? half : total - half;
            float kh[16];
            const unsigned qhb = MIX == 0 ? (unsigned)((tok0 + 4 * hh) * 512 + dir * 256 + hd * 64 + 32 * m + r) * 2u : (unsigned)((tok0 + 4 * hh) * 256 + dir * 128 + hd * 32 + r) * 2u;
#pragma unroll
            for (int li = 0; li < 16; ++li) {
                const float cv = dir == 0 ? cum[li] : (total - cum[li] + la[li]);
                const float eq = __expf(fminf(cv - ref, 80.f)), ek = __expf(fminf(ref - cv, 80.f));
                const int tkl = 8 * (li >> 2) + (li & 3);
                const float qv = bf2f(LD16(vob + PROWB(li) + qcolb + 64u * m)) * (MIX == 1 ? 0.17677669529663687f : 1.f);
                Qt[(tkl + 4 * hh) * PITCH + 32 * m + r] = f2bf(qv * eq);
                Kt[(tkl + 4 * hh) * PITCH + 32 * m + r] = f2bf(kk[li] * ek);
                kh[li] = kk[li] * __expf(total - cv);
                const float qh = qv * __expf(cv);
                *(bf16_t*)(QH + (qhb + (unsigned)(tkl * (MIX == 0 ? 512 : 256) * 2))) = f2bf(qh);
            }
            const bf16x8 khat0 = pack8(kh), khat1 = pack8(kh + 8);
            if (hh == 0) ACH[((c * 4 + hd) * 2 + dir) * DK + 32 * m + r] = __expf(total);
#pragma unroll
            for (int n = 0; n < 2; ++n) {
                f32x16 ds = zero16();
                ds = MFMA32(khat0, vf[n][0], ds); ds = MFMA32(khat1, vf[n][1], ds);
                const unsigned dsb = (unsigned)(((c * 4 + hd) * 2 + dir) * (DK * 64) + (32 * m + 4 * hh) * 64 + 32 * n + r) * 4u;
#pragma unroll
                for (int i = 0; i < 16; ++i) *(float*)(DS + (dsb + (unsigned)(((i & 3) + 8 * (i >> 2)) * 64 * 4))) = ds[i];
            }
        }
        __builtin_amdgcn_fence(__ATOMIC_RELEASE, "wavefront");
        __builtin_amdgcn_wave_barrier();
        f32x16 pt = zero16();
#pragma unroll
        for (int s = 0; s < DK / 16; ++s) {
            const bf16x8 kfr = *(const LAS bf16x8*)(Kt + r * PITCH + 16 * s + 8 * hh);
            const bf16x8 qfr = *(const LAS bf16x8*)(Qt + r * PITCH + 16 * s + 8 * hh);
            pt = MFMA32(kfr, qfr, pt);
        }
#pragma unroll
        for (int i = 0; i < 16; ++i) { const int srow = crow(i, hh); const bool keep = dir == 0 ? (srow <= r) : (srow >= r); PT[i] += keep ? pt[i] : 0.f; }
        __builtin_amdgcn_fence(__ATOMIC_RELEASE, "wavefront");
        __builtin_amdgcn_wave_barrier();
    }
#undef PROWB
#undef LD16
    float ptv[16];
#pragma unroll
    for (int i = 0; i < 16; ++i) ptv[i] = PT[i];
    const bf16x8 pf0 = pack8(ptv), pf1 = pack8(ptv + 8);
    float* oi = OI + (size_t)((MIX * 256 + c) * 4 + hd) * 2048;
#pragma unroll
    for (int n = 0; n < 2; ++n) {
        f32x16 ot = zero16();
        ot = MFMA32(vf[n][0], pf0, ot); ot = MFMA32(vf[n][1], pf1, ot);
#pragma unroll
        for (int g = 0; g < 4; ++g) *(f32x4*)(oi + ((n * 4 + g) * 64 + lane) * 4) = (f32x4){ot[4 * g], ot[4 * g + 1], ot[4 * g + 2], ot[4 * g + 3]};
    }
}

DI void m1_rg_unit(const Params& p, int l, int c, int nb, int lane) {
    const int r = lane & 31, hh = lane >> 5, tok0 = c * 32;
    const bf16_t* proj = (const bf16_t*)(p.ws + WS_BIG);
    int s0, s1;
    if (c < 128) { s0 = (c >> 3) * 256; s1 = s0 + 256; } else { s0 = 4096 + ((c - 128) >> 5) * 1024; s1 = s0 + 1024; }
    float* HL = (float*)(p.ws + WS_HL); float* CP = (float*)(p.ws + WS_CP);
    float* RAGA = (float*)(p.ws + WS_RAGA); float* RAGH = (float*)(p.ws + WS_RAGH);
#pragma unroll 1
    for (int dir = 0; dir < 2; ++dir) {
        const int sgn = dir ? -1 : 1, tbase = dir ? tok0 + 31 : tok0;
        const float* cw = p.IN(18) + (size_t)(l * 2 + dir) * 4 * 256;
        const float* cb = p.IN(19) + (size_t)(l * 2 + dir) * 256;
        bf16x8 af[4];
        const int t = tbase + sgn * r;
#pragma unroll
        for (int s = 0; s < 4; ++s) {
            const int ch0 = 64 * nb + 16 * s + 8 * hh;
            float xc[8];
            { const f32x4 b0 = *(const f32x4*)(cb + ch0), b1 = *(const f32x4*)(cb + ch0 + 4);
              xc[0] = b0.x; xc[1] = b0.y; xc[2] = b0.z; xc[3] = b0.w; xc[4] = b1.x; xc[5] = b1.y; xc[6] = b1.z; xc[7] = b1.w; }
#pragma unroll
            for (int tap = 0; tap < 4; ++tap) {
                const int tt = t + sgn * (tap - 3);
                if (tt >= s0 && tt < s1) {
                    const u32x4 uu = *(const u32x4*)(proj + (size_t)tt * NP + C_X + ch0);
                    const f32x4 w0 = *(const f32x4*)(cw + tap * 256 + ch0), w1 = *(const f32x4*)(cw + tap * 256 + ch0 + 4);
                    xc[0] += w0.x * __uint_as_float(uu.x << 16); xc[1] += w0.y * __uint_as_float(uu.x & 0xffff0000u);
                    xc[2] += w0.z * __uint_as_float(uu.y << 16); xc[3] += w0.w * __uint_as_float(uu.y & 0xffff0000u);
                    xc[4] += w1.x * __uint_as_float(uu.z << 16); xc[5] += w1.y * __uint_as_float(uu.z & 0xffff0000u);
                    xc[6] += w1.z * __uint_as_float(uu.w << 16); xc[7] += w1.w * __uint_as_float(uu.w & 0xffff0000u);
                }
            }
            af[s] = pack8(xc);
        }
        const float* wr_ = p.IN(20) + (size_t)((l * 2 + dir) * 4 + nb) * 4096;
        const float* wi_ = p.IN(22) + (size_t)((l * 2 + dir) * 4 + nb) * 4096;
#pragma unroll 1
        for (int n = 0; n < 2; ++n) {
            f32x16 rr = zero16(), ri = zero16();
#pragma unroll
            for (int s = 0; s < 4; ++s) {
                float br_[8], bi_[8];
#pragma unroll
                for (int j = 0; j < 8; ++j) { br_[j] = wr_[(16 * s + 8 * hh + j) * 64 + 32 * n + r]; bi_[j] = wi_[(16 * s + 8 * hh + j) * 64 + 32 * n + r]; }
                rr = MFMA32(af[s], pack8(br_), rr); ri = MFMA32(af[s], pack8(bi_), ri);
            }
            const int ch = 64 * nb + 32 * n + r;
            const float cbv = cb[ch]; float cwv[4];
#pragma unroll
            for (int tap = 0; tap < 4; ++tap) cwv[tap] = cw[tap * 256 + ch];
            const float brv = p.IN(21)[(l * 2 + dir) * 256 + ch], biv = p.IN(23)[(l * 2 + dir) * 256 + ch];
            const float lam = p.IN(24)[(l * 2 + dir) * 256 + ch];
            const float c8 = -8.f * log1pf(__expf(-lam));
            float a[16], bx[16];
#pragma unroll
            for (int li = 0; li < 16; ++li) {
                const int tg = tbase + sgn * (8 * (li >> 2) + 4 * hh + (li & 3));
                float xcv = cbv;
#pragma unroll
                for (int tap = 0; tap < 4; ++tap) { const int tt = tg + sgn * (tap - 3);
                    if (tt >= s0 && tt < s1) xcv += cwv[tap] * bf2f(proj[(size_t)tt * NP + C_X + ch]); }
                const float rv = sigmoidf_(rr[li] + brv), iv = sigmoidf_(ri[li] + biv);
                const float loga = c8 * rv;
                a[li] = __expf(loga); bx[li] = sqrtf(-expm1f(2.f * loga)) * iv * xcv;
            }
            float Ag[4], Bg[4], pA[4], pB[4];
#pragma unroll
            for (int g = 0; g < 4; ++g) { float hl = 0.f, ap = 1.f;
#pragma unroll
                for (int i = 0; i < 4; ++i) { hl = a[4 * g + i] * hl + bx[4 * g + i]; ap *= a[4 * g + i]; }
                Ag[g] = ap; Bg[g] = hl; pA[g] = shx(ap, lane, 32); pB[g] = shx(hl, lane, 32); }
            float Hrun = 0.f, Prun = 1.f;
            const bool first = (hh == 0);
#pragma unroll
            for (int g = 0; g < 4; ++g) {
                const float A0 = first ? Ag[g] : pA[g], B0 = first ? Bg[g] : pB[g];
                const float A1 = first ? pA[g] : Ag[g], B1 = first ? pB[g] : Bg[g];
                float hcur = first ? Hrun : (A0 * Hrun + B0), pcur = first ? Prun : Prun * A0;
                Hrun = A1 * (A0 * Hrun + B0) + B1; Prun = Prun * A0 * A1;
#pragma unroll
                for (int i = 0; i < 4; ++i) { hcur = a[4 * g + i] * hcur + bx[4 * g + i]; pcur *= a[4 * g + i];
                    const int tg = tbase + sgn * (8 * g + 4 * hh + i);
                    HL[((size_t)dir * NTOK + tg) * 256 + ch] = hcur; CP[((size_t)dir * NTOK + tg) * 256 + ch] = pcur; }
            }
            if (hh == 0) { RAGA[(c * 2 + dir) * 256 + ch] = Prun; RAGH[(c * 2 + dir) * 256 + ch] = Hrun; }
        }
    }
}

DI void phase_m1(const Params& p, int l, LAS unsigned char* lds, const int tid) {
    const int lane = tid & 63, wid = __builtin_amdgcn_readfirstlane(tid >> 6), gw = blockIdx.x * 8 + wid, GW = gridDim.x * 8;
    LAS unsigned char* wl = lds + wid * 16384;
    for (int u = gw; u < 3072; u += GW) {
        const int ty = u % 3, idx = u / 3, c = idx >> 2, hd = idx & 3;
        int ln = lane; asm volatile("" : "+v"(ln));
        if (ty == 0) m1_gla_unit<0>(p, l, c, hd, wl, ln);
        else if (ty == 1) m1_rg_unit(p, l, c, hd, ln);
        else m1_gla_unit<1>(p, l, c, hd, wl, ln);
    }
}

DI void phase_m2(const Params& p, int l, const int tid) {
    const int gt = blockIdx.x * 512 + tid, GT = gridDim.x * 512;
    for (int id = gt; id < 20 * 49152; id += GT) {
        const int sq = id / 49152; int rem = id % 49152;
        int mix, hd, dir, de;
        if (rem < 32768) { mix = 0; hd = rem >> 13; dir = (rem >> 12) & 1; de = rem & 4095; }
        else { rem -= 32768; mix = 1; hd = rem >> 12; dir = (rem >> 11) & 1; de = rem & 2047; }
        const int dk = mix == 0 ? 64 : 32, d = de >> 6;
        float* DS = (float*)(p.ws + (mix == 0 ? WS_DSA : WS_DSB));
        const float* ACH = (const float*)(p.ws + (mix == 0 ? WS_ACHA : WS_ACHB));
        int c0, N; float S = 0.f;
        if (sq < 16) { c0 = sq * 8; N = 8; }
        else { c0 = 128 + (sq - 16) * 32; N = 32; const int b = sq - 16;
            S = mix == 0 ? p.IN(2)[(size_t)((((b * 2 + l) * 2 + dir) * 4 + hd)) * 4096 + de] : p.IN(3)[(size_t)((((b * 2 + l) * 2 + dir) * 4 + hd)) * 2048 + de]; }
        for (int n0 = 0; n0 < N; n0 += 8) {
            float v[8], av[8];
#pragma unroll
            for (int i = 0; i < 8; ++i) { const int n = n0 + i, c = c0 + (dir == 0 ? n : N - 1 - n); const size_t ui = (size_t)((c * 4 + hd) * 2 + dir);
                v[i] = DS[ui * (dk * 64) + de]; av[i] = ACH[ui * dk + d]; }
#pragma unroll
            for (int i = 0; i < 8; ++i) { const int n = n0 + i, c = c0 + (dir == 0 ? n : N - 1 - n); const size_t ui = (size_t)((c * 4 + hd) * 2 + dir);
                DS[ui * (dk * 64) + de] = S; S = av[i] * S + v[i]; }
        }
        if (sq < 16) { const int b = sq;
            if (mix == 0) p.out[OUT_SH + (size_t)((((b * 2 + l) * 2 + dir) * 4 + hd)) * 4096 + de] = S;
            else p.out[OUT_SG + (size_t)((((b * 2 + l) * 2 + dir) * 4 + hd)) * 2048 + de] = S; }
    }
    float* RAGH = (float*)(p.ws + WS_RAGH); const float* RAGA = (const float*)(p.ws + WS_RAGA);
    for (int id = gt; id < 20 * 512; id += GT) {
        const int sq = id / 512, dir = (id >> 8) & 1, ch = id & 255;
        int c0, N; float h = 0.f;
        if (sq < 16) { c0 = sq * 8; N = 8; } else { c0 = 128 + (sq - 16) * 32; N = 32; h = p.IN(4)[((size_t)((sq - 16) * 2 + l) * 2 + dir) * 256 + ch]; }
        for (int n0 = 0; n0 < N; n0 += 8) {
            float v[8], av[8];
#pragma unroll
            for (int i = 0; i < 8; ++i) { const int n = n0 + i, c = c0 + (dir == 0 ? n : N - 1 - n); v[i] = RAGH[(c * 2 + dir) * 256 + ch]; av[i] = RAGA[(c * 2 + dir) * 256 + ch]; }
#pragma unroll
            for (int i = 0; i < 8; ++i) { const int n = n0 + i, c = c0 + (dir == 0 ? n : N - 1 - n); RAGH[(c * 2 + dir) * 256 + ch] = h; h = av[i] * h + v[i]; }
        }
        if (sq < 16) p.out[OUT_SR + ((size_t)(sq * 2 + l) * 2 + dir) * 256 + ch] = h;
    }
}

template <int MIX>
DI void m3_gla_unit(const Params& p, int l, int c, int hd, int lane) {
    constexpr int DK = MIX == 0 ? 64 : 32;
    const int r = lane & 31, hh = lane >> 5, tok0 = c * 32;
    const bf16_t* proj = (const bf16_t*)(p.ws + WS_BIG);
    const float* DS = (const float*)(p.ws + (MIX == 0 ? WS_DSA : WS_DSB));
    const bf16_t* QH = (const bf16_t*)(p.ws + (MIX == 0 ? WS_QHA : WS_QHB));
    const float* oi = (const float*)(p.ws + WS_OI) + (size_t)((MIX * 256 + c) * 4 + hd) * 2048;
    bf16_t* mix = (bf16_t*)(p.ws + WS_HM);
    f32x16 acc[2];
#pragma unroll
    for (int n = 0; n < 2; ++n)
#pragma unroll
        for (int g = 0; g < 4; ++g) { const f32x4 v = *(const f32x4*)(oi + ((n * 4 + g) * 64 + lane) * 4); acc[n][4 * g] = v.x; acc[n][4 * g + 1] = v.y; acc[n][4 * g + 2] = v.z; acc[n][4 * g + 3] = v.w; }
#pragma unroll
    for (int dir = 0; dir < 2; ++dir) {
        const float* sp = DS + (size_t)((c * 4 + hd) * 2 + dir) * (DK * 64);
#pragma unroll
        for (int s = 0; s < DK / 16; ++s) {
            const bf16x8 qf = MIX == 0 ? *(const bf16x8*)(QH + (size_t)(tok0 + r) * 512 + dir * 256 + hd * 64 + 16 * s + 8 * hh)
                                       : *(const bf16x8*)(QH + (size_t)(tok0 + r) * 256 + dir * 128 + hd * 32 + 16 * s + 8 * hh);
#pragma unroll
            for (int n = 0; n < 2; ++n) {
                float sv[8];
#pragma unroll
                for (int j = 0; j < 8; ++j) sv[j] = sp[(16 * s + 8 * hh + j) * 64 + 32 * n + r];
                acc[n] = MFMA32(pack8(sv), qf, acc[n]);
            }
        }
    }
    float ss = 0.f;
#pragma unroll
    for (int n = 0; n < 2; ++n)
#pragma unroll
        for (int i = 0; i < 16; ++i) ss += acc[n][i] * acc[n][i];
    ss += shx(ss, lane, 32);
    const float rstd = rsqrtf(ss * (1.f / 64.f) + 1e-6f);
    const float* gain = (MIX == 0 ? p.IN(14) : p.IN(17)) + l * 256 + hd * 64;
    const bf16_t* grow = proj + (size_t)(tok0 + r) * NP + (MIX == 0 ? A_G : B_G) + hd * 64;
    bf16_t* orow = mix + (size_t)(tok0 + r) * 1024 + MIX * 256 + hd * 64;
#pragma unroll
    for (int n = 0; n < 2; ++n)
#pragma unroll
        for (int g = 0; g < 4; ++g) {
            const int e = 32 * n + 8 * g + 4 * hh;
            const u32x2 gg = *(const u32x2*)(grow + e); const f32x4 gn = *(const f32x4*)(gain + e);
            const float g0 = __uint_as_float(gg.x << 16), g1 = __uint_as_float(gg.x & 0xffff0000u), g2 = __uint_as_float(gg.y << 16), g3 = __uint_as_float(gg.y & 0xffff0000u);
            u32x2 o; o.x = pk2(acc[n][4 * g] * rstd * gn.x * siluf_(g0), acc[n][4 * g + 1] * rstd * gn.y * siluf_(g1));
            o.y = pk2(acc[n][4 * g + 2] * rstd * gn.z * siluf_(g2), acc[n][4 * g + 3] * rstd * gn.w * siluf_(g3));
            *(u32x2*)(orow + e) = o;
        }
}

DI float gelu_tanh(float x) { const float u = 0.7978845608028654f * (x + 0.044715f * x * x * x); const float t = 1.f - 2.f / (__expf(2.f * u) + 1.f); return 0.5f * x * (1.f + t); }

DI void phase_m3(const Params& p, int l, const int tid) {
    const int lane = tid & 63, wid = __builtin_amdgcn_readfirstlane(tid >> 6), gw = blockIdx.x * 8 + wid, GW = gridDim.x * 8;
    for (int u = gw; u < 2048; u += GW) {
        const int ty = u & 1, idx = u >> 1, c = idx >> 2, hd = idx & 3;
        int ln = lane; asm volatile("" : "+v"(ln));
        if (ty == 0) m3_gla_unit<0>(p, l, c, hd, ln); else m3_gla_unit<1>(p, l, c, hd, ln);
    }
    const int gt = blockIdx.x * 512 + tid, GT = gridDim.x * 512;
    const bf16_t* proj = (const bf16_t*)(p.ws + WS_BIG);
    bf16_t* mix = (bf16_t*)(p.ws + WS_HM);
    const float* HL = (const float*)(p.ws + WS_HL); const float* CP = (const float*)(p.ws + WS_CP); const float* HIN = (const float*)(p.ws + WS_RAGH);
    for (int id = gt; id < NTOK * 64; id += GT) {
        const int tok = id >> 6, ch = (id & 63) * 4, c = tok >> 5;
        const f32x4 hf = *(const f32x4*)(HL + (size_t)tok * 256 + ch), hb = *(const f32x4*)(HL + ((size_t)NTOK + tok) * 256 + ch);
        const f32x4 cf = *(const f32x4*)(CP + (size_t)tok * 256 + ch), cb = *(const f32x4*)(CP + ((size_t)NTOK + tok) * 256 + ch);
        const f32x4 inf_ = *(const f32x4*)(HIN + (c * 2 + 0) * 256 + ch), inb = *(const f32x4*)(HIN + (c * 2 + 1) * 256 + ch);
        const u32x2 gg = *(const u32x2*)(proj + (size_t)tok * NP + C_G + ch);
        const f32x4 y = hf + cf * inf_ + hb + cb * inb;
        u32x2 o; o.x = pk2(y.x * gelu_tanh(__uint_as_float(gg.x << 16)), y.y * gelu_tanh(__uint_as_float(gg.x & 0xffff0000u)));
        o.y = pk2(y.z * gelu_tanh(__uint_as_float(gg.y << 16)), y.w * gelu_tanh(__uint_as_float(gg.y & 0xffff0000u)));
        *(u32x2*)(mix + (size_t)tok * 1024 + 512 + ch) = o;
    }
    const float* sw = p.IN(25) + l * 3 * 256;
    for (int id = gt; id < NTOK * 64; id += GT) {
        const int tok = id >> 6, ch = (id & 63) * 4;
        const int seg = tok < 4096 ? 256 : 64, pos = tok & (seg - 1);
        f32x4 y = {0.f, 0.f, 0.f, 0.f};
#pragma unroll
        for (int j = 0; j < 3; ++j) {
            const int pp = pos + j - 1;
            if (pp >= 0 && pp < seg) {
                const int tt = tok + j - 1;
                const u32x2 cc = *(const u32x2*)(proj + (size_t)tt * NP + D_C + ch), vv = *(const u32x2*)(proj + (size_t)tt * NP + D_V + ch);
                const f32x4 w = *(const f32x4*)(sw + j * 256 + ch);
                y.x += w.x * __uint_as_float(cc.x << 16) * __uint_as_float(vv.x << 16); y.y += w.y * __uint_as_float(cc.x & 0xffff0000u) * __uint_as_float(vv.x & 0xffff0000u);
                y.z += w.z * __uint_as_float(cc.y << 16) * __uint_as_float(vv.y << 16); y.w += w.w * __uint_as_float(cc.y & 0xffff0000u) * __uint_as_float(vv.y & 0xffff0000u);
            }
        }
        const u32x2 bb = *(const u32x2*)(proj + (size_t)tok * NP + D_B + ch);
        u32x2 o; o.x = pk2(y.x * __uint_as_float(bb.x << 16), y.y * __uint_as_float(bb.x & 0xffff0000u));
        o.y = pk2(y.z * __uint_as_float(bb.y << 16), y.w * __uint_as_float(bb.y & 0xffff0000u));
        *(u32x2*)(mix + (size_t)tok * 1024 + 768 + ch) = o;
    }
}

__global__ void __launch_bounds__(512, 2) fwd_kernel(Params pin) {
    extern __shared__ __attribute__((aligned(16))) unsigned char lds_raw[];
    LAS unsigned char* lds = (LAS unsigned char*)lds_raw;
    cg::grid_group grid = cg::this_grid();
    const int G = gridDim.x, bid = blockIdx.x;
    for (int ph = pin.ph_lo; ph < pin.ph_hi; ++ph) {
        size_t zo = 0; asm volatile("" : "+s"(zo));
        int tid = threadIdx.x; asm volatile("" : "+v"(tid));
        Params p = pin; p.ws += zo; p.out += zo; p.zo = zo;
        const float* mod = (const float*)(p.ws + WS_MOD);
        bf16_t* hm = (bf16_t*)(p.ws + WS_HM); bf16_t* big = (bf16_t*)(p.ws + WS_BIG);
        if (ph == 0) phase_p0(p, lds, tid);
        else if (ph == 19) phase_norm(p, 0, 2, tid);
        else {
            const int l = (ph - 1) / 9, s = (ph - 1) % 9;
            pg8::StaticOrder S;
            if (s == 0) phase_norm(p, l, 0, tid);
            else if (s == 1) { pg8::Gemm g{hm, (const bf16_t*)(p.ws + WS_WIN) + (size_t)l * NP * 1024, NTOK, NP, 1024}; S.init(NTOK, NP, G, bid);
                pg8::EpiBf16<0> E{big, NP}; pg8::gemm_phase(lds, g, S, E, tid); }
            else if (s == 2) phase_m1(p, l, lds, tid);
            else if (s == 3) phase_m2(p, l, tid);
            else if (s == 4) phase_m3(p, l, tid);
            else if (s == 5) { pg8::Gemm g{hm, (const bf16_t*)(p.ws + WS_WOUT) + (size_t)l * 1024 * 1024, NTOK, 1024, 1024}; S.init(NTOK, 1024, G, bid);
                pg8::EpiResid E{l == 0 ? p.IN(0) : p.out, l == 0 ? p.IN(1) - (size_t)4096 * 1024 : p.out, p.out, mod + (size_t)l * 5 * 6144 + 2048}; pg8::gemm_phase(lds, g, S, E, tid); }
            else if (s == 6) phase_norm(p, l, 1, tid);
            else if (s == 7) { pg8::Gemm g{hm, (const bf16_t*)(p.ws + WS_W1) + (size_t)l * 4096 * 1024, NTOK, DFF, 1024}; S.init(NTOK, DFF, G, bid);
                pg8::EpiBf16<1> E{big, DFF}; pg8::gemm_phase(lds, g, S, E, tid); }
            else { pg8::Gemm g{big, (const bf16_t*)(p.ws + WS_W2) + (size_t)l * 1024 * 4096, NTOK, 1024, DFF}; S.init(NTOK, 1024, G, bid);
                pg8::EpiResid E{p.out, p.out, p.out, mod + (size_t)l * 5 * 6144 + 5120}; pg8::gemm_phase(lds, g, S, E, tid); }
        }
        if (ph + 1 < pin.ph_hi) grid.sync();
    }
}

extern "C" void kernel_launch(void* const* d_in, const int* in_sizes, int n_in, void* d_out, int out_size, void* d_ws, size_t ws_size, hipStream_t stream) {
    static int grid = 0;
    if (grid == 0) {
        if (n_in != 29 || ws_size < WS_END) { fprintf(stderr, "kernel_launch: unexpected n_in %d / ws %zu\n", n_in, ws_size); grid = -1; return; }
        int dev = 0, cus = 0, per_cu = 0;
        hipGetDevice(&dev); hipDeviceGetAttribute(&cus, hipDeviceAttributeMultiprocessorCount, dev);
        if (hipFuncSetAttribute((const void*)fwd_kernel, hipFuncAttributeMaxDynamicSharedMemorySize, LDS_BYTES) != hipSuccess) { fprintf(stderr, "kernel_launch: hipFuncSetAttribute failed\n"); grid = -1; return; }
        if (hipOccupancyMaxActiveBlocksPerMultiprocessor(&per_cu, (const void*)fwd_kernel, 512, LDS_BYTES) != hipSuccess || per_cu < 1) { fprintf(stderr, "kernel_launch: occupancy query says %d\n", per_cu); per_cu = 1; }
        (void)hipGetLastError();
        grid = cus * 1;
        if (grid <= 0) grid = 256;
    }
    if (grid < 0) return;
    Params p{};
    for (int i = 0; i < 29; ++i) p.in[i] = (const float*)d_in[i];
    p.out = (float*)d_out; p.ws = (unsigned char*)d_ws;
#if MEGA
    p.ph_lo = 0; p.ph_hi = 20;
    void* args[] = {&p};
    hipError_t e = hipLaunchCooperativeKernel((const void*)fwd_kernel, dim3(grid), dim3(512), args, LDS_BYTES, stream);
    if (e != hipSuccess) fprintf(stderr, "cooperative launch failed: %s (grid %d)\n", hipGetErrorString(e), grid);
#else
    for (int ph = 0; ph < 20; ++ph) { p.ph_lo = ph; p.ph_hi = ph + 1; hipLaunchKernelGGL(fwd_kernel, dim3(grid), dim3(512), LDS_BYTES, stream, p); }
#endif
}
```

```cpp
#include <hip/hip_runtime.h>
#include <hip/hip_cooperative_groups.h>
#include <cstdio>
#include <cstdint>
namespace cg = cooperative_groups;

#ifndef MEGA
#define MEGA 1
#endif
#ifndef REPEAT_MASK
#define REPEAT_MASK 0u
#endif

#define DI __device__ __forceinline__
#define LAS __attribute__((address_space(3)))
typedef unsigned short bf16_t;
typedef short bf16x8 __attribute__((ext_vector_type(8)));
typedef float f32x4 __attribute__((ext_vector_type(4)));
typedef float f32x16 __attribute__((ext_vector_type(16)));
typedef unsigned u32x4 __attribute__((ext_vector_type(4)));
typedef unsigned u32x2 __attribute__((ext_vector_type(2)));
typedef __bf16 bf16x2_t __attribute__((ext_vector_type(2)));
typedef float f32x2_t __attribute__((ext_vector_type(2)));

constexpr int NTOK = 8192, DM = 1024, NP = 3584, DFF = 4096;
constexpr int A_Q = 0, A_I = 256, A_FF = 512, A_FB = 768, A_G = 1024, B_Q = 1280, B_K = 1408, B_V = 1536, B_G = 1792, B_AF = 2048, B_AB = 2064,
              C_X = 2080, C_G = 2336, D_B = 2592, D_C = 2848, D_V = 3104, PW = 3360;
constexpr size_t MiB = 1u << 20;
constexpr size_t WS_WIN = 0, WS_WOUT = 14 * MiB, WS_W1 = 18 * MiB, WS_W2 = 34 * MiB, WS_MOD = 50 * MiB, WS_HM = 51 * MiB, WS_BIG = 67 * MiB,
                 WS_OI = 131 * MiB, WS_DSA = 147 * MiB, WS_DSB = 179 * MiB, WS_QHA = 195 * MiB, WS_QHB = 203 * MiB, WS_HL = 207 * MiB, WS_CP = 223 * MiB,
                 WS_ACHA = 239 * MiB, WS_ACHB = 239 * MiB + 512 * 1024, WS_RAGA = 240 * MiB, WS_RAGH = 240 * MiB + 512 * 1024, WS_END = 241 * MiB;
constexpr int OUT_SH = 8388608, OUT_SG = OUT_SH + 1048576, OUT_SR = OUT_SG + 524288;
constexpr int LDS_BYTES = 147456;

struct Params { const float* in[29]; float* out; unsigned char* ws; size_t zo; int ph_lo, ph_hi;
    DI const float* IN(int i) const { return in[i] + zo; } };

DI float bf2f(bf16_t u) { return __uint_as_float(((unsigned)u) << 16); }
DI unsigned pk2(float lo, float hi) { f32x2_t v = {lo, hi}; bf16x2_t b = __builtin_convertvector(v, bf16x2_t); return __builtin_bit_cast(unsigned, b); }
DI bf16_t f2bf(float x) { return (bf16_t)(pk2(x, 0.f) & 0xffffu); }
DI bf16x8 pack8(const float* v) { u32x4 p; p.x = pk2(v[0], v[1]); p.y = pk2(v[2], v[3]); p.z = pk2(v[4], v[5]); p.w = pk2(v[6], v[7]); return __builtin_bit_cast(bf16x8, p); }
DI float sigmoidf_(float x) { return 1.f / (1.f + __expf(-x)); }
DI float siluf_(float x) { return x / (1.f + __expf(-x)); }
DI int crow(int reg, int h) { return (reg & 3) + 8 * (reg >> 2) + 4 * h; }
#define MFMA32(a, b, c) __builtin_amdgcn_mfma_f32_32x32x16_bf16((a), (b), (c), 0, 0, 0)
DI f32x16 zero16() { f32x16 z; for (int i = 0; i < 16; ++i) z[i] = 0.f; return z; }
DI float shx(float v, int lane, int m) { return __int_as_float(__builtin_amdgcn_ds_bpermute((lane ^ m) << 2, __float_as_int(v))); }
DI int modrow_of(int row) { return row < 4096 ? 0 : 1 + ((row - 4096) >> 10); }

namespace pg8 {
constexpr int BM = 256, BK = 64, HALF = 128, HTB = HALF * BK * 2, NXCD = 8, WGM = 8;
__host__ __device__ __forceinline__ int lds_byte(int r, int c) { const int st = (r >> 4) * 2 + (c >> 5), rr = r & 15, cc = c & 31, ob = rr * 64 + cc * 2; return st * 1024 + (ob ^ (((ob >> 9) & 1) << 5)); }
__host__ __device__ __forceinline__ void stage_rc(int b, int& R, int& C) { const int st = b / 1024, sb = b % 1024, swz = sb ^ (((sb >> 9) & 1) << 5); R = (st >> 1) * 16 + swz / 64; C = (st & 1) * 32 + (swz % 64) / 2; }
__host__ __device__ __forceinline__ int perm32(int rho) { const int n = rho >> 4, i = rho & 15; return 8 * (i >> 2) + 4 * n + (i & 3); }
struct Unit { int pm, pn, pk; };
struct Gemm { const bf16_t* A; const bf16_t* Bt; int M, N, K, lda; };
struct StaticOrder {
    int nM, nN, nwg, G, c, KS;
    __host__ __device__ void init(int M, int N, int G_, int c_, int KS_ = 1) { KS = KS_; nM = M / BM; nN = (N / BM) * KS; nwg = nM * nN; G = G_; c = c_; }
    __host__ __device__ bool next(int i, Unit& u) const {
        const long L = (long)i * G + c; if (L >= nwg) return false;
        int wgid = (int)L; { const int q = nwg / NXCD, r = nwg % NXCD, xcd = wgid % NXCD, off = wgid / NXCD; wgid = (xcd < r ? xcd * (q + 1) : r * (q + 1) + (xcd - r) * q) + off; }
        const int nig = WGM * nN, gid = wgid / nig, fm = gid * WGM, gsz = (nM - fm) < WGM ? (nM - fm) : WGM;
        u.pm = fm + ((wgid % nig) % gsz); const int pv = (wgid % nig) / gsz; u.pn = pv / KS; u.pk = pv % KS; return true;
    }
};
template <class Epi>
__device__ __forceinline__ void gemm_phase(LAS unsigned char* lds, const Gemm g, const StaticOrder& S, const Epi& E, const int tid) {
    const int wid = __builtin_amdgcn_readfirstlane(tid >> 6), lane = tid & 63, wr = wid >> 2, wc = wid & 3, fr = lane & 15, fq = lane >> 4;
    const int K = g.lda, nt = g.K / BK;
    unsigned voffA[2], voffB[2];
#pragma unroll
    for (int i = 0; i < 2; ++i) { int R, C; stage_rc(tid * 16 + i * 8192, R, C); const int Rb = (R & ~31) + perm32(R & 31);
        voffA[i] = (unsigned)(R * K + C) * 2u; voffB[i] = (unsigned)(Rb * K + C) * 2u; }
    const size_t kstep = (size_t)(BK * 2);
    const size_t hstep = (size_t)HALF * K * 2;
    const size_t tstep = 2 * hstep;
    const unsigned ldsw = (unsigned)wid * 1024u;
    const int aoff = lds_byte(wr * 64 + fr, fq * 8), boff = lds_byte(wc * 32 + fr, fq * 8);
#define PG8_SA(b, h) (((b) * 2 + (h)) * HTB)
#define PG8_SB(b, h) ((4 + (b) * 2 + (h)) * HTB)
#define PG8_STAGE(bufoff, gbase, voff) do { _Pragma("unroll") for (int _i = 0; _i < 2; ++_i) \
        __builtin_amdgcn_global_load_lds((const unsigned*)((const char*)(gbase) + (voff)[_i]), (LAS unsigned*)(lds + (bufoff) + ldsw + _i * 8192), 16, 0, 0); } while (0)
#define PG8_LDA(dst, b, h) do { _Pragma("unroll") for (int m = 0; m < 4; ++m) _Pragma("unroll") for (int k = 0; k < 2; ++k) dst[m][k] = *(const LAS bf16x8*)(lds + PG8_SA(b, h) + aoff + m * 2048 + k * 1024); } while (0)
#define PG8_LDB(dst, b, h) do { _Pragma("unroll") for (int n = 0; n < 2; ++n) _Pragma("unroll") for (int k = 0; k < 2; ++k) dst[n][k] = *(const LAS bf16x8*)(lds + PG8_SB(b, h) + boff + n * 2048 + k * 1024); } while (0)
#define PG8_MMA(ai, bj, At, Bt) do { __builtin_amdgcn_s_setprio(1); _Pragma("unroll") for (int m = 0; m < 4; ++m) _Pragma("unroll") for (int n = 0; n < 2; ++n) _Pragma("unroll") for (int k = 0; k < 2; ++k) \
        acc[ai][bj][m][n] = __builtin_amdgcn_mfma_f32_16x16x32_bf16(Bt[n][k], At[m][k], acc[ai][bj][m][n], 0, 0, 0); __builtin_amdgcn_s_setprio(0); } while (0)
#define PG8_WAIT_V(n) asm volatile("s_waitcnt vmcnt(" #n ")" ::: "memory")
#define PG8_WAIT_L(n) asm volatile("s_waitcnt lgkmcnt(" #n ")" ::: "memory")
#define PG8_BAR __builtin_amdgcn_s_barrier()
#define PG8_SCHED __builtin_amdgcn_sched_barrier(0)
    Unit cur, nxt; int ui = 0;
    if (!S.next(0, cur)) return;
    f32x4 acc[2][2][4][2];
#pragma unroll
    for (int a = 0; a < 2; ++a)
#pragma unroll
        for (int b = 0; b < 2; ++b)
#pragma unroll
            for (int m = 0; m < 4; ++m)
#pragma unroll
                for (int n = 0; n < 2; ++n) acc[a][b][m][n] = (f32x4){0.f, 0.f, 0.f, 0.f};
    bf16x8 At[4][2], B0[2][2], B1[2][2];
    const size_t ksplit = (size_t)g.K * 2;
    const char* cA = (const char*)g.A + (size_t)cur.pm * tstep + cur.pk * ksplit; const char* cB = (const char*)g.Bt + (size_t)cur.pn * tstep + cur.pk * ksplit;
    PG8_STAGE(PG8_SB(0, 0), cB, voffB); PG8_STAGE(PG8_SA(0, 0), cA, voffA); PG8_STAGE(PG8_SB(0, 1), cB + hstep, voffB); PG8_STAGE(PG8_SA(0, 1), cA + hstep, voffA);
    if (wr == 1) PG8_BAR;
    PG8_WAIT_V(4); PG8_BAR;
    PG8_STAGE(PG8_SB(1, 0), cB + kstep, voffB); PG8_STAGE(PG8_SA(1, 0), cA + kstep, voffA); PG8_STAGE(PG8_SB(1, 1), cB + hstep + kstep, voffB);
    PG8_WAIT_V(6); PG8_BAR;
    for (;;) {
        const bool has_next = S.next(ui + 1, nxt);
        const char* nA = has_next ? (const char*)g.A + (size_t)nxt.pm * tstep + nxt.pk * ksplit : cA; const char* nB = has_next ? (const char*)g.Bt + (size_t)nxt.pn * tstep + nxt.pk * ksplit : cB;
        for (int t = 0; t < nt; t += 2) {
            const bool last = (t == nt - 2);
            const char* a1 = cA + (size_t)(t + 1) * kstep;
            const char* a2 = last ? nA : cA + (size_t)(t + 2) * kstep; const char* b2 = last ? nB : cB + (size_t)(t + 2) * kstep;
            const char* a3 = a2 + kstep; const char* b3 = b2 + kstep;
            PG8_LDB(B0, 0, 0); PG8_SCHED; PG8_LDA(At, 0, 0); PG8_STAGE(PG8_SA(1, 1), a1 + hstep, voffA);
            PG8_WAIT_L(8); PG8_BAR; PG8_WAIT_L(0); PG8_MMA(0, 0, At, B0); PG8_BAR; PG8_SCHED;
            PG8_LDB(B1, 0, 1); PG8_STAGE(PG8_SB(0, 0), b2, voffB);
            PG8_BAR; PG8_WAIT_L(0); PG8_MMA(0, 1, At, B1); PG8_BAR;
            PG8_LDA(At, 0, 1); PG8_STAGE(PG8_SA(0, 0), a2, voffA);
            PG8_BAR; PG8_WAIT_L(0); PG8_MMA(1, 0, At, B0); PG8_BAR; PG8_SCHED;
            PG8_STAGE(PG8_SB(0, 1), b2 + hstep, voffB);
            PG8_WAIT_V(6); PG8_BAR; PG8_MMA(1, 1, At, B1); PG8_BAR;
            PG8_LDB(B0, 1, 0); PG8_SCHED; PG8_LDA(At, 1, 0); PG8_STAGE(PG8_SA(0, 1), a2 + hstep, voffA);
            PG8_WAIT_L(8); PG8_BAR; PG8_WAIT_L(0); PG8_MMA(0, 0, At, B0); PG8_BAR; PG8_SCHED;
            PG8_LDB(B1, 1, 1); PG8_STAGE(PG8_SB(1, 0), b3, voffB);
            PG8_BAR; PG8_WAIT_L(0); PG8_MMA(0, 1, At, B1); PG8_BAR;
            PG8_LDA(At, 1, 1); PG8_STAGE(PG8_SA(1, 0), a3, voffA);
            PG8_BAR; PG8_WAIT_L(0); PG8_MMA(1, 0, At, B0); PG8_BAR; PG8_SCHED;
            PG8_STAGE(PG8_SB(1, 1), b3 + hstep, voffB);
            PG8_WAIT_V(6); PG8_BAR; PG8_MMA(1, 1, At, B1); PG8_BAR;
        }
        E(acc, cur, wr, wc, fr, fq);
        if (!has_next) break;
#pragma unroll
        for (int a = 0; a < 2; ++a)
#pragma unroll
            for (int b = 0; b < 2; ++b)
#pragma unroll
                for (int m = 0; m < 4; ++m)
#pragma unroll
                    for (int n = 0; n < 2; ++n) acc[a][b][m][n] = (f32x4){0.f, 0.f, 0.f, 0.f};
        cur = nxt; cA = nA; cB = nB; ++ui;
    }
    PG8_WAIT_V(0);
    if (wr == 0) PG8_BAR;
    PG8_BAR;
#undef PG8_SA
#undef PG8_SB
#undef PG8_STAGE
#undef PG8_LDA
#undef PG8_LDB
#undef PG8_MMA
#undef PG8_WAIT_V
#undef PG8_WAIT_L
#undef PG8_BAR
#undef PG8_SCHED
}

template <int ACT> struct EpiBf16 {
    bf16_t* O; int ldc;
    __device__ __forceinline__ void operator()(const f32x4 (&acc)[2][2][4][2], const Unit& u, int wr, int wc, int fr, int fq) const {
        const int row0 = u.pm * BM + wr * 64 + fr, col0 = u.pn * BM + wc * 32 + 8 * fq;
#pragma unroll
        for (int ai = 0; ai < 2; ++ai)
#pragma unroll
            for (int m = 0; m < 4; ++m) { bf16_t* rowp = O + (size_t)(row0 + ai * HALF + m * 16) * ldc + col0;
#pragma unroll
                for (int bj = 0; bj < 2; ++bj) { f32x4 v0 = acc[ai][bj][m][0], v1 = acc[ai][bj][m][1];
                    if (ACT == 1) {
#pragma unroll
                        for (int q = 0; q < 4; ++q) { float a = fmaxf(v0[q], 0.f), b = fmaxf(v1[q], 0.f); v0[q] = a * a; v1[q] = b * b; } }
                    u32x4 w; w.x = pk2(v0[0], v0[1]); w.y = pk2(v0[2], v0[3]); w.z = pk2(v1[0], v1[1]); w.w = pk2(v1[2], v1[3]);
                    *(u32x4*)(rowp + bj * HALF) = w; } }
    }
};
struct EpiResid {
    const float* xin_lo; const float* xin_hi; float* xout; const float* gate; bf16_t* pb;
    __device__ __forceinline__ void operator()(const f32x4 (&acc)[2][2][4][2], const Unit& u, int wr, int wc, int fr, int fq) const {
        const int rowb = u.pm * BM; const float* xin = rowb < 4096 ? xin_lo : xin_hi; const float* gp = gate + modrow_of(rowb) * 6144;
        const int row0 = rowb + wr * 64 + fr, col0 = u.pn * BM + wc * 32 + 8 * fq;
        f32x4 gv[2][2];
#pragma unroll
        for (int bj = 0; bj < 2; ++bj)
#pragma unroll
            for (int n = 0; n < 2; ++n) gv[bj][n] = *(const f32x4*)(gp + col0 + bj * HALF + 4 * n);
        if (u.pk == 0) {
#pragma unroll
            for (int ai = 0; ai < 2; ++ai)
#pragma unroll
                for (int m = 0; m < 4; ++m) { const size_t ro = (size_t)(row0 + ai * HALF + m * 16) * 1024 + col0;
#pragma unroll
                    for (int bj = 0; bj < 2; ++bj)
#pragma unroll
                        for (int n = 0; n < 2; ++n) { const f32x4 xi = *(const f32x4*)(xin + ro + bj * HALF + 4 * n);
                            *(f32x4*)(xout + ro + bj * HALF + 4 * n) = xi + gv[bj][n] * acc[ai][bj][m][n]; } }
        } else {
#pragma unroll
            for (int ai = 0; ai < 2; ++ai)
#pragma unroll
                for (int m = 0; m < 4; ++m) { const size_t ro = (size_t)(row0 + ai * HALF + m * 16) * 1024 + col0;
#pragma unroll
                    for (int bj = 0; bj < 2; ++bj) { const f32x4 v0 = gv[bj][0] * acc[ai][bj][m][0], v1 = gv[bj][1] * acc[ai][bj][m][1];
                        u32x4 w; w.x = pk2(v0[0], v0[1]); w.y = pk2(v0[2], v0[3]); w.z = pk2(v1[0], v1[1]); w.w = pk2(v1[2], v1[3]);
                        *(u32x4*)(pb + ro + bj * HALF) = w; } }
        }
    }
};
}

DI void transpose_unit(const float* __restrict__ W, int K, int N, int Npad, bf16_t* WT, int unit, int lane) {
    const int nblk = Npad / 64, kb = unit / nblk, nb = unit % nblk, n = nb * 64 + lane, k0 = kb * 64;
    u32x4 o[8];
    if (n < N) {
        float v[64];
#pragma unroll
        for (int kk = 0; kk < 64; ++kk) v[kk] = W[(size_t)(k0 + kk) * N + n];
#pragma unroll
        for (int q = 0; q < 8; ++q) { o[q].x = pk2(v[8 * q], v[8 * q + 1]); o[q].y = pk2(v[8 * q + 2], v[8 * q + 3]); o[q].z = pk2(v[8 * q + 4], v[8 * q + 5]); o[q].w = pk2(v[8 * q + 6], v[8 * q + 7]); }
    } else {
#pragma unroll
        for (int q = 0; q < 8; ++q) o[q] = (u32x4){0u, 0u, 0u, 0u};
    }
    u32x4* dst = (u32x4*)(WT + (size_t)n * K + k0);
#pragma unroll
    for (int q = 0; q < 8; ++q) dst[q] = o[q];
}

DI void phase_p0(const Params& p, LAS unsigned char* lds, const int tid) {
    const int lane = tid & 63, wid = tid >> 6, G = gridDim.x, bid = blockIdx.x;
    const float* c = p.IN(5); const float* c_ctx = p.IN(6); const float* ada_w = p.IN(9); const float* ada_b = p.IN(10);
    float* mod = (float*)(p.ws + WS_MOD);
    LAS float* st = (LAS float*)lds + wid * 640;
    LAS float* red = (LAS float*)(lds + 32768);
    for (int bu = bid; bu < 192; bu += G) {
        const int l = bu / 96, cgp = bu % 96, col = cgp * 64 + lane;
        for (int i = lane; i < 640; i += 64) { const int row = i / 128, k = wid * 128 + (i % 128); const float cv = row == 0 ? c_ctx[k] : c[(row - 1) * 1024 + k]; st[i] = siluf_(cv); }
        __syncthreads();
        float acc[5] = {0.f, 0.f, 0.f, 0.f, 0.f};
        const float* W = ada_w + (size_t)l * 1024 * 6144 + (size_t)(wid * 128) * 6144 + col;
#pragma unroll 16
        for (int kk = 0; kk < 128; ++kk) { const float w = W[(size_t)kk * 6144];
#pragma unroll
            for (int row = 0; row < 5; ++row) acc[row] += st[row * 128 + kk] * w; }
#pragma unroll
        for (int row = 0; row < 5; ++row) red[(wid * 5 + row) * 64 + lane] = acc[row];
        __syncthreads();
        if (tid < 320) { const int row = tid / 64, ln = tid % 64; float s = 0.f;
#pragma unroll
            for (int w = 0; w < 8; ++w) s += red[(w * 5 + row) * 64 + ln];
            const int cc = cgp * 64 + ln; mod[(l * 5 + row) * 6144 + cc] = s + ada_b[l * 6144 + cc]; }
        __syncthreads();
    }
    const int gw = bid * 8 + wid, GW = G * 8;
    for (int u = gw; u < 6400; u += GW) {
        const int l = u / 3200; int r = u % 3200;
        if (r < 896) transpose_unit(p.IN(11) + (size_t)l * 1024 * PW, 1024, PW, NP, (bf16_t*)(p.ws + WS_WIN) + (size_t)l * NP * 1024, r, lane);
        else if (r < 1152) transpose_unit(p.IN(12) + (size_t)l * 1024 * 1024, 1024, 1024, 1024, (bf16_t*)(p.ws + WS_WOUT) + (size_t)l * 1024 * 1024, r - 896, lane);
        else if (r < 2176) transpose_unit(p.IN(26) + (size_t)l * 1024 * 4096, 1024, 4096, 4096, (bf16_t*)(p.ws + WS_W1) + (size_t)l * 4096 * 1024, r - 1152, lane);
        else transpose_unit(p.IN(27) + (size_t)l * 4096 * 1024, 4096, 1024, 1024, (bf16_t*)(p.ws + WS_W2) + (size_t)l * 1024 * 4096, r - 2176, lane);
    }
}

DI void phase_norm(const Params& p, int l, int which, const int tid) {
    const int lane = tid & 63, wid = tid >> 6, gw = blockIdx.x * 8 + wid, GW = gridDim.x * 8;
    const float* mod = (const float*)(p.ws + WS_MOD);
    bf16_t* hm = (bf16_t*)(p.ws + WS_HM);
    const float* g = which == 0 ? p.IN(7) + l * 1024 : (which == 1 ? p.IN(8) + l * 1024 : p.IN(28));
    const bool first = (which == 0 && l == 0);
    for (int row0 = gw; row0 < NTOK; row0 += 4 * GW) {
        f32x4 v[4][4]; float ss[4];
#pragma unroll
        for (int k = 0; k < 4; ++k) {
            const int row = row0 + k * GW; ss[k] = 0.f;
            if (row < NTOK) {
                const float* xr = first ? (row < 4096 ? p.IN(0) + (size_t)row * 1024 : p.IN(1) + (size_t)(row - 4096) * 1024) : p.out + (size_t)row * 1024;
#pragma unroll
                for (int j = 0; j < 4; ++j) v[k][j] = ((const f32x4*)xr)[lane + 64 * j];
                if (!first) {
                    const bf16_t* pr = (const bf16_t*)(p.ws + WS_DSA) + (size_t)row * 1024;
#pragma unroll
                    for (int j = 0; j < 4; ++j) { const u32x2 pp = ((const u32x2*)pr)[lane + 64 * j];
                        v[k][j].x += __uint_as_float(pp.x << 16); v[k][j].y += __uint_as_float(pp.x & 0xffff0000u); v[k][j].z += __uint_as_float(pp.y << 16); v[k][j].w += __uint_as_float(pp.y & 0xffff0000u); }
                }
            }
        }
#pragma unroll
        for (int k = 0; k < 4; ++k) {
            const int row = row0 + k * GW;
            if (row < NTOK) {
#pragma unroll
                for (int j = 0; j < 4; ++j) ss[k] += (v[k][j].x * v[k][j].x + v[k][j].y * v[k][j].y) + (v[k][j].z * v[k][j].z + v[k][j].w * v[k][j].w);
            }
        }
#pragma unroll
        for (int o = 1; o < 64; o <<= 1) {
#pragma unroll
            for (int k = 0; k < 4; ++k) ss[k] += shx(ss[k], lane, o);
        }
#pragma unroll
        for (int k = 0; k < 4; ++k) {
            const int row = row0 + k * GW;
            if (row < NTOK) {
                const float rstd = rsqrtf(ss[k] * (1.f / 1024.f) + 1e-6f);
                if (which == 2) {
                    float* yo = p.out + (size_t)row * 1024;
#pragma unroll
                    for (int j = 0; j < 4; ++j) { const f32x4 gv = ((const f32x4*)g)[lane + 64 * j]; ((f32x4*)yo)[lane + 64 * j] = v[k][j] * rstd * gv; }
                } else {
                    const float* mr = mod + (size_t)(l * 5 + modrow_of(row)) * 6144 + (which == 0 ? 0 : 3072);
#pragma unroll
                    for (int j = 0; j < 4; ++j) { const f32x4 gv = ((const f32x4*)g)[lane + 64 * j]; const f32x4 sh = ((const f32x4*)mr)[lane + 64 * j], sc = ((const f32x4*)(mr + 1024))[lane + 64 * j];
                        const f32x4 hv = v[k][j] * rstd * gv * (sc + 1.f) + sh;
                        u32x2 o; o.x = pk2(hv.x, hv.y); o.y = pk2(hv.z, hv.w);
                        ((u32x2*)(hm + (size_t)row * 1024))[lane + 64 * j] = o;
                        if (!first) ((f32x4*)(p.out + (size_t)row * 1024))[lane + 64 * j] = v[k][j]; }
                }
            }
        }
    }
}

template <int MIX>
DI void m1_gla_unit(const Params& p, int l, int c, int hd, LAS unsigned char* wl, int lane) {
    constexpr int DK = MIX == 0 ? 64 : 32, NT = DK / 32, PITCH = DK + 8;
    const int r = lane & 31, hh = lane >> 5, tok0 = c * 32;
    const char* proj = (const char*)(p.ws + WS_BIG);
    LAS bf16_t* Qt = (LAS bf16_t*)wl; LAS bf16_t* Kt = Qt + 32 * PITCH;
    char* DS = (char*)(p.ws + (MIX == 0 ? WS_DSA : WS_DSB));
    float* ACH = (float*)(p.ws + (MIX == 0 ? WS_ACHA : WS_ACHB));
    char* QH = (char*)(p.ws + (MIX == 0 ? WS_QHA : WS_QHB));
    float* OI = (float*)(p.ws + WS_OI);
    const unsigned voa0 = (unsigned)((tok0 + 4 * hh) * NP) * 2u, vob0 = voa0 + (unsigned)r * 2u;
    unsigned voa = voa0, vob = vob0;
#define PROWB(li) ((unsigned)((8 * ((li) >> 2) + ((li) & 3)) * NP * 2))
#define LD16(off) (*(const bf16_t*)(proj + (off)))
    const unsigned vcolb = (unsigned)((MIX == 0 ? A_I : B_V) + hd * 64) * 2u;
    bf16x8 vf[2][2];
#pragma unroll
    for (int n = 0; n < 2; ++n)
#pragma unroll
        for (int st = 0; st < 2; ++st) {
#pragma unroll
            for (int j = 0; j < 8; ++j) vf[n][st][j] = (short)LD16(vob + PROWB(8 * st + j) + vcolb + 64u * n);
            __builtin_amdgcn_sched_barrier(0);
        }
    const unsigned qcolb = (unsigned)((MIX == 0 ? A_Q : B_Q) + hd * DK) * 2u;
    f32x16 PT = zero16();
#pragma unroll 1
    for (int dir = 0; dir < 2; ++dir) {
#pragma unroll 1
        for (int m = 0; m < NT; ++m) {
            voa = voa0; vob = vob0; asm volatile("" : "+v"(voa), "+v"(vob));
            float la[16], kk[16];
            if (MIX == 0) {
                const unsigned zcolb = (unsigned)((dir == 0 ? A_FF : A_FB) + hd * 64 + 32 * m) * 2u;
                const float* lbl = p.IN(13);
                float lb = 0.f;
                if (l == 1) { const int ch = hd * 64 + 32 * m + r; const float l0 = lbl[(0 * 2 + dir) * 256 + ch], l1 = lbl[(1 * 2 + dir) * 256 + ch]; lb = 1.f / (1.f + __expf(l0 - l1)); }
#pragma unroll
                for (int li = 0; li < 16; ++li) { const float z = bf2f(LD16(vob + PROWB(li) + zcolb));
                    const float e = __expf(-z), sg = 1.f / (1.f + e), omsg = e * sg;
                    const float f = lb + (1.f - lb) * sg; kk[li] = (1.f - lb) * omsg; la[li] = __logf(fmaxf(f, 1e-20f)); }
            } else {
                const unsigned kcolb = (unsigned)(B_K + hd * 32) * 2u, acolb = (unsigned)(dir == 0 ? B_AF : B_AB) * 2u;
                float w2[16];
#pragma unroll
                for (int rho = 0; rho < 16; ++rho) w2[rho] = p.IN(15)[((l * 2 + dir) * 16 + rho) * 128 + hd * 32 + r];
                const float ba = p.IN(16)[(l * 2 + dir) * 128 + hd * 32 + r];
#pragma unroll
                for (int li = 0; li < 16; ++li) {
                    if ((li & 3) == 0 && li) __builtin_amdgcn_sched_barrier(0);
                    const u32x4 a0 = *(const u32x4*)(proj + (voa + PROWB(li) + acolb)), a1 = *(const u32x4*)(proj + (voa + PROWB(li) + acolb + 16u));
                    float w = ba;
#pragma unroll
                    for (int qd = 0; qd < 4; ++qd) { w += __uint_as_float(a0[qd] << 16) * w2[2 * qd] + __uint_as_float(a0[qd] & 0xffff0000u) * w2[2 * qd + 1];
                        w += __uint_as_float(a1[qd] << 16) * w2[8 + 2 * qd] + __uint_as_float(a1[qd] & 0xffff0000u) * w2[8 + 2 * qd + 1]; }
                    const float ls = fminf(w, 0.f) - log1pf(__expf(-fabsf(w)));
                    la[li] = ls * (1.f / 16.f);
                    kk[li] = bf2f(LD16(vob + PROWB(li) + kcolb));
                }
            }
            float gs[4], pgs[4];
#pragma unroll
            for (int g = 0; g < 4; ++g) { gs[g] = (la[4 * g] + la[4 * g + 1]) + (la[4 * g + 2] + la[4 * g + 3]); pgs[g] = shx(gs[g], lane, 32); }
            float run = 0.f, half = 0.f; float cum[16];
#pragma unroll
            for (int g = 0; g < 4; ++g) { float b = run + (hh ? pgs[g] : 0.f); run += gs[g] + pgs[g]; if (g == 1) half = run;
#pragma unroll
                for (int i = 0; i < 4; ++i) { b += la[4 * g + i]; cum[4 * g + i] = b; } }
            const float total = run;
            const float ref = dir == 0 ? half : total - half;
            float kh[16];
            const unsigned qhb = MIX == 0 ? (unsigned)((tok0 + 4 * hh) * 512 + dir * 256 + hd * 64 + 32 * m + r) * 2u : (unsigned)((tok0 + 4 * hh) * 256 + dir * 128 + hd * 32 + r) * 2u;
#pragma unroll
            for (int li = 0; li < 16; ++li) {
                const float cv = dir == 0 ? cum[li] : (total - cum[li] + la[li]);
                const float eq = __expf(fminf(cv - ref, 80.f)), ek = __expf(fminf(ref - cv, 80.f));
                const int tkl = 8 * (li >> 2) + (li & 3);
                const float qv = bf2f(LD16(vob + PROWB(li) + qcolb + 64u * m)) * (MIX == 1 ? 0.17677669529663687f : 1.f);
                Qt[(tkl + 4 * hh) * PITCH + 32 * m + r] = f2bf(qv * eq);
                Kt[(tkl + 4 * hh) * PITCH + 32 * m + r] = f2bf(kk[li] * ek);
                kh[li] = kk[li] * __expf(total - cv);
                const float qh = qv * __expf(cv);
                *(bf16_t*)(QH + (qhb + (unsigned)(tkl * (MIX == 0 ? 512 : 256) * 2))) = f2bf(qh);
            }
            const bf16x8 khat0 = pack8(kh), khat1 = pack8(kh + 8);
            if (hh == 0) ACH[((c * 4 + hd) * 2 + dir) * DK + 32 * m + r] = __expf(total);
#pragma unroll
            for (int n = 0; n < 2; ++n) {
                f32x16 ds = zero16();
                ds = MFMA32(khat0, vf[n][0], ds); ds = MFMA32(khat1, vf[n][1], ds);
                const unsigned dsb = (unsigned)(((c * 4 + hd) * 2 + dir) * (DK * 64) + (32 * m + 4 * hh) * 64 + 32 * n + r) * 4u;
#pragma unroll
                for (int i = 0; i < 16; ++i) *(float*)(DS + (dsb + (unsigned)(((i & 3) + 8 * (i >> 2)) * 64 * 4))) = ds[i];
            }
        }
        __builtin_amdgcn_fence(__ATOMIC_RELEASE, "wavefront");
        __builtin_amdgcn_wave_barrier();
        f32x16 pt = zero16();
#pragma unroll
        for (int s = 0; s < DK / 16; ++s) {
            const bf16x8 kfr = *(const LAS bf16x8*)(Kt + r * PITCH + 16 * s + 8 * hh);
            const bf16x8 qfr = *(const LAS bf16x8*)(Qt + r * PITCH + 16 * s + 8 * hh);
            pt = MFMA32(kfr, qfr, pt);
        }
#pragma unroll
        for (int i = 0; i < 16; ++i) { const int srow = crow(i, hh); const bool keep = dir == 0 ? (srow <= r) : (srow >= r); PT[i] += keep ? pt[i] : 0.f; }
        __builtin_amdgcn_fence(__ATOMIC_RELEASE, "wavefront");
        __builtin_amdgcn_wave_barrier();
    }
#undef PROWB
#undef LD16
    float ptv[16];
#pragma unroll
    for (int i = 0; i < 16; ++i) ptv[i] = PT[i];
    const bf16x8 pf0 = pack8(ptv), pf1 = pack8(ptv + 8);
    float* oi = OI + (size_t)((MIX * 256 + c) * 4 + hd) * 2048;
#pragma unroll
    for (int n = 0; n < 2; ++n) {
        f32x16 ot = zero16();
        ot = MFMA32(vf[n][0], pf0, ot); ot = MFMA32(vf[n][1], pf1, ot);
#pragma unroll
        for (int g = 0; g < 4; ++g) *(f32x4*)(oi + ((n * 4 + g) * 64 + lane) * 4) = (f32x4){ot[4 * g], ot[4 * g + 1], ot[4 * g + 2], ot[4 * g + 3]};
    }
}

DI void m1_rg_unit(const Params& p, int l, int c, int nb, int lane) {
    const int r = lane & 31, hh = lane >> 5, tok0 = c * 32;
    const bf16_t* proj = (const bf16_t*)(p.ws + WS_BIG);
    int s0, s1;
    if (c < 128) { s0 = (c >> 3) * 256; s1 = s0 + 256; } else { s0 = 4096 + ((c - 128) >> 5) * 1024; s1 = s0 + 1024; }
    float* HL = (float*)(p.ws + WS_HL); float* CP = (float*)(p.ws + WS_CP);
    float* RAGA = (float*)(p.ws + WS_RAGA); float* RAGH = (float*)(p.ws + WS_RAGH);
#pragma unroll 1
    for (int dir = 0; dir < 2; ++dir) {
        const int sgn = dir ? -1 : 1, tbase = dir ? tok0 + 31 : tok0;
        const float* cw = p.IN(18) + (size_t)(l * 2 + dir) * 4 * 256;
        const float* cb = p.IN(19) + (size_t)(l * 2 + dir) * 256;
        bf16x8 af[4];
        const int t = tbase + sgn * r;
#pragma unroll
        for (int s = 0; s < 4; ++s) {
            const int ch0 = 64 * nb + 16 * s + 8 * hh;
            float xc[8];
            { const f32x4 b0 = *(const f32x4*)(cb + ch0), b1 = *(const f32x4*)(cb + ch0 + 4);
              xc[0] = b0.x; xc[1] = b0.y; xc[2] = b0.z; xc[3] = b0.w; xc[4] = b1.x; xc[5] = b1.y; xc[6] = b1.z; xc[7] = b1.w; }
#pragma unroll
            for (int tap = 0; tap < 4; ++tap) {
                const int tt = t + sgn * (tap - 3);
                if (tt >= s0 && tt < s1) {
                    const u32x4 uu = *(const u32x4*)(proj + (size_t)tt * NP + C_X + ch0);
                    const f32x4 w0 = *(const f32x4*)(cw + tap * 256 + ch0), w1 = *(const f32x4*)(cw + tap * 256 + ch0 + 4);
                    xc[0] += w0.x * __uint_as_float(uu.x << 16); xc[1] += w0.y * __uint_as_float(uu.x & 0xffff0000u);
                    xc[2] += w0.z * __uint_as_float(uu.y << 16); xc[3] += w0.w * __uint_as_float(uu.y & 0xffff0000u);
                    xc[4] += w1.x * __uint_as_float(uu.z << 16); xc[5] += w1.y * __uint_as_float(uu.z & 0xffff0000u);
                    xc[6] += w1.z * __uint_as_float(uu.w << 16); xc[7] += w1.w * __uint_as_float(uu.w & 0xffff0000u);
                }
            }
            af[s] = pack8(xc);
        }
        const float* wr_ = p.IN(20) + (size_t)((l * 2 + dir) * 4 + nb) * 4096;
        const float* wi_ = p.IN(22) + (size_t)((l * 2 + dir) * 4 + nb) * 4096;
#pragma unroll 1
        for (int n = 0; n < 2; ++n) {
            f32x16 rr = zero16(), ri = zero16();
#pragma unroll
            for (int s = 0; s < 4; ++s) {
                float br_[8], bi_[8];
#pragma unroll
                for (int j = 0; j < 8; ++j) { br_[j] = wr_[(16 * s + 8 * hh + j) * 64 + 32 * n + r]; bi_[j] = wi_[(16 * s + 8 * hh + j) * 64 + 32 * n + r]; }
                rr = MFMA32(af[s], pack8(br_), rr); ri = MFMA32(af[s], pack8(bi_), ri);
            }
            const int ch = 64 * nb + 32 * n + r;
            const float cbv = cb[ch]; float cwv[4];
#pragma unroll
            for (int tap = 0; tap < 4; ++tap) cwv[tap] = cw[tap * 256 + ch];
            const float brv = p.IN(21)[(l * 2 + dir) * 256 + ch], biv = p.IN(23)[(l * 2 + dir) * 256 + ch];
            const float lam = p.IN(24)[(l * 2 + dir) * 256 + ch];
            const float c8 = -8.f * log1pf(__expf(-lam));
            float a[16], bx[16];
#pragma unroll
            for (int li = 0; li < 16; ++li) {
                const int tg = tbase + sgn * (8 * (li >> 2) + 4 * hh + (li & 3));
                float xcv = cbv;
#pragma unroll
                for (int tap = 0; tap < 4; ++tap) { const int tt = tg + sgn * (tap - 3);
                    if (tt >= s0 && tt < s1) xcv += cwv[tap] * bf2f(proj[(size_t)tt * NP + C_X + ch]); }
                const float rv = sigmoidf_(rr[li] + brv), iv = sigmoidf_(ri[li] + biv);
                const float loga = c8 * rv;
                a[li] = __expf(loga); bx[li] = sqrtf(-expm1f(2.f * loga)) * iv * xcv;
            }
            float Ag[4], Bg[4], pA[4], pB[4];
#pragma unroll
            for (int g = 0; g < 4; ++g) { float hl = 0.f, ap = 1.f;
#pragma unroll
                for (int i = 0; i < 4; ++i) { hl = a[4 * g + i] * hl + bx[4 * g + i]; ap *= a[4 * g + i]; }
                Ag[g] = ap; Bg[g] = hl; pA[g] = shx(ap, lane, 32); pB[g] = shx(hl, lane, 32); }
            float Hrun = 0.f, Prun = 1.f;
            const bool first = (hh == 0);
#pragma unroll
            for (int g = 0; g < 4; ++g) {
                const float A0 = first ? Ag[g] : pA[g], B0 = first ? Bg[g] : pB[g];
                const float A1 = first ? pA[g] : Ag[g], B1 = first ? pB[g] : Bg[g];
                float hcur = first ? Hrun : (A0 * Hrun + B0), pcur = first ? Prun : Prun * A0;
                Hrun = A1 * (A0 * Hrun + B0) + B1; Prun = Prun * A0 * A1;
#pragma unroll
                for (int i = 0; i < 4; ++i) { hcur = a[4 * g + i] * hcur + bx[4 * g + i]; pcur *= a[4 * g + i];
                    const int tg = tbase + sgn * (8 * g + 4 * hh + i);
                    HL[((size_t)dir * NTOK + tg) * 256 + ch] = hcur; CP[((size_t)dir * NTOK + tg) * 256 + ch] = pcur; }
            }
            if (hh == 0) { RAGA[(c * 2 + dir) * 256 + ch] = Prun; RAGH[(c * 2 + dir) * 256 + ch] = Hrun; }
        }
    }
}

DI void phase_m1(const Params& p, int l, LAS unsigned char* lds, const int tid) {
    const int lane = tid & 63, wid = __builtin_amdgcn_readfirstlane(tid >> 6), gw = blockIdx.x * 8 + wid, GW = gridDim.x * 8;
    LAS unsigned char* wl = lds + wid * 16384;
    for (int u = gw; u < 3072; u += GW) {
        const int ty = u % 3, idx = u / 3, c = idx >> 2, hd = idx & 3;
        int ln = lane; asm volatile("" : "+v"(ln));
        if (ty == 0) m1_gla_unit<0>(p, l, c, hd, wl, ln);
        else if (ty == 1) m1_rg_unit(p, l, c, hd, ln);
        else m1_gla_unit<1>(p, l, c, hd, wl, ln);
    }
}

DI void phase_m2(const Params& p, int l, const int tid) {
    const int gt = blockIdx.x * 512 + tid, GT = gridDim.x * 512;
    for (int id = gt; id < 20 * 49152; id += GT) {
        const int sq = id / 49152; int rem = id % 49152;
        int mix, hd, dir, de;
        if (rem < 32768) { mix = 0; hd = rem >> 13; dir = (rem >> 12) & 1; de = rem & 4095; }
        else { rem -= 32768; mix = 1; hd = rem >> 12; dir = (rem >> 11) & 1; de = rem & 2047; }
        const int dk = mix == 0 ? 64 : 32, d = de >> 6;
        float* DS = (float*)(p.ws + (mix == 0 ? WS_DSA : WS_DSB));
        const float* ACH = (const float*)(p.ws + (mix == 0 ? WS_ACHA : WS_ACHB));
        int c0, N; float S = 0.f;
        if (sq < 16) { c0 = sq * 8; N = 8; }
        else { c0 = 128 + (sq - 16) * 32; N = 32; const int b = sq - 16;
            S = mix == 0 ? p.IN(2)[(size_t)((((b * 2 + l) * 2 + dir) * 4 + hd)) * 4096 + de] : p.IN(3)[(size_t)((((b * 2 + l) * 2 + dir) * 4 + hd)) * 2048 + de]; }
        for (int n0 = 0; n0 < N; n0 += 8) {
            float v[8], av[8];
#pragma unroll
            for (int i = 0; i < 8; ++i) { const int n = n0 + i, c = c0 + (dir == 0 ? n : N - 1 - n); const size_t ui = (size_t)((c * 4 + hd) * 2 + dir);
                v[i] = DS[ui * (dk * 64) + de]; av[i] = ACH[ui * dk + d]; }
#pragma unroll
            for (int i = 0; i < 8; ++i) { const int n = n0 + i, c = c0 + (dir == 0 ? n : N - 1 - n); const size_t ui = (size_t)((c * 4 + hd) * 2 + dir);
                DS[ui * (dk * 64) + de] = S; S = av[i] * S + v[i]; }
        }
        if (sq < 16) { const int b = sq;
            if (mix == 0) p.out[OUT_SH + (size_t)((((b * 2 + l) * 2 + dir) * 4 + hd)) * 4096 + de] = S;
            else p.out[OUT_SG + (size_t)((((b * 2 + l) * 2 + dir) * 4 + hd)) * 2048 + de] = S; }
    }
    float* RAGH = (float*)(p.ws + WS_RAGH); const float* RAGA = (const float*)(p.ws + WS_RAGA);
    for (int id = gt; id < 20 * 512; id += GT) {
        const int sq = id / 512, dir = (id >> 8) & 1, ch = id & 255;
        int c0, N; float h = 0.f;
        if (sq < 16) { c0 = sq * 8; N = 8; } else { c0 = 128 + (sq - 16) * 32; N = 32; h = p.IN(4)[((size_t)((sq - 16) * 2 + l) * 2 + dir) * 256 + ch]; }
        for (int n0 = 0; n0 < N; n0 += 8) {
            float v[8], av[8];
#pragma unroll
            for (int i = 0; i < 8; ++i) { const int n = n0 + i, c = c0 + (dir == 0 ? n : N - 1 - n); v[i] = RAGH[(c * 2 + dir) * 256 + ch]; av[i] = RAGA[(c * 2 + dir) * 256 + ch]; }
#pragma unroll
            for (int i = 0; i < 8; ++i) { const int n = n0 + i, c = c0 + (dir == 0 ? n : N - 1 - n); RAGH[(c * 2 + dir) * 256 + ch] = h; h = av[i] * h + v[i]; }
        }
        if (sq < 16) p.out[OUT_SR + ((size_t)(sq * 2 + l) * 2 + dir) * 256 + ch] = h;
    }
}

template <int MIX>
DI void m3_gla_unit(const Params& p, int l, int c, int hd, int lane) {
    constexpr int DK = MIX == 0 ? 64 : 32;
    const int r = lane & 31, hh = lane >> 5, tok0 = c * 32;
    const bf16_t* proj = (const bf16_t*)(p.ws + WS_BIG);
    const float* DS = (const float*)(p.ws + (MIX == 0 ? WS_DSA : WS_DSB));
    const bf16_t* QH = (const bf16_t*)(p.ws + (MIX == 0 ? WS_QHA : WS_QHB));
    const float* oi = (const float*)(p.ws + WS_OI) + (size_t)((MIX * 256 + c) * 4 + hd) * 2048;
    bf16_t* mix = (bf16_t*)(p.ws + WS_HM);
    f32x16 acc[2];
#pragma unroll
    for (int n = 0; n < 2; ++n)
#pragma unroll
        for (int g = 0; g < 4; ++g) { const f32x4 v = *(const f32x4*)(oi + ((n * 4 + g) * 64 + lane) * 4); acc[n][4 * g] = v.x; acc[n][4 * g + 1] = v.y; acc[n][4 * g + 2] = v.z; acc[n][4 * g + 3] = v.w; }
#pragma unroll
    for (int dir = 0; dir < 2; ++dir) {
        const float* sp = DS + (size_t)((c * 4 + hd) * 2 + dir) * (DK * 64);
#pragma unroll
        for (int s = 0; s < DK / 16; ++s) {
            const bf16x8 qf = MIX == 0 ? *(const bf16x8*)(QH + (size_t)(tok0 + r) * 512 + dir * 256 + hd * 64 + 16 * s + 8 * hh)
                                       : *(const bf16x8*)(QH + (size_t)(tok0 + r) * 256 + dir * 128 + hd * 32 + 16 * s + 8 * hh);
#pragma unroll
            for (int n = 0; n < 2; ++n) {
                float sv[8];
#pragma unroll
                for (int j = 0; j < 8; ++j) sv[j] = sp[(16 * s + 8 * hh + j) * 64 + 32 * n + r];
                acc[n] = MFMA32(pack8(sv), qf, acc[n]);
            }
        }
    }
    float ss = 0.f;
#pragma unroll
    for (int n = 0; n < 2; ++n)
#pragma unroll
        for (int i = 0; i < 16; ++i) ss += acc[n][i] * acc[n][i];
    ss += shx(ss, lane, 32);
    const float rstd = rsqrtf(ss * (1.f / 64.f) + 1e-6f);
    const float* gain = (MIX == 0 ? p.IN(14) : p.IN(17)) + l * 256 + hd * 64;
    const bf16_t* grow = proj + (size_t)(tok0 + r) * NP + (MIX == 0 ? A_G : B_G) + hd * 64;
    bf16_t* orow = mix + (size_t)(tok0 + r) * 1024 + MIX * 256 + hd * 64;
#pragma unroll
    for (int n = 0; n < 2; ++n)
#pragma unroll
        for (int g = 0; g < 4; ++g) {
            const int e = 32 * n + 8 * g + 4 * hh;
            const u32x2 gg = *(const u32x2*)(grow + e); const f32x4 gn = *(const f32x4*)(gain + e);
            const float g0 = __uint_as_float(gg.x << 16), g1 = __uint_as_float(gg.x & 0xffff0000u), g2 = __uint_as_float(gg.y << 16), g3 = __uint_as_float(gg.y & 0xffff0000u);
            u32x2 o; o.x = pk2(acc[n][4 * g] * rstd * gn.x * siluf_(g0), acc[n][4 * g + 1] * rstd * gn.y * siluf_(g1));
            o.y = pk2(acc[n][4 * g + 2] * rstd * gn.z * siluf_(g2), acc[n][4 * g + 3] * rstd * gn.w * siluf_(g3));
            *(u32x2*)(orow + e) = o;
        }
}

DI float gelu_tanh(float x) { const float u = 0.7978845608028654f * (x + 0.044715f * x * x * x); const float t = 1.f - 2.f / (__expf(2.f * u) + 1.f); return 0.5f * x * (1.f + t); }

DI void phase_m3(const Params& p, int l, const int tid) {
    const int lane = tid & 63, wid = __builtin_amdgcn_readfirstlane(tid >> 6), gw = blockIdx.x * 8 + wid, GW = gridDim.x * 8;
    for (int u = gw; u < 2048; u += GW) {
        const int ty = u & 1, idx = u >> 1, c = idx >> 2, hd = idx & 3;
        int ln = lane; asm volatile("" : "+v"(ln));
        if (ty == 0) m3_gla_unit<0>(p, l, c, hd, ln); else m3_gla_unit<1>(p, l, c, hd, ln);
    }
    const int gt = blockIdx.x * 512 + tid, GT = gridDim.x * 512;
    const bf16_t* proj = (const bf16_t*)(p.ws + WS_BIG);
    bf16_t* mix = (bf16_t*)(p.ws + WS_HM);
    const float* HL = (const float*)(p.ws + WS_HL); const float* CP = (const float*)(p.ws + WS_CP); const float* HIN = (const float*)(p.ws + WS_RAGH);
    for (int id = gt; id < NTOK * 64; id += GT) {
        const int tok = id >> 6, ch = (id & 63) * 4, c = tok >> 5;
        const f32x4 hf = *(const f32x4*)(HL + (size_t)tok * 256 + ch), hb = *(const f32x4*)(HL + ((size_t)NTOK + tok) * 256 + ch);
        const f32x4 cf = *(const f32x4*)(CP + (size_t)tok * 256 + ch), cb = *(const f32x4*)(CP + ((size_t)NTOK + tok) * 256 + ch);
        const f32x4 inf_ = *(const f32x4*)(HIN + (c * 2 + 0) * 256 + ch), inb = *(const f32x4*)(HIN + (c * 2 + 1) * 256 + ch);
        const u32x2 gg = *(const u32x2*)(proj + (size_t)tok * NP + C_G + ch);
        const f32x4 y = hf + cf * inf_ + hb + cb * inb;
        u32x2 o; o.x = pk2(y.x * gelu_tanh(__uint_as_float(gg.x << 16)), y.y * gelu_tanh(__uint_as_float(gg.x & 0xffff0000u)));
        o.y = pk2(y.z * gelu_tanh(__uint_as_float(gg.y << 16)), y.w * gelu_tanh(__uint_as_float(gg.y & 0xffff0000u)));
        *(u32x2*)(mix + (size_t)tok * 1024 + 512 + ch) = o;
    }
    const float* sw = p.IN(25) + l * 3 * 256;
    for (int id = gt; id < NTOK * 64; id += GT) {
        const int tok = id >> 6, ch = (id & 63) * 4;
        const int seg = tok < 4096 ? 256 : 64, pos = tok & (seg - 1);
        f32x4 y = {0.f, 0.f, 0.f, 0.f};
#pragma unroll
        for (int j = 0; j < 3; ++j) {
            const int pp = pos + j - 1;
            if (pp >= 0 && pp < seg) {
                const int tt = tok + j - 1;
                const u32x2 cc = *(const u32x2*)(proj + (size_t)tt * NP + D_C + ch), vv = *(const u32x2*)(proj + (size_t)tt * NP + D_V + ch);
                const f32x4 w = *(const f32x4*)(sw + j * 256 + ch);
                y.x += w.x * __uint_as_float(cc.x << 16) * __uint_as_float(vv.x << 16); y.y += w.y * __uint_as_float(cc.x & 0xffff0000u) * __uint_as_float(vv.x & 0xffff0000u);
                y.z += w.z * __uint_as_float(cc.y << 16) * __uint_as_float(vv.y << 16); y.w += w.w * __uint_as_float(cc.y & 0xffff0000u) * __uint_as_float(vv.y & 0xffff0000u);
            }
        }
        const u32x2 bb = *(const u32x2*)(proj + (size_t)tok * NP + D_B + ch);
        u32x2 o; o.x = pk2(y.x * __uint_as_float(bb.x << 16), y.y * __uint_as_float(bb.x & 0xffff0000u));
        o.y = pk2(y.z * __uint_as_float(bb.y << 16), y.w * __uint_as_float(bb.y & 0xffff0000u));
        *(u32x2*)(mix + (size_t)tok * 1024 + 768 + ch) = o;
    }
}

__global__ void __launch_bounds__(512, 2) fwd_kernel(Params pin) {
    extern __shared__ __attribute__((aligned(16))) unsigned char lds_raw[];
    LAS unsigned char* lds = (LAS unsigned char*)lds_raw;
    cg::grid_group grid = cg::this_grid();
    const int G = gridDim.x, bid = blockIdx.x;
    for (int ph2 = 2 * pin.ph_lo; ph2 < 2 * pin.ph_hi; ++ph2) {
        const int ph = ph2 >> 1;
        if ((ph2 & 1) && !((REPEAT_MASK >> ph) & 1u)) continue;
        size_t zo = 0; asm volatile("" : "+s"(zo));
        int tid = threadIdx.x; asm volatile("" : "+v"(tid));
        Params p = pin; p.ws += zo; p.out += zo; p.zo = zo;
        const float* mod = (const float*)(p.ws + WS_MOD);
        bf16_t* hm = (bf16_t*)(p.ws + WS_HM); bf16_t* big = (bf16_t*)(p.ws + WS_BIG);
        if (ph == 0) phase_p0(p, lds, tid);
        else if (ph == 19) phase_norm(p, 0, 2, tid);
        else {
            const int l = (ph - 1) / 9, s = (ph - 1) % 9;
            pg8::StaticOrder S;
            if (s == 0) phase_norm(p, l, 0, tid);
            else if (s == 1) { pg8::Gemm g{hm, (const bf16_t*)(p.ws + WS_WIN) + (size_t)l * NP * 1024, NTOK, NP, 1024, 1024}; S.init(NTOK, NP, G, bid);
                pg8::EpiBf16<0> E{big, NP}; pg8::gemm_phase(lds, g, S, E, tid); }
            else if (s == 2) phase_m1(p, l, lds, tid);
            else if (s == 3) phase_m2(p, l, tid);
            else if (s == 4) phase_m3(p, l, tid);
            else if (s == 5) { pg8::Gemm g{hm, (const bf16_t*)(p.ws + WS_WOUT) + (size_t)l * 1024 * 1024, NTOK, 1024, 512, 1024}; S.init(NTOK, 1024, G, bid, 2);
                pg8::EpiResid E{l == 0 ? p.IN(0) : p.out, l == 0 ? p.IN(1) - (size_t)4096 * 1024 : p.out, p.out, mod + (size_t)l * 5 * 6144 + 2048, (bf16_t*)(p.ws + WS_DSA)}; pg8::gemm_phase(lds, g, S, E, tid); }
            else if (s == 6) phase_norm(p, l, 1, tid);
            else if (s == 7) { pg8::Gemm g{hm, (const bf16_t*)(p.ws + WS_W1) + (size_t)l * 4096 * 1024, NTOK, DFF, 1024, 1024}; S.init(NTOK, DFF, G, bid);
                pg8::EpiBf16<1> E{big, DFF}; pg8::gemm_phase(lds, g, S, E, tid); }
            else { pg8::Gemm g{big, (const bf16_t*)(p.ws + WS_W2) + (size_t)l * 1024 * 4096, NTOK, 1024, 2048, DFF}; S.init(NTOK, 1024, G, bid, 2);
                pg8::EpiResid E{p.out, p.out, p.out, mod + (size_t)l * 5 * 6144 + 5120, (bf16_t*)(p.ws + WS_DSA)}; pg8::gemm_phase(lds, g, S, E, tid); }
        }
        if (ph2 + 2 < 2 * pin.ph_hi || (!(ph2 & 1) && ((REPEAT_MASK >> ph) & 1u))) grid.sync();
    }
}

extern "C" void kernel_launch(void* const* d_in, const int* in_sizes, int n_in, void* d_out, int out_size, void* d_ws, size_t ws_size, hipStream_t stream) {
    static int grid = 0;
    if (grid == 0) {
        if (n_in != 29 || ws_size < WS_END) { fprintf(stderr, "kernel_launch: unexpected n_in %d / ws %zu\n", n_in, ws_size); grid = -1; return; }
        int dev = 0, cus = 0, per_cu = 0;
        hipGetDevice(&dev); hipDeviceGetAttribute(&cus, hipDeviceAttributeMultiprocessorCount, dev);
        if (hipFuncSetAttribute((const void*)fwd_kernel, hipFuncAttributeMaxDynamicSharedMemorySize, LDS_BYTES) != hipSuccess) { fprintf(stderr, "kernel_launch: hipFuncSetAttribute failed\n"); grid = -1; return; }
        if (hipOccupancyMaxActiveBlocksPerMultiprocessor(&per_cu, (const void*)fwd_kernel, 512, LDS_BYTES) != hipSuccess || per_cu < 1) { fprintf(stderr, "kernel_launch: occupancy query says %d\n", per_cu); per_cu = 1; }
        (void)hipGetLastError();
        grid = cus * 1;
        if (grid <= 0) grid = 256;
    }
    if (grid < 0) return;
    Params p{};
    for (int i = 0; i < 29; ++i) p.in[i] = (const float*)d_in[i];
    p.out = (float*)d_out; p.ws = (unsigned char*)d_ws;
#if MEGA
    p.ph_lo = 0; p.ph_hi = 20;
    void* args[] = {&p};
    hipError_t e = hipLaunchCooperativeKernel((const void*)fwd_kernel, dim3(grid), dim3(512), args, LDS_BYTES, stream);
    if (e != hipSuccess) fprintf(stderr, "cooperative launch failed: %s (grid %d)\n", hipGetErrorString(e), grid);
#else
    for (int ph = 0; ph < 20; ++ph) { p.ph_lo = ph; p.ph_hi = ph + 1; hipLaunchKernelGGL(fwd_kernel, dim3(grid), dim3(512), LDS_BYTES, stream, p); }
#endif
}
```

```cpp
#include <hip/hip_runtime.h>
#include <hip/hip_cooperative_groups.h>
#include <cstdio>
#include <cstdint>
namespace cg = cooperative_groups;

#ifndef MEGA
#define MEGA 1
#endif
#ifndef REPEAT_MASK
#define REPEAT_MASK 0u
#endif

#define DI __device__ __forceinline__
#define LAS __attribute__((address_space(3)))
typedef unsigned short bf16_t;
typedef short bf16x8 __attribute__((ext_vector_type(8)));
typedef float f32x4 __attribute__((ext_vector_type(4)));
typedef float f32x16 __attribute__((ext_vector_type(16)));
typedef unsigned u32x4 __attribute__((ext_vector_type(4)));
typedef unsigned u32x2 __attribute__((ext_vector_type(2)));
typedef __bf16 bf16x2_t __attribute__((ext_vector_type(2)));
typedef float f32x2_t __attribute__((ext_vector_type(2)));

constexpr int NTOK = 8192, DM = 1024, NP = 3584, DFF = 4096;
constexpr int A_Q = 0, A_I = 256, A_FF = 512, A_FB = 768, A_G = 1024, B_Q = 1280, B_K = 1408, B_V = 1536, B_G = 1792, B_AF = 2048, B_AB = 2064,
              C_X = 2080, C_G = 2336, D_B = 2592, D_C = 2848, D_V = 3104, PW = 3360;
constexpr size_t MiB = 1u << 20;
constexpr size_t WS_WIN = 0, WS_WOUT = 14 * MiB, WS_W1 = 18 * MiB, WS_W2 = 34 * MiB, WS_MOD = 50 * MiB, WS_HM = 51 * MiB, WS_BIG = 67 * MiB,
                 WS_OI = 131 * MiB, WS_DSA = 147 * MiB, WS_DSB = 179 * MiB, WS_QHA = 195 * MiB, WS_QHB = 203 * MiB, WS_HL = 207 * MiB, WS_CP = 223 * MiB,
                 WS_ACHA = 239 * MiB, WS_ACHB = 239 * MiB + 512 * 1024, WS_RAGA = 240 * MiB, WS_RAGH = 240 * MiB + 512 * 1024, WS_BAR = 241 * MiB, WS_END = 242 * MiB;
constexpr int OUT_SH = 8388608, OUT_SG = OUT_SH + 1048576, OUT_SR = OUT_SG + 524288;
constexpr int LDS_BYTES = 147456;

struct Params { const float* in[29]; float* out; unsigned char* ws; size_t zo; int ph_lo, ph_hi;
    DI const float* IN(int i) const { return in[i] + zo; } };

DI float bf2f(bf16_t u) { return __uint_as_float(((unsigned)u) << 16); }
DI unsigned pk2(float lo, float hi) { f32x2_t v = {lo, hi}; bf16x2_t b = __builtin_convertvector(v, bf16x2_t); return __builtin_bit_cast(unsigned, b); }
DI bf16_t f2bf(float x) { return (bf16_t)(pk2(x, 0.f) & 0xffffu); }
DI bf16x8 pack8(const float* v) { u32x4 p; p.x = pk2(v[0], v[1]); p.y = pk2(v[2], v[3]); p.z = pk2(v[4], v[5]); p.w = pk2(v[6], v[7]); return __builtin_bit_cast(bf16x8, p); }
DI float rcpf_(float x) { return __builtin_amdgcn_rcpf(x); }
DI float sigmoidf_(float x) { return rcpf_(1.f + __expf(-x)); }
DI float siluf_(float x) { return x * rcpf_(1.f + __expf(-x)); }
DI float om_exp(float x) { const float s = -x * (1.f + x * 0.5f * (1.f + x * (1.f / 3.f) * (1.f + x * 0.25f * (1.f + x * 0.2f * (1.f + x * (1.f / 6.f)))))); return x > -0.3f ? s : 1.f - __expf(x); }
DI int crow(int reg, int h) { return (reg & 3) + 8 * (reg >> 2) + 4 * h; }
#define MFMA32(a, b, c) __builtin_amdgcn_mfma_f32_32x32x16_bf16((a), (b), (c), 0, 0, 0)
DI f32x16 zero16() { f32x16 z; for (int i = 0; i < 16; ++i) z[i] = 0.f; return z; }
DI float shx(float v, int lane, int m) { return __int_as_float(__builtin_amdgcn_ds_bpermute((lane ^ m) << 2, __float_as_int(v))); }
DI int modrow_of(int row) { return row < 4096 ? 0 : 1 + ((row - 4096) >> 10); }


#define XB_TMO      128
#define XB_XCNT(j)  (256  + 64 * (j))
#define XB_XSUB(j)  (1280 + 64 * (j))
#define XB_XGEN(j)  (2304 + 64 * (j))
#define XB_TOP      3328
#define XB_TOPGEN   3392
#define XCD_BAR_WORDS 3456
#define XB_SPIN_CAP (1u << 18)
DI unsigned xb_ld(unsigned* p)              { return __hip_atomic_load(p, __ATOMIC_RELAXED, __HIP_MEMORY_SCOPE_AGENT); }
DI unsigned xb_add(unsigned* p, unsigned v) { return __hip_atomic_fetch_add(p, v, __ATOMIC_RELAXED, __HIP_MEMORY_SCOPE_AGENT); }
DI unsigned xb_xcc_id() { return (unsigned)__builtin_amdgcn_s_getreg((3 << 11) | 20) & 0xFu; }
#define XB_SPIN(cond, bar) do { unsigned _sp = 0; while (cond) { __builtin_amdgcn_s_sleep(1); \
    if ((++_sp & 255u) == 0u) { if (xb_ld(&(bar)[XB_TMO])) break; if (_sp > XB_SPIN_CAP) { atomicAdd(&(bar)[XB_TMO], 1u); break; } } } } while (0)
struct XcdBarrier { unsigned* bar; unsigned x; volatile LAS unsigned* st; };
DI XcdBarrier xcd_barrier_post(unsigned* bar, volatile LAS unsigned* st) {
    XcdBarrier b; b.bar = bar; b.x = xb_xcc_id(); b.st = st;
    if (threadIdx.x == 0) (void)xb_add(&bar[XB_XCNT(b.x)], 1u);
    return b;
}
DI void xcd_barrier_complete(unsigned* bar, unsigned x, unsigned& nloc, unsigned& nx) {
    const unsigned G = gridDim.x * gridDim.y * gridDim.z;
    unsigned sum, cnt, mine, sp = 0u;
    for (;;) {
        sum = 0u; cnt = 0u; mine = 0u;
#pragma unroll
        for (unsigned j = 0; j < 16; ++j) { const unsigned c = xb_ld(&bar[XB_XCNT(j)]); sum += c; cnt += (c > 0u) ? 1u : 0u; mine = (j == x) ? c : mine; }
        if (sum == G) break;
        __builtin_amdgcn_s_sleep(1);
        if ((++sp & 255u) == 0u) { if (xb_ld(&bar[XB_TMO])) break; if (sp > XB_SPIN_CAP) { atomicAdd(&bar[XB_TMO], 1u); break; } }
    }
    nloc = mine > 0u ? mine : 1u; nx = cnt > 0u ? cnt : 1u;
}
DI void xcd_barrier(const XcdBarrier& b) {
    asm volatile("s_waitcnt vmcnt(0)" ::: "memory");
    __syncthreads();
    if (threadIdx.x == 0) {
        unsigned* bar = b.bar;
        __builtin_amdgcn_s_waitcnt(0);
        unsigned nloc = b.st[0], nx = b.st[1];
        if (nloc == 0u) { xcd_barrier_complete(bar, b.x, nloc, nx); b.st[0] = nloc; b.st[1] = nx; }
        const unsigned old = xb_add(&bar[XB_XSUB(b.x)], 1u);
        const unsigned gen = old / nloc;
        if (old + 1u == (gen + 1u) * nloc) {
            __builtin_amdgcn_fence(__ATOMIC_RELEASE, "agent");
            asm volatile("s_waitcnt vmcnt(0)" ::: "memory");
            const unsigned og = xb_add(&bar[XB_TOP], 1u);
            const unsigned tg = og / nx;
            if (og + 1u == (tg + 1u) * nx) xb_add(&bar[XB_TOPGEN], 1u);
            else XB_SPIN(xb_ld(&bar[XB_TOPGEN]) == tg, bar);
            __builtin_amdgcn_fence(__ATOMIC_ACQUIRE, "agent");
            xb_add(&bar[XB_XGEN(b.x)], 1u);
            asm volatile("s_waitcnt vmcnt(0)" ::: "memory");
        } else {
            XB_SPIN(xb_ld(&bar[XB_XGEN(b.x)]) == gen, bar);
            __builtin_amdgcn_fence(__ATOMIC_ACQUIRE, "agent");
            asm volatile("s_waitcnt vmcnt(0)" ::: "memory");
        }
    }
    __syncthreads();
}

namespace pg8 {
constexpr int BM = 256, BK = 64, HALF = 128, HTB = HALF * BK * 2, NXCD = 8, WGM = 8;
__host__ __device__ __forceinline__ int lds_byte(int r, int c) { const int st = (r >> 4) * 2 + (c >> 5), rr = r & 15, cc = c & 31, ob = rr * 64 + cc * 2; return st * 1024 + (ob ^ (((ob >> 9) & 1) << 5)); }
__host__ __device__ __forceinline__ void stage_rc(int b, int& R, int& C) { const int st = b / 1024, sb = b % 1024, swz = sb ^ (((sb >> 9) & 1) << 5); R = (st >> 1) * 16 + swz / 64; C = (st & 1) * 32 + (swz % 64) / 2; }
__host__ __device__ __forceinline__ int perm32(int rho) { const int n = rho >> 4, i = rho & 15; return 8 * (i >> 2) + 4 * n + (i & 3); }
struct Unit { int pm, pn, pk; };
struct Gemm { const bf16_t* A; const bf16_t* Bt; int M, N, K, lda; };
struct StaticOrder {
    int nM, nN, nwg, G, c, KS;
    __host__ __device__ void init(int M, int N, int G_, int c_, int KS_ = 1) { KS = KS_; nM = M / BM; nN = (N / BM) * KS; nwg = nM * nN; G = G_; c = c_; }
    __host__ __device__ bool next(int i, Unit& u) const {
        const long L = (long)i * G + c; if (L >= nwg) return false;
        int wgid = (int)L; { const int q = nwg / NXCD, r = nwg % NXCD, xcd = wgid % NXCD, off = wgid / NXCD; wgid = (xcd < r ? xcd * (q + 1) : r * (q + 1) + (xcd - r) * q) + off; }
        const int nig = WGM * nN, gid = wgid / nig, fm = gid * WGM, gsz = (nM - fm) < WGM ? (nM - fm) : WGM;
        u.pm = fm + ((wgid % nig) % gsz); const int pv = (wgid % nig) / gsz; u.pn = pv / KS; u.pk = pv % KS; return true;
    }
};
template <class Epi>
__device__ __forceinline__ void gemm_phase(LAS unsigned char* lds, const Gemm g, const StaticOrder& S, const Epi& E, const int tid) {
    const int wid = __builtin_amdgcn_readfirstlane(tid >> 6), lane = tid & 63, wr = wid >> 2, wc = wid & 3, fr = lane & 15, fq = lane >> 4;
    const int K = g.lda, nt = g.K / BK;
    unsigned voffA[2], voffB[2];
#pragma unroll
    for (int i = 0; i < 2; ++i) { int R, C; stage_rc(tid * 16 + i * 8192, R, C); const int Rb = (R & ~31) + perm32(R & 31);
        voffA[i] = (unsigned)(R * K + C) * 2u; voffB[i] = (unsigned)(Rb * K + C) * 2u; }
    const size_t kstep = (size_t)(BK * 2);
    const size_t hstep = (size_t)HALF * K * 2;
    const size_t tstep = 2 * hstep;
    const unsigned ldsw = (unsigned)wid * 1024u;
    const int aoff = lds_byte(wr * 64 + fr, fq * 8), boff = lds_byte(wc * 32 + fr, fq * 8);
#define PG8_SA(b, h) (((b) * 2 + (h)) * HTB)
#define PG8_SB(b, h) ((4 + (b) * 2 + (h)) * HTB)
#define PG8_STAGE(bufoff, gbase, voff) do { _Pragma("unroll") for (int _i = 0; _i < 2; ++_i) \
        __builtin_amdgcn_global_load_lds((const unsigned*)((const char*)(gbase) + (voff)[_i]), (LAS unsigned*)(lds + (bufoff) + ldsw + _i * 8192), 16, 0, 0); } while (0)
#define PG8_LDA(dst, b, h) do { _Pragma("unroll") for (int m = 0; m < 4; ++m) _Pragma("unroll") for (int k = 0; k < 2; ++k) dst[m][k] = *(const LAS bf16x8*)(lds + PG8_SA(b, h) + aoff + m * 2048 + k * 1024); } while (0)
#define PG8_LDB(dst, b, h) do { _Pragma("unroll") for (int n = 0; n < 2; ++n) _Pragma("unroll") for (int k = 0; k < 2; ++k) dst[n][k] = *(const LAS bf16x8*)(lds + PG8_SB(b, h) + boff + n * 2048 + k * 1024); } while (0)
#define PG8_MMA(ai, bj, At, Bt) do { __builtin_amdgcn_s_setprio(1); _Pragma("unroll") for (int m = 0; m < 4; ++m) _Pragma("unroll") for (int n = 0; n < 2; ++n) _Pragma("unroll") for (int k = 0; k < 2; ++k) \
        acc[ai][bj][m][n] = __builtin_amdgcn_mfma_f32_16x16x32_bf16(Bt[n][k], At[m][k], acc[ai][bj][m][n], 0, 0, 0); __builtin_amdgcn_s_setprio(0); } while (0)
#define PG8_WAIT_V(n) asm volatile("s_waitcnt vmcnt(" #n ")" ::: "memory")
#define PG8_WAIT_L(n) asm volatile("s_waitcnt lgkmcnt(" #n ")" ::: "memory")
#define PG8_BAR __builtin_amdgcn_s_barrier()
#define PG8_SCHED __builtin_amdgcn_sched_barrier(0)
    Unit cur, nxt; int ui = 0;
    if (!S.next(0, cur)) return;
    f32x4 acc[2][2][4][2];
#pragma unroll
    for (int a = 0; a < 2; ++a)
#pragma unroll
        for (int b = 0; b < 2; ++b)
#pragma unroll
            for (int m = 0; m < 4; ++m)
#pragma unroll
                for (int n = 0; n < 2; ++n) acc[a][b][m][n] = (f32x4){0.f, 0.f, 0.f, 0.f};
    bf16x8 At[4][2], B0[2][2], B1[2][2];
    const size_t ksplit = (size_t)g.K * 2;
    const char* cA = (const char*)g.A + (size_t)cur.pm * tstep + cur.pk * ksplit; const char* cB = (const char*)g.Bt + (size_t)cur.pn * tstep + cur.pk * ksplit;
    PG8_STAGE(PG8_SB(0, 0), cB, voffB); PG8_STAGE(PG8_SA(0, 0), cA, voffA); PG8_STAGE(PG8_SB(0, 1), cB + hstep, voffB); PG8_STAGE(PG8_SA(0, 1), cA + hstep, voffA);
    if (wr == 1) PG8_BAR;
    PG8_WAIT_V(4); PG8_BAR;
    PG8_STAGE(PG8_SB(1, 0), cB + kstep, voffB); PG8_STAGE(PG8_SA(1, 0), cA + kstep, voffA); PG8_STAGE(PG8_SB(1, 1), cB + hstep + kstep, voffB);
    PG8_WAIT_V(6); PG8_BAR;
    for (;;) {
        const bool has_next = S.next(ui + 1, nxt);
        const char* nA = has_next ? (const char*)g.A + (size_t)nxt.pm * tstep + nxt.pk * ksplit : cA; const char* nB = has_next ? (const char*)g.Bt + (size_t)nxt.pn * tstep + nxt.pk * ksplit : cB;
        for (int t = 0; t < nt; t += 2) {
            const bool last = (t == nt - 2);
            const char* a1 = cA + (size_t)(t + 1) * kstep;
            const char* a2 = last ? nA : cA + (size_t)(t + 2) * kstep; const char* b2 = last ? nB : cB + (size_t)(t + 2) * kstep;
            const char* a3 = a2 + kstep; const char* b3 = b2 + kstep;
            PG8_LDB(B0, 0, 0); PG8_SCHED; PG8_LDA(At, 0, 0); PG8_STAGE(PG8_SA(1, 1), a1 + hstep, voffA);
            PG8_WAIT_L(8); PG8_BAR; PG8_WAIT_L(0); PG8_MMA(0, 0, At, B0); PG8_BAR; PG8_SCHED;
            PG8_LDB(B1, 0, 1); PG8_STAGE(PG8_SB(0, 0), b2, voffB);
            PG8_BAR; PG8_WAIT_L(0); PG8_MMA(0, 1, At, B1); PG8_BAR;
            PG8_LDA(At, 0, 1); PG8_STAGE(PG8_SA(0, 0), a2, voffA);
            PG8_BAR; PG8_WAIT_L(0); PG8_MMA(1, 0, At, B0); PG8_BAR; PG8_SCHED;
            PG8_STAGE(PG8_SB(0, 1), b2 + hstep, voffB);
            PG8_WAIT_V(6); PG8_BAR; PG8_MMA(1, 1, At, B1); PG8_BAR;
            PG8_LDB(B0, 1, 0); PG8_SCHED; PG8_LDA(At, 1, 0); PG8_STAGE(PG8_SA(0, 1), a2 + hstep, voffA);
            PG8_WAIT_L(8); PG8_BAR; PG8_WAIT_L(0); PG8_MMA(0, 0, At, B0); PG8_BAR; PG8_SCHED;
            PG8_LDB(B1, 1, 1); PG8_STAGE(PG8_SB(1, 0), b3, voffB);
            PG8_BAR; PG8_WAIT_L(0); PG8_MMA(0, 1, At, B1); PG8_BAR;
            PG8_LDA(At, 1, 1); PG8_STAGE(PG8_SA(1, 0), a3, voffA);
            PG8_BAR; PG8_WAIT_L(0); PG8_MMA(1, 0, At, B0); PG8_BAR; PG8_SCHED;
            PG8_STAGE(PG8_SB(1, 1), b3 + hstep, voffB);
            PG8_WAIT_V(6); PG8_BAR; PG8_MMA(1, 1, At, B1); PG8_BAR;
        }
        E(acc, cur, wr, wc, fr, fq);
        if (!has_next) break;
#pragma unroll
        for (int a = 0; a < 2; ++a)
#pragma unroll
            for (int b = 0; b < 2; ++b)
#pragma unroll
                for (int m = 0; m < 4; ++m)
#pragma unroll
                    for (int n = 0; n < 2; ++n) acc[a][b][m][n] = (f32x4){0.f, 0.f, 0.f, 0.f};
        cur = nxt; cA = nA; cB = nB; ++ui;
    }
    PG8_WAIT_V(0);
    if (wr == 0) PG8_BAR;
    PG8_BAR;
#undef PG8_SA
#undef PG8_SB
#undef PG8_STAGE
#undef PG8_LDA
#undef PG8_LDB
#undef PG8_MMA
#undef PG8_WAIT_V
#undef PG8_WAIT_L
#undef PG8_BAR
#undef PG8_SCHED
}

template <int ACT> struct EpiBf16 {
    bf16_t* O; int ldc;
    __device__ __forceinline__ void operator()(const f32x4 (&acc)[2][2][4][2], const Unit& u, int wr, int wc, int fr, int fq) const {
        const int row0 = u.pm * BM + wr * 64 + fr, col0 = u.pn * BM + wc * 32 + 8 * fq;
#pragma unroll
        for (int ai = 0; ai < 2; ++ai)
#pragma unroll
            for (int m = 0; m < 4; ++m) { bf16_t* rowp = O + (size_t)(row0 + ai * HALF + m * 16) * ldc + col0;
#pragma unroll
                for (int bj = 0; bj < 2; ++bj) { f32x4 v0 = acc[ai][bj][m][0], v1 = acc[ai][bj][m][1];
                    if (ACT == 1) {
#pragma unroll
                        for (int q = 0; q < 4; ++q) { float a = fmaxf(v0[q], 0.f), b = fmaxf(v1[q], 0.f); v0[q] = a * a; v1[q] = b * b; } }
                    u32x4 w; w.x = pk2(v0[0], v0[1]); w.y = pk2(v0[2], v0[3]); w.z = pk2(v1[0], v1[1]); w.w = pk2(v1[2], v1[3]);
                    *(u32x4*)(rowp + bj * HALF) = w; } }
    }
};
struct EpiResid {
    const float* xin_lo; const float* xin_hi; float* xout; const float* gate; bf16_t* pb;
    __device__ __forceinline__ void operator()(const f32x4 (&acc)[2][2][4][2], const Unit& u, int wr, int wc, int fr, int fq) const {
        const int rowb = u.pm * BM; const float* xin = rowb < 4096 ? xin_lo : xin_hi; const float* gp = gate + modrow_of(rowb) * 6144;
        const int row0 = rowb + wr * 64 + fr, col0 = u.pn * BM + wc * 32 + 8 * fq;
        f32x4 gv[2][2];
#pragma unroll
        for (int bj = 0; bj < 2; ++bj)
#pragma unroll
            for (int n = 0; n < 2; ++n) gv[bj][n] = *(const f32x4*)(gp + col0 + bj * HALF + 4 * n);
        if (u.pk == 0) {
#pragma unroll
            for (int ai = 0; ai < 2; ++ai)
#pragma unroll
                for (int m = 0; m < 4; ++m) { const size_t ro = (size_t)(row0 + ai * HALF + m * 16) * 1024 + col0;
#pragma unroll
                    for (int bj = 0; bj < 2; ++bj)
#pragma unroll
                        for (int n = 0; n < 2; ++n) { const f32x4 xi = *(const f32x4*)(xin + ro + bj * HALF + 4 * n);
                            *(f32x4*)(xout + ro + bj * HALF + 4 * n) = xi + gv[bj][n] * acc[ai][bj][m][n]; } }
        } else {
#pragma unroll
            for (int ai = 0; ai < 2; ++ai)
#pragma unroll
                for (int m = 0; m < 4; ++m) { const size_t ro = (size_t)(row0 + ai * HALF + m * 16) * 1024 + col0;
#pragma unroll
                    for (int bj = 0; bj < 2; ++bj) { const f32x4 v0 = gv[bj][0] * acc[ai][bj][m][0], v1 = gv[bj][1] * acc[ai][bj][m][1];
                        u32x4 w; w.x = pk2(v0[0], v0[1]); w.y = pk2(v0[2], v0[3]); w.z = pk2(v1[0], v1[1]); w.w = pk2(v1[2], v1[3]);
                        *(u32x4*)(pb + ro + bj * HALF) = w; } }
        }
    }
};
}

DI void transpose_unit(const float* __restrict__ W, int K, int N, int Npad, bf16_t* WT, int unit, int lane, LAS unsigned char* scr) {
    const int nblk = Npad / 64, kb = unit / nblk, nb = unit % nblk, n = nb * 64 + lane, k0 = kb * 64;
    u32x4 o[8];
    if (n < N) {
        float v[64];
#pragma unroll
        for (int kk = 0; kk < 64; ++kk) v[kk] = W[(size_t)(k0 + kk) * N + n];
#pragma unroll
        for (int q = 0; q < 8; ++q) { o[q].x = pk2(v[8 * q], v[8 * q + 1]); o[q].y = pk2(v[8 * q + 2], v[8 * q + 3]); o[q].z = pk2(v[8 * q + 4], v[8 * q + 5]); o[q].w = pk2(v[8 * q + 6], v[8 * q + 7]); }
    } else {
#pragma unroll
        for (int q = 0; q < 8; ++q) o[q] = (u32x4){0u, 0u, 0u, 0u};
    }
#pragma unroll
    for (int q = 0; q < 8; ++q) *(LAS u32x4*)(scr + lane * 144 + q * 16) = o[q];
    __builtin_amdgcn_fence(__ATOMIC_RELEASE, "wavefront"); __builtin_amdgcn_wave_barrier();
    const int ch = lane & 7, rb = lane >> 3;
#pragma unroll
    for (int j = 0; j < 8; ++j) { const int row = rb + 8 * j; const u32x4 w = *(const LAS u32x4*)(scr + row * 144 + ch * 16);
        *(u32x4*)(WT + (size_t)(nb * 64 + row) * K + k0 + ch * 8) = w; }
    __builtin_amdgcn_fence(__ATOMIC_RELEASE, "wavefront"); __builtin_amdgcn_wave_barrier();
}

DI void phase_p0(const Params& p, LAS unsigned char* lds, const int tid) {
    const int lane = tid & 63, wid = tid >> 6, G = gridDim.x, bid = blockIdx.x;
    const float* c = p.IN(5); const float* c_ctx = p.IN(6); const float* ada_w = p.IN(9); const float* ada_b = p.IN(10);
    float* mod = (float*)(p.ws + WS_MOD);
    LAS float* st = (LAS float*)lds + wid * 640;
    LAS float* red = (LAS float*)(lds + 32768);
    for (int bu = bid; bu < 192; bu += G) {
        const int l = bu / 96, cgp = bu % 96, col = cgp * 64 + lane;
        for (int i = lane; i < 640; i += 64) { const int row = i / 128, k = wid * 128 + (i % 128); const float cv = row == 0 ? c_ctx[k] : c[(row - 1) * 1024 + k]; st[i] = siluf_(cv); }
        __syncthreads();
        float acc[5] = {0.f, 0.f, 0.f, 0.f, 0.f};
        const float* W = ada_w + (size_t)l * 1024 * 6144 + (size_t)(wid * 128) * 6144 + col;
#pragma unroll 16
        for (int kk = 0; kk < 128; ++kk) { const float w = W[(size_t)kk * 6144];
#pragma unroll
            for (int row = 0; row < 5; ++row) acc[row] += st[row * 128 + kk] * w; }
#pragma unroll
        for (int row = 0; row < 5; ++row) red[(wid * 5 + row) * 64 + lane] = acc[row];
        __syncthreads();
        if (tid < 320) { const int row = tid / 64, ln = tid % 64; float s = 0.f;
#pragma unroll
            for (int w = 0; w < 8; ++w) s += red[(w * 5 + row) * 64 + ln];
            const int cc = cgp * 64 + ln; mod[(l * 5 + row) * 6144 + cc] = s + ada_b[l * 6144 + cc]; }
        __syncthreads();
    }
    const int gw = bid * 8 + wid, GW = G * 8;
    LAS unsigned char* scr = lds + 65536 + wid * 9216;
    for (int u = gw; u < 6400; u += GW) {
        const int l = u / 3200; int r = u % 3200;
        if (r < 896) transpose_unit(p.IN(11) + (size_t)l * 1024 * PW, 1024, PW, NP, (bf16_t*)(p.ws + WS_WIN) + (size_t)l * NP * 1024, r, lane, scr);
        else if (r < 1152) transpose_unit(p.IN(12) + (size_t)l * 1024 * 1024, 1024, 1024, 1024, (bf16_t*)(p.ws + WS_WOUT) + (size_t)l * 1024 * 1024, r - 896, lane, scr);
        else if (r < 2176) transpose_unit(p.IN(26) + (size_t)l * 1024 * 4096, 1024, 4096, 4096, (bf16_t*)(p.ws + WS_W1) + (size_t)l * 4096 * 1024, r - 1152, lane, scr);
        else transpose_unit(p.IN(27) + (size_t)l * 4096 * 1024, 4096, 1024, 1024, (bf16_t*)(p.ws + WS_W2) + (size_t)l * 1024 * 4096, r - 2176, lane, scr);
    }
}

DI void phase_norm(const Params& p, int l, int which, const int tid) {
    const int lane = tid & 63, wid = tid >> 6, gw = blockIdx.x * 8 + wid, GW = gridDim.x * 8;
    const float* mod = (const float*)(p.ws + WS_MOD);
    bf16_t* hm = (bf16_t*)(p.ws + WS_HM);
    const float* g = which == 0 ? p.IN(7) + l * 1024 : (which == 1 ? p.IN(8) + l * 1024 : p.IN(28));
    const bool first = (which == 0 && l == 0);
    for (int row0 = gw; row0 < NTOK; row0 += 4 * GW) {
        f32x4 v[4][4]; float ss[4];
#pragma unroll
        for (int k = 0; k < 4; ++k) {
            const int row = row0 + k * GW; ss[k] = 0.f;
            if (row < NTOK) {
                const float* xr = first ? (row < 4096 ? p.IN(0) + (size_t)row * 1024 : p.IN(1) + (size_t)(row - 4096) * 1024) : p.out + (size_t)row * 1024;
#pragma unroll
                for (int j = 0; j < 4; ++j) v[k][j] = ((const f32x4*)xr)[lane + 64 * j];
                if (!first) {
                    const bf16_t* pr = (const bf16_t*)(p.ws + WS_DSA) + (size_t)row * 1024;
#pragma unroll
                    for (int j = 0; j < 4; ++j) { const u32x2 pp = ((const u32x2*)pr)[lane + 64 * j];
                        v[k][j].x += __uint_as_float(pp.x << 16); v[k][j].y += __uint_as_float(pp.x & 0xffff0000u); v[k][j].z += __uint_as_float(pp.y << 16); v[k][j].w += __uint_as_float(pp.y & 0xffff0000u); }
                }
            }
        }
#pragma unroll
        for (int k = 0; k < 4; ++k) {
            const int row = row0 + k * GW;
            if (row < NTOK) {
#pragma unroll
                for (int j = 0; j < 4; ++j) ss[k] += (v[k][j].x * v[k][j].x + v[k][j].y * v[k][j].y) + (v[k][j].z * v[k][j].z + v[k][j].w * v[k][j].w);
            }
        }
#pragma unroll
        for (int o = 1; o < 64; o <<= 1) {
#pragma unroll
            for (int k = 0; k < 4; ++k) ss[k] += shx(ss[k], lane, o);
        }
#pragma unroll
        for (int k = 0; k < 4; ++k) {
            const int row = row0 + k * GW;
            if (row < NTOK) {
                const float rstd = rsqrtf(ss[k] * (1.f / 1024.f) + 1e-6f);
                if (which == 2) {
                    float* yo = p.out + (size_t)row * 1024;
#pragma unroll
                    for (int j = 0; j < 4; ++j) { const f32x4 gv = ((const f32x4*)g)[lane + 64 * j]; ((f32x4*)yo)[lane + 64 * j] = v[k][j] * rstd * gv; }
                } else {
                    const float* mr = mod + (size_t)(l * 5 + modrow_of(row)) * 6144 + (which == 0 ? 0 : 3072);
#pragma unroll
                    for (int j = 0; j < 4; ++j) { const f32x4 gv = ((const f32x4*)g)[lane + 64 * j]; const f32x4 sh = ((const f32x4*)mr)[lane + 64 * j], sc = ((const f32x4*)(mr + 1024))[lane + 64 * j];
                        const f32x4 hv = v[k][j] * rstd * gv * (sc + 1.f) + sh;
                        u32x2 o; o.x = pk2(hv.x, hv.y); o.y = pk2(hv.z, hv.w);
                        ((u32x2*)(hm + (size_t)row * 1024))[lane + 64 * j] = o;
                        if (!first) ((f32x4*)(p.out + (size_t)row * 1024))[lane + 64 * j] = v[k][j]; }
                }
            }
        }
    }
}

constexpr int M1_TILE_BYTES = 66048, M1_WL_BYTES = 9216;
template <int NCOL8, int NROWS>
DI void stage_tile(const char* proj, LAS unsigned char* tile, int row_first, int col0, int pitchB, int dstB, int s0, int s1, int tid) {
    constexpr int NCH = NCOL8 * NROWS, IT = (NCH + 511) / 512;
    u32x4 v[IT];
#pragma unroll
    for (int i = 0; i < IT; ++i) { const int id = tid + 512 * i; const int row = id / NCOL8, cc = id % NCOL8, t = row_first + row;
        v[i] = (u32x4){0u, 0u, 0u, 0u};
        if (id < NCH && t >= s0 && t < s1) v[i] = *(const u32x4*)(proj + ((size_t)t * NP + col0 + cc * 8) * 2); }
#pragma unroll
    for (int i = 0; i < IT; ++i) { const int id = tid + 512 * i; const int row = id / NCOL8, cc = id % NCOL8;
        if (id < NCH) *(LAS u32x4*)(tile + row * pitchB + dstB + cc * 16) = v[i]; }
}

template <int MIX>
DI void m1_gla_wave(const Params& p, int l, int c, int hd, int dir, const LAS unsigned char* tile, LAS unsigned char* wl, const LAS unsigned char* wlp, int lane) {
    constexpr int DK = MIX == 0 ? 64 : 32, NT = DK / 32, PITCH = DK + 8, TP = MIX == 0 ? 1032 : 552;
    const int r = lane & 31, hh = lane >> 5, tok0 = c * 32;
    const LAS bf16_t* T = (const LAS bf16_t*)tile;
    LAS bf16_t* Qt = (LAS bf16_t*)wl; LAS bf16_t* Kt = Qt + 32 * PITCH;
    char* DS = (char*)(p.ws + (MIX == 0 ? WS_DSA : WS_DSB));
    float* ACH = (float*)(p.ws + (MIX == 0 ? WS_ACHA : WS_ACHB));
    char* QH = (char*)(p.ws + (MIX == 0 ? WS_QHA : WS_QHB));
    float* OI = (float*)(p.ws + WS_OI);
    const int tba = 4 * hh * TP, tb = tba + r;
#define TROW(li) ((8 * ((li) >> 2) + ((li) & 3)) * TP)
    const int vcol = MIX == 0 ? 256 + hd * 64 : 256 + hd * 64;
    bf16x8 vf[2][2];
#pragma unroll
    for (int n = 0; n < 2; ++n)
#pragma unroll
        for (int st = 0; st < 2; ++st)
#pragma unroll
            for (int j = 0; j < 8; ++j) vf[n][st][j] = (short)T[tb + TROW(8 * st + j) + vcol + 32 * n];
    const int qcol = MIX == 0 ? hd * 64 : hd * 32;
#pragma unroll 1
    for (int m = 0; m < NT; ++m) {
        float la[16], kk[16];
        if (MIX == 0) {
            const int zcol = (dir == 0 ? 512 : 768) + hd * 64 + 32 * m;
            const float* lbl = p.IN(13);
            float lb = 0.f;
            if (l == 1) { const int ch = hd * 64 + 32 * m + r; const float l0 = lbl[(0 * 2 + dir) * 256 + ch], l1 = lbl[(1 * 2 + dir) * 256 + ch]; lb = rcpf_(1.f + __expf(l0 - l1)); }
#pragma unroll
            for (int li = 0; li < 16; ++li) { const float z = bf2f(T[tb + TROW(li) + zcol]);
                const float e = __expf(-z), sg = rcpf_(1.f + e), omsg = e * sg;
                const float f = lb + (1.f - lb) * sg; kk[li] = (1.f - lb) * omsg; la[li] = __logf(fmaxf(f, 1e-20f)); }
        } else {
            const int kcol = 128 + hd * 32, acol = 512 + dir * 16;
            float w2[16];
#pragma unroll
            for (int rho = 0; rho < 16; ++rho) w2[rho] = p.IN(15)[((l * 2 + dir) * 16 + rho) * 128 + hd * 32 + r];
            const float ba = p.IN(16)[(l * 2 + dir) * 128 + hd * 32 + r];
#pragma unroll
            for (int li = 0; li < 16; ++li) {
                const u32x4 a0 = *(const LAS u32x4*)(T + tba + TROW(li) + acol), a1 = *(const LAS u32x4*)(T + tba + TROW(li) + acol + 8);
                float w = ba;
#pragma unroll
                for (int qd = 0; qd < 4; ++qd) { w += __uint_as_float(a0[qd] << 16) * w2[2 * qd] + __uint_as_float(a0[qd] & 0xffff0000u) * w2[2 * qd + 1];
                    w += __uint_as_float(a1[qd] << 16) * w2[8 + 2 * qd] + __uint_as_float(a1[qd] & 0xffff0000u) * w2[8 + 2 * qd + 1]; }
                const float ls = fminf(w, 0.f) - __logf(1.f + __expf(-fabsf(w)));
                la[li] = ls * (1.f / 16.f);
                kk[li] = bf2f(T[tb + TROW(li) + kcol]);
            }
        }
        float gs[4], pgs[4];
#pragma unroll
        for (int g = 0; g < 4; ++g) { gs[g] = (la[4 * g] + la[4 * g + 1]) + (la[4 * g + 2] + la[4 * g + 3]); pgs[g] = shx(gs[g], lane, 32); }
        float run = 0.f, half = 0.f; float cum[16];
#pragma unroll
        for (int g = 0; g < 4; ++g) { float b = run + (hh ? pgs[g] : 0.f); run += gs[g] + pgs[g]; if (g == 1) half = run;
#pragma unroll
            for (int i = 0; i < 4; ++i) { b += la[4 * g + i]; cum[4 * g + i] = b; } }
        const float total = run;
        const float ref = dir == 0 ? half : total - half;
        float kh[16];
        const unsigned qhb = MIX == 0 ? (unsigned)((tok0 + 4 * hh) * 512 + dir * 256 + hd * 64 + 32 * m + r) * 2u : (unsigned)((tok0 + 4 * hh) * 256 + dir * 128 + hd * 32 + r) * 2u;
#pragma unroll
        for (int li = 0; li < 16; ++li) {
            const float cv = dir == 0 ? cum[li] : (total - cum[li] + la[li]);
            const float eq = __expf(fminf(cv - ref, 80.f)), ek = __expf(fminf(ref - cv, 80.f));
            const int tkl = 8 * (li >> 2) + (li & 3);
            const float qv = bf2f(T[tb + TROW(li) + qcol + 32 * m]) * (MIX == 1 ? 0.17677669529663687f : 1.f);
            Qt[(tkl + 4 * hh) * PITCH + 32 * m + r] = f2bf(qv * eq);
            Kt[(tkl + 4 * hh) * PITCH + 32 * m + r] = f2bf(kk[li] * ek);
            kh[li] = kk[li] * __expf(total - cv);
            const float qh = qv * __expf(cv);
            *(bf16_t*)(QH + (qhb + (unsigned)(tkl * (MIX == 0 ? 512 : 256) * 2))) = f2bf(qh);
        }
        const bf16x8 khat0 = pack8(kh), khat1 = pack8(kh + 8);
        if (hh == 0) ACH[((c * 4 + hd) * 2 + dir) * DK + 32 * m + r] = __expf(total);
#pragma unroll
        for (int n = 0; n < 2; ++n) {
            f32x16 ds = zero16();
            ds = MFMA32(khat0, vf[n][0], ds); ds = MFMA32(khat1, vf[n][1], ds);
            const unsigned dsb = (unsigned)(((c * 4 + hd) * 2 + dir) * (DK * 64) + (32 * m + 4 * hh) * 64 + 32 * n + r) * 4u;
#pragma unroll
            for (int i = 0; i < 16; ++i) *(float*)(DS + (dsb + (unsigned)(((i & 3) + 8 * (i >> 2)) * 64 * 4))) = ds[i];
        }
    }
#undef TROW
    __builtin_amdgcn_fence(__ATOMIC_RELEASE, "wavefront");
    __builtin_amdgcn_wave_barrier();
    f32x16 pt = zero16();
#pragma unroll
    for (int s = 0; s < DK / 16; ++s) {
        const bf16x8 kfr = *(const LAS bf16x8*)(Kt + r * PITCH + 16 * s + 8 * hh);
        const bf16x8 qfr = *(const LAS bf16x8*)(Qt + r * PITCH + 16 * s + 8 * hh);
        pt = MFMA32(kfr, qfr, pt);
    }
    __builtin_amdgcn_fence(__ATOMIC_RELEASE, "wavefront");
    __builtin_amdgcn_wave_barrier();
    LAS float* ex = (LAS float*)wl; const LAS float* exp_ = (const LAS float*)wlp;
#pragma unroll
    for (int i = 0; i < 16; ++i) { const int srow = crow(i, hh); const bool keep = dir == 0 ? (srow <= r) : (srow >= r); pt[i] = keep ? pt[i] : 0.f; ex[i * 64 + lane] = pt[i]; }
    __syncthreads();
    float ptv[16];
#pragma unroll
    for (int i = 0; i < 16; ++i) ptv[i] = pt[i] + exp_[i * 64 + lane];
    const bf16x8 pf0 = pack8(ptv), pf1 = pack8(ptv + 8);
    float* oi = OI + (size_t)((MIX * 256 + c) * 4 + hd) * 2048;
    {
        f32x16 ot = zero16();
        const bf16x8 va = dir == 0 ? vf[0][0] : vf[1][0], vb = dir == 0 ? vf[0][1] : vf[1][1];
        ot = MFMA32(va, pf0, ot); ot = MFMA32(vb, pf1, ot);
#pragma unroll
        for (int g = 0; g < 4; ++g) *(f32x4*)(oi + ((dir * 4 + g) * 64 + lane) * 4) = (f32x4){ot[4 * g], ot[4 * g + 1], ot[4 * g + 2], ot[4 * g + 3]};
    }
}

DI void m1_rg_wave(const Params& p, int l, int c, int nb, int dir, const LAS unsigned char* tile, int lane) {
    constexpr int TP = 264;
    const int r = lane & 31, hh = lane >> 5, tok0 = c * 32;
    const LAS bf16_t* T = (const LAS bf16_t*)tile;
    float* HL = (float*)(p.ws + WS_HL); float* CP = (float*)(p.ws + WS_CP);
    float* RAGA = (float*)(p.ws + WS_RAGA); float* RAGH = (float*)(p.ws + WS_RAGH);
    const int sgn = dir ? -1 : 1, lbase = dir ? 31 : 0;
    const float* cw = p.IN(18) + (size_t)(l * 2 + dir) * 4 * 256;
    const float* cb = p.IN(19) + (size_t)(l * 2 + dir) * 256;
    bf16x8 af[4];
    const int trow = lbase + sgn * r + 3;
#pragma unroll
    for (int s = 0; s < 4; ++s) {
        const int ch0 = 64 * nb + 16 * s + 8 * hh;
        float xc[8];
        { const f32x4 b0 = *(const f32x4*)(cb + ch0), b1 = *(const f32x4*)(cb + ch0 + 4);
          xc[0] = b0.x; xc[1] = b0.y; xc[2] = b0.z; xc[3] = b0.w; xc[4] = b1.x; xc[5] = b1.y; xc[6] = b1.z; xc[7] = b1.w; }
#pragma unroll
        for (int tap = 0; tap < 4; ++tap) {
            const u32x4 uu = *(const LAS u32x4*)(T + (trow + sgn * (tap - 3)) * TP + ch0);
            const f32x4 w0 = *(const f32x4*)(cw + tap * 256 + ch0), w1 = *(const f32x4*)(cw + tap * 256 + ch0 + 4);
            xc[0] += w0.x * __uint_as_float(uu.x << 16); xc[1] += w0.y * __uint_as_float(uu.x & 0xffff0000u);
            xc[2] += w0.z * __uint_as_float(uu.y << 16); xc[3] += w0.w * __uint_as_float(uu.y & 0xffff0000u);
            xc[4] += w1.x * __uint_as_float(uu.z << 16); xc[5] += w1.y * __uint_as_float(uu.z & 0xffff0000u);
            xc[6] += w1.z * __uint_as_float(uu.w << 16); xc[7] += w1.w * __uint_as_float(uu.w & 0xffff0000u);
        }
        af[s] = pack8(xc);
    }
    const float* wr_ = p.IN(20) + (size_t)((l * 2 + dir) * 4 + nb) * 4096;
    const float* wi_ = p.IN(22) + (size_t)((l * 2 + dir) * 4 + nb) * 4096;
#pragma unroll 1
    for (int n = 0; n < 2; ++n) {
        f32x16 rr = zero16(), ri = zero16();
#pragma unroll
        for (int s = 0; s < 4; ++s) {
            float br_[8], bi_[8];
#pragma unroll
            for (int j = 0; j < 8; ++j) { br_[j] = wr_[(16 * s + 8 * hh + j) * 64 + 32 * n + r]; bi_[j] = wi_[(16 * s + 8 * hh + j) * 64 + 32 * n + r]; }
            rr = MFMA32(af[s], pack8(br_), rr); ri = MFMA32(af[s], pack8(bi_), ri);
        }
        const int ch = 64 * nb + 32 * n + r;
        const float cbv = cb[ch]; float cwv[4];
#pragma unroll
        for (int tap = 0; tap < 4; ++tap) cwv[tap] = cw[tap * 256 + ch];
        const float brv = p.IN(21)[(l * 2 + dir) * 256 + ch], biv = p.IN(23)[(l * 2 + dir) * 256 + ch];
        const float lam = p.IN(24)[(l * 2 + dir) * 256 + ch];
        const float c8 = -8.f * log1pf(__expf(-lam));
        float a[16], bx[16];
#pragma unroll
        for (int li = 0; li < 16; ++li) {
            const int tr = lbase + sgn * (8 * (li >> 2) + 4 * hh + (li & 3)) + 3;
            float xcv = cbv;
#pragma unroll
            for (int tap = 0; tap < 4; ++tap) xcv += cwv[tap] * bf2f(T[(tr + sgn * (tap - 3)) * TP + ch]);
            const float rv = sigmoidf_(rr[li] + brv), iv = sigmoidf_(ri[li] + biv);
            const float loga = c8 * rv;
            a[li] = __expf(loga); bx[li] = __builtin_amdgcn_sqrtf(om_exp(2.f * loga)) * iv * xcv;
        }
        float Ag[4], Bg[4], pA[4], pB[4];
#pragma unroll
        for (int g = 0; g < 4; ++g) { float hl = 0.f, ap = 1.f;
#pragma unroll
            for (int i = 0; i < 4; ++i) { hl = a[4 * g + i] * hl + bx[4 * g + i]; ap *= a[4 * g + i]; }
            Ag[g] = ap; Bg[g] = hl; pA[g] = shx(ap, lane, 32); pB[g] = shx(hl, lane, 32); }
        float Hrun = 0.f, Prun = 1.f;
        const bool first = (hh == 0);
#pragma unroll
        for (int g = 0; g < 4; ++g) {
            const float A0 = first ? Ag[g] : pA[g], B0 = first ? Bg[g] : pB[g];
            const float A1 = first ? pA[g] : Ag[g], B1 = first ? pB[g] : Bg[g];
            float hcur = first ? Hrun : (A0 * Hrun + B0), pcur = first ? Prun : Prun * A0;
            Hrun = A1 * (A0 * Hrun + B0) + B1; Prun = Prun * A0 * A1;
#pragma unroll
            for (int i = 0; i < 4; ++i) { hcur = a[4 * g + i] * hcur + bx[4 * g + i]; pcur *= a[4 * g + i];
                const int tg = tok0 + lbase + sgn * (8 * g + 4 * hh + i);
                HL[((size_t)dir * NTOK + tg) * 256 + ch] = hcur; CP[((size_t)dir * NTOK + tg) * 256 + ch] = pcur; }
        }
        if (hh == 0) { RAGA[(c * 2 + dir) * 256 + ch] = Prun; RAGH[(c * 2 + dir) * 256 + ch] = Hrun; }
    }
}

DI void phase_m1(const Params& p, int l, LAS unsigned char* lds, const int tid) {
    const int lane = tid & 63, wid = __builtin_amdgcn_readfirstlane(tid >> 6);
    const char* proj = (const char*)(p.ws + WS_BIG);
    LAS unsigned char* tile = lds;
    LAS unsigned char* wl = lds + M1_TILE_BYTES + wid * M1_WL_BYTES;
    LAS unsigned char* wlp = lds + M1_TILE_BYTES + (wid ^ 1) * M1_WL_BYTES;
    for (int c = blockIdx.x; c < 256; c += gridDim.x) {
        int ln = lane, td = tid; asm volatile("" : "+v"(ln), "+v"(td));
        const int tok0 = c * 32;
        int s0, s1;
        if (c < 128) { s0 = (c >> 3) * 256; s1 = s0 + 256; } else { s0 = 4096 + ((c - 128) >> 5) * 1024; s1 = s0 + 1024; }
        stage_tile<128, 32>(proj, tile, tok0, 0, 2064, 0, 0, NTOK, td);
        __syncthreads();
        m1_gla_wave<0>(p, l, c, wid >> 1, wid & 1, tile, wl, wlp, ln);
        __builtin_amdgcn_sched_barrier(0); asm volatile("" : "+v"(ln), "+v"(td));
        stage_tile<64, 32>(proj, tile, tok0, B_Q, 1104, 0, 0, NTOK, td);
        stage_tile<4, 32>(proj, tile, tok0, B_AF, 1104, 1024, 0, NTOK, td);
        __syncthreads();
        m1_gla_wave<1>(p, l, c, wid >> 1, wid & 1, tile, wl, wlp, ln);
        __builtin_amdgcn_sched_barrier(0); asm volatile("" : "+v"(ln), "+v"(td));
        stage_tile<32, 38>(proj, tile, tok0 - 3, C_X, 528, 0, s0, s1, td);
        __syncthreads();
        m1_rg_wave(p, l, c, wid >> 1, wid & 1, tile, ln);
        __syncthreads();
    }
}

DI void m2_chain4(const Params& p, int l, int id4) {
    const int sq = id4 / 12288; int rem = id4 % 12288;
    int mix, hd, dir, de;
    if (rem < 8192) { mix = 0; hd = rem >> 11; dir = (rem >> 10) & 1; de = (rem & 1023) * 4; }
    else { rem -= 8192; mix = 1; hd = rem >> 10; dir = (rem >> 9) & 1; de = (rem & 511) * 4; }
    const int dk = mix == 0 ? 64 : 32, d = de >> 6;
    float* DS = (float*)(p.ws + (mix == 0 ? WS_DSA : WS_DSB));
    const float* ACH = (const float*)(p.ws + (mix == 0 ? WS_ACHA : WS_ACHB));
    float zf = 0.f; asm volatile("" : "+v"(zf));
    int c0, N; f32x4 S = {zf, zf, zf, zf};
    if (sq < 16) { c0 = sq * 8; N = 8; }
    else { c0 = 128 + (sq - 16) * 32; N = 32; const int b = sq - 16;
        S = mix == 0 ? *(const f32x4*)(p.IN(2) + (size_t)((((b * 2 + l) * 2 + dir) * 4 + hd)) * 4096 + de) : *(const f32x4*)(p.IN(3) + (size_t)((((b * 2 + l) * 2 + dir) * 4 + hd)) * 2048 + de); }
    for (int n0 = 0; n0 < N; n0 += 8) {
        f32x4 v[8]; float av[8];
#pragma unroll
        for (int i = 0; i < 8; ++i) { const int n = n0 + i, c = c0 + (dir == 0 ? n : N - 1 - n); const size_t ui = (size_t)((c * 4 + hd) * 2 + dir);
            v[i] = *(const f32x4*)(DS + ui * (dk * 64) + de); av[i] = ACH[ui * dk + d]; }
#pragma unroll
        for (int i = 0; i < 8; ++i) { const int n = n0 + i, c = c0 + (dir == 0 ? n : N - 1 - n); const size_t ui = (size_t)((c * 4 + hd) * 2 + dir);
            *(f32x4*)(DS + ui * (dk * 64) + de) = S; S = S * av[i] + v[i]; }
    }
    if (sq < 16) { const int b = sq;
        if (mix == 0) *(f32x4*)(p.out + OUT_SH + (size_t)((((b * 2 + l) * 2 + dir) * 4 + hd)) * 4096 + de) = S;
        else *(f32x4*)(p.out + OUT_SG + (size_t)((((b * 2 + l) * 2 + dir) * 4 + hd)) * 2048 + de) = S; }
}
DI void phase_m2(const Params& p, int l, const int tid) {
    const int gt = blockIdx.x * 512 + tid, GT = gridDim.x * 512;
    constexpr int NLAT = 4 * 12288, NCTX = 16 * 12288;
    if (GT >= 2 * NLAT) {
        if (gt < NLAT) m2_chain4(p, l, NCTX + gt);
        else for (int id = gt - NLAT; id < NCTX; id += GT - NLAT) m2_chain4(p, l, id);
    } else {
        for (int id = gt; id < NCTX + NLAT; id += GT) m2_chain4(p, l, id);
    }
    float* RAGH = (float*)(p.ws + WS_RAGH); const float* RAGA = (const float*)(p.ws + WS_RAGA);
    for (int id = GT - 1 - gt; id < 20 * 512; id += GT) {
        const int sq = id / 512, dir = (id >> 8) & 1, ch = id & 255;
        int c0, N; float h = 0.f;
        if (sq < 16) { c0 = sq * 8; N = 8; } else { c0 = 128 + (sq - 16) * 32; N = 32; h = p.IN(4)[((size_t)((sq - 16) * 2 + l) * 2 + dir) * 256 + ch]; }
        for (int n0 = 0; n0 < N; n0 += 8) {
            float v[8], av[8];
#pragma unroll
            for (int i = 0; i < 8; ++i) { const int n = n0 + i, c = c0 + (dir == 0 ? n : N - 1 - n); v[i] = RAGH[(c * 2 + dir) * 256 + ch]; av[i] = RAGA[(c * 2 + dir) * 256 + ch]; }
#pragma unroll
            for (int i = 0; i < 8; ++i) { const int n = n0 + i, c = c0 + (dir == 0 ? n : N - 1 - n); RAGH[(c * 2 + dir) * 256 + ch] = h; h = av[i] * h + v[i]; }
        }
        if (sq < 16) p.out[OUT_SR + ((size_t)(sq * 2 + l) * 2 + dir) * 256 + ch] = h;
    }
}

template <int MIX>
DI void m3_gla_unit(const Params& p, int l, int c, int hd, int lane) {
    constexpr int DK = MIX == 0 ? 64 : 32;
    const int r = lane & 31, hh = lane >> 5, tok0 = c * 32;
    const bf16_t* proj = (const bf16_t*)(p.ws + WS_BIG);
    const float* DS = (const float*)(p.ws + (MIX == 0 ? WS_DSA : WS_DSB));
    const bf16_t* QH = (const bf16_t*)(p.ws + (MIX == 0 ? WS_QHA : WS_QHB));
    const float* oi = (const float*)(p.ws + WS_OI) + (size_t)((MIX * 256 + c) * 4 + hd) * 2048;
    bf16_t* mix = (bf16_t*)(p.ws + WS_HM);
    f32x16 acc[2];
#pragma unroll
    for (int n = 0; n < 2; ++n)
#pragma unroll
        for (int g = 0; g < 4; ++g) { const f32x4 v = *(const f32x4*)(oi + ((n * 4 + g) * 64 + lane) * 4); acc[n][4 * g] = v.x; acc[n][4 * g + 1] = v.y; acc[n][4 * g + 2] = v.z; acc[n][4 * g + 3] = v.w; }
#pragma unroll
    for (int dir = 0; dir < 2; ++dir) {
        const float* sp = DS + (size_t)((c * 4 + hd) * 2 + dir) * (DK * 64);
#pragma unroll
        for (int s = 0; s < DK / 16; ++s) {
            const bf16x8 qf = MIX == 0 ? *(const bf16x8*)(QH + (size_t)(tok0 + r) * 512 + dir * 256 + hd * 64 + 16 * s + 8 * hh)
                                       : *(const bf16x8*)(QH + (size_t)(tok0 + r) * 256 + dir * 128 + hd * 32 + 16 * s + 8 * hh);
#pragma unroll
            for (int n = 0; n < 2; ++n) {
                float sv[8];
#pragma unroll
                for (int j = 0; j < 8; ++j) sv[j] = sp[(16 * s + 8 * hh + j) * 64 + 32 * n + r];
                acc[n] = MFMA32(pack8(sv), qf, acc[n]);
            }
        }
    }
    float ss = 0.f;
#pragma unroll
    for (int n = 0; n < 2; ++n)
#pragma unroll
        for (int i = 0; i < 16; ++i) ss += acc[n][i] * acc[n][i];
    ss += shx(ss, lane, 32);
    const float rstd = rsqrtf(ss * (1.f / 64.f) + 1e-6f);
    const float* gain = (MIX == 0 ? p.IN(14) : p.IN(17)) + l * 256 + hd * 64;
    const bf16_t* grow = proj + (size_t)(tok0 + r) * NP + (MIX == 0 ? A_G : B_G) + hd * 64;
    bf16_t* orow = mix + (size_t)(tok0 + r) * 1024 + MIX * 256 + hd * 64;
#pragma unroll
    for (int n = 0; n < 2; ++n)
#pragma unroll
        for (int g = 0; g < 4; ++g) {
            const int e = 32 * n + 8 * g + 4 * hh;
            const u32x2 gg = *(const u32x2*)(grow + e); const f32x4 gn = *(const f32x4*)(gain + e);
            const float g0 = __uint_as_float(gg.x << 16), g1 = __uint_as_float(gg.x & 0xffff0000u), g2 = __uint_as_float(gg.y << 16), g3 = __uint_as_float(gg.y & 0xffff0000u);
            u32x2 o; o.x = pk2(acc[n][4 * g] * rstd * gn.x * siluf_(g0), acc[n][4 * g + 1] * rstd * gn.y * siluf_(g1));
            o.y = pk2(acc[n][4 * g + 2] * rstd * gn.z * siluf_(g2), acc[n][4 * g + 3] * rstd * gn.w * siluf_(g3));
            *(u32x2*)(orow + e) = o;
        }
}

DI float gelu_tanh(float x) { const float u = 0.7978845608028654f * (x + 0.044715f * x * x * x); const float t = 1.f - 2.f * rcpf_(__expf(2.f * u) + 1.f); return 0.5f * x * (1.f + t); }

DI void phase_m3(const Params& p, int l, const int tid) {
    const int lane = tid & 63, wid = __builtin_amdgcn_readfirstlane(tid >> 6), gw = blockIdx.x * 8 + wid, GW = gridDim.x * 8;
    for (int u = gw; u < 2048; u += GW) {
        const int ty = u & 1, idx = u >> 1, c = idx >> 2, hd = idx & 3;
        int ln = lane; asm volatile("" : "+v"(ln));
        if (ty == 0) m3_gla_unit<0>(p, l, c, hd, ln); else m3_gla_unit<1>(p, l, c, hd, ln);
    }
    const int gt = blockIdx.x * 512 + tid, GT = gridDim.x * 512;
    const bf16_t* proj = (const bf16_t*)(p.ws + WS_BIG);
    bf16_t* mix = (bf16_t*)(p.ws + WS_HM);
    const float* HL = (const float*)(p.ws + WS_HL); const float* CP = (const float*)(p.ws + WS_CP); const float* HIN = (const float*)(p.ws + WS_RAGH);
    for (int id = gt; id < NTOK * 64; id += GT) {
        const int tok = id >> 6, ch = (id & 63) * 4, c = tok >> 5;
        const f32x4 hf = *(const f32x4*)(HL + (size_t)tok * 256 + ch), hb = *(const f32x4*)(HL + ((size_t)NTOK + tok) * 256 + ch);
        const f32x4 cf = *(const f32x4*)(CP + (size_t)tok * 256 + ch), cb = *(const f32x4*)(CP + ((size_t)NTOK + tok) * 256 + ch);
        const f32x4 inf_ = *(const f32x4*)(HIN + (c * 2 + 0) * 256 + ch), inb = *(const f32x4*)(HIN + (c * 2 + 1) * 256 + ch);
        const u32x2 gg = *(const u32x2*)(proj + (size_t)tok * NP + C_G + ch);
        const f32x4 y = hf + cf * inf_ + hb + cb * inb;
        u32x2 o; o.x = pk2(y.x * gelu_tanh(__uint_as_float(gg.x << 16)), y.y * gelu_tanh(__uint_as_float(gg.x & 0xffff0000u)));
        o.y = pk2(y.z * gelu_tanh(__uint_as_float(gg.y << 16)), y.w * gelu_tanh(__uint_as_float(gg.y & 0xffff0000u)));
        *(u32x2*)(mix + (size_t)tok * 1024 + 512 + ch) = o;
    }
    const float* sw = p.IN(25) + l * 3 * 256;
    for (int id = gt; id < NTOK * 64; id += GT) {
        const int tok = id >> 6, ch = (id & 63) * 4;
        const int seg = tok < 4096 ? 256 : 64, pos = tok & (seg - 1);
        f32x4 y = {0.f, 0.f, 0.f, 0.f};
#pragma unroll
        for (int j = 0; j < 3; ++j) {
            const int pp = pos + j - 1;
            if (pp >= 0 && pp < seg) {
                const int tt = tok + j - 1;
                const u32x2 cc = *(const u32x2*)(proj + (size_t)tt * NP + D_C + ch), vv = *(const u32x2*)(proj + (size_t)tt * NP + D_V + ch);
                const f32x4 w = *(const f32x4*)(sw + j * 256 + ch);
                y.x += w.x * __uint_as_float(cc.x << 16) * __uint_as_float(vv.x << 16); y.y += w.y * __uint_as_float(cc.x & 0xffff0000u) * __uint_as_float(vv.x & 0xffff0000u);
                y.z += w.z * __uint_as_float(cc.y << 16) * __uint_as_float(vv.y << 16); y.w += w.w * __uint_as_float(cc.y & 0xffff0000u) * __uint_as_float(vv.y & 0xffff0000u);
            }
        }
        const u32x2 bb = *(const u32x2*)(proj + (size_t)tok * NP + D_B + ch);
        u32x2 o; o.x = pk2(y.x * __uint_as_float(bb.x << 16), y.y * __uint_as_float(bb.x & 0xffff0000u));
        o.y = pk2(y.z * __uint_as_float(bb.y << 16), y.w * __uint_as_float(bb.y & 0xffff0000u));
        *(u32x2*)(mix + (size_t)tok * 1024 + 768 + ch) = o;
    }
}

__global__ void __launch_bounds__(512, 2) fwd_kernel(Params pin) {
    extern __shared__ __attribute__((aligned(16))) unsigned char lds_raw[];
    LAS unsigned char* lds = (LAS unsigned char*)lds_raw;
    cg::grid_group grid = cg::this_grid();
    const int G = gridDim.x, bid = blockIdx.x;
    volatile LAS unsigned* bst = (volatile LAS unsigned*)(lds + LDS_BYTES - 16);
    if (threadIdx.x < 4) bst[threadIdx.x] = 0u;
    __syncthreads();
    const XcdBarrier xbar = xcd_barrier_post((unsigned*)(pin.ws + WS_BAR), bst);
    int nsync = 0;
    for (int ph2 = 2 * pin.ph_lo; ph2 < 2 * pin.ph_hi; ++ph2) {
        const int ph = ph2 >> 1;
        if ((ph2 & 1) && !((REPEAT_MASK >> ph) & 1u)) continue;
        size_t zo = 0; asm volatile("" : "+s"(zo));
        int tid = threadIdx.x; asm volatile("" : "+v"(tid));
        Params p = pin; p.ws += zo; p.out += zo; p.zo = zo;
        const float* mod = (const float*)(p.ws + WS_MOD);
        bf16_t* hm = (bf16_t*)(p.ws + WS_HM); bf16_t* big = (bf16_t*)(p.ws + WS_BIG);
        if (ph == 0) phase_p0(p, lds, tid);
        else if (ph == 19) phase_norm(p, 0, 2, tid);
        else {
            const int l = (ph - 1) / 9, s = (ph - 1) % 9;
            pg8::StaticOrder S;
            if (s == 0) phase_norm(p, l, 0, tid);
            else if (s == 1) { pg8::Gemm g{hm, (const bf16_t*)(p.ws + WS_WIN) + (size_t)l * NP * 1024, NTOK, NP, 1024, 1024}; S.init(NTOK, NP, G, bid);
                pg8::EpiBf16<0> E{big, NP}; pg8::gemm_phase(lds, g, S, E, tid); }
            else if (s == 2) phase_m1(p, l, lds, tid);
            else if (s == 3) phase_m2(p, l, tid);
            else if (s == 4) phase_m3(p, l, tid);
            else if (s == 5) { pg8::Gemm g{hm, (const bf16_t*)(p.ws + WS_WOUT) + (size_t)l * 1024 * 1024, NTOK, 1024, 512, 1024}; S.init(NTOK, 1024, G, bid, 2);
                pg8::EpiResid E{l == 0 ? p.IN(0) : p.out, l == 0 ? p.IN(1) - (size_t)4096 * 1024 : p.out, p.out, mod + (size_t)l * 5 * 6144 + 2048, (bf16_t*)(p.ws + WS_DSA)}; pg8::gemm_phase(lds, g, S, E, tid); }
            else if (s == 6) phase_norm(p, l, 1, tid);
            else if (s == 7) { pg8::Gemm g{hm, (const bf16_t*)(p.ws + WS_W1) + (size_t)l * 4096 * 1024, NTOK, DFF, 1024, 1024}; S.init(NTOK, DFF, G, bid);
                pg8::EpiBf16<1> E{big, DFF}; pg8::gemm_phase(lds, g, S, E, tid); }
            else { pg8::Gemm g{big, (const bf16_t*)(p.ws + WS_W2) + (size_t)l * 1024 * 4096, NTOK, 1024, 2048, DFF}; S.init(NTOK, 1024, G, bid, 2);
                pg8::EpiResid E{p.out, p.out, p.out, mod + (size_t)l * 5 * 6144 + 5120, (bf16_t*)(p.ws + WS_DSA)}; pg8::gemm_phase(lds, g, S, E, tid); }
        }
        if (ph2 + 2 < 2 * pin.ph_hi || (!(ph2 & 1) && ((REPEAT_MASK >> ph) & 1u))) { if (nsync == 0) grid.sync(); else xcd_barrier(xbar); ++nsync; }
    }
}

extern "C" void kernel_launch(void* const* d_in, const int* in_sizes, int n_in, void* d_out, int out_size, void* d_ws, size_t ws_size, hipStream_t stream) {
    static int grid = 0;
    if (grid == 0) {
        if (n_in != 29 || ws_size < WS_END) { fprintf(stderr, "kernel_launch: unexpected n_in %d / ws %zu\n", n_in, ws_size); grid = -1; return; }
        int dev = 0, cus = 0, per_cu = 0;
        hipGetDevice(&dev); hipDeviceGetAttribute(&cus, hipDeviceAttributeMultiprocessorCount, dev);
        if (hipFuncSetAttribute((const void*)fwd_kernel, hipFuncAttributeMaxDynamicSharedMemorySize, LDS_BYTES) != hipSuccess) { fprintf(stderr, "kernel_launch: hipFuncSetAttribute failed\n"); grid = -1; return; }
        if (hipOccupancyMaxActiveBlocksPerMultiprocessor(&per_cu, (const void*)fwd_kernel, 512, LDS_BYTES) != hipSuccess || per_cu < 1) { fprintf(stderr, "kernel_launch: occupancy query says %d\n", per_cu); per_cu = 1; }
        (void)hipGetLastError();
        grid = cus * 1;
        if (grid <= 0) grid = 256;
    }
    if (grid < 0) return;
    if (hipMemsetAsync((char*)d_ws + WS_BAR, 0, 16384, stream) != hipSuccess) { fprintf(stderr, "kernel_launch: memset failed\n"); return; }
    Params p{};
    for (int i = 0; i < 29; ++i) p.in[i] = (const float*)d_in[i];
    p.out = (float*)d_out; p.ws = (unsigned char*)d_ws;
#if MEGA
    p.ph_lo = 0; p.ph_hi = 20;
    void* args[] = {&p};
    hipError_t e = hipLaunchCooperativeKernel((const void*)fwd_kernel, dim3(grid), dim3(512), args, LDS_BYTES, stream);
    if (e != hipSuccess) fprintf(stderr, "cooperative launch failed: %s (grid %d)\n", hipGetErrorString(e), grid);
#else
    for (int ph = 0; ph < 20; ++ph) { p.ph_lo = ph; p.ph_hi = ph + 1; hipLaunchKernelGGL(fwd_kernel, dim3(grid), dim3(512), LDS_BYTES, stream, p); }
#endif
}
```

```cpp
#include <hip/hip_runtime.h>
#include <hip/hip_cooperative_groups.h>
#include <cstdio>
#include <cstdint>
namespace cg = cooperative_groups;

#ifndef MEGA
#define MEGA 1
#endif
#ifndef REPEAT_MASK
#define REPEAT_MASK 0u
#endif

#define DI __device__ __forceinline__
#define LAS __attribute__((address_space(3)))
typedef unsigned short bf16_t;
typedef short bf16x8 __attribute__((ext_vector_type(8)));
typedef float f32x4 __attribute__((ext_vector_type(4)));
typedef float f32x16 __attribute__((ext_vector_type(16)));
typedef unsigned u32x4 __attribute__((ext_vector_type(4)));
typedef unsigned u32x2 __attribute__((ext_vector_type(2)));
typedef __bf16 bf16x2_t __attribute__((ext_vector_type(2)));
typedef float f32x2_t __attribute__((ext_vector_type(2)));

constexpr int NTOK = 8192, DM = 1024, NP = 3584, DFF = 4096;
constexpr int A_Q = 0, A_I = 256, A_FF = 512, A_FB = 768, A_G = 1024, B_Q = 1280, B_K = 1408, B_V = 1536, B_G = 1792, B_AF = 2048, B_AB = 2064,
              C_X = 2080, C_G = 2336, D_B = 2592, D_C = 2848, D_V = 3104, PW = 3360;
constexpr size_t MiB = 1u << 20;
constexpr size_t WS_WIN = 0, WS_WOUT = 14 * MiB, WS_W1 = 18 * MiB, WS_W2 = 34 * MiB, WS_MOD = 50 * MiB, WS_HM = 51 * MiB, WS_BIG = 67 * MiB,
                 WS_OI = 131 * MiB, WS_DSA = 147 * MiB, WS_DSB = 179 * MiB, WS_QHA = 195 * MiB, WS_QHB = 203 * MiB, WS_HL = 207 * MiB, WS_CP = 223 * MiB,
                 WS_ACHA = 239 * MiB, WS_ACHB = 239 * MiB + 512 * 1024, WS_RAGA = 240 * MiB, WS_RAGH = 240 * MiB + 512 * 1024, WS_BAR = 241 * MiB, WS_END = 242 * MiB;
constexpr int OUT_SH = 8388608, OUT_SG = OUT_SH + 1048576, OUT_SR = OUT_SG + 524288;
constexpr int LDS_BYTES = 147456;

struct Params { const float* in[29]; float* out; unsigned char* ws; size_t zo; int ph_lo, ph_hi;
    DI const float* IN(int i) const { return in[i] + zo; } };

DI float bf2f(bf16_t u) { return __uint_as_float(((unsigned)u) << 16); }
DI unsigned pk2(float lo, float hi) { f32x2_t v = {lo, hi}; bf16x2_t b = __builtin_convertvector(v, bf16x2_t); return __builtin_bit_cast(unsigned, b); }
DI bf16_t f2bf(float x) { return (bf16_t)(pk2(x, 0.f) & 0xffffu); }
DI bf16x8 pack8(const float* v) { u32x4 p; p.x = pk2(v[0], v[1]); p.y = pk2(v[2], v[3]); p.z = pk2(v[4], v[5]); p.w = pk2(v[6], v[7]); return __builtin_bit_cast(bf16x8, p); }
DI float rcpf_(float x) { return __builtin_amdgcn_rcpf(x); }
DI float sigmoidf_(float x) { return rcpf_(1.f + __expf(-x)); }
DI float siluf_(float x) { return x * rcpf_(1.f + __expf(-x)); }
DI float om_exp(float x) { const float s = -x * (1.f + x * 0.5f * (1.f + x * (1.f / 3.f) * (1.f + x * 0.25f * (1.f + x * 0.2f * (1.f + x * (1.f / 6.f)))))); return x > -0.3f ? s : 1.f - __expf(x); }
DI int crow(int reg, int h) { return (reg & 3) + 8 * (reg >> 2) + 4 * h; }
#define MFMA32(a, b, c) __builtin_amdgcn_mfma_f32_32x32x16_bf16((a), (b), (c), 0, 0, 0)
DI f32x16 zero16() { f32x16 z; for (int i = 0; i < 16; ++i) z[i] = 0.f; return z; }
DI float shx(float v, int lane, int m) { return __int_as_float(__builtin_amdgcn_ds_bpermute((lane ^ m) << 2, __float_as_int(v))); }
DI int modrow_of(int row) { return row < 4096 ? 0 : 1 + ((row - 4096) >> 10); }


#define XB_TMO      128
#define XB_XCNT(j)  (256  + 64 * (j))
#define XB_XSUB(j)  (1280 + 64 * (j))
#define XB_XGEN(j)  (2304 + 64 * (j))
#define XB_TOP      3328
#define XB_TOPGEN   3392
#define XCD_BAR_WORDS 3456
#define XB_SPIN_CAP (1u << 18)
DI unsigned xb_ld(unsigned* p)              { return __hip_atomic_load(p, __ATOMIC_RELAXED, __HIP_MEMORY_SCOPE_AGENT); }
DI unsigned xb_add(unsigned* p, unsigned v) { return __hip_atomic_fetch_add(p, v, __ATOMIC_RELAXED, __HIP_MEMORY_SCOPE_AGENT); }
DI unsigned xb_xcc_id() { return (unsigned)__builtin_amdgcn_s_getreg((3 << 11) | 20) & 0xFu; }
#define XB_SPIN(cond, bar) do { unsigned _sp = 0; while (cond) { __builtin_amdgcn_s_sleep(1); \
    if ((++_sp & 255u) == 0u) { if (xb_ld(&(bar)[XB_TMO])) break; if (_sp > XB_SPIN_CAP) { atomicAdd(&(bar)[XB_TMO], 1u); break; } } } } while (0)
struct XcdBarrier { unsigned* bar; unsigned x; volatile LAS unsigned* st; };
DI XcdBarrier xcd_barrier_post(unsigned* bar, volatile LAS unsigned* st) {
    XcdBarrier b; b.bar = bar; b.x = xb_xcc_id(); b.st = st;
    if (threadIdx.x == 0) (void)xb_add(&bar[XB_XCNT(b.x)], 1u);
    return b;
}
DI void xcd_barrier_complete(unsigned* bar, unsigned x, unsigned& nloc, unsigned& nx) {
    const unsigned G = gridDim.x * gridDim.y * gridDim.z;
    unsigned sum, cnt, mine, sp = 0u;
    for (;;) {
        sum = 0u; cnt = 0u; mine = 0u;
#pragma unroll
        for (unsigned j = 0; j < 16; ++j) { const unsigned c = xb_ld(&bar[XB_XCNT(j)]); sum += c; cnt += (c > 0u) ? 1u : 0u; mine = (j == x) ? c : mine; }
        if (sum == G) break;
        __builtin_amdgcn_s_sleep(1);
        if ((++sp & 255u) == 0u) { if (xb_ld(&bar[XB_TMO])) break; if (sp > XB_SPIN_CAP) { atomicAdd(&bar[XB_TMO], 1u); break; } }
    }
    nloc = mine > 0u ? mine : 1u; nx = cnt > 0u ? cnt : 1u;
}
DI void xcd_barrier(const XcdBarrier& b) {
    asm volatile("s_waitcnt vmcnt(0)" ::: "memory");
    __syncthreads();
    if (threadIdx.x == 0) {
        unsigned* bar = b.bar;
        __builtin_amdgcn_s_waitcnt(0);
        unsigned nloc = b.st[0], nx = b.st[1];
        if (nloc == 0u) { xcd_barrier_complete(bar, b.x, nloc, nx); b.st[0] = nloc; b.st[1] = nx; }
        const unsigned old = xb_add(&bar[XB_XSUB(b.x)], 1u);
        const unsigned gen = old / nloc;
        if (old + 1u == (gen + 1u) * nloc) {
            __builtin_amdgcn_fence(__ATOMIC_RELEASE, "agent");
            asm volatile("s_waitcnt vmcnt(0)" ::: "memory");
            const unsigned og = xb_add(&bar[XB_TOP], 1u);
            const unsigned tg = og / nx;
            if (og + 1u == (tg + 1u) * nx) xb_add(&bar[XB_TOPGEN], 1u);
            else XB_SPIN(xb_ld(&bar[XB_TOPGEN]) == tg, bar);
            __builtin_amdgcn_fence(__ATOMIC_ACQUIRE, "agent");
            xb_add(&bar[XB_XGEN(b.x)], 1u);
            asm volatile("s_waitcnt vmcnt(0)" ::: "memory");
        } else {
            XB_SPIN(xb_ld(&bar[XB_XGEN(b.x)]) == gen, bar);
            __builtin_amdgcn_fence(__ATOMIC_ACQUIRE, "agent");
            asm volatile("s_waitcnt vmcnt(0)" ::: "memory");
        }
    }
    __syncthreads();
}

namespace pg8 {
constexpr int BM = 256, BK = 64, HALF = 128, HTB = HALF * BK * 2, NXCD = 8, WGM = 8;
__host__ __device__ __forceinline__ int lds_byte(int r, int c) { const int st = (r >> 4) * 2 + (c >> 5), rr = r & 15, cc = c & 31, ob = rr * 64 + cc * 2; return st * 1024 + (ob ^ (((ob >> 9) & 1) << 5)); }
__host__ __device__ __forceinline__ void stage_rc(int b, int& R, int& C) { const int st = b / 1024, sb = b % 1024, swz = sb ^ (((sb >> 9) & 1) << 5); R = (st >> 1) * 16 + swz / 64; C = (st & 1) * 32 + (swz % 64) / 2; }
__host__ __device__ __forceinline__ int perm32(int rho) { const int n = rho >> 4, i = rho & 15; return 8 * (i >> 2) + 4 * n + (i & 3); }
struct Unit { int pm, pn, pk; };
struct Gemm { const bf16_t* A; const bf16_t* Bt; int M, N, K, lda; };
struct StaticOrder {
    int nM, nN, nwg, G, c, KS;
    __host__ __device__ void init(int M, int N, int G_, int c_, int KS_ = 1) { KS = KS_; nM = M / BM; nN = (N / BM) * KS; nwg = nM * nN; G = G_; c = c_; }
    __host__ __device__ bool next(int i, Unit& u) const {
        const long L = (long)i * G + c; if (L >= nwg) return false;
        int wgid = (int)L; { const int q = nwg / NXCD, r = nwg % NXCD, xcd = wgid % NXCD, off = wgid / NXCD; wgid = (xcd < r ? xcd * (q + 1) : r * (q + 1) + (xcd - r) * q) + off; }
        const int nig = WGM * nN, gid = wgid / nig, fm = gid * WGM, gsz = (nM - fm) < WGM ? (nM - fm) : WGM;
        u.pm = fm + ((wgid % nig) % gsz); const int pv = (wgid % nig) / gsz; u.pn = pv / KS; u.pk = pv % KS; return true;
    }
};
template <class Epi>
__device__ __forceinline__ void gemm_phase(LAS unsigned char* lds, const Gemm g, const StaticOrder& S, const Epi& E, const int tid) {
    const int wid = __builtin_amdgcn_readfirstlane(tid >> 6), lane = tid & 63, wr = wid >> 2, wc = wid & 3, fr = lane & 15, fq = lane >> 4;
    const int K = g.lda, nt = g.K / BK;
    unsigned voffA[2], voffB[2];
#pragma unroll
    for (int i = 0; i < 2; ++i) { int R, C; stage_rc(tid * 16 + i * 8192, R, C); const int Rb = (R & ~31) + perm32(R & 31);
        voffA[i] = (unsigned)(R * K + C) * 2u; voffB[i] = (unsigned)(Rb * K + C) * 2u; }
    const size_t kstep = (size_t)(BK * 2);
    const size_t hstep = (size_t)HALF * K * 2;
    const size_t tstep = 2 * hstep;
    const unsigned ldsw = (unsigned)wid * 1024u;
    const int aoff = lds_byte(wr * 64 + fr, fq * 8), boff = lds_byte(wc * 32 + fr, fq * 8);
#define PG8_SA(b, h) (((b) * 2 + (h)) * HTB)
#define PG8_SB(b, h) ((4 + (b) * 2 + (h)) * HTB)
#define PG8_STAGE(bufoff, gbase, voff) do { _Pragma("unroll") for (int _i = 0; _i < 2; ++_i) \
        __builtin_amdgcn_global_load_lds((const unsigned*)((const char*)(gbase) + (voff)[_i]), (LAS unsigned*)(lds + (bufoff) + ldsw + _i * 8192), 16, 0, 0); } while (0)
#define PG8_LDA(dst, b, h) do { _Pragma("unroll") for (int m = 0; m < 4; ++m) _Pragma("unroll") for (int k = 0; k < 2; ++k) dst[m][k] = *(const LAS bf16x8*)(lds + PG8_SA(b, h) + aoff + m * 2048 + k * 1024); } while (0)
#define PG8_LDB(dst, b, h) do { _Pragma("unroll") for (int n = 0; n < 2; ++n) _Pragma("unroll") for (int k = 0; k < 2; ++k) dst[n][k] = *(const LAS bf16x8*)(lds + PG8_SB(b, h) + boff + n * 2048 + k * 1024); } while (0)
#define PG8_MMA(ai, bj, At, Bt) do { __builtin_amdgcn_s_setprio(1); _Pragma("unroll") for (int m = 0; m < 4; ++m) _Pragma("unroll") for (int n = 0; n < 2; ++n) _Pragma("unroll") for (int k = 0; k < 2; ++k) \
        acc[ai][bj][m][n] = __builtin_amdgcn_mfma_f32_16x16x32_bf16(Bt[n][k], At[m][k], acc[ai][bj][m][n], 0, 0, 0); __builtin_amdgcn_s_setprio(0); } while (0)
#define PG8_WAIT_V(n) asm volatile("s_waitcnt vmcnt(" #n ")" ::: "memory")
#define PG8_WAIT_L(n) asm volatile("s_waitcnt lgkmcnt(" #n ")" ::: "memory")
#define PG8_BAR __builtin_amdgcn_s_barrier()
#define PG8_SCHED __builtin_amdgcn_sched_barrier(0)
    Unit cur, nxt; int ui = 0;
    if (!S.next(0, cur)) return;
    f32x4 acc[2][2][4][2];
#pragma unroll
    for (int a = 0; a < 2; ++a)
#pragma unroll
        for (int b = 0; b < 2; ++b)
#pragma unroll
            for (int m = 0; m < 4; ++m)
#pragma unroll
                for (int n = 0; n < 2; ++n) acc[a][b][m][n] = (f32x4){0.f, 0.f, 0.f, 0.f};
    bf16x8 At[4][2], B0[2][2], B1[2][2];
    const size_t ksplit = (size_t)g.K * 2;
    const char* cA = (const char*)g.A + (size_t)cur.pm * tstep + cur.pk * ksplit; const char* cB = (const char*)g.Bt + (size_t)cur.pn * tstep + cur.pk * ksplit;
    PG8_STAGE(PG8_SB(0, 0), cB, voffB); PG8_STAGE(PG8_SA(0, 0), cA, voffA); PG8_STAGE(PG8_SB(0, 1), cB + hstep, voffB); PG8_STAGE(PG8_SA(0, 1), cA + hstep, voffA);
    if (wr == 1) PG8_BAR;
    PG8_WAIT_V(4); PG8_BAR;
    PG8_STAGE(PG8_SB(1, 0), cB + kstep, voffB); PG8_STAGE(PG8_SA(1, 0), cA + kstep, voffA); PG8_STAGE(PG8_SB(1, 1), cB + hstep + kstep, voffB);
    PG8_WAIT_V(6); PG8_BAR;
    for (;;) {
        const bool has_next = S.next(ui + 1, nxt);
        const char* nA = has_next ? (const char*)g.A + (size_t)nxt.pm * tstep + nxt.pk * ksplit : cA; const char* nB = has_next ? (const char*)g.Bt + (size_t)nxt.pn * tstep + nxt.pk * ksplit : cB;
        for (int t = 0; t < nt; t += 2) {
            const bool last = (t == nt - 2);
            const char* a1 = cA + (size_t)(t + 1) * kstep;
            const char* a2 = last ? nA : cA + (size_t)(t + 2) * kstep; const char* b2 = last ? nB : cB + (size_t)(t + 2) * kstep;
            const char* a3 = a2 + kstep; const char* b3 = b2 + kstep;
            PG8_LDB(B0, 0, 0); PG8_SCHED; PG8_LDA(At, 0, 0); PG8_STAGE(PG8_SA(1, 1), a1 + hstep, voffA);
            PG8_WAIT_L(8); PG8_BAR; PG8_WAIT_L(0); PG8_MMA(0, 0, At, B0); PG8_BAR; PG8_SCHED;
            PG8_LDB(B1, 0, 1); PG8_STAGE(PG8_SB(0, 0), b2, voffB);
            PG8_BAR; PG8_WAIT_L(0); PG8_MMA(0, 1, At, B1); PG8_BAR;
            PG8_LDA(At, 0, 1); PG8_STAGE(PG8_SA(0, 0), a2, voffA);
            PG8_BAR; PG8_WAIT_L(0); PG8_MMA(1, 0, At, B0); PG8_BAR; PG8_SCHED;
            PG8_STAGE(PG8_SB(0, 1), b2 + hstep, voffB);
            PG8_WAIT_V(6); PG8_BAR; PG8_MMA(1, 1, At, B1); PG8_BAR;
            PG8_LDB(B0, 1, 0); PG8_SCHED; PG8_LDA(At, 1, 0); PG8_STAGE(PG8_SA(0, 1), a2 + hstep, voffA);
            PG8_WAIT_L(8); PG8_BAR; PG8_WAIT_L(0); PG8_MMA(0, 0, At, B0); PG8_BAR; PG8_SCHED;
            PG8_LDB(B1, 1, 1); PG8_STAGE(PG8_SB(1, 0), b3, voffB);
            PG8_BAR; PG8_WAIT_L(0); PG8_MMA(0, 1, At, B1); PG8_BAR;
            PG8_LDA(At, 1, 1); PG8_STAGE(PG8_SA(1, 0), a3, voffA);
            PG8_BAR; PG8_WAIT_L(0); PG8_MMA(1, 0, At, B0); PG8_BAR; PG8_SCHED;
            PG8_STAGE(PG8_SB(1, 1), b3 + hstep, voffB);
            PG8_WAIT_V(6); PG8_BAR; PG8_MMA(1, 1, At, B1); PG8_BAR;
        }
        E(acc, cur, wr, wc, fr, fq);
        if (!has_next) break;
#pragma unroll
        for (int a = 0; a < 2; ++a)
#pragma unroll
            for (int b = 0; b < 2; ++b)
#pragma unroll
                for (int m = 0; m < 4; ++m)
#pragma unroll
                    for (int n = 0; n < 2; ++n) acc[a][b][m][n] = (f32x4){0.f, 0.f, 0.f, 0.f};
        cur = nxt; cA = nA; cB = nB; ++ui;
    }
    PG8_WAIT_V(0);
    if (wr == 0) PG8_BAR;
    PG8_BAR;
#undef PG8_SA
#undef PG8_SB
#undef PG8_STAGE
#undef PG8_LDA
#undef PG8_LDB
#undef PG8_MMA
#undef PG8_WAIT_V
#undef PG8_WAIT_L
#undef PG8_BAR
#undef PG8_SCHED
}

template <int ACT> struct EpiBf16 {
    bf16_t* O; int ldc;
    __device__ __forceinline__ void operator()(const f32x4 (&acc)[2][2][4][2], const Unit& u, int wr, int wc, int fr, int fq) const {
        const int row0 = u.pm * BM + wr * 64 + fr, col0 = u.pn * BM + wc * 32 + 8 * fq;
#pragma unroll
        for (int ai = 0; ai < 2; ++ai)
#pragma unroll
            for (int m = 0; m < 4; ++m) { bf16_t* rowp = O + (size_t)(row0 + ai * HALF + m * 16) * ldc + col0;
#pragma unroll
                for (int bj = 0; bj < 2; ++bj) { f32x4 v0 = acc[ai][bj][m][0], v1 = acc[ai][bj][m][1];
                    if (ACT == 1) {
#pragma unroll
                        for (int q = 0; q < 4; ++q) { float a = fmaxf(v0[q], 0.f), b = fmaxf(v1[q], 0.f); v0[q] = a * a; v1[q] = b * b; } }
                    u32x4 w; w.x = pk2(v0[0], v0[1]); w.y = pk2(v0[2], v0[3]); w.z = pk2(v1[0], v1[1]); w.w = pk2(v1[2], v1[3]);
                    *(u32x4*)(rowp + bj * HALF) = w; } }
    }
};
struct EpiResid {
    const float* gate; bf16_t* pb;
    __device__ __forceinline__ void operator()(const f32x4 (&acc)[2][2][4][2], const Unit& u, int wr, int wc, int fr, int fq) const {
        const int rowb = u.pm * BM; const float* gp = gate + modrow_of(rowb) * 6144;
        const int row0 = rowb + wr * 64 + fr, col0 = u.pn * BM + wc * 32 + 8 * fq;
        bf16_t* pbk = pb + (size_t)u.pk * ((size_t)NTOK * 1024);
        f32x4 gv[2][2];
#pragma unroll
        for (int bj = 0; bj < 2; ++bj)
#pragma unroll
            for (int n = 0; n < 2; ++n) gv[bj][n] = *(const f32x4*)(gp + col0 + bj * HALF + 4 * n);
#pragma unroll
        for (int ai = 0; ai < 2; ++ai)
#pragma unroll
            for (int m = 0; m < 4; ++m) { const size_t ro = (size_t)(row0 + ai * HALF + m * 16) * 1024 + col0;
#pragma unroll
                for (int bj = 0; bj < 2; ++bj) { const f32x4 v0 = gv[bj][0] * acc[ai][bj][m][0], v1 = gv[bj][1] * acc[ai][bj][m][1];
                    u32x4 w; w.x = pk2(v0[0], v0[1]); w.y = pk2(v0[2], v0[3]); w.z = pk2(v1[0], v1[1]); w.w = pk2(v1[2], v1[3]);
                    *(u32x4*)(pbk + ro + bj * HALF) = w; } }
    }
};
}

DI void transpose_unit(const float* __restrict__ W, int K, int N, int Npad, bf16_t* WT, int unit, int lane, LAS unsigned char* scr) {
    const int nblk = Npad / 64, kb = unit / nblk, nb = unit % nblk, n = nb * 64 + lane, k0 = kb * 64;
    u32x4 o[8];
    if (n < N) {
        float v[64];
#pragma unroll
        for (int kk = 0; kk < 64; ++kk) v[kk] = W[(size_t)(k0 + kk) * N + n];
#pragma unroll
        for (int q = 0; q < 8; ++q) { o[q].x = pk2(v[8 * q], v[8 * q + 1]); o[q].y = pk2(v[8 * q + 2], v[8 * q + 3]); o[q].z = pk2(v[8 * q + 4], v[8 * q + 5]); o[q].w = pk2(v[8 * q + 6], v[8 * q + 7]); }
    } else {
#pragma unroll
        for (int q = 0; q < 8; ++q) o[q] = (u32x4){0u, 0u, 0u, 0u};
    }
#pragma unroll
    for (int q = 0; q < 8; ++q) *(LAS u32x4*)(scr + lane * 144 + q * 16) = o[q];
    __builtin_amdgcn_fence(__ATOMIC_RELEASE, "wavefront"); __builtin_amdgcn_wave_barrier();
    const int ch = lane & 7, rb = lane >> 3;
#pragma unroll
    for (int j = 0; j < 8; ++j) { const int row = rb + 8 * j; const u32x4 w = *(const LAS u32x4*)(scr + row * 144 + ch * 16);
        *(u32x4*)(WT + (size_t)(nb * 64 + row) * K + k0 + ch * 8) = w; }
    __builtin_amdgcn_fence(__ATOMIC_RELEASE, "wavefront"); __builtin_amdgcn_wave_barrier();
}

DI void phase_p0(const Params& p, LAS unsigned char* lds, const int tid) {
    const int lane = tid & 63, wid = tid >> 6, G = gridDim.x, bid = blockIdx.x;
    const float* c = p.IN(5); const float* c_ctx = p.IN(6); const float* ada_w = p.IN(9); const float* ada_b = p.IN(10);
    float* mod = (float*)(p.ws + WS_MOD);
    LAS float* st = (LAS float*)lds + wid * 640;
    LAS float* red = (LAS float*)(lds + 32768);
    for (int bu = bid; bu < 192; bu += G) {
        const int l = bu / 96, cgp = bu % 96, col = cgp * 64 + lane;
        for (int i = lane; i < 640; i += 64) { const int row = i / 128, k = wid * 128 + (i % 128); const float cv = row == 0 ? c_ctx[k] : c[(row - 1) * 1024 + k]; st[i] = siluf_(cv); }
        __syncthreads();
        float acc[5] = {0.f, 0.f, 0.f, 0.f, 0.f};
        const float* W = ada_w + (size_t)l * 1024 * 6144 + (size_t)(wid * 128) * 6144 + col;
#pragma unroll 16
        for (int kk = 0; kk < 128; ++kk) { const float w = W[(size_t)kk * 6144];
#pragma unroll
            for (int row = 0; row < 5; ++row) acc[row] += st[row * 128 + kk] * w; }
#pragma unroll
        for (int row = 0; row < 5; ++row) red[(wid * 5 + row) * 64 + lane] = acc[row];
        __syncthreads();
        if (tid < 320) { const int row = tid / 64, ln = tid % 64; float s = 0.f;
#pragma unroll
            for (int w = 0; w < 8; ++w) s += red[(w * 5 + row) * 64 + ln];
            const int cc = cgp * 64 + ln; mod[(l * 5 + row) * 6144 + cc] = s + ada_b[l * 6144 + cc]; }
        __syncthreads();
    }
    const int gw = bid * 8 + wid, GW = G * 8;
    LAS unsigned char* scr = lds + 65536 + wid * 9216;
    for (int u = gw; u < 6400; u += GW) {
        const int l = u / 3200; int r = u % 3200;
        if (r < 896) transpose_unit(p.IN(11) + (size_t)l * 1024 * PW, 1024, PW, NP, (bf16_t*)(p.ws + WS_WIN) + (size_t)l * NP * 1024, r, lane, scr);
        else if (r < 1152) transpose_unit(p.IN(12) + (size_t)l * 1024 * 1024, 1024, 1024, 1024, (bf16_t*)(p.ws + WS_WOUT) + (size_t)l * 1024 * 1024, r - 896, lane, scr);
        else if (r < 2176) transpose_unit(p.IN(26) + (size_t)l * 1024 * 4096, 1024, 4096, 4096, (bf16_t*)(p.ws + WS_W1) + (size_t)l * 4096 * 1024, r - 1152, lane, scr);
        else transpose_unit(p.IN(27) + (size_t)l * 4096 * 1024, 4096, 1024, 1024, (bf16_t*)(p.ws + WS_W2) + (size_t)l * 1024 * 4096, r - 2176, lane, scr);
    }
}

DI void phase_norm(const Params& p, int l, int which, const int tid) {
    const int lane = tid & 63, wid = tid >> 6, gw = blockIdx.x * 8 + wid, GW = gridDim.x * 8;
    const float* mod = (const float*)(p.ws + WS_MOD);
    bf16_t* hm = (bf16_t*)(p.ws + WS_HM);
    const float* g = which == 0 ? p.IN(7) + l * 1024 : (which == 1 ? p.IN(8) + l * 1024 : p.IN(28));
    const bool first = (which == 0 && l == 0), from_in = (l == 0 && which != 2);
    for (int row0 = gw; row0 < NTOK; row0 += 4 * GW) {
        f32x4 v[4][4]; float ss[4];
#pragma unroll
        for (int k = 0; k < 4; ++k) {
            const int row = row0 + k * GW; ss[k] = 0.f;
            if (row < NTOK) {
                const float* xr = from_in ? (row < 4096 ? p.IN(0) + (size_t)row * 1024 : p.IN(1) + (size_t)(row - 4096) * 1024) : p.out + (size_t)row * 1024;
#pragma unroll
                for (int j = 0; j < 4; ++j) v[k][j] = ((const f32x4*)xr)[lane + 64 * j];
                if (!first) {
                    const bf16_t* pr = (const bf16_t*)(p.ws + WS_DSA) + (size_t)row * 1024;
#pragma unroll
                    for (int j = 0; j < 4; ++j) { const u32x2 pp = ((const u32x2*)pr)[lane + 64 * j], pq = ((const u32x2*)(pr + (size_t)NTOK * 1024))[lane + 64 * j];
                        v[k][j].x += __uint_as_float(pp.x << 16) + __uint_as_float(pq.x << 16); v[k][j].y += __uint_as_float(pp.x & 0xffff0000u) + __uint_as_float(pq.x & 0xffff0000u);
                        v[k][j].z += __uint_as_float(pp.y << 16) + __uint_as_float(pq.y << 16); v[k][j].w += __uint_as_float(pp.y & 0xffff0000u) + __uint_as_float(pq.y & 0xffff0000u); }
                }
            }
        }
#pragma unroll
        for (int k = 0; k < 4; ++k) {
            const int row = row0 + k * GW;
            if (row < NTOK) {
#pragma unroll
                for (int j = 0; j < 4; ++j) ss[k] += (v[k][j].x * v[k][j].x + v[k][j].y * v[k][j].y) + (v[k][j].z * v[k][j].z + v[k][j].w * v[k][j].w);
            }
        }
#pragma unroll
        for (int o = 1; o < 64; o <<= 1) {
#pragma unroll
            for (int k = 0; k < 4; ++k) ss[k] += shx(ss[k], lane, o);
        }
#pragma unroll
        for (int k = 0; k < 4; ++k) {
            const int row = row0 + k * GW;
            if (row < NTOK) {
                const float rstd = rsqrtf(ss[k] * (1.f / 1024.f) + 1e-6f);
                if (which == 2) {
                    float* yo = p.out + (size_t)row * 1024;
#pragma unroll
                    for (int j = 0; j < 4; ++j) { const f32x4 gv = ((const f32x4*)g)[lane + 64 * j]; ((f32x4*)yo)[lane + 64 * j] = v[k][j] * rstd * gv; }
                } else {
                    const float* mr = mod + (size_t)(l * 5 + modrow_of(row)) * 6144 + (which == 0 ? 0 : 3072);
#pragma unroll
                    for (int j = 0; j < 4; ++j) { const f32x4 gv = ((const f32x4*)g)[lane + 64 * j]; const f32x4 sh = ((const f32x4*)mr)[lane + 64 * j], sc = ((const f32x4*)(mr + 1024))[lane + 64 * j];
                        const f32x4 hv = v[k][j] * rstd * gv * (sc + 1.f) + sh;
                        u32x2 o; o.x = pk2(hv.x, hv.y); o.y = pk2(hv.z, hv.w);
                        ((u32x2*)(hm + (size_t)row * 1024))[lane + 64 * j] = o;
                        if (!first) ((f32x4*)(p.out + (size_t)row * 1024))[lane + 64 * j] = v[k][j]; }
                }
            }
        }
    }
}

constexpr int M1_TILE_BYTES = 66048, M1_WL_BYTES = 9216;
template <int NCOL8, int NROWS>
DI void stage_tile(const char* proj, LAS unsigned char* tile, int row_first, int col0, int pitchB, int dstB, int s0, int s1, int tid) {
    constexpr int NCH = NCOL8 * NROWS, IT = (NCH + 511) / 512;
    u32x4 v[IT];
#pragma unroll
    for (int i = 0; i < IT; ++i) { const int id = tid + 512 * i; const int row = id / NCOL8, cc = id % NCOL8, t = row_first + row;
        v[i] = (u32x4){0u, 0u, 0u, 0u};
        if (id < NCH && t >= s0 && t < s1) v[i] = *(const u32x4*)(proj + ((size_t)t * NP + col0 + cc * 8) * 2); }
#pragma unroll
    for (int i = 0; i < IT; ++i) { const int id = tid + 512 * i; const int row = id / NCOL8, cc = id % NCOL8;
        if (id < NCH) *(LAS u32x4*)(tile + row * pitchB + dstB + cc * 16) = v[i]; }
}

template <int MIX>
DI void m1_gla_wave(const Params& p, int l, int c, int hd, int dir, const LAS unsigned char* tile, LAS unsigned char* wl, const LAS unsigned char* wlp, int lane) {
    constexpr int DK = MIX == 0 ? 64 : 32, NT = DK / 32, PITCH = DK + 8, TP = MIX == 0 ? 1032 : 552;
    const int r = lane & 31, hh = lane >> 5, tok0 = c * 32;
    const LAS bf16_t* T = (const LAS bf16_t*)tile;
    LAS bf16_t* Qt = (LAS bf16_t*)wl; LAS bf16_t* Kt = Qt + 32 * PITCH;
    char* DS = (char*)(p.ws + (MIX == 0 ? WS_DSA : WS_DSB));
    float* ACH = (float*)(p.ws + (MIX == 0 ? WS_ACHA : WS_ACHB));
    char* QH = (char*)(p.ws + (MIX == 0 ? WS_QHA : WS_QHB));
    float* OI = (float*)(p.ws + WS_OI);
    const int tba = 4 * hh * TP, tb = tba + r;
#define TROW(li) ((8 * ((li) >> 2) + ((li) & 3)) * TP)
    const int vcol = MIX == 0 ? 256 + hd * 64 : 256 + hd * 64;
    bf16x8 vf[2][2];
#pragma unroll
    for (int n = 0; n < 2; ++n)
#pragma unroll
        for (int st = 0; st < 2; ++st)
#pragma unroll
            for (int j = 0; j < 8; ++j) vf[n][st][j] = (short)T[tb + TROW(8 * st + j) + vcol + 32 * n];
    const int qcol = MIX == 0 ? hd * 64 : hd * 32;
#pragma unroll 1
    for (int m = 0; m < NT; ++m) {
        float la[16], kk[16];
        if (MIX == 0) {
            const int zcol = (dir == 0 ? 512 : 768) + hd * 64 + 32 * m;
            const float* lbl = p.IN(13);
            float lb = 0.f;
            if (l == 1) { const int ch = hd * 64 + 32 * m + r; const float l0 = lbl[(0 * 2 + dir) * 256 + ch], l1 = lbl[(1 * 2 + dir) * 256 + ch]; lb = rcpf_(1.f + __expf(l0 - l1)); }
#pragma unroll
            for (int li = 0; li < 16; ++li) { const float z = bf2f(T[tb + TROW(li) + zcol]);
                const float e = __expf(-z), sg = rcpf_(1.f + e), omsg = e * sg;
                const float f = lb + (1.f - lb) * sg; kk[li] = (1.f - lb) * omsg; la[li] = __logf(fmaxf(f, 1e-20f)); }
        } else {
            const int kcol = 128 + hd * 32, acol = 512 + dir * 16;
            float w2[16];
#pragma unroll
            for (int rho = 0; rho < 16; ++rho) w2[rho] = p.IN(15)[((l * 2 + dir) * 16 + rho) * 128 + hd * 32 + r];
            const float ba = p.IN(16)[(l * 2 + dir) * 128 + hd * 32 + r];
#pragma unroll
            for (int li = 0; li < 16; ++li) {
                const u32x4 a0 = *(const LAS u32x4*)(T + tba + TROW(li) + acol), a1 = *(const LAS u32x4*)(T + tba + TROW(li) + acol + 8);
                float w = ba;
#pragma unroll
                for (int qd = 0; qd < 4; ++qd) { w += __uint_as_float(a0[qd] << 16) * w2[2 * qd] + __uint_as_float(a0[qd] & 0xffff0000u) * w2[2 * qd + 1];
                    w += __uint_as_float(a1[qd] << 16) * w2[8 + 2 * qd] + __uint_as_float(a1[qd] & 0xffff0000u) * w2[8 + 2 * qd + 1]; }
                const float ls = fminf(w, 0.f) - __logf(1.f + __expf(-fabsf(w)));
                la[li] = ls * (1.f / 16.f);
                kk[li] = bf2f(T[tb + TROW(li) + kcol]);
            }
        }
        float gs[4], pgs[4];
#pragma unroll
        for (int g = 0; g < 4; ++g) { gs[g] = (la[4 * g] + la[4 * g + 1]) + (la[4 * g + 2] + la[4 * g + 3]); pgs[g] = shx(gs[g], lane, 32); }
        float run = 0.f, half = 0.f; float cum[16];
#pragma unroll
        for (int g = 0; g < 4; ++g) { float b = run + (hh ? pgs[g] : 0.f); run += gs[g] + pgs[g]; if (g == 1) half = run;
#pragma unroll
            for (int i = 0; i < 4; ++i) { b += la[4 * g + i]; cum[4 * g + i] = b; } }
        const float total = run;
        const float ref = dir == 0 ? half : total - half;
        float kh[16];
        const unsigned qhb = MIX == 0 ? (unsigned)((tok0 + 4 * hh) * 512 + dir * 256 + hd * 64 + 32 * m + r) * 2u : (unsigned)((tok0 + 4 * hh) * 256 + dir * 128 + hd * 32 + r) * 2u;
#pragma unroll
        for (int li = 0; li < 16; ++li) {
            const float cv = dir == 0 ? cum[li] : (total - cum[li] + la[li]);
            const float eq = __expf(fminf(cv - ref, 80.f)), ek = __expf(fminf(ref - cv, 80.f));
            const int tkl = 8 * (li >> 2) + (li & 3);
            const float qv = bf2f(T[tb + TROW(li) + qcol + 32 * m]) * (MIX == 1 ? 0.17677669529663687f : 1.f);
            Qt[(tkl + 4 * hh) * PITCH + 32 * m + r] = f2bf(qv * eq);
            Kt[(tkl + 4 * hh) * PITCH + 32 * m + r] = f2bf(kk[li] * ek);
            kh[li] = kk[li] * __expf(total - cv);
            const float qh = qv * __expf(cv);
            *(bf16_t*)(QH + (qhb + (unsigned)(tkl * (MIX == 0 ? 512 : 256) * 2))) = f2bf(qh);
        }
        const bf16x8 khat0 = pack8(kh), khat1 = pack8(kh + 8);
        if (hh == 0) ACH[((c * 4 + hd) * 2 + dir) * DK + 32 * m + r] = __expf(total);
#pragma unroll
        for (int n = 0; n < 2; ++n) {
            f32x16 ds = zero16();
            ds = MFMA32(khat0, vf[n][0], ds); ds = MFMA32(khat1, vf[n][1], ds);
            const unsigned dsb = (unsigned)(((c * 4 + hd) * 2 + dir) * (DK * 64) + (32 * m + 4 * hh) * 64 + 32 * n + r) * 4u;
#pragma unroll
            for (int i = 0; i < 16; ++i) *(float*)(DS + (dsb + (unsigned)(((i & 3) + 8 * (i >> 2)) * 64 * 4))) = ds[i];
        }
    }
#undef TROW
    __builtin_amdgcn_fence(__ATOMIC_RELEASE, "wavefront");
    __builtin_amdgcn_wave_barrier();
    f32x16 pt = zero16();
#pragma unroll
    for (int s = 0; s < DK / 16; ++s) {
        const bf16x8 kfr = *(const LAS bf16x8*)(Kt + r * PITCH + 16 * s + 8 * hh);
        const bf16x8 qfr = *(const LAS bf16x8*)(Qt + r * PITCH + 16 * s + 8 * hh);
        pt = MFMA32(kfr, qfr, pt);
    }
    __builtin_amdgcn_fence(__ATOMIC_RELEASE, "wavefront");
    __builtin_amdgcn_wave_barrier();
    LAS float* ex = (LAS float*)wl; const LAS float* exp_ = (const LAS float*)wlp;
#pragma unroll
    for (int i = 0; i < 16; ++i) { const int srow = crow(i, hh); const bool keep = dir == 0 ? (srow <= r) : (srow >= r); pt[i] = keep ? pt[i] : 0.f; ex[i * 64 + lane] = pt[i]; }
    __syncthreads();
    float ptv[16];
#pragma unroll
    for (int i = 0; i < 16; ++i) ptv[i] = pt[i] + exp_[i * 64 + lane];
    const bf16x8 pf0 = pack8(ptv), pf1 = pack8(ptv + 8);
    float* oi = OI + (size_t)((MIX * 256 + c) * 4 + hd) * 2048;
    {
        f32x16 ot = zero16();
        const bf16x8 va = dir == 0 ? vf[0][0] : vf[1][0], vb = dir == 0 ? vf[0][1] : vf[1][1];
        ot = MFMA32(va, pf0, ot); ot = MFMA32(vb, pf1, ot);
#pragma unroll
        for (int g = 0; g < 4; ++g) *(f32x4*)(oi + ((dir * 4 + g) * 64 + lane) * 4) = (f32x4){ot[4 * g], ot[4 * g + 1], ot[4 * g + 2], ot[4 * g + 3]};
    }
}

DI void m1_rg_wave(const Params& p, int l, int c, int nb, int dir, const LAS unsigned char* tile, int lane) {
    constexpr int TP = 264;
    const int r = lane & 31, hh = lane >> 5, tok0 = c * 32;
    const LAS bf16_t* T = (const LAS bf16_t*)tile;
    float* HL = (float*)(p.ws + WS_HL); float* CP = (float*)(p.ws + WS_CP);
    float* RAGA = (float*)(p.ws + WS_RAGA); float* RAGH = (float*)(p.ws + WS_RAGH);
    const int sgn = dir ? -1 : 1, lbase = dir ? 31 : 0;
    const float* cw = p.IN(18) + (size_t)(l * 2 + dir) * 4 * 256;
    const float* cb = p.IN(19) + (size_t)(l * 2 + dir) * 256;
    bf16x8 af[4];
    const int trow = lbase + sgn * r + 3;
#pragma unroll
    for (int s = 0; s < 4; ++s) {
        const int ch0 = 64 * nb + 16 * s + 8 * hh;
        float xc[8];
        { const f32x4 b0 = *(const f32x4*)(cb + ch0), b1 = *(const f32x4*)(cb + ch0 + 4);
          xc[0] = b0.x; xc[1] = b0.y; xc[2] = b0.z; xc[3] = b0.w; xc[4] = b1.x; xc[5] = b1.y; xc[6] = b1.z; xc[7] = b1.w; }
#pragma unroll
        for (int tap = 0; tap < 4; ++tap) {
            const u32x4 uu = *(const LAS u32x4*)(T + (trow + sgn * (tap - 3)) * TP + ch0);
            const f32x4 w0 = *(const f32x4*)(cw + tap * 256 + ch0), w1 = *(const f32x4*)(cw + tap * 256 + ch0 + 4);
            xc[0] += w0.x * __uint_as_float(uu.x << 16); xc[1] += w0.y * __uint_as_float(uu.x & 0xffff0000u);
            xc[2] += w0.z * __uint_as_float(uu.y << 16); xc[3] += w0.w * __uint_as_float(uu.y & 0xffff0000u);
            xc[4] += w1.x * __uint_as_float(uu.z << 16); xc[5] += w1.y * __uint_as_float(uu.z & 0xffff0000u);
            xc[6] += w1.z * __uint_as_float(uu.w << 16); xc[7] += w1.w * __uint_as_float(uu.w & 0xffff0000u);
        }
        af[s] = pack8(xc);
    }
    const float* wr_ = p.IN(20) + (size_t)((l * 2 + dir) * 4 + nb) * 4096;
    const float* wi_ = p.IN(22) + (size_t)((l * 2 + dir) * 4 + nb) * 4096;
#pragma unroll 1
    for (int n = 0; n < 2; ++n) {
        f32x16 rr = zero16(), ri = zero16();
#pragma unroll
        for (int s = 0; s < 4; ++s) {
            float br_[8], bi_[8];
#pragma unroll
            for (int j = 0; j < 8; ++j) { br_[j] = wr_[(16 * s + 8 * hh + j) * 64 + 32 * n + r]; bi_[j] = wi_[(16 * s + 8 * hh + j) * 64 + 32 * n + r]; }
            rr = MFMA32(af[s], pack8(br_), rr); ri = MFMA32(af[s], pack8(bi_), ri);
        }
        const int ch = 64 * nb + 32 * n + r;
        const float cbv = cb[ch]; float cwv[4];
#pragma unroll
        for (int tap = 0; tap < 4; ++tap) cwv[tap] = cw[tap * 256 + ch];
        const float brv = p.IN(21)[(l * 2 + dir) * 256 + ch], biv = p.IN(23)[(l * 2 + dir) * 256 + ch];
        const float lam = p.IN(24)[(l * 2 + dir) * 256 + ch];
        const float c8 = -8.f * log1pf(__expf(-lam));
        float a[16], bx[16];
#pragma unroll
        for (int li = 0; li < 16; ++li) {
            const int tr = lbase + sgn * (8 * (li >> 2) + 4 * hh + (li & 3)) + 3;
            float xcv = cbv;
#pragma unroll
            for (int tap = 0; tap < 4; ++tap) xcv += cwv[tap] * bf2f(T[(tr + sgn * (tap - 3)) * TP + ch]);
            const float rv = sigmoidf_(rr[li] + brv), iv = sigmoidf_(ri[li] + biv);
            const float loga = c8 * rv;
            a[li] = __expf(loga); bx[li] = __builtin_amdgcn_sqrtf(om_exp(2.f * loga)) * iv * xcv;
        }
        float Ag[4], Bg[4], pA[4], pB[4];
#pragma unroll
        for (int g = 0; g < 4; ++g) { float hl = 0.f, ap = 1.f;
#pragma unroll
            for (int i = 0; i < 4; ++i) { hl = a[4 * g + i] * hl + bx[4 * g + i]; ap *= a[4 * g + i]; }
            Ag[g] = ap; Bg[g] = hl; pA[g] = shx(ap, lane, 32); pB[g] = shx(hl, lane, 32); }
        float Hrun = 0.f, Prun = 1.f;
        const bool first = (hh == 0);
#pragma unroll
        for (int g = 0; g < 4; ++g) {
            const float A0 = first ? Ag[g] : pA[g], B0 = first ? Bg[g] : pB[g];
            const float A1 = first ? pA[g] : Ag[g], B1 = first ? pB[g] : Bg[g];
            float hcur = first ? Hrun : (A0 * Hrun + B0), pcur = first ? Prun : Prun * A0;
            Hrun = A1 * (A0 * Hrun + B0) + B1; Prun = Prun * A0 * A1;
#pragma unroll
            for (int i = 0; i < 4; ++i) { hcur = a[4 * g + i] * hcur + bx[4 * g + i]; pcur *= a[4 * g + i];
                const int tg = tok0 + lbase + sgn * (8 * g + 4 * hh + i);
                HL[((size_t)dir * NTOK + tg) * 256 + ch] = hcur; CP[((size_t)dir * NTOK + tg) * 256 + ch] = pcur; }
        }
        if (hh == 0) { RAGA[(c * 2 + dir) * 256 + ch] = Prun; RAGH[(c * 2 + dir) * 256 + ch] = Hrun; }
    }
}

DI void phase_m1(const Params& p, int l, LAS unsigned char* lds, const int tid) {
    const int lane = tid & 63, wid = __builtin_amdgcn_readfirstlane(tid >> 6);
    const char* proj = (const char*)(p.ws + WS_BIG);
    LAS unsigned char* tile = lds;
    LAS unsigned char* wl = lds + M1_TILE_BYTES + wid * M1_WL_BYTES;
    LAS unsigned char* wlp = lds + M1_TILE_BYTES + (wid ^ 1) * M1_WL_BYTES;
    for (int c = blockIdx.x; c < 256; c += gridDim.x) {
        int ln = lane, td = tid; asm volatile("" : "+v"(ln), "+v"(td));
        const int tok0 = c * 32;
        int s0, s1;
        if (c < 128) { s0 = (c >> 3) * 256; s1 = s0 + 256; } else { s0 = 4096 + ((c - 128) >> 5) * 1024; s1 = s0 + 1024; }
        stage_tile<128, 32>(proj, tile, tok0, 0, 2064, 0, 0, NTOK, td);
        __syncthreads();
        m1_gla_wave<0>(p, l, c, wid >> 1, wid & 1, tile, wl, wlp, ln);
        __builtin_amdgcn_sched_barrier(0); asm volatile("" : "+v"(ln), "+v"(td));
        stage_tile<64, 32>(proj, tile, tok0, B_Q, 1104, 0, 0, NTOK, td);
        stage_tile<4, 32>(proj, tile, tok0, B_AF, 1104, 1024, 0, NTOK, td);
        __syncthreads();
        m1_gla_wave<1>(p, l, c, wid >> 1, wid & 1, tile, wl, wlp, ln);
        __builtin_amdgcn_sched_barrier(0); asm volatile("" : "+v"(ln), "+v"(td));
        stage_tile<32, 38>(proj, tile, tok0 - 3, C_X, 528, 0, s0, s1, td);
        __syncthreads();
        m1_rg_wave(p, l, c, wid >> 1, wid & 1, tile, ln);
        __syncthreads();
    }
}

DI void m2_chain4(const Params& p, int l, int id4) {
    const int sq = id4 / 12288; int rem = id4 % 12288;
    int mix, hd, dir, de;
    if (rem < 8192) { mix = 0; hd = rem >> 11; dir = (rem >> 10) & 1; de = (rem & 1023) * 4; }
    else { rem -= 8192; mix = 1; hd = rem >> 10; dir = (rem >> 9) & 1; de = (rem & 511) * 4; }
    const int dk = mix == 0 ? 64 : 32, d = de >> 6;
    float* DS = (float*)(p.ws + (mix == 0 ? WS_DSA : WS_DSB));
    const float* ACH = (const float*)(p.ws + (mix == 0 ? WS_ACHA : WS_ACHB));
    float zf = 0.f; asm volatile("" : "+v"(zf));
    int c0, N; f32x4 S = {zf, zf, zf, zf};
    if (sq < 16) { c0 = sq * 8; N = 8; }
    else { c0 = 128 + (sq - 16) * 32; N = 32; const int b = sq - 16;
        S = mix == 0 ? *(const f32x4*)(p.IN(2) + (size_t)((((b * 2 + l) * 2 + dir) * 4 + hd)) * 4096 + de) : *(const f32x4*)(p.IN(3) + (size_t)((((b * 2 + l) * 2 + dir) * 4 + hd)) * 2048 + de); }
    for (int n0 = 0; n0 < N; n0 += 8) {
        f32x4 v[8]; float av[8];
#pragma unroll
        for (int i = 0; i < 8; ++i) { const int n = n0 + i, c = c0 + (dir == 0 ? n : N - 1 - n); const size_t ui = (size_t)((c * 4 + hd) * 2 + dir);
            v[i] = *(const f32x4*)(DS + ui * (dk * 64) + de); av[i] = ACH[ui * dk + d]; }
#pragma unroll
        for (int i = 0; i < 8; ++i) { const int n = n0 + i, c = c0 + (dir == 0 ? n : N - 1 - n); const size_t ui = (size_t)((c * 4 + hd) * 2 + dir);
            *(f32x4*)(DS + ui * (dk * 64) + de) = S; S = S * av[i] + v[i]; }
    }
    if (sq < 16) { const int b = sq;
        if (mix == 0) *(f32x4*)(p.out + OUT_SH + (size_t)((((b * 2 + l) * 2 + dir) * 4 + hd)) * 4096 + de) = S;
        else *(f32x4*)(p.out + OUT_SG + (size_t)((((b * 2 + l) * 2 + dir) * 4 + hd)) * 2048 + de) = S; }
}
DI void phase_m2(const Params& p, int l, const int tid) {
    const int gt = blockIdx.x * 512 + tid, GT = gridDim.x * 512;
    constexpr int NLAT = 4 * 12288, NCTX = 16 * 12288;
    if (GT >= 2 * NLAT) {
        if (gt < NLAT) m2_chain4(p, l, NCTX + gt);
        else for (int id = gt - NLAT; id < NCTX; id += GT - NLAT) m2_chain4(p, l, id);
    } else {
        for (int id = gt; id < NCTX + NLAT; id += GT) m2_chain4(p, l, id);
    }
    float* RAGH = (float*)(p.ws + WS_RAGH); const float* RAGA = (const float*)(p.ws + WS_RAGA);
    for (int id = GT - 1 - gt; id < 20 * 512; id += GT) {
        const int sq = id / 512, dir = (id >> 8) & 1, ch = id & 255;
        int c0, N; float h = 0.f;
        if (sq < 16) { c0 = sq * 8; N = 8; } else { c0 = 128 + (sq - 16) * 32; N = 32; h = p.IN(4)[((size_t)((sq - 16) * 2 + l) * 2 + dir) * 256 + ch]; }
        for (int n0 = 0; n0 < N; n0 += 8) {
            float v[8], av[8];
#pragma unroll
            for (int i = 0; i < 8; ++i) { const int n = n0 + i, c = c0 + (dir == 0 ? n : N - 1 - n); v[i] = RAGH[(c * 2 + dir) * 256 + ch]; av[i] = RAGA[(c * 2 + dir) * 256 + ch]; }
#pragma unroll
            for (int i = 0; i < 8; ++i) { const int n = n0 + i, c = c0 + (dir == 0 ? n : N - 1 - n); RAGH[(c * 2 + dir) * 256 + ch] = h; h = av[i] * h + v[i]; }
        }
        if (sq < 16) p.out[OUT_SR + ((size_t)(sq * 2 + l) * 2 + dir) * 256 + ch] = h;
    }
}

template <int MIX>
DI void m3_gla_unit(const Params& p, int l, int c, int hd, int lane) {
    constexpr int DK = MIX == 0 ? 64 : 32;
    const int r = lane & 31, hh = lane >> 5, tok0 = c * 32;
    const bf16_t* proj = (const bf16_t*)(p.ws + WS_BIG);
    const float* DS = (const float*)(p.ws + (MIX == 0 ? WS_DSA : WS_DSB));
    const bf16_t* QH = (const bf16_t*)(p.ws + (MIX == 0 ? WS_QHA : WS_QHB));
    const float* oi = (const float*)(p.ws + WS_OI) + (size_t)((MIX * 256 + c) * 4 + hd) * 2048;
    bf16_t* mix = (bf16_t*)(p.ws + WS_HM);
    f32x16 acc[2];
#pragma unroll
    for (int n = 0; n < 2; ++n)
#pragma unroll
        for (int g = 0; g < 4; ++g) { const f32x4 v = *(const f32x4*)(oi + ((n * 4 + g) * 64 + lane) * 4); acc[n][4 * g] = v.x; acc[n][4 * g + 1] = v.y; acc[n][4 * g + 2] = v.z; acc[n][4 * g + 3] = v.w; }
#pragma unroll
    for (int dir = 0; dir < 2; ++dir) {
        const float* sp = DS + (size_t)((c * 4 + hd) * 2 + dir) * (DK * 64);
#pragma unroll
        for (int s = 0; s < DK / 16; ++s) {
            const bf16x8 qf = MIX == 0 ? *(const bf16x8*)(QH + (size_t)(tok0 + r) * 512 + dir * 256 + hd * 64 + 16 * s + 8 * hh)
                                       : *(const bf16x8*)(QH + (size_t)(tok0 + r) * 256 + dir * 128 + hd * 32 + 16 * s + 8 * hh);
#pragma unroll
            for (int n = 0; n < 2; ++n) {
                float sv[8];
#pragma unroll
                for (int j = 0; j < 8; ++j) sv[j] = sp[(16 * s + 8 * hh + j) * 64 + 32 * n + r];
                acc[n] = MFMA32(pack8(sv), qf, acc[n]);
            }
        }
    }
    float ss = 0.f;
#pragma unroll
    for (int n = 0; n < 2; ++n)
#pragma unroll
        for (int i = 0; i < 16; ++i) ss += acc[n][i] * acc[n][i];
    ss += shx(ss, lane, 32);
    const float rstd = rsqrtf(ss * (1.f / 64.f) + 1e-6f);
    const float* gain = (MIX == 0 ? p.IN(14) : p.IN(17)) + l * 256 + hd * 64;
    const bf16_t* grow = proj + (size_t)(tok0 + r) * NP + (MIX == 0 ? A_G : B_G) + hd * 64;
    bf16_t* orow = mix + (size_t)(tok0 + r) * 1024 + MIX * 256 + hd * 64;
#pragma unroll
    for (int n = 0; n < 2; ++n)
#pragma unroll
        for (int g = 0; g < 4; ++g) {
            const int e = 32 * n + 8 * g + 4 * hh;
            const u32x2 gg = *(const u32x2*)(grow + e); const f32x4 gn = *(const f32x4*)(gain + e);
            const float g0 = __uint_as_float(gg.x << 16), g1 = __uint_as_float(gg.x & 0xffff0000u), g2 = __uint_as_float(gg.y << 16), g3 = __uint_as_float(gg.y & 0xffff0000u);
            u32x2 o; o.x = pk2(acc[n][4 * g] * rstd * gn.x * siluf_(g0), acc[n][4 * g + 1] * rstd * gn.y * siluf_(g1));
            o.y = pk2(acc[n][4 * g + 2] * rstd * gn.z * siluf_(g2), acc[n][4 * g + 3] * rstd * gn.w * siluf_(g3));
            *(u32x2*)(orow + e) = o;
        }
}

DI float gelu_tanh(float x) { const float u = 0.7978845608028654f * (x + 0.044715f * x * x * x); const float t = 1.f - 2.f * rcpf_(__expf(2.f * u) + 1.f); return 0.5f * x * (1.f + t); }

DI void phase_m3(const Params& p, int l, const int tid) {
    const int lane = tid & 63, wid = __builtin_amdgcn_readfirstlane(tid >> 6), gw = blockIdx.x * 8 + wid, GW = gridDim.x * 8;
    for (int u = gw; u < 2048; u += GW) {
        const int ty = u & 1, idx = u >> 1, c = idx >> 2, hd = idx & 3;
        int ln = lane; asm volatile("" : "+v"(ln));
        if (ty == 0) m3_gla_unit<0>(p, l, c, hd, ln); else m3_gla_unit<1>(p, l, c, hd, ln);
    }
    const int gt = blockIdx.x * 512 + tid, GT = gridDim.x * 512;
    const bf16_t* proj = (const bf16_t*)(p.ws + WS_BIG);
    bf16_t* mix = (bf16_t*)(p.ws + WS_HM);
    const float* HL = (const float*)(p.ws + WS_HL); const float* CP = (const float*)(p.ws + WS_CP); const float* HIN = (const float*)(p.ws + WS_RAGH);
    for (int id = gt; id < NTOK * 64; id += GT) {
        const int tok = id >> 6, ch = (id & 63) * 4, c = tok >> 5;
        const f32x4 hf = *(const f32x4*)(HL + (size_t)tok * 256 + ch), hb = *(const f32x4*)(HL + ((size_t)NTOK + tok) * 256 + ch);
        const f32x4 cf = *(const f32x4*)(CP + (size_t)tok * 256 + ch), cb = *(const f32x4*)(CP + ((size_t)NTOK + tok) * 256 + ch);
        const f32x4 inf_ = *(const f32x4*)(HIN + (c * 2 + 0) * 256 + ch), inb = *(const f32x4*)(HIN + (c * 2 + 1) * 256 + ch);
        const u32x2 gg = *(const u32x2*)(proj + (size_t)tok * NP + C_G + ch);
        const f32x4 y = hf + cf * inf_ + hb + cb * inb;
        u32x2 o; o.x = pk2(y.x * gelu_tanh(__uint_as_float(gg.x << 16)), y.y * gelu_tanh(__uint_as_float(gg.x & 0xffff0000u)));
        o.y = pk2(y.z * gelu_tanh(__uint_as_float(gg.y << 16)), y.w * gelu_tanh(__uint_as_float(gg.y & 0xffff0000u)));
        *(u32x2*)(mix + (size_t)tok * 1024 + 512 + ch) = o;
    }
    const float* sw = p.IN(25) + l * 3 * 256;
    for (int id = gt; id < NTOK * 64; id += GT) {
        const int tok = id >> 6, ch = (id & 63) * 4;
        const int seg = tok < 4096 ? 256 : 64, pos = tok & (seg - 1);
        f32x4 y = {0.f, 0.f, 0.f, 0.f};
#pragma unroll
        for (int j = 0; j < 3; ++j) {
            const int pp = pos + j - 1;
            if (pp >= 0 && pp < seg) {
                const int tt = tok + j - 1;
                const u32x2 cc = *(const u32x2*)(proj + (size_t)tt * NP + D_C + ch), vv = *(const u32x2*)(proj + (size_t)tt * NP + D_V + ch);
                const f32x4 w = *(const f32x4*)(sw + j * 256 + ch);
                y.x += w.x * __uint_as_float(cc.x << 16) * __uint_as_float(vv.x << 16); y.y += w.y * __uint_as_float(cc.x & 0xffff0000u) * __uint_as_float(vv.x & 0xffff0000u);
                y.z += w.z * __uint_as_float(cc.y << 16) * __uint_as_float(vv.y << 16); y.w += w.w * __uint_as_float(cc.y & 0xffff0000u) * __uint_as_float(vv.y & 0xffff0000u);
            }
        }
        const u32x2 bb = *(const u32x2*)(proj + (size_t)tok * NP + D_B + ch);
        u32x2 o; o.x = pk2(y.x * __uint_as_float(bb.x << 16), y.y * __uint_as_float(bb.x & 0xffff0000u));
        o.y = pk2(y.z * __uint_as_float(bb.y << 16), y.w * __uint_as_float(bb.y & 0xffff0000u));
        *(u32x2*)(mix + (size_t)tok * 1024 + 768 + ch) = o;
    }
}

__global__ void __launch_bounds__(512, 2) fwd_kernel(Params pin) {
    extern __shared__ __attribute__((aligned(16))) unsigned char lds_raw[];
    LAS unsigned char* lds = (LAS unsigned char*)lds_raw;
    cg::grid_group grid = cg::this_grid();
    const int G = gridDim.x, bid = blockIdx.x;
    volatile LAS unsigned* bst = (volatile LAS unsigned*)(lds + LDS_BYTES - 16);
    if (threadIdx.x < 4) bst[threadIdx.x] = 0u;
    __syncthreads();
    const XcdBarrier xbar = xcd_barrier_post((unsigned*)(pin.ws + WS_BAR), bst);
    int nsync = 0;
    for (int ph2 = 2 * pin.ph_lo; ph2 < 2 * pin.ph_hi; ++ph2) {
        const int ph = ph2 >> 1;
        if ((ph2 & 1) && !((REPEAT_MASK >> ph) & 1u)) continue;
        size_t zo = 0; asm volatile("" : "+s"(zo));
        int tid = threadIdx.x; asm volatile("" : "+v"(tid));
        Params p = pin; p.ws += zo; p.out += zo; p.zo = zo;
        const float* mod = (const float*)(p.ws + WS_MOD);
        bf16_t* hm = (bf16_t*)(p.ws + WS_HM); bf16_t* big = (bf16_t*)(p.ws + WS_BIG);
        if (ph == 0) phase_p0(p, lds, tid);
        else if (ph == 19) phase_norm(p, 0, 2, tid);
        else {
            const int l = (ph - 1) / 9, s = (ph - 1) % 9;
            pg8::StaticOrder S;
            if (s == 0) phase_norm(p, l, 0, tid);
            else if (s == 1) { pg8::Gemm g{hm, (const bf16_t*)(p.ws + WS_WIN) + (size_t)l * NP * 1024, NTOK, NP, 1024, 1024}; S.init(NTOK, NP, G, bid);
                pg8::EpiBf16<0> E{big, NP}; pg8::gemm_phase(lds, g, S, E, tid); }
            else if (s == 2) phase_m1(p, l, lds, tid);
            else if (s == 3) phase_m2(p, l, tid);
            else if (s == 4) phase_m3(p, l, tid);
            else if (s == 5) { pg8::Gemm g{hm, (const bf16_t*)(p.ws + WS_WOUT) + (size_t)l * 1024 * 1024, NTOK, 1024, 512, 1024}; S.init(NTOK, 1024, G, bid, 2);
                pg8::EpiResid E{mod + (size_t)l * 5 * 6144 + 2048, (bf16_t*)(p.ws + WS_DSA)}; pg8::gemm_phase(lds, g, S, E, tid); }
            else if (s == 6) phase_norm(p, l, 1, tid);
            else if (s == 7) { pg8::Gemm g{hm, (const bf16_t*)(p.ws + WS_W1) + (size_t)l * 4096 * 1024, NTOK, DFF, 1024, 1024}; S.init(NTOK, DFF, G, bid);
                pg8::EpiBf16<1> E{big, DFF}; pg8::gemm_phase(lds, g, S, E, tid); }
            else { pg8::Gemm g{big, (const bf16_t*)(p.ws + WS_W2) + (size_t)l * 1024 * 4096, NTOK, 1024, 2048, DFF}; S.init(NTOK, 1024, G, bid, 2);
                pg8::EpiResid E{mod + (size_t)l * 5 * 6144 + 5120, (bf16_t*)(p.ws + WS_DSA)}; pg8::gemm_phase(lds, g, S, E, tid); }
        }
        if (ph2 + 2 < 2 * pin.ph_hi || (!(ph2 & 1) && ((REPEAT_MASK >> ph) & 1u))) { if (nsync == 0) grid.sync(); else xcd_barrier(xbar); ++nsync; }
    }
}

extern "C" void kernel_launch(void* const* d_in, const int* in_sizes, int n_in, void* d_out, int out_size, void* d_ws, size_t ws_size, hipStream_t stream) {
    static int grid = 0;
    if (grid == 0) {
        if (n_in != 29 || ws_size < WS_END) { fprintf(stderr, "kernel_launch: unexpected n_in %d / ws %zu\n", n_in, ws_size); grid = -1; return; }
        int dev = 0, cus = 0, per_cu = 0;
        hipGetDevice(&dev); hipDeviceGetAttribute(&cus, hipDeviceAttributeMultiprocessorCount, dev);
        if (hipFuncSetAttribute((const void*)fwd_kernel, hipFuncAttributeMaxDynamicSharedMemorySize, LDS_BYTES) != hipSuccess) { fprintf(stderr, "kernel_launch: hipFuncSetAttribute failed\n"); grid = -1; return; }
        if (hipOccupancyMaxActiveBlocksPerMultiprocessor(&per_cu, (const void*)fwd_kernel, 512, LDS_BYTES) != hipSuccess || per_cu < 1) { fprintf(stderr, "kernel_launch: occupancy query says %d\n", per_cu); per_cu = 1; }
        (void)hipGetLastError();
        grid = cus * 1;
        if (grid <= 0) grid = 256;
    }
    if (grid < 0) return;
    if (hipMemsetAsync((char*)d_ws + WS_BAR, 0, 16384, stream) != hipSuccess) { fprintf(stderr, "kernel_launch: memset failed\n"); return; }
    Params p{};
    for (int i = 0; i < 29; ++i) p.in[i] = (const float*)d_in[i];
    p.out = (float*)d_out; p.ws = (unsigned char*)d_ws;
#if MEGA
    p.ph_lo = 0; p.ph_hi = 20;
    void* args[] = {&p};
    hipError_t e = hipLaunchCooperativeKernel((const void*)fwd_kernel, dim3(grid), dim3(512), args, LDS_BYTES, stream);
    if (e != hipSuccess) fprintf(stderr, "cooperative launch failed: %s (grid %d)\n", hipGetErrorString(e), grid);
#else
    for (int ph = 0; ph < 20; ++ph) { p.ph_lo = ph; p.ph_hi = ph + 1; hipLaunchKernelGGL(fwd_kernel, dim3(grid), dim3(512), LDS_BYTES, stream, p); }
#endif
}
```

```cpp
#include <hip/hip_runtime.h>
#include <hip/hip_cooperative_groups.h>
#include <cstdio>
#include <cstdint>
namespace cg = cooperative_groups;

#ifndef MEGA
#define MEGA 1
#endif
#ifndef REPEAT_MASK
#define REPEAT_MASK 0u
#endif

#define DI __device__ __forceinline__
#define LAS __attribute__((address_space(3)))
typedef unsigned short bf16_t;
typedef short bf16x8 __attribute__((ext_vector_type(8)));
typedef float f32x4 __attribute__((ext_vector_type(4)));
typedef float f32x16 __attribute__((ext_vector_type(16)));
typedef unsigned u32x4 __attribute__((ext_vector_type(4)));
typedef unsigned u32x2 __attribute__((ext_vector_type(2)));
typedef __bf16 bf16x2_t __attribute__((ext_vector_type(2)));
typedef float f32x2_t __attribute__((ext_vector_type(2)));

constexpr int NTOK = 8192, DM = 1024, NP = 3584, DFF = 4096;
constexpr int A_Q = 0, A_I = 256, A_FF = 512, A_FB = 768, A_G = 1024, B_Q = 1280, B_K = 1408, B_V = 1536, B_G = 1792, B_AF = 2048, B_AB = 2064,
              C_X = 2080, C_G = 2336, D_B = 2592, D_C = 2848, D_V = 3104, PW = 3360;
constexpr size_t MiB = 1u << 20;
constexpr size_t WS_WIN = 0, WS_WOUT = 14 * MiB, WS_W1 = 18 * MiB, WS_W2 = 34 * MiB, WS_MOD = 50 * MiB, WS_HM = 51 * MiB, WS_BIG = 67 * MiB,
                 WS_OI = 131 * MiB, WS_DSA = 147 * MiB, WS_DSB = 179 * MiB, WS_QHA = 195 * MiB, WS_QHB = 203 * MiB, WS_HL = 207 * MiB, WS_CP = 223 * MiB,
                 WS_ACHA = 239 * MiB, WS_ACHB = 239 * MiB + 512 * 1024, WS_RAGA = 240 * MiB, WS_RAGH = 240 * MiB + 512 * 1024, WS_BAR = 241 * MiB, WS_END = 242 * MiB;
constexpr int OUT_SH = 8388608, OUT_SG = OUT_SH + 1048576, OUT_SR = OUT_SG + 524288;
constexpr int LDS_BYTES = 147456;

struct Params { const float* in[29]; float* out; unsigned char* ws; size_t zo; int ph_lo, ph_hi;
    DI const float* IN(int i) const { return in[i] + zo; } };

DI float bf2f(bf16_t u) { return __uint_as_float(((unsigned)u) << 16); }
DI unsigned pk2(float lo, float hi) { f32x2_t v = {lo, hi}; bf16x2_t b = __builtin_convertvector(v, bf16x2_t); return __builtin_bit_cast(unsigned, b); }
DI bf16_t f2bf(float x) { return (bf16_t)(pk2(x, 0.f) & 0xffffu); }
DI bf16x8 pack8(const float* v) { u32x4 p; p.x = pk2(v[0], v[1]); p.y = pk2(v[2], v[3]); p.z = pk2(v[4], v[5]); p.w = pk2(v[6], v[7]); return __builtin_bit_cast(bf16x8, p); }
DI float rcpf_(float x) { return __builtin_amdgcn_rcpf(x); }
DI float sigmoidf_(float x) { return rcpf_(1.f + __expf(-x)); }
DI float siluf_(float x) { return x * rcpf_(1.f + __expf(-x)); }
DI float om_exp(float x) { const float s = -x * (1.f + x * 0.5f * (1.f + x * (1.f / 3.f) * (1.f + x * 0.25f * (1.f + x * 0.2f * (1.f + x * (1.f / 6.f)))))); return x > -0.3f ? s : 1.f - __expf(x); }
DI int crow(int reg, int h) { return (reg & 3) + 8 * (reg >> 2) + 4 * h; }
#define MFMA32(a, b, c) __builtin_amdgcn_mfma_f32_32x32x16_bf16((a), (b), (c), 0, 0, 0)
DI f32x16 zero16() { f32x16 z; for (int i = 0; i < 16; ++i) z[i] = 0.f; return z; }
DI float shx(float v, int lane, int m) { return __int_as_float(__builtin_amdgcn_ds_bpermute((lane ^ m) << 2, __float_as_int(v))); }
DI int modrow_of(int row) { return row < 4096 ? 0 : 1 + ((row - 4096) >> 10); }


#define XB_TMO      128
#define XB_XCNT(j)  (256  + 64 * (j))
#define XB_XSUB(j)  (1280 + 64 * (j))
#define XB_XGEN(j)  (2304 + 64 * (j))
#define XB_TOP      3328
#define XB_TOPGEN   3392
#define XCD_BAR_WORDS 3456
#define XB_SPIN_CAP (1u << 18)
DI unsigned xb_ld(unsigned* p)              { return __hip_atomic_load(p, __ATOMIC_RELAXED, __HIP_MEMORY_SCOPE_AGENT); }
DI unsigned xb_add(unsigned* p, unsigned v) { return __hip_atomic_fetch_add(p, v, __ATOMIC_RELAXED, __HIP_MEMORY_SCOPE_AGENT); }
DI unsigned xb_xcc_id() { return (unsigned)__builtin_amdgcn_s_getreg((3 << 11) | 20) & 0xFu; }
#define XB_SPIN(cond, bar) do { unsigned _sp = 0; while (cond) { __builtin_amdgcn_s_sleep(1); \
    if ((++_sp & 255u) == 0u) { if (xb_ld(&(bar)[XB_TMO])) break; if (_sp > XB_SPIN_CAP) { atomicAdd(&(bar)[XB_TMO], 1u); break; } } } } while (0)
struct XcdBarrier { unsigned* bar; unsigned x; volatile LAS unsigned* st; };
DI XcdBarrier xcd_barrier_post(unsigned* bar, volatile LAS unsigned* st) {
    XcdBarrier b; b.bar = bar; b.x = xb_xcc_id(); b.st = st;
    if (threadIdx.x == 0) (void)xb_add(&bar[XB_XCNT(b.x)], 1u);
    return b;
}
DI void xcd_barrier_complete(unsigned* bar, unsigned x, unsigned& nloc, unsigned& nx) {
    const unsigned G = gridDim.x * gridDim.y * gridDim.z;
    unsigned sum, cnt, mine, sp = 0u;
    for (;;) {
        sum = 0u; cnt = 0u; mine = 0u;
#pragma unroll
        for (unsigned j = 0; j < 16; ++j) { const unsigned c = xb_ld(&bar[XB_XCNT(j)]); sum += c; cnt += (c > 0u) ? 1u : 0u; mine = (j == x) ? c : mine; }
        if (sum == G) break;
        __builtin_amdgcn_s_sleep(1);
        if ((++sp & 255u) == 0u) { if (xb_ld(&bar[XB_TMO])) break; if (sp > XB_SPIN_CAP) { atomicAdd(&bar[XB_TMO], 1u); break; } }
    }
    nloc = mine > 0u ? mine : 1u; nx = cnt > 0u ? cnt : 1u;
}
DI void xcd_barrier(const XcdBarrier& b) {
    asm volatile("s_waitcnt vmcnt(0)" ::: "memory");
    __syncthreads();
    if (threadIdx.x == 0) {
        unsigned* bar = b.bar;
        __builtin_amdgcn_s_waitcnt(0);
        unsigned nloc = b.st[0], nx = b.st[1];
        if (nloc == 0u) { xcd_barrier_complete(bar, b.x, nloc, nx); b.st[0] = nloc; b.st[1] = nx; }
        const unsigned old = xb_add(&bar[XB_XSUB(b.x)], 1u);
        const unsigned gen = old / nloc;
        if (old + 1u == (gen + 1u) * nloc) {
            __builtin_amdgcn_fence(__ATOMIC_RELEASE, "agent");
            asm volatile("s_waitcnt vmcnt(0)" ::: "memory");
            const unsigned og = xb_add(&bar[XB_TOP], 1u);
            const unsigned tg = og / nx;
            if (og + 1u == (tg + 1u) * nx) xb_add(&bar[XB_TOPGEN], 1u);
            else XB_SPIN(xb_ld(&bar[XB_TOPGEN]) == tg, bar);
            __builtin_amdgcn_fence(__ATOMIC_ACQUIRE, "agent");
            xb_add(&bar[XB_XGEN(b.x)], 1u);
            asm volatile("s_waitcnt vmcnt(0)" ::: "memory");
        } else {
            XB_SPIN(xb_ld(&bar[XB_XGEN(b.x)]) == gen, bar);
            __builtin_amdgcn_fence(__ATOMIC_ACQUIRE, "agent");
            asm volatile("s_waitcnt vmcnt(0)" ::: "memory");
        }
    }
    __syncthreads();
}

namespace pg8 {
constexpr int BM = 256, BK = 64, HALF = 128, HTB = HALF * BK * 2, NXCD = 8, WGM = 8;
__host__ __device__ __forceinline__ int lds_byte(int r, int c) { const int st = (r >> 4) * 2 + (c >> 5), rr = r & 15, cc = c & 31, ob = rr * 64 + cc * 2; return st * 1024 + (ob ^ (((ob >> 9) & 1) << 5)); }
__host__ __device__ __forceinline__ void stage_rc(int b, int& R, int& C) { const int st = b / 1024, sb = b % 1024, swz = sb ^ (((sb >> 9) & 1) << 5); R = (st >> 1) * 16 + swz / 64; C = (st & 1) * 32 + (swz % 64) / 2; }
__host__ __device__ __forceinline__ int perm32(int rho) { const int n = rho >> 4, i = rho & 15; return 8 * (i >> 2) + 4 * n + (i & 3); }
struct Unit { int pm, pn, pk; };
struct Gemm { const bf16_t* A; const bf16_t* Bt; int M, N, K, lda; };
struct StaticOrder {
    int nM, nN, nwg, G, c, KS;
    __host__ __device__ void init(int M, int N, int G_, int c_, int KS_ = 1) { KS = KS_; nM = M / BM; nN = (N / BM) * KS; nwg = nM * nN; G = G_; c = c_; }
    __host__ __device__ bool next(int i, Unit& u) const {
        const long L = (long)i * G + c; if (L >= nwg) return false;
        int wgid = (int)L; { const int q = nwg / NXCD, r = nwg % NXCD, xcd = wgid % NXCD, off = wgid / NXCD; wgid = (xcd < r ? xcd * (q + 1) : r * (q + 1) + (xcd - r) * q) + off; }
        const int nig = WGM * nN, gid = wgid / nig, fm = gid * WGM, gsz = (nM - fm) < WGM ? (nM - fm) : WGM;
        u.pm = fm + ((wgid % nig) % gsz); const int pv = (wgid % nig) / gsz; u.pn = pv / KS; u.pk = pv % KS; return true;
    }
};
template <class Epi>
__device__ __forceinline__ void gemm_phase(LAS unsigned char* lds, const Gemm g, const StaticOrder& S, const Epi& E, const int tid) {
    const int wid = __builtin_amdgcn_readfirstlane(tid >> 6), lane = tid & 63, wr = wid >> 2, wc = wid & 3, fr = lane & 15, fq = lane >> 4;
    const int K = g.lda, nt = g.K / BK;
    unsigned voffA[2], voffB[2];
#pragma unroll
    for (int i = 0; i < 2; ++i) { int R, C; stage_rc(tid * 16 + i * 8192, R, C); const int Rb = (R & ~31) + perm32(R & 31);
        voffA[i] = (unsigned)(R * K + C) * 2u; voffB[i] = (unsigned)(Rb * K + C) * 2u; }
    const size_t kstep = (size_t)(BK * 2);
    const size_t hstep = (size_t)HALF * K * 2;
    const size_t tstep = 2 * hstep;
    const unsigned ldsw = (unsigned)wid * 1024u;
    const int aoff = lds_byte(wr * 64 + fr, fq * 8), boff = lds_byte(wc * 32 + fr, fq * 8);
#define PG8_SA(b, h) (((b) * 2 + (h)) * HTB)
#define PG8_SB(b, h) ((4 + (b) * 2 + (h)) * HTB)
#define PG8_STAGE(bufoff, gbase, voff) do { _Pragma("unroll") for (int _i = 0; _i < 2; ++_i) \
        __builtin_amdgcn_global_load_lds((const unsigned*)((const char*)(gbase) + (voff)[_i]), (LAS unsigned*)(lds + (bufoff) + ldsw + _i * 8192), 16, 0, 0); } while (0)
#define PG8_LDA(dst, b, h) do { _Pragma("unroll") for (int m = 0; m < 4; ++m) _Pragma("unroll") for (int k = 0; k < 2; ++k) dst[m][k] = *(const LAS bf16x8*)(lds + PG8_SA(b, h) + aoff + m * 2048 + k * 1024); } while (0)
#define PG8_LDB(dst, b, h) do { _Pragma("unroll") for (int n = 0; n < 2; ++n) _Pragma("unroll") for (int k = 0; k < 2; ++k) dst[n][k] = *(const LAS bf16x8*)(lds + PG8_SB(b, h) + boff + n * 2048 + k * 1024); } while (0)
#define PG8_MMA(ai, bj, At, Bt) do { __builtin_amdgcn_s_setprio(1); _Pragma("unroll") for (int m = 0; m < 4; ++m) _Pragma("unroll") for (int n = 0; n < 2; ++n) _Pragma("unroll") for (int k = 0; k < 2; ++k) \
        acc[ai][bj][m][n] = __builtin_amdgcn_mfma_f32_16x16x32_bf16(Bt[n][k], At[m][k], acc[ai][bj][m][n], 0, 0, 0); __builtin_amdgcn_s_setprio(0); } while (0)
#define PG8_WAIT_V(n) asm volatile("s_waitcnt vmcnt(" #n ")" ::: "memory")
#define PG8_WAIT_L(n) asm volatile("s_waitcnt lgkmcnt(" #n ")" ::: "memory")
#define PG8_BAR __builtin_amdgcn_s_barrier()
#define PG8_SCHED __builtin_amdgcn_sched_barrier(0)
    Unit cur, nxt; int ui = 0;
    if (!S.next(0, cur)) return;
    f32x4 acc[2][2][4][2];
#pragma unroll
    for (int a = 0; a < 2; ++a)
#pragma unroll
        for (int b = 0; b < 2; ++b)
#pragma unroll
            for (int m = 0; m < 4; ++m)
#pragma unroll
                for (int n = 0; n < 2; ++n) acc[a][b][m][n] = (f32x4){0.f, 0.f, 0.f, 0.f};
    bf16x8 At[4][2], B0[2][2], B1[2][2];
    const size_t ksplit = (size_t)g.K * 2;
    const char* cA = (const char*)g.A + (size_t)cur.pm * tstep + cur.pk * ksplit; const char* cB = (const char*)g.Bt + (size_t)cur.pn * tstep + cur.pk * ksplit;
    PG8_STAGE(PG8_SB(0, 0), cB, voffB); PG8_STAGE(PG8_SA(0, 0), cA, voffA); PG8_STAGE(PG8_SB(0, 1), cB + hstep, voffB); PG8_STAGE(PG8_SA(0, 1), cA + hstep, voffA);
    if (wr == 1) PG8_BAR;
    PG8_WAIT_V(4); PG8_BAR;
    PG8_STAGE(PG8_SB(1, 0), cB + kstep, voffB); PG8_STAGE(PG8_SA(1, 0), cA + kstep, voffA); PG8_STAGE(PG8_SB(1, 1), cB + hstep + kstep, voffB);
    PG8_WAIT_V(6); PG8_BAR;
    for (;;) {
        const bool has_next = S.next(ui + 1, nxt);
        const char* nA = has_next ? (const char*)g.A + (size_t)nxt.pm * tstep + nxt.pk * ksplit : cA; const char* nB = has_next ? (const char*)g.Bt + (size_t)nxt.pn * tstep + nxt.pk * ksplit : cB;
        for (int t = 0; t < nt; t += 2) {
            const bool last = (t == nt - 2);
            const char* a1 = cA + (size_t)(t + 1) * kstep;
            const char* a2 = last ? nA : cA + (size_t)(t + 2) * kstep; const char* b2 = last ? nB : cB + (size_t)(t + 2) * kstep;
            const char* a3 = a2 + kstep; const char* b3 = b2 + kstep;
            PG8_LDB(B0, 0, 0); PG8_SCHED; PG8_LDA(At, 0, 0); PG8_STAGE(PG8_SA(1, 1), a1 + hstep, voffA);
            PG8_WAIT_L(8); PG8_BAR; PG8_WAIT_L(0); PG8_MMA(0, 0, At, B0); PG8_BAR; PG8_SCHED;
            PG8_LDB(B1, 0, 1); PG8_STAGE(PG8_SB(0, 0), b2, voffB);
            PG8_BAR; PG8_WAIT_L(0); PG8_MMA(0, 1, At, B1); PG8_BAR;
            PG8_LDA(At, 0, 1); PG8_STAGE(PG8_SA(0, 0), a2, voffA);
            PG8_BAR; PG8_WAIT_L(0); PG8_MMA(1, 0, At, B0); PG8_BAR; PG8_SCHED;
            PG8_STAGE(PG8_SB(0, 1), b2 + hstep, voffB);
            PG8_WAIT_V(6); PG8_BAR; PG8_MMA(1, 1, At, B1); PG8_BAR;
            PG8_LDB(B0, 1, 0); PG8_SCHED; PG8_LDA(At, 1, 0); PG8_STAGE(PG8_SA(0, 1), a2 + hstep, voffA);
            PG8_WAIT_L(8); PG8_BAR; PG8_WAIT_L(0); PG8_MMA(0, 0, At, B0); PG8_BAR; PG8_SCHED;
            PG8_LDB(B1, 1, 1); PG8_STAGE(PG8_SB(1, 0), b3, voffB);
            PG8_BAR; PG8_WAIT_L(0); PG8_MMA(0, 1, At, B1); PG8_BAR;
            PG8_LDA(At, 1, 1); PG8_STAGE(PG8_SA(1, 0), a3, voffA);
            PG8_BAR; PG8_WAIT_L(0); PG8_MMA(1, 0, At, B0); PG8_BAR; PG8_SCHED;
            PG8_STAGE(PG8_SB(1, 1), b3 + hstep, voffB);
            PG8_WAIT_V(6); PG8_BAR; PG8_MMA(1, 1, At, B1); PG8_BAR;
        }
        E(acc, cur, wr, wc, fr, fq);
        if (!has_next) break;
#pragma unroll
        for (int a = 0; a < 2; ++a)
#pragma unroll
            for (int b = 0; b < 2; ++b)
#pragma unroll
                for (int m = 0; m < 4; ++m)
#pragma unroll
                    for (int n = 0; n < 2; ++n) acc[a][b][m][n] = (f32x4){0.f, 0.f, 0.f, 0.f};
        cur = nxt; cA = nA; cB = nB; ++ui;
    }
    PG8_WAIT_V(0);
    if (wr == 0) PG8_BAR;
    PG8_BAR;
#undef PG8_SA
#undef PG8_SB
#undef PG8_STAGE
#undef PG8_LDA
#undef PG8_LDB
#undef PG8_MMA
#undef PG8_WAIT_V
#undef PG8_WAIT_L
#undef PG8_BAR
#undef PG8_SCHED
}

template <int ACT> struct EpiBf16 {
    bf16_t* O; int ldc;
    __device__ __forceinline__ void operator()(const f32x4 (&acc)[2][2][4][2], const Unit& u, int wr, int wc, int fr, int fq) const {
        const int row0 = u.pm * BM + wr * 64 + fr, col0 = u.pn * BM + wc * 32 + 8 * fq;
#pragma unroll
        for (int ai = 0; ai < 2; ++ai)
#pragma unroll
            for (int m = 0; m < 4; ++m) { bf16_t* rowp = O + (size_t)(row0 + ai * HALF + m * 16) * ldc + col0;
#pragma unroll
                for (int bj = 0; bj < 2; ++bj) { f32x4 v0 = acc[ai][bj][m][0], v1 = acc[ai][bj][m][1];
                    if (ACT == 1) {
#pragma unroll
                        for (int q = 0; q < 4; ++q) { float a = fmaxf(v0[q], 0.f), b = fmaxf(v1[q], 0.f); v0[q] = a * a; v1[q] = b * b; } }
                    u32x4 w; w.x = pk2(v0[0], v0[1]); w.y = pk2(v0[2], v0[3]); w.z = pk2(v1[0], v1[1]); w.w = pk2(v1[2], v1[3]);
                    *(u32x4*)(rowp + bj * HALF) = w; } }
    }
};
struct EpiResid {
    const float* gate; bf16_t* pb;
    __device__ __forceinline__ void operator()(const f32x4 (&acc)[2][2][4][2], const Unit& u, int wr, int wc, int fr, int fq) const {
        const int rowb = u.pm * BM; const float* gp = gate + modrow_of(rowb) * 6144;
        const int row0 = rowb + wr * 64 + fr, col0 = u.pn * BM + wc * 32 + 8 * fq;
        bf16_t* pbk = pb + (size_t)u.pk * ((size_t)NTOK * 1024);
        f32x4 gv[2][2];
#pragma unroll
        for (int bj = 0; bj < 2; ++bj)
#pragma unroll
            for (int n = 0; n < 2; ++n) gv[bj][n] = *(const f32x4*)(gp + col0 + bj * HALF + 4 * n);
#pragma unroll
        for (int ai = 0; ai < 2; ++ai)
#pragma unroll
            for (int m = 0; m < 4; ++m) { const size_t ro = (size_t)(row0 + ai * HALF + m * 16) * 1024 + col0;
#pragma unroll
                for (int bj = 0; bj < 2; ++bj) { const f32x4 v0 = gv[bj][0] * acc[ai][bj][m][0], v1 = gv[bj][1] * acc[ai][bj][m][1];
                    u32x4 w; w.x = pk2(v0[0], v0[1]); w.y = pk2(v0[2], v0[3]); w.z = pk2(v1[0], v1[1]); w.w = pk2(v1[2], v1[3]);
                    *(u32x4*)(pbk + ro + bj * HALF) = w; } }
    }
};
}

DI void transpose_unit(const float* __restrict__ W, int K, int N, int Npad, bf16_t* WT, int unit, int lane, LAS unsigned char* scr) {
    const int nblk = Npad / 64, kb = unit / nblk, nb = unit % nblk, n = nb * 64 + lane, k0 = kb * 64;
    u32x4 o[8];
    if (n < N) {
        float v[64];
#pragma unroll
        for (int kk = 0; kk < 64; ++kk) v[kk] = W[(size_t)(k0 + kk) * N + n];
#pragma unroll
        for (int q = 0; q < 8; ++q) { o[q].x = pk2(v[8 * q], v[8 * q + 1]); o[q].y = pk2(v[8 * q + 2], v[8 * q + 3]); o[q].z = pk2(v[8 * q + 4], v[8 * q + 5]); o[q].w = pk2(v[8 * q + 6], v[8 * q + 7]); }
    } else {
#pragma unroll
        for (int q = 0; q < 8; ++q) o[q] = (u32x4){0u, 0u, 0u, 0u};
    }
#pragma unroll
    for (int q = 0; q < 8; ++q) *(LAS u32x4*)(scr + lane * 144 + q * 16) = o[q];
    __builtin_amdgcn_fence(__ATOMIC_RELEASE, "wavefront"); __builtin_amdgcn_wave_barrier();
    const int ch = lane & 7, rb = lane >> 3;
#pragma unroll
    for (int j = 0; j < 8; ++j) { const int row = rb + 8 * j; const u32x4 w = *(const LAS u32x4*)(scr + row * 144 + ch * 16);
        *(u32x4*)(WT + (size_t)(nb * 64 + row) * K + k0 + ch * 8) = w; }
    __builtin_amdgcn_fence(__ATOMIC_RELEASE, "wavefront"); __builtin_amdgcn_wave_barrier();
}

DI void phase_p0(const Params& p, LAS unsigned char* lds, const int tid) {
    const int lane = tid & 63, wid = tid >> 6, G = gridDim.x, bid = blockIdx.x;
    const float* c = p.IN(5); const float* c_ctx = p.IN(6); const float* ada_w = p.IN(9); const float* ada_b = p.IN(10);
    float* mod = (float*)(p.ws + WS_MOD);
    LAS float* st = (LAS float*)lds + wid * 640;
    LAS float* red = (LAS float*)(lds + 32768);
    for (int bu = bid; bu < 192; bu += G) {
        const int l = bu / 96, cgp = bu % 96, col = cgp * 64 + lane;
        for (int i = lane; i < 640; i += 64) { const int row = i / 128, k = wid * 128 + (i % 128); const float cv = row == 0 ? c_ctx[k] : c[(row - 1) * 1024 + k]; st[i] = siluf_(cv); }
        __syncthreads();
        float acc[5] = {0.f, 0.f, 0.f, 0.f, 0.f};
        const float* W = ada_w + (size_t)l * 1024 * 6144 + (size_t)(wid * 128) * 6144 + col;
#pragma unroll 16
        for (int kk = 0; kk < 128; ++kk) { const float w = W[(size_t)kk * 6144];
#pragma unroll
            for (int row = 0; row < 5; ++row) acc[row] += st[row * 128 + kk] * w; }
#pragma unroll
        for (int row = 0; row < 5; ++row) red[(wid * 5 + row) * 64 + lane] = acc[row];
        __syncthreads();
        if (tid < 320) { const int row = tid / 64, ln = tid % 64; float s = 0.f;
#pragma unroll
            for (int w = 0; w < 8; ++w) s += red[(w * 5 + row) * 64 + ln];
            const int cc = cgp * 64 + ln; mod[(l * 5 + row) * 6144 + cc] = s + ada_b[l * 6144 + cc]; }
        __syncthreads();
    }
    const int gw = bid * 8 + wid, GW = G * 8;
    LAS unsigned char* scr = lds + 65536 + wid * 9216;
    for (int u = gw; u < 6400; u += GW) {
        const int l = u / 3200; int r = u % 3200;
        if (r < 896) transpose_unit(p.IN(11) + (size_t)l * 1024 * PW, 1024, PW, NP, (bf16_t*)(p.ws + WS_WIN) + (size_t)l * NP * 1024, r, lane, scr);
        else if (r < 1152) transpose_unit(p.IN(12) + (size_t)l * 1024 * 1024, 1024, 1024, 1024, (bf16_t*)(p.ws + WS_WOUT) + (size_t)l * 1024 * 1024, r - 896, lane, scr);
        else if (r < 2176) transpose_unit(p.IN(26) + (size_t)l * 1024 * 4096, 1024, 4096, 4096, (bf16_t*)(p.ws + WS_W1) + (size_t)l * 4096 * 1024, r - 1152, lane, scr);
        else transpose_unit(p.IN(27) + (size_t)l * 4096 * 1024, 4096, 1024, 1024, (bf16_t*)(p.ws + WS_W2) + (size_t)l * 1024 * 4096, r - 2176, lane, scr);
    }
}

DI void phase_norm(const Params& p, int l, int which, const int tid) {
    const int lane = tid & 63, wid = tid >> 6, gw = blockIdx.x * 8 + wid, GW = gridDim.x * 8;
    const float* mod = (const float*)(p.ws + WS_MOD);
    bf16_t* hm = (bf16_t*)(p.ws + WS_HM);
    const float* g = which == 0 ? p.IN(7) + l * 1024 : (which == 1 ? p.IN(8) + l * 1024 : p.IN(28));
    const bool first = (which == 0 && l == 0), from_in = (l == 0 && which != 2);
    for (int row0 = gw; row0 < NTOK; row0 += 4 * GW) {
        f32x4 v[4][4]; float ss[4];
#pragma unroll
        for (int k = 0; k < 4; ++k) {
            const int row = row0 + k * GW; ss[k] = 0.f;
            if (row < NTOK) {
                const float* xr = from_in ? (row < 4096 ? p.IN(0) + (size_t)row * 1024 : p.IN(1) + (size_t)(row - 4096) * 1024) : p.out + (size_t)row * 1024;
#pragma unroll
                for (int j = 0; j < 4; ++j) v[k][j] = ((const f32x4*)xr)[lane + 64 * j];
                if (!first) {
                    const bf16_t* pr = (const bf16_t*)(p.ws + WS_DSA) + (size_t)row * 1024;
#pragma unroll
                    for (int j = 0; j < 4; ++j) { const u32x2 pp = ((const u32x2*)pr)[lane + 64 * j], pq = ((const u32x2*)(pr + (size_t)NTOK * 1024))[lane + 64 * j];
                        v[k][j].x += __uint_as_float(pp.x << 16) + __uint_as_float(pq.x << 16); v[k][j].y += __uint_as_float(pp.x & 0xffff0000u) + __uint_as_float(pq.x & 0xffff0000u);
                        v[k][j].z += __uint_as_float(pp.y << 16) + __uint_as_float(pq.y << 16); v[k][j].w += __uint_as_float(pp.y & 0xffff0000u) + __uint_as_float(pq.y & 0xffff0000u); }
                }
            }
        }
#pragma unroll
        for (int k = 0; k < 4; ++k) {
            const int row = row0 + k * GW;
            if (row < NTOK) {
#pragma unroll
                for (int j = 0; j < 4; ++j) ss[k] += (v[k][j].x * v[k][j].x + v[k][j].y * v[k][j].y) + (v[k][j].z * v[k][j].z + v[k][j].w * v[k][j].w);
            }
        }
#pragma unroll
        for (int o = 1; o < 64; o <<= 1) {
#pragma unroll
            for (int k = 0; k < 4; ++k) ss[k] += shx(ss[k], lane, o);
        }
#pragma unroll
        for (int k = 0; k < 4; ++k) {
            const int row = row0 + k * GW;
            if (row < NTOK) {
                const float rstd = rsqrtf(ss[k] * (1.f / 1024.f) + 1e-6f);
                if (which == 2) {
                    float* yo = p.out + (size_t)row * 1024;
#pragma unroll
                    for (int j = 0; j < 4; ++j) { const f32x4 gv = ((const f32x4*)g)[lane + 64 * j]; ((f32x4*)yo)[lane + 64 * j] = v[k][j] * rstd * gv; }
                } else {
                    const float* mr = mod + (size_t)(l * 5 + modrow_of(row)) * 6144 + (which == 0 ? 0 : 3072);
#pragma unroll
                    for (int j = 0; j < 4; ++j) { const f32x4 gv = ((const f32x4*)g)[lane + 64 * j]; const f32x4 sh = ((const f32x4*)mr)[lane + 64 * j], sc = ((const f32x4*)(mr + 1024))[lane + 64 * j];
                        const f32x4 hv = v[k][j] * rstd * gv * (sc + 1.f) + sh;
                        u32x2 o; o.x = pk2(hv.x, hv.y); o.y = pk2(hv.z, hv.w);
                        ((u32x2*)(hm + (size_t)row * 1024))[lane + 64 * j] = o;
                        if (!first) ((f32x4*)(p.out + (size_t)row * 1024))[lane + 64 * j] = v[k][j]; }
                }
            }
        }
    }
}

constexpr int M1_TILE_BYTES = 66048, M1_WL_BYTES = 9216;
template <int NCOL8, int NROWS>
DI void stage_tile(const char* proj, LAS unsigned char* tile, int row_first, int col0, int pitchB, int dstB, int s0, int s1, int tid) {
    constexpr int NCH = NCOL8 * NROWS, IT = (NCH + 511) / 512;
    u32x4 v[IT];
#pragma unroll
    for (int i = 0; i < IT; ++i) { const int id = tid + 512 * i; const int row = id / NCOL8, cc = id % NCOL8, t = row_first + row;
        v[i] = (u32x4){0u, 0u, 0u, 0u};
        if (id < NCH && t >= s0 && t < s1) v[i] = *(const u32x4*)(proj + ((size_t)t * NP + col0 + cc * 8) * 2); }
#pragma unroll
    for (int i = 0; i < IT; ++i) { const int id = tid + 512 * i; const int row = id / NCOL8, cc = id % NCOL8;
        if (id < NCH) *(LAS u32x4*)(tile + row * pitchB + dstB + cc * 16) = v[i]; }
}

template <int MIX>
DI void m1_gla_wave(const Params& p, int l, int c, int hd, int dir, const LAS unsigned char* tile, LAS unsigned char* wl, const LAS unsigned char* wlp, int lane) {
    constexpr int DK = MIX == 0 ? 64 : 32, NT = DK / 32, PITCH = DK + 8, TP = MIX == 0 ? 1032 : 552;
    const int r = lane & 31, hh = lane >> 5, tok0 = c * 32;
    const LAS bf16_t* T = (const LAS bf16_t*)tile;
    LAS bf16_t* Qt = (LAS bf16_t*)wl; LAS bf16_t* Kt = Qt + 32 * PITCH;
    char* DS = (char*)(p.ws + (MIX == 0 ? WS_DSA : WS_DSB));
    float* ACH = (float*)(p.ws + (MIX == 0 ? WS_ACHA : WS_ACHB));
    char* QH = (char*)(p.ws + (MIX == 0 ? WS_QHA : WS_QHB));
    float* OI = (float*)(p.ws + WS_OI);
    const int tba = 4 * hh * TP, tb = tba + r;
#define TROW(li) ((8 * ((li) >> 2) + ((li) & 3)) * TP)
    const int vcol = MIX == 0 ? 256 + hd * 64 : 256 + hd * 64;
    bf16x8 vf[2][2];
#pragma unroll
    for (int n = 0; n < 2; ++n)
#pragma unroll
        for (int st = 0; st < 2; ++st)
#pragma unroll
            for (int j = 0; j < 8; ++j) vf[n][st][j] = (short)T[tb + TROW(8 * st + j) + vcol + 32 * n];
    const int qcol = MIX == 0 ? hd * 64 : hd * 32;
#pragma unroll 1
    for (int m = 0; m < NT; ++m) {
        float la[16], kk[16];
        if (MIX == 0) {
            const int zcol = (dir == 0 ? 512 : 768) + hd * 64 + 32 * m;
            const float* lbl = p.IN(13);
            float lb = 0.f;
            if (l == 1) { const int ch = hd * 64 + 32 * m + r; const float l0 = lbl[(0 * 2 + dir) * 256 + ch], l1 = lbl[(1 * 2 + dir) * 256 + ch]; lb = rcpf_(1.f + __expf(l0 - l1)); }
#pragma unroll
            for (int li = 0; li < 16; ++li) { const float z = bf2f(T[tb + TROW(li) + zcol]);
                const float e = __expf(-z), sg = rcpf_(1.f + e), omsg = e * sg;
                const float f = lb + (1.f - lb) * sg; kk[li] = (1.f - lb) * omsg; la[li] = __logf(fmaxf(f, 1e-20f)); }
        } else {
            const int kcol = 128 + hd * 32, acol = 512 + dir * 16;
            float w2[16];
#pragma unroll
            for (int rho = 0; rho < 16; ++rho) w2[rho] = p.IN(15)[((l * 2 + dir) * 16 + rho) * 128 + hd * 32 + r];
            const float ba = p.IN(16)[(l * 2 + dir) * 128 + hd * 32 + r];
#pragma unroll
            for (int li = 0; li < 16; ++li) {
                const u32x4 a0 = *(const LAS u32x4*)(T + tba + TROW(li) + acol), a1 = *(const LAS u32x4*)(T + tba + TROW(li) + acol + 8);
                float w = ba;
#pragma unroll
                for (int qd = 0; qd < 4; ++qd) { w += __uint_as_float(a0[qd] << 16) * w2[2 * qd] + __uint_as_float(a0[qd] & 0xffff0000u) * w2[2 * qd + 1];
                    w += __uint_as_float(a1[qd] << 16) * w2[8 + 2 * qd] + __uint_as_float(a1[qd] & 0xffff0000u) * w2[8 + 2 * qd + 1]; }
                const float ls = fminf(w, 0.f) - __logf(1.f + __expf(-fabsf(w)));
                la[li] = ls * (1.f / 16.f);
                kk[li] = bf2f(T[tb + TROW(li) + kcol]);
            }
        }
        float gs[4], pgs[4];
#pragma unroll
        for (int g = 0; g < 4; ++g) { gs[g] = (la[4 * g] + la[4 * g + 1]) + (la[4 * g + 2] + la[4 * g + 3]); pgs[g] = shx(gs[g], lane, 32); }
        float run = 0.f, half = 0.f; float cum[16];
#pragma unroll
        for (int g = 0; g < 4; ++g) { float b = run + (hh ? pgs[g] : 0.f); run += gs[g] + pgs[g]; if (g == 1) half = run;
#pragma unroll
            for (int i = 0; i < 4; ++i) { b += la[4 * g + i]; cum[4 * g + i] = b; } }
        const float total = run;
        const float ref = dir == 0 ? half : total - half;
        float kh[16];
        const unsigned qhb = MIX == 0 ? (unsigned)((tok0 + 4 * hh) * 512 + dir * 256 + hd * 64 + 32 * m + r) * 2u : (unsigned)((tok0 + 4 * hh) * 256 + dir * 128 + hd * 32 + r) * 2u;
#pragma unroll
        for (int li = 0; li < 16; ++li) {
            const float cv = dir == 0 ? cum[li] : (total - cum[li] + la[li]);
            const float eq = __expf(fminf(cv - ref, 80.f)), ek = __expf(fminf(ref - cv, 80.f));
            const int tkl = 8 * (li >> 2) + (li & 3);
            const float qv = bf2f(T[tb + TROW(li) + qcol + 32 * m]) * (MIX == 1 ? 0.17677669529663687f : 1.f);
            Qt[(tkl + 4 * hh) * PITCH + 32 * m + r] = f2bf(qv * eq);
            Kt[(tkl + 4 * hh) * PITCH + 32 * m + r] = f2bf(kk[li] * ek);
            kh[li] = kk[li] * __expf(total - cv);
            const float qh = qv * __expf(cv);
            *(bf16_t*)(QH + (qhb + (unsigned)(tkl * (MIX == 0 ? 512 : 256) * 2))) = f2bf(qh);
        }
        const bf16x8 khat0 = pack8(kh), khat1 = pack8(kh + 8);
        if (hh == 0) ACH[((c * 4 + hd) * 2 + dir) * DK + 32 * m + r] = __expf(total);
#pragma unroll
        for (int n = 0; n < 2; ++n) {
            f32x16 ds = zero16();
            ds = MFMA32(khat0, vf[n][0], ds); ds = MFMA32(khat1, vf[n][1], ds);
            const unsigned dsb = (unsigned)(((c * 4 + hd) * 2 + dir) * (DK * 64) * 2) + (unsigned)((n * (DK / 16) + 2 * m) * 1024 + r * 16 + hh * 8);
#pragma unroll
            for (int g = 0; g < 4; ++g) { u32x2 w; w.x = pk2(ds[4 * g], ds[4 * g + 1]); w.y = pk2(ds[4 * g + 2], ds[4 * g + 3]);
                *(u32x2*)(DS + (dsb + (unsigned)((g >> 1) * 1024 + (g & 1) * 512))) = w; }
        }
    }
#undef TROW
    __builtin_amdgcn_fence(__ATOMIC_RELEASE, "wavefront");
    __builtin_amdgcn_wave_barrier();
    f32x16 pt = zero16();
#pragma unroll
    for (int s = 0; s < DK / 16; ++s) {
        const bf16x8 kfr = *(const LAS bf16x8*)(Kt + r * PITCH + 16 * s + 8 * hh);
        const bf16x8 qfr = *(const LAS bf16x8*)(Qt + r * PITCH + 16 * s + 8 * hh);
        pt = MFMA32(kfr, qfr, pt);
    }
    __builtin_amdgcn_fence(__ATOMIC_RELEASE, "wavefront");
    __builtin_amdgcn_wave_barrier();
    LAS float* ex = (LAS float*)wl; const LAS float* exp_ = (const LAS float*)wlp;
#pragma unroll
    for (int i = 0; i < 16; ++i) { const int srow = crow(i, hh); const bool keep = dir == 0 ? (srow <= r) : (srow >= r); pt[i] = keep ? pt[i] : 0.f; ex[i * 64 + lane] = pt[i]; }
    __syncthreads();
    float ptv[16];
#pragma unroll
    for (int i = 0; i < 16; ++i) ptv[i] = pt[i] + exp_[i * 64 + lane];
    const bf16x8 pf0 = pack8(ptv), pf1 = pack8(ptv + 8);
    float* oi = OI + (size_t)((MIX * 256 + c) * 4 + hd) * 2048;
    {
        f32x16 ot = zero16();
        const bf16x8 va = dir == 0 ? vf[0][0] : vf[1][0], vb = dir == 0 ? vf[0][1] : vf[1][1];
        ot = MFMA32(va, pf0, ot); ot = MFMA32(vb, pf1, ot);
#pragma unroll
        for (int g = 0; g < 4; ++g) *(f32x4*)(oi + ((dir * 4 + g) * 64 + lane) * 4) = (f32x4){ot[4 * g], ot[4 * g + 1], ot[4 * g + 2], ot[4 * g + 3]};
    }
}

DI void m1_rg_wave(const Params& p, int l, int c, int nb, int dir, const LAS unsigned char* tile, int lane) {
    constexpr int TP = 264;
    const int r = lane & 31, hh = lane >> 5, tok0 = c * 32;
    const LAS bf16_t* T = (const LAS bf16_t*)tile;
    float* HL = (float*)(p.ws + WS_HL); float* CP = (float*)(p.ws + WS_CP);
    float* RAGA = (float*)(p.ws + WS_RAGA); float* RAGH = (float*)(p.ws + WS_RAGH);
    const int sgn = dir ? -1 : 1, lbase = dir ? 31 : 0;
    const float* cw = p.IN(18) + (size_t)(l * 2 + dir) * 4 * 256;
    const float* cb = p.IN(19) + (size_t)(l * 2 + dir) * 256;
    bf16x8 af[4];
    const int trow = lbase + sgn * r + 3;
#pragma unroll
    for (int s = 0; s < 4; ++s) {
        const int ch0 = 64 * nb + 16 * s + 8 * hh;
        float xc[8];
        { const f32x4 b0 = *(const f32x4*)(cb + ch0), b1 = *(const f32x4*)(cb + ch0 + 4);
          xc[0] = b0.x; xc[1] = b0.y; xc[2] = b0.z; xc[3] = b0.w; xc[4] = b1.x; xc[5] = b1.y; xc[6] = b1.z; xc[7] = b1.w; }
#pragma unroll
        for (int tap = 0; tap < 4; ++tap) {
            const u32x4 uu = *(const LAS u32x4*)(T + (trow + sgn * (tap - 3)) * TP + ch0);
            const f32x4 w0 = *(const f32x4*)(cw + tap * 256 + ch0), w1 = *(const f32x4*)(cw + tap * 256 + ch0 + 4);
            xc[0] += w0.x * __uint_as_float(uu.x << 16); xc[1] += w0.y * __uint_as_float(uu.x & 0xffff0000u);
            xc[2] += w0.z * __uint_as_float(uu.y << 16); xc[3] += w0.w * __uint_as_float(uu.y & 0xffff0000u);
            xc[4] += w1.x * __uint_as_float(uu.z << 16); xc[5] += w1.y * __uint_as_float(uu.z & 0xffff0000u);
            xc[6] += w1.z * __uint_as_float(uu.w << 16); xc[7] += w1.w * __uint_as_float(uu.w & 0xffff0000u);
        }
        af[s] = pack8(xc);
    }
    const float* wr_ = p.IN(20) + (size_t)((l * 2 + dir) * 4 + nb) * 4096;
    const float* wi_ = p.IN(22) + (size_t)((l * 2 + dir) * 4 + nb) * 4096;
#pragma unroll 1
    for (int n = 0; n < 2; ++n) {
        f32x16 rr = zero16(), ri = zero16();
#pragma unroll
        for (int s = 0; s < 4; ++s) {
            float br_[8], bi_[8];
#pragma unroll
            for (int j = 0; j < 8; ++j) { br_[j] = wr_[(16 * s + 8 * hh + j) * 64 + 32 * n + r]; bi_[j] = wi_[(16 * s + 8 * hh + j) * 64 + 32 * n + r]; }
            rr = MFMA32(af[s], pack8(br_), rr); ri = MFMA32(af[s], pack8(bi_), ri);
        }
        const int ch = 64 * nb + 32 * n + r;
        const float cbv = cb[ch]; float cwv[4];
#pragma unroll
        for (int tap = 0; tap < 4; ++tap) cwv[tap] = cw[tap * 256 + ch];
        const float brv = p.IN(21)[(l * 2 + dir) * 256 + ch], biv = p.IN(23)[(l * 2 + dir) * 256 + ch];
        const float lam = p.IN(24)[(l * 2 + dir) * 256 + ch];
        const float c8 = -8.f * log1pf(__expf(-lam));
        float a[16], bx[16];
#pragma unroll
        for (int li = 0; li < 16; ++li) {
            const int tr = lbase + sgn * (8 * (li >> 2) + 4 * hh + (li & 3)) + 3;
            float xcv = cbv;
#pragma unroll
            for (int tap = 0; tap < 4; ++tap) xcv += cwv[tap] * bf2f(T[(tr + sgn * (tap - 3)) * TP + ch]);
            const float rv = sigmoidf_(rr[li] + brv), iv = sigmoidf_(ri[li] + biv);
            const float loga = c8 * rv;
            a[li] = __expf(loga); bx[li] = __builtin_amdgcn_sqrtf(om_exp(2.f * loga)) * iv * xcv;
        }
        float Ag[4], Bg[4], pA[4], pB[4];
#pragma unroll
        for (int g = 0; g < 4; ++g) { float hl = 0.f, ap = 1.f;
#pragma unroll
            for (int i = 0; i < 4; ++i) { hl = a[4 * g + i] * hl + bx[4 * g + i]; ap *= a[4 * g + i]; }
            Ag[g] = ap; Bg[g] = hl; pA[g] = shx(ap, lane, 32); pB[g] = shx(hl, lane, 32); }
        float Hrun = 0.f, Prun = 1.f;
        const bool first = (hh == 0);
#pragma unroll
        for (int g = 0; g < 4; ++g) {
            const float A0 = first ? Ag[g] : pA[g], B0 = first ? Bg[g] : pB[g];
            const float A1 = first ? pA[g] : Ag[g], B1 = first ? pB[g] : Bg[g];
            float hcur = first ? Hrun : (A0 * Hrun + B0), pcur = first ? Prun : Prun * A0;
            Hrun = A1 * (A0 * Hrun + B0) + B1; Prun = Prun * A0 * A1;
#pragma unroll
            for (int i = 0; i < 4; ++i) { hcur = a[4 * g + i] * hcur + bx[4 * g + i]; pcur *= a[4 * g + i];
                const int tg = tok0 + lbase + sgn * (8 * g + 4 * hh + i);
                HL[((size_t)dir * NTOK + tg) * 256 + ch] = hcur; CP[((size_t)dir * NTOK + tg) * 256 + ch] = pcur; }
        }
        if (hh == 0) { RAGA[(c * 2 + dir) * 256 + ch] = Prun; RAGH[(c * 2 + dir) * 256 + ch] = Hrun; }
    }
}

DI void phase_m1(const Params& p, int l, LAS unsigned char* lds, const int tid) {
    const int lane = tid & 63, wid = __builtin_amdgcn_readfirstlane(tid >> 6);
    const char* proj = (const char*)(p.ws + WS_BIG);
    LAS unsigned char* tile = lds;
    LAS unsigned char* wl = lds + M1_TILE_BYTES + wid * M1_WL_BYTES;
    LAS unsigned char* wlp = lds + M1_TILE_BYTES + (wid ^ 1) * M1_WL_BYTES;
    for (int c = blockIdx.x; c < 256; c += gridDim.x) {
        int ln = lane, td = tid; asm volatile("" : "+v"(ln), "+v"(td));
        const int tok0 = c * 32;
        int s0, s1;
        if (c < 128) { s0 = (c >> 3) * 256; s1 = s0 + 256; } else { s0 = 4096 + ((c - 128) >> 5) * 1024; s1 = s0 + 1024; }
        stage_tile<128, 32>(proj, tile, tok0, 0, 2064, 0, 0, NTOK, td);
        __syncthreads();
        m1_gla_wave<0>(p, l, c, wid >> 1, wid & 1, tile, wl, wlp, ln);
        __builtin_amdgcn_sched_barrier(0); asm volatile("" : "+v"(ln), "+v"(td));
        stage_tile<64, 32>(proj, tile, tok0, B_Q, 1104, 0, 0, NTOK, td);
        stage_tile<4, 32>(proj, tile, tok0, B_AF, 1104, 1024, 0, NTOK, td);
        __syncthreads();
        m1_gla_wave<1>(p, l, c, wid >> 1, wid & 1, tile, wl, wlp, ln);
        __builtin_amdgcn_sched_barrier(0); asm volatile("" : "+v"(ln), "+v"(td));
        stage_tile<32, 38>(proj, tile, tok0 - 3, C_X, 528, 0, s0, s1, td);
        __syncthreads();
        m1_rg_wave(p, l, c, wid >> 1, wid & 1, tile, ln);
        __syncthreads();
    }
}

DI void m2_chain8(const Params& p, int l, int id) {
    const int sq = id / 6144; int rem = id % 6144;
    const int hd = rem / 1536, dir = (rem / 768) & 1; int f = rem % 768;
    const int mix = f < 512 ? 0 : 1; if (mix) f -= 512;
    const int dk = mix == 0 ? 64 : 32, S_ = dk / 16;
    const int lane_ = f & 63, ns = f >> 6, n = ns / S_, s = ns % S_;
    const int d0 = 16 * s + 8 * (lane_ >> 5), e = 32 * n + (lane_ & 31);
    char* DS = (char*)(p.ws + (mix == 0 ? WS_DSA : WS_DSB));
    const float* ACH = (const float*)(p.ws + (mix == 0 ? WS_ACHA : WS_ACHB));
    float zf = 0.f; asm volatile("" : "+v"(zf));
    float S[8];
#pragma unroll
    for (int j = 0; j < 8; ++j) S[j] = zf;
    int c0, N;
    if (sq < 16) { c0 = sq * 8; N = 8; }
    else { c0 = 128 + (sq - 16) * 32; N = 32; const int b = sq - 16;
        const float* s0p = mix == 0 ? p.IN(2) + (size_t)((((b * 2 + l) * 2 + dir) * 4 + hd)) * 4096 : p.IN(3) + (size_t)((((b * 2 + l) * 2 + dir) * 4 + hd)) * 2048;
#pragma unroll
        for (int j = 0; j < 8; ++j) S[j] = s0p[(d0 + j) * 64 + e]; }
    for (int n0 = 0; n0 < N; n0 += 8) {
        u32x4 v[8]; f32x4 a0[8], a1[8];
#pragma unroll
        for (int i = 0; i < 8; ++i) { const int nn = n0 + i, c = c0 + (dir == 0 ? nn : N - 1 - nn); const size_t ui = (size_t)((c * 4 + hd) * 2 + dir);
            v[i] = *(const u32x4*)(DS + ui * (dk * 128) + f * 16); a0[i] = *(const f32x4*)(ACH + ui * dk + d0); a1[i] = *(const f32x4*)(ACH + ui * dk + d0 + 4); }
#pragma unroll
        for (int i = 0; i < 8; ++i) { const int nn = n0 + i, c = c0 + (dir == 0 ? nn : N - 1 - nn); const size_t ui = (size_t)((c * 4 + hd) * 2 + dir);
            u32x4 o; o.x = pk2(S[0], S[1]); o.y = pk2(S[2], S[3]); o.z = pk2(S[4], S[5]); o.w = pk2(S[6], S[7]);
            *(u32x4*)(DS + ui * (dk * 128) + f * 16) = o;
            S[0] = a0[i].x * S[0] + __uint_as_float(v[i].x << 16); S[1] = a0[i].y * S[1] + __uint_as_float(v[i].x & 0xffff0000u);
            S[2] = a0[i].z * S[2] + __uint_as_float(v[i].y << 16); S[3] = a0[i].w * S[3] + __uint_as_float(v[i].y & 0xffff0000u);
            S[4] = a1[i].x * S[4] + __uint_as_float(v[i].z << 16); S[5] = a1[i].y * S[5] + __uint_as_float(v[i].z & 0xffff0000u);
            S[6] = a1[i].z * S[6] + __uint_as_float(v[i].w << 16); S[7] = a1[i].w * S[7] + __uint_as_float(v[i].w & 0xffff0000u); }
    }
    if (sq < 16) { const int b = sq;
        float* op = mix == 0 ? p.out + OUT_SH + (size_t)((((b * 2 + l) * 2 + dir) * 4 + hd)) * 4096 : p.out + OUT_SG + (size_t)((((b * 2 + l) * 2 + dir) * 4 + hd)) * 2048;
#pragma unroll
        for (int j = 0; j < 8; ++j) op[(d0 + j) * 64 + e] = S[j]; }
}
DI void phase_m2(const Params& p, int l, const int tid) {
    const int gt = blockIdx.x * 512 + tid, GT = gridDim.x * 512;
    for (int id = gt; id < 20 * 6144; id += GT) m2_chain8(p, l, 20 * 6144 - 1 - id);
    float* RAGH = (float*)(p.ws + WS_RAGH); const float* RAGA = (const float*)(p.ws + WS_RAGA);
    for (int id = GT - 1 - gt; id < 20 * 512; id += GT) {
        const int sq = id / 512, dir = (id >> 8) & 1, ch = id & 255;
        int c0, N; float h = 0.f;
        if (sq < 16) { c0 = sq * 8; N = 8; } else { c0 = 128 + (sq - 16) * 32; N = 32; h = p.IN(4)[((size_t)((sq - 16) * 2 + l) * 2 + dir) * 256 + ch]; }
        for (int n0 = 0; n0 < N; n0 += 8) {
            float v[8], av[8];
#pragma unroll
            for (int i = 0; i < 8; ++i) { const int n = n0 + i, c = c0 + (dir == 0 ? n : N - 1 - n); v[i] = RAGH[(c * 2 + dir) * 256 + ch]; av[i] = RAGA[(c * 2 + dir) * 256 + ch]; }
#pragma unroll
            for (int i = 0; i < 8; ++i) { const int n = n0 + i, c = c0 + (dir == 0 ? n : N - 1 - n); RAGH[(c * 2 + dir) * 256 + ch] = h; h = av[i] * h + v[i]; }
        }
        if (sq < 16) p.out[OUT_SR + ((size_t)(sq * 2 + l) * 2 + dir) * 256 + ch] = h;
    }
}

template <int MIX>
DI void m3_gla_unit(const Params& p, int l, int c, int hd, int lane) {
    constexpr int DK = MIX == 0 ? 64 : 32;
    const int r = lane & 31, hh = lane >> 5, tok0 = c * 32;
    const bf16_t* proj = (const bf16_t*)(p.ws + WS_BIG);
    const bf16_t* DS = (const bf16_t*)(p.ws + (MIX == 0 ? WS_DSA : WS_DSB));
    const bf16_t* QH = (const bf16_t*)(p.ws + (MIX == 0 ? WS_QHA : WS_QHB));
    const float* oi = (const float*)(p.ws + WS_OI) + (size_t)((MIX * 256 + c) * 4 + hd) * 2048;
    bf16_t* mix = (bf16_t*)(p.ws + WS_HM);
    f32x16 acc[2];
#pragma unroll
    for (int n = 0; n < 2; ++n)
#pragma unroll
        for (int g = 0; g < 4; ++g) { const f32x4 v = *(const f32x4*)(oi + ((n * 4 + g) * 64 + lane) * 4); acc[n][4 * g] = v.x; acc[n][4 * g + 1] = v.y; acc[n][4 * g + 2] = v.z; acc[n][4 * g + 3] = v.w; }
#pragma unroll
    for (int dir = 0; dir < 2; ++dir) {
        const bf16_t* sp = DS + (size_t)((c * 4 + hd) * 2 + dir) * (DK * 64);
#pragma unroll
        for (int s = 0; s < DK / 16; ++s) {
            const bf16x8 qf = MIX == 0 ? *(const bf16x8*)(QH + (size_t)(tok0 + r) * 512 + dir * 256 + hd * 64 + 16 * s + 8 * hh)
                                       : *(const bf16x8*)(QH + (size_t)(tok0 + r) * 256 + dir * 128 + hd * 32 + 16 * s + 8 * hh);
#pragma unroll
            for (int n = 0; n < 2; ++n) {
                const bf16x8 sf = *(const bf16x8*)(sp + ((n * (DK / 16) + s) * 64 + lane) * 8);
                acc[n] = MFMA32(sf, qf, acc[n]);
            }
        }
    }
    float ss = 0.f;
#pragma unroll
    for (int n = 0; n < 2; ++n)
#pragma unroll
        for (int i = 0; i < 16; ++i) ss += acc[n][i] * acc[n][i];
    ss += shx(ss, lane, 32);
    const float rstd = rsqrtf(ss * (1.f / 64.f) + 1e-6f);
    const float* gain = (MIX == 0 ? p.IN(14) : p.IN(17)) + l * 256 + hd * 64;
    const bf16_t* grow = proj + (size_t)(tok0 + r) * NP + (MIX == 0 ? A_G : B_G) + hd * 64;
    bf16_t* orow = mix + (size_t)(tok0 + r) * 1024 + MIX * 256 + hd * 64;
#pragma unroll
    for (int n = 0; n < 2; ++n)
#pragma unroll
        for (int g = 0; g < 4; ++g) {
            const int e = 32 * n + 8 * g + 4 * hh;
            const u32x2 gg = *(const u32x2*)(grow + e); const f32x4 gn = *(const f32x4*)(gain + e);
            const float g0 = __uint_as_float(gg.x << 16), g1 = __uint_as_float(gg.x & 0xffff0000u), g2 = __uint_as_float(gg.y << 16), g3 = __uint_as_float(gg.y & 0xffff0000u);
            u32x2 o; o.x = pk2(acc[n][4 * g] * rstd * gn.x * siluf_(g0), acc[n][4 * g + 1] * rstd * gn.y * siluf_(g1));
            o.y = pk2(acc[n][4 * g + 2] * rstd * gn.z * siluf_(g2), acc[n][4 * g + 3] * rstd * gn.w * siluf_(g3));
            *(u32x2*)(orow + e) = o;
        }
}

DI float gelu_tanh(float x) { const float u = 0.7978845608028654f * (x + 0.044715f * x * x * x); const float t = 1.f - 2.f * rcpf_(__expf(2.f * u) + 1.f); return 0.5f * x * (1.f + t); }

DI void phase_m3(const Params& p, int l, const int tid) {
    const int lane = tid & 63, wid = __builtin_amdgcn_readfirstlane(tid >> 6), gw = blockIdx.x * 8 + wid, GW = gridDim.x * 8;
    for (int u = gw; u < 2048; u += GW) {
        const int ty = u & 1, idx = u >> 1, c = idx >> 2, hd = idx & 3;
        int ln = lane; asm volatile("" : "+v"(ln));
        if (ty == 0) m3_gla_unit<0>(p, l, c, hd, ln); else m3_gla_unit<1>(p, l, c, hd, ln);
    }
    const int gt = blockIdx.x * 512 + tid, GT = gridDim.x * 512;
    const bf16_t* proj = (const bf16_t*)(p.ws + WS_BIG);
    bf16_t* mix = (bf16_t*)(p.ws + WS_HM);
    const float* HL = (const float*)(p.ws + WS_HL); const float* CP = (const float*)(p.ws + WS_CP); const float* HIN = (const float*)(p.ws + WS_RAGH);
    for (int id = gt; id < NTOK * 64; id += GT) {
        const int tok = id >> 6, ch = (id & 63) * 4, c = tok >> 5;
        const f32x4 hf = *(const f32x4*)(HL + (size_t)tok * 256 + ch), hb = *(const f32x4*)(HL + ((size_t)NTOK + tok) * 256 + ch);
        const f32x4 cf = *(const f32x4*)(CP + (size_t)tok * 256 + ch), cb = *(const f32x4*)(CP + ((size_t)NTOK + tok) * 256 + ch);
        const f32x4 inf_ = *(const f32x4*)(HIN + (c * 2 + 0) * 256 + ch), inb = *(const f32x4*)(HIN + (c * 2 + 1) * 256 + ch);
        const u32x2 gg = *(const u32x2*)(proj + (size_t)tok * NP + C_G + ch);
        const f32x4 y = hf + cf * inf_ + hb + cb * inb;
        u32x2 o; o.x = pk2(y.x * gelu_tanh(__uint_as_float(gg.x << 16)), y.y * gelu_tanh(__uint_as_float(gg.x & 0xffff0000u)));
        o.y = pk2(y.z * gelu_tanh(__uint_as_float(gg.y << 16)), y.w * gelu_tanh(__uint_as_float(gg.y & 0xffff0000u)));
        *(u32x2*)(mix + (size_t)tok * 1024 + 512 + ch) = o;
    }
    const float* sw = p.IN(25) + l * 3 * 256;
    for (int id = gt; id < NTOK * 64; id += GT) {
        const int tok = id >> 6, ch = (id & 63) * 4;
        const int seg = tok < 4096 ? 256 : 64, pos = tok & (seg - 1);
        f32x4 y = {0.f, 0.f, 0.f, 0.f};
#pragma unroll
        for (int j = 0; j < 3; ++j) {
            const int pp = pos + j - 1;
            if (pp >= 0 && pp < seg) {
                const int tt = tok + j - 1;
                const u32x2 cc = *(const u32x2*)(proj + (size_t)tt * NP + D_C + ch), vv = *(const u32x2*)(proj + (size_t)tt * NP + D_V + ch);
                const f32x4 w = *(const f32x4*)(sw + j * 256 + ch);
                y.x += w.x * __uint_as_float(cc.x << 16) * __uint_as_float(vv.x << 16); y.y += w.y * __uint_as_float(cc.x & 0xffff0000u) * __uint_as_float(vv.x & 0xffff0000u);
                y.z += w.z * __uint_as_float(cc.y << 16) * __uint_as_float(vv.y << 16); y.w += w.w * __uint_as_float(cc.y & 0xffff0000u) * __uint_as_float(vv.y & 0xffff0000u);
            }
        }
        const u32x2 bb = *(const u32x2*)(proj + (size_t)tok * NP + D_B + ch);
        u32x2 o; o.x = pk2(y.x * __uint_as_float(bb.x << 16), y.y * __uint_as_float(bb.x & 0xffff0000u));
        o.y = pk2(y.z * __uint_as_float(bb.y << 16), y.w * __uint_as_float(bb.y & 0xffff0000u));
        *(u32x2*)(mix + (size_t)tok * 1024 + 768 + ch) = o;
    }
}

__global__ void __launch_bounds__(512, 2) fwd_kernel(Params pin) {
    extern __shared__ __attribute__((aligned(16))) unsigned char lds_raw[];
    LAS unsigned char* lds = (LAS unsigned char*)lds_raw;
    cg::grid_group grid = cg::this_grid();
    const int G = gridDim.x, bid = blockIdx.x;
    volatile LAS unsigned* bst = (volatile LAS unsigned*)(lds + LDS_BYTES - 16);
    if (threadIdx.x < 4) bst[threadIdx.x] = 0u;
    __syncthreads();
    const XcdBarrier xbar = xcd_barrier_post((unsigned*)(pin.ws + WS_BAR), bst);
    int nsync = 0;
    for (int ph2 = 2 * pin.ph_lo; ph2 < 2 * pin.ph_hi; ++ph2) {
        const int ph = ph2 >> 1;
        if ((ph2 & 1) && !((REPEAT_MASK >> ph) & 1u)) continue;
        size_t zo = 0; asm volatile("" : "+s"(zo));
        int tid = threadIdx.x; asm volatile("" : "+v"(tid));
        Params p = pin; p.ws += zo; p.out += zo; p.zo = zo;
        const float* mod = (const float*)(p.ws + WS_MOD);
        bf16_t* hm = (bf16_t*)(p.ws + WS_HM); bf16_t* big = (bf16_t*)(p.ws + WS_BIG);
        if (ph == 0) phase_p0(p, lds, tid);
        else if (ph == 19) phase_norm(p, 0, 2, tid);
        else {
            const int l = (ph - 1) / 9, s = (ph - 1) % 9;
            pg8::StaticOrder S;
            if (s == 0) phase_norm(p, l, 0, tid);
            else if (s == 1) { pg8::Gemm g{hm, (const bf16_t*)(p.ws + WS_WIN) + (size_t)l * NP * 1024, NTOK, NP, 1024, 1024}; S.init(NTOK, NP, G, bid);
                pg8::EpiBf16<0> E{big, NP}; pg8::gemm_phase(lds, g, S, E, tid); }
            else if (s == 2) phase_m1(p, l, lds, tid);
            else if (s == 3) phase_m2(p, l, tid);
            else if (s == 4) phase_m3(p, l, tid);
            else if (s == 5) { pg8::Gemm g{hm, (const bf16_t*)(p.ws + WS_WOUT) + (size_t)l * 1024 * 1024, NTOK, 1024, 512, 1024}; S.init(NTOK, 1024, G, bid, 2);
                pg8::EpiResid E{mod + (size_t)l * 5 * 6144 + 2048, (bf16_t*)(p.ws + WS_DSA)}; pg8::gemm_phase(lds, g, S, E, tid); }
            else if (s == 6) phase_norm(p, l, 1, tid);
            else if (s == 7) { pg8::Gemm g{hm, (const bf16_t*)(p.ws + WS_W1) + (size_t)l * 4096 * 1024, NTOK, DFF, 1024, 1024}; S.init(NTOK, DFF, G, bid);
                pg8::EpiBf16<1> E{big, DFF}; pg8::gemm_phase(lds, g, S, E, tid); }
            else { pg8::Gemm g{big, (const bf16_t*)(p.ws + WS_W2) + (size_t)l * 1024 * 4096, NTOK, 1024, 2048, DFF}; S.init(NTOK, 1024, G, bid, 2);
                pg8::EpiResid E{mod + (size_t)l * 5 * 6144 + 5120, (bf16_t*)(p.ws + WS_DSA)}; pg8::gemm_phase(lds, g, S, E, tid); }
        }
        if (ph2 + 2 < 2 * pin.ph_hi || (!(ph2 & 1) && ((REPEAT_MASK >> ph) & 1u))) { if (nsync == 0) grid.sync(); else xcd_barrier(xbar); ++nsync; }
    }
}

extern "C" void kernel_launch(void* const* d_in, const int* in_sizes, int n_in, void* d_out, int out_size, void* d_ws, size_t ws_size, hipStream_t stream) {
    static int grid = 0;
    if (grid == 0) {
        if (n_in != 29 || ws_size < WS_END) { fprintf(stderr, "kernel_launch: unexpected n_in %d / ws %zu\n", n_in, ws_size); grid = -1; return; }
        int dev = 0, cus = 0, per_cu = 0;
        hipGetDevice(&dev); hipDeviceGetAttribute(&cus, hipDeviceAttributeMultiprocessorCount, dev);
        if (hipFuncSetAttribute((const void*)fwd_kernel, hipFuncAttributeMaxDynamicSharedMemorySize, LDS_BYTES) != hipSuccess) { fprintf(stderr, "kernel_launch: hipFuncSetAttribute failed\n"); grid = -1; return; }
        if (hipOccupancyMaxActiveBlocksPerMultiprocessor(&per_cu, (const void*)fwd_kernel, 512, LDS_BYTES) != hipSuccess || per_cu < 1) { fprintf(stderr, "kernel_launch: occupancy query says %d\n", per_cu); per_cu = 1; }
        (void)hipGetLastError();
        grid = cus * 1;
        if (grid <= 0) grid = 256;
    }
    if (grid < 0) return;
    if (hipMemsetAsync((char*)d_ws + WS_BAR, 0, 16384, stream) != hipSuccess) { fprintf(stderr, "kernel_launch: memset failed\n"); return; }
    Params p{};
    for (int i = 0; i < 29; ++i) p.in[i] = (const float*)d_in[i];
    p.out = (float*)d_out; p.ws = (unsigned char*)d_ws;
#if MEGA
    p.ph_lo = 0; p.ph_hi = 20;
    void* args[] = {&p};
    hipError_t e = hipLaunchCooperativeKernel((const void*)fwd_kernel, dim3(grid), dim3(512), args, LDS_BYTES, stream);
    if (e != hipSuccess) fprintf(stderr, "cooperative launch failed: %s (grid %d)\n", hipGetErrorString(e), grid);
#else
    for (int ph = 0; ph < 20; ++ph) { p.ph_lo = ph; p.ph_hi = ph + 1; hipLaunchKernelGGL(fwd_kernel, dim3(grid), dim3(512), LDS_BYTES, stream, p); }
#endif
}
```

```cpp
#include <hip/hip_runtime.h>
#include <hip/hip_cooperative_groups.h>
#include <cstdio>
#include <cstdint>
namespace cg = cooperative_groups;

#ifndef MEGA
#define MEGA 1
#endif
#ifndef M1_PROBE_STAGES
#define M1_PROBE_STAGES 7
#endif
#ifndef REPEAT_MASK
#define REPEAT_MASK 0u
#endif

#define DI __device__ __forceinline__
#define LAS __attribute__((address_space(3)))
typedef unsigned short bf16_t;
typedef short bf16x8 __attribute__((ext_vector_type(8)));
typedef float f32x4 __attribute__((ext_vector_type(4)));
typedef float f32x16 __attribute__((ext_vector_type(16)));
typedef unsigned u32x4 __attribute__((ext_vector_type(4)));
typedef unsigned u32x2 __attribute__((ext_vector_type(2)));
typedef __bf16 bf16x2_t __attribute__((ext_vector_type(2)));
typedef float f32x2_t __attribute__((ext_vector_type(2)));

constexpr int NTOK = 8192, DM = 1024, NP = 3584, DFF = 4096;
constexpr int A_Q = 0, A_I = 256, A_FF = 512, A_FB = 768, A_G = 1024, B_Q = 1280, B_K = 1408, B_V = 1536, B_G = 1792, B_AF = 2048, B_AB = 2064,
              C_X = 2080, C_G = 2336, D_B = 2592, D_C = 2848, D_V = 3104, PW = 3360;
constexpr size_t MiB = 1u << 20;
constexpr size_t WS_WIN = 0, WS_WOUT = 14 * MiB, WS_W1 = 18 * MiB, WS_W2 = 34 * MiB, WS_MOD = 50 * MiB, WS_HM = 51 * MiB, WS_BIG = 67 * MiB,
                 WS_OI = 131 * MiB, WS_DSA = 147 * MiB, WS_DSB = 179 * MiB, WS_QHA = 195 * MiB, WS_QHB = 203 * MiB, WS_HL = 207 * MiB, WS_CP = 223 * MiB,
                 WS_ACHA = 239 * MiB, WS_ACHB = 239 * MiB + 512 * 1024, WS_RAGA = 240 * MiB, WS_RAGH = 240 * MiB + 512 * 1024, WS_BAR = 241 * MiB, WS_END = 242 * MiB;
constexpr int OUT_SH = 8388608, OUT_SG = OUT_SH + 1048576, OUT_SR = OUT_SG + 524288;
constexpr int LDS_BYTES = 147456;

struct Params { const float* in[29]; float* out; unsigned char* ws; size_t zo; int ph_lo, ph_hi;
    DI const float* IN(int i) const { return in[i] + zo; } };

DI float bf2f(bf16_t u) { return __uint_as_float(((unsigned)u) << 16); }
DI unsigned pk2(float lo, float hi) { f32x2_t v = {lo, hi}; bf16x2_t b = __builtin_convertvector(v, bf16x2_t); return __builtin_bit_cast(unsigned, b); }
DI bf16_t f2bf(float x) { return (bf16_t)(pk2(x, 0.f) & 0xffffu); }
DI bf16x8 pack8(const float* v) { u32x4 p; p.x = pk2(v[0], v[1]); p.y = pk2(v[2], v[3]); p.z = pk2(v[4], v[5]); p.w = pk2(v[6], v[7]); return __builtin_bit_cast(bf16x8, p); }
DI float rcpf_(float x) { return __builtin_amdgcn_rcpf(x); }
DI float sigmoidf_(float x) { return rcpf_(1.f + __expf(-x)); }
DI float siluf_(float x) { return x * rcpf_(1.f + __expf(-x)); }
DI float om_exp(float x) { const float s = -x * (1.f + x * 0.5f * (1.f + x * (1.f / 3.f) * (1.f + x * 0.25f * (1.f + x * 0.2f * (1.f + x * (1.f / 6.f)))))); return x > -0.3f ? s : 1.f - __expf(x); }
DI int crow(int reg, int h) { return (reg & 3) + 8 * (reg >> 2) + 4 * h; }
#define MFMA32(a, b, c) __builtin_amdgcn_mfma_f32_32x32x16_bf16((a), (b), (c), 0, 0, 0)
DI f32x16 zero16() { f32x16 z; for (int i = 0; i < 16; ++i) z[i] = 0.f; return z; }
DI float shx(float v, int lane, int m) { return __int_as_float(__builtin_amdgcn_ds_bpermute((lane ^ m) << 2, __float_as_int(v))); }
DI int modrow_of(int row) { return row < 4096 ? 0 : 1 + ((row - 4096) >> 10); }


#define XB_TMO      128
#define XB_XCNT(j)  (256  + 64 * (j))
#define XB_XSUB(j)  (1280 + 64 * (j))
#define XB_XGEN(j)  (2304 + 64 * (j))
#define XB_TOP      3328
#define XB_TOPGEN   3392
#define XCD_BAR_WORDS 3456
#define XB_SPIN_CAP (1u << 18)
DI unsigned xb_ld(unsigned* p)              { return __hip_atomic_load(p, __ATOMIC_RELAXED, __HIP_MEMORY_SCOPE_AGENT); }
DI unsigned xb_add(unsigned* p, unsigned v) { return __hip_atomic_fetch_add(p, v, __ATOMIC_RELAXED, __HIP_MEMORY_SCOPE_AGENT); }
DI unsigned xb_xcc_id() { return (unsigned)__builtin_amdgcn_s_getreg((3 << 11) | 20) & 0xFu; }
#define XB_SPIN(cond, bar) do { unsigned _sp = 0; while (cond) { __builtin_amdgcn_s_sleep(1); \
    if ((++_sp & 255u) == 0u) { if (xb_ld(&(bar)[XB_TMO])) break; if (_sp > XB_SPIN_CAP) { atomicAdd(&(bar)[XB_TMO], 1u); break; } } } } while (0)
struct XcdBarrier { unsigned* bar; unsigned x; volatile LAS unsigned* st; };
DI XcdBarrier xcd_barrier_post(unsigned* bar, volatile LAS unsigned* st) {
    XcdBarrier b; b.bar = bar; b.x = xb_xcc_id(); b.st = st;
    if (threadIdx.x == 0) (void)xb_add(&bar[XB_XCNT(b.x)], 1u);
    return b;
}
DI void xcd_barrier_complete(unsigned* bar, unsigned x, unsigned& nloc, unsigned& nx) {
    const unsigned G = gridDim.x * gridDim.y * gridDim.z;
    unsigned sum, cnt, mine, sp = 0u;
    for (;;) {
        sum = 0u; cnt = 0u; mine = 0u;
#pragma unroll
        for (unsigned j = 0; j < 16; ++j) { const unsigned c = xb_ld(&bar[XB_XCNT(j)]); sum += c; cnt += (c > 0u) ? 1u : 0u; mine = (j == x) ? c : mine; }
        if (sum == G) break;
        __builtin_amdgcn_s_sleep(1);
        if ((++sp & 255u) == 0u) { if (xb_ld(&bar[XB_TMO])) break; if (sp > XB_SPIN_CAP) { atomicAdd(&bar[XB_TMO], 1u); break; } }
    }
    nloc = mine > 0u ? mine : 1u; nx = cnt > 0u ? cnt : 1u;
}
DI void xcd_barrier(const XcdBarrier& b) {
    asm volatile("s_waitcnt vmcnt(0)" ::: "memory");
    __syncthreads();
    if (threadIdx.x == 0) {
        unsigned* bar = b.bar;
        __builtin_amdgcn_s_waitcnt(0);
        unsigned nloc = b.st[0], nx = b.st[1];
        if (nloc == 0u) { xcd_barrier_complete(bar, b.x, nloc, nx); b.st[0] = nloc; b.st[1] = nx; }
        const unsigned old = xb_add(&bar[XB_XSUB(b.x)], 1u);
        const unsigned gen = old / nloc;
        if (old + 1u == (gen + 1u) * nloc) {
            __builtin_amdgcn_fence(__ATOMIC_RELEASE, "agent");
            asm volatile("s_waitcnt vmcnt(0)" ::: "memory");
            const unsigned og = xb_add(&bar[XB_TOP], 1u);
            const unsigned tg = og / nx;
            if (og + 1u == (tg + 1u) * nx) xb_add(&bar[XB_TOPGEN], 1u);
            else XB_SPIN(xb_ld(&bar[XB_TOPGEN]) == tg, bar);
            __builtin_amdgcn_fence(__ATOMIC_ACQUIRE, "agent");
            xb_add(&bar[XB_XGEN(b.x)], 1u);
            asm volatile("s_waitcnt vmcnt(0)" ::: "memory");
        } else {
            XB_SPIN(xb_ld(&bar[XB_XGEN(b.x)]) == gen, bar);
            __builtin_amdgcn_fence(__ATOMIC_ACQUIRE, "agent");
            asm volatile("s_waitcnt vmcnt(0)" ::: "memory");
        }
    }
    __syncthreads();
}

namespace pg8 {
constexpr int BM = 256, BK = 64, HALF = 128, HTB = HALF * BK * 2, NXCD = 8, WGM = 8;
__host__ __device__ __forceinline__ int lds_byte(int r, int c) { const int st = (r >> 4) * 2 + (c >> 5), rr = r & 15, cc = c & 31, ob = rr * 64 + cc * 2; return st * 1024 + (ob ^ (((ob >> 9) & 1) << 5)); }
__host__ __device__ __forceinline__ void stage_rc(int b, int& R, int& C) { const int st = b / 1024, sb = b % 1024, swz = sb ^ (((sb >> 9) & 1) << 5); R = (st >> 1) * 16 + swz / 64; C = (st & 1) * 32 + (swz % 64) / 2; }
__host__ __device__ __forceinline__ int perm32(int rho) { const int n = rho >> 4, i = rho & 15; return 8 * (i >> 2) + 4 * n + (i & 3); }
struct Unit { int pm, pn, pk; };
struct Gemm { const bf16_t* A; const bf16_t* Bt; int M, N, K, lda; };
struct StaticOrder {
    int nM, nN, nwg, G, c, KS;
    __host__ __device__ void init(int M, int N, int G_, int c_, int KS_ = 1) { KS = KS_; nM = M / BM; nN = (N / BM) * KS; nwg = nM * nN; G = G_; c = c_; }
    __host__ __device__ bool next(int i, Unit& u) const {
        const long L = (long)i * G + c; if (L >= nwg) return false;
        int wgid = (int)L; { const int q = nwg / NXCD, r = nwg % NXCD, xcd = wgid % NXCD, off = wgid / NXCD; wgid = (xcd < r ? xcd * (q + 1) : r * (q + 1) + (xcd - r) * q) + off; }
        const int nig = WGM * nN, gid = wgid / nig, fm = gid * WGM, gsz = (nM - fm) < WGM ? (nM - fm) : WGM;
        u.pm = fm + ((wgid % nig) % gsz); const int pv = (wgid % nig) / gsz; u.pn = pv / KS; u.pk = pv % KS; return true;
    }
};
template <class Epi>
__device__ __forceinline__ void gemm_phase(LAS unsigned char* lds, const Gemm g, const StaticOrder& S, const Epi& E, const int tid) {
    const int wid = __builtin_amdgcn_readfirstlane(tid >> 6), lane = tid & 63, wr = wid >> 2, wc = wid & 3, fr = lane & 15, fq = lane >> 4;
    const int K = g.lda, nt = g.K / BK;
    unsigned voffA[2], voffB[2];
#pragma unroll
    for (int i = 0; i < 2; ++i) { int R, C; stage_rc(tid * 16 + i * 8192, R, C); const int Rb = (R & ~31) + perm32(R & 31);
        voffA[i] = (unsigned)(R * K + C) * 2u; voffB[i] = (unsigned)(Rb * K + C) * 2u; }
    const size_t kstep = (size_t)(BK * 2);
    const size_t hstep = (size_t)HALF * K * 2;
    const size_t tstep = 2 * hstep;
    const unsigned ldsw = (unsigned)wid * 1024u;
    const int aoff = lds_byte(wr * 64 + fr, fq * 8), boff = lds_byte(wc * 32 + fr, fq * 8);
#define PG8_SA(b, h) (((b) * 2 + (h)) * HTB)
#define PG8_SB(b, h) ((4 + (b) * 2 + (h)) * HTB)
#define PG8_STAGE(bufoff, gbase, voff) do { _Pragma("unroll") for (int _i = 0; _i < 2; ++_i) \
        __builtin_amdgcn_global_load_lds((const unsigned*)((const char*)(gbase) + (voff)[_i]), (LAS unsigned*)(lds + (bufoff) + ldsw + _i * 8192), 16, 0, 0); } while (0)
#define PG8_LDA(dst, b, h) do { _Pragma("unroll") for (int m = 0; m < 4; ++m) _Pragma("unroll") for (int k = 0; k < 2; ++k) dst[m][k] = *(const LAS bf16x8*)(lds + PG8_SA(b, h) + aoff + m * 2048 + k * 1024); } while (0)
#define PG8_LDB(dst, b, h) do { _Pragma("unroll") for (int n = 0; n < 2; ++n) _Pragma("unroll") for (int k = 0; k < 2; ++k) dst[n][k] = *(const LAS bf16x8*)(lds + PG8_SB(b, h) + boff + n * 2048 + k * 1024); } while (0)
#define PG8_MMA(ai, bj, At, Bt) do { __builtin_amdgcn_s_setprio(1); _Pragma("unroll") for (int m = 0; m < 4; ++m) _Pragma("unroll") for (int n = 0; n < 2; ++n) _Pragma("unroll") for (int k = 0; k < 2; ++k) \
        acc[ai][bj][m][n] = __builtin_amdgcn_mfma_f32_16x16x32_bf16(Bt[n][k], At[m][k], acc[ai][bj][m][n], 0, 0, 0); __builtin_amdgcn_s_setprio(0); } while (0)
#define PG8_WAIT_V(n) asm volatile("s_waitcnt vmcnt(" #n ")" ::: "memory")
#define PG8_WAIT_L(n) asm volatile("s_waitcnt lgkmcnt(" #n ")" ::: "memory")
#define PG8_BAR __builtin_amdgcn_s_barrier()
#define PG8_SCHED __builtin_amdgcn_sched_barrier(0)
    Unit cur, nxt; int ui = 0;
    if (!S.next(0, cur)) return;
    f32x4 acc[2][2][4][2];
#pragma unroll
    for (int a = 0; a < 2; ++a)
#pragma unroll
        for (int b = 0; b < 2; ++b)
#pragma unroll
            for (int m = 0; m < 4; ++m)
#pragma unroll
                for (int n = 0; n < 2; ++n) acc[a][b][m][n] = (f32x4){0.f, 0.f, 0.f, 0.f};
    bf16x8 At[4][2], B0[2][2], B1[2][2];
    const size_t ksplit = (size_t)g.K * 2;
    const char* cA = (const char*)g.A + (size_t)cur.pm * tstep + cur.pk * ksplit; const char* cB = (const char*)g.Bt + (size_t)cur.pn * tstep + cur.pk * ksplit;
    PG8_STAGE(PG8_SB(0, 0), cB, voffB); PG8_STAGE(PG8_SA(0, 0), cA, voffA); PG8_STAGE(PG8_SB(0, 1), cB + hstep, voffB); PG8_STAGE(PG8_SA(0, 1), cA + hstep, voffA);
    if (wr == 1) PG8_BAR;
    PG8_WAIT_V(4); PG8_BAR;
    PG8_STAGE(PG8_SB(1, 0), cB + kstep, voffB); PG8_STAGE(PG8_SA(1, 0), cA + kstep, voffA); PG8_STAGE(PG8_SB(1, 1), cB + hstep + kstep, voffB);
    PG8_WAIT_V(6); PG8_BAR;
    for (;;) {
        const bool has_next = S.next(ui + 1, nxt);
        const char* nA = has_next ? (const char*)g.A + (size_t)nxt.pm * tstep + nxt.pk * ksplit : cA; const char* nB = has_next ? (const char*)g.Bt + (size_t)nxt.pn * tstep + nxt.pk * ksplit : cB;
        for (int t = 0; t < nt; t += 2) {
            const bool last = (t == nt - 2);
            const char* a1 = cA + (size_t)(t + 1) * kstep;
            const char* a2 = last ? nA : cA + (size_t)(t + 2) * kstep; const char* b2 = last ? nB : cB + (size_t)(t + 2) * kstep;
            const char* a3 = a2 + kstep; const char* b3 = b2 + kstep;
            PG8_LDB(B0, 0, 0); PG8_SCHED; PG8_LDA(At, 0, 0); PG8_STAGE(PG8_SA(1, 1), a1 + hstep, voffA);
            PG8_WAIT_L(8); PG8_BAR; PG8_WAIT_L(0); PG8_MMA(0, 0, At, B0); PG8_BAR; PG8_SCHED;
            PG8_LDB(B1, 0, 1); PG8_STAGE(PG8_SB(0, 0), b2, voffB);
            PG8_BAR; PG8_WAIT_L(0); PG8_MMA(0, 1, At, B1); PG8_BAR;
            PG8_LDA(At, 0, 1); PG8_STAGE(PG8_SA(0, 0), a2, voffA);
            PG8_BAR; PG8_WAIT_L(0); PG8_MMA(1, 0, At, B0); PG8_BAR; PG8_SCHED;
            PG8_STAGE(PG8_SB(0, 1), b2 + hstep, voffB);
            PG8_WAIT_V(6); PG8_BAR; PG8_MMA(1, 1, At, B1); PG8_BAR;
            PG8_LDB(B0, 1, 0); PG8_SCHED; PG8_LDA(At, 1, 0); PG8_STAGE(PG8_SA(0, 1), a2 + hstep, voffA);
            PG8_WAIT_L(8); PG8_BAR; PG8_WAIT_L(0); PG8_MMA(0, 0, At, B0); PG8_BAR; PG8_SCHED;
            PG8_LDB(B1, 1, 1); PG8_STAGE(PG8_SB(1, 0), b3, voffB);
            PG8_BAR; PG8_WAIT_L(0); PG8_MMA(0, 1, At, B1); PG8_BAR;
            PG8_LDA(At, 1, 1); PG8_STAGE(PG8_SA(1, 0), a3, voffA);
            PG8_BAR; PG8_WAIT_L(0); PG8_MMA(1, 0, At, B0); PG8_BAR; PG8_SCHED;
            PG8_STAGE(PG8_SB(1, 1), b3 + hstep, voffB);
            PG8_WAIT_V(6); PG8_BAR; PG8_MMA(1, 1, At, B1); PG8_BAR;
        }
        E(acc, cur, wr, wc, fr, fq);
        if (!has_next) break;
#pragma unroll
        for (int a = 0; a < 2; ++a)
#pragma unroll
            for (int b = 0; b < 2; ++b)
#pragma unroll
                for (int m = 0; m < 4; ++m)
#pragma unroll
                    for (int n = 0; n < 2; ++n) acc[a][b][m][n] = (f32x4){0.f, 0.f, 0.f, 0.f};
        cur = nxt; cA = nA; cB = nB; ++ui;
    }
    PG8_WAIT_V(0);
    if (wr == 0) PG8_BAR;
    PG8_BAR;
#undef PG8_SA
#undef PG8_SB
#undef PG8_STAGE
#undef PG8_LDA
#undef PG8_LDB
#undef PG8_MMA
#undef PG8_WAIT_V
#undef PG8_WAIT_L
#undef PG8_BAR
#undef PG8_SCHED
}

template <int ACT> struct EpiBf16 {
    bf16_t* O; int ldc;
    __device__ __forceinline__ void operator()(const f32x4 (&acc)[2][2][4][2], const Unit& u, int wr, int wc, int fr, int fq) const {
        const int row0 = u.pm * BM + wr * 64 + fr, col0 = u.pn * BM + wc * 32 + 8 * fq;
#pragma unroll
        for (int ai = 0; ai < 2; ++ai)
#pragma unroll
            for (int m = 0; m < 4; ++m) { bf16_t* rowp = O + (size_t)(row0 + ai * HALF + m * 16) * ldc + col0;
#pragma unroll
                for (int bj = 0; bj < 2; ++bj) { f32x4 v0 = acc[ai][bj][m][0], v1 = acc[ai][bj][m][1];
                    if (ACT == 1) {
#pragma unroll
                        for (int q = 0; q < 4; ++q) { float a = fmaxf(v0[q], 0.f), b = fmaxf(v1[q], 0.f); v0[q] = a * a; v1[q] = b * b; } }
                    u32x4 w; w.x = pk2(v0[0], v0[1]); w.y = pk2(v0[2], v0[3]); w.z = pk2(v1[0], v1[1]); w.w = pk2(v1[2], v1[3]);
                    *(u32x4*)(rowp + bj * HALF) = w; } }
    }
};
struct EpiResid {
    const float* gate; bf16_t* pb;
    __device__ __forceinline__ void operator()(const f32x4 (&acc)[2][2][4][2], const Unit& u, int wr, int wc, int fr, int fq) const {
        const int rowb = u.pm * BM; const float* gp = gate + modrow_of(rowb) * 6144;
        const int row0 = rowb + wr * 64 + fr, col0 = u.pn * BM + wc * 32 + 8 * fq;
        bf16_t* pbk = pb + (size_t)u.pk * ((size_t)NTOK * 1024);
        f32x4 gv[2][2];
#pragma unroll
        for (int bj = 0; bj < 2; ++bj)
#pragma unroll
            for (int n = 0; n < 2; ++n) gv[bj][n] = *(const f32x4*)(gp + col0 + bj * HALF + 4 * n);
#pragma unroll
        for (int ai = 0; ai < 2; ++ai)
#pragma unroll
            for (int m = 0; m < 4; ++m) { const size_t ro = (size_t)(row0 + ai * HALF + m * 16) * 1024 + col0;
#pragma unroll
                for (int bj = 0; bj < 2; ++bj) { const f32x4 v0 = gv[bj][0] * acc[ai][bj][m][0], v1 = gv[bj][1] * acc[ai][bj][m][1];
                    u32x4 w; w.x = pk2(v0[0], v0[1]); w.y = pk2(v0[2], v0[3]); w.z = pk2(v1[0], v1[1]); w.w = pk2(v1[2], v1[3]);
                    *(u32x4*)(pbk + ro + bj * HALF) = w; } }
    }
};
}

DI void transpose_unit(const float* __restrict__ W, int K, int N, int Npad, bf16_t* WT, int unit, int lane, LAS unsigned char* scr) {
    const int nblk = Npad / 64, kb = unit / nblk, nb = unit % nblk, n = nb * 64 + lane, k0 = kb * 64;
    u32x4 o[8];
    if (n < N) {
        float v[64];
#pragma unroll
        for (int kk = 0; kk < 64; ++kk) v[kk] = W[(size_t)(k0 + kk) * N + n];
#pragma unroll
        for (int q = 0; q < 8; ++q) { o[q].x = pk2(v[8 * q], v[8 * q + 1]); o[q].y = pk2(v[8 * q + 2], v[8 * q + 3]); o[q].z = pk2(v[8 * q + 4], v[8 * q + 5]); o[q].w = pk2(v[8 * q + 6], v[8 * q + 7]); }
    } else {
#pragma unroll
        for (int q = 0; q < 8; ++q) o[q] = (u32x4){0u, 0u, 0u, 0u};
    }
#pragma unroll
    for (int q = 0; q < 8; ++q) *(LAS u32x4*)(scr + lane * 144 + q * 16) = o[q];
    __builtin_amdgcn_fence(__ATOMIC_RELEASE, "wavefront"); __builtin_amdgcn_wave_barrier();
    const int ch = lane & 7, rb = lane >> 3;
#pragma unroll
    for (int j = 0; j < 8; ++j) { const int row = rb + 8 * j; const u32x4 w = *(const LAS u32x4*)(scr + row * 144 + ch * 16);
        *(u32x4*)(WT + (size_t)(nb * 64 + row) * K + k0 + ch * 8) = w; }
    __builtin_amdgcn_fence(__ATOMIC_RELEASE, "wavefront"); __builtin_amdgcn_wave_barrier();
}

DI void phase_p0(const Params& p, LAS unsigned char* lds, const int tid) {
    const int lane = tid & 63, wid = tid >> 6, G = gridDim.x, bid = blockIdx.x;
    const float* c = p.IN(5); const float* c_ctx = p.IN(6); const float* ada_w = p.IN(9); const float* ada_b = p.IN(10);
    float* mod = (float*)(p.ws + WS_MOD);
    LAS float* st = (LAS float*)lds + wid * 640;
    LAS float* red = (LAS float*)(lds + 32768);
    for (int bu = bid; bu < 192; bu += G) {
        const int l = bu / 96, cgp = bu % 96, col = cgp * 64 + lane;
        for (int i = lane; i < 640; i += 64) { const int row = i / 128, k = wid * 128 + (i % 128); const float cv = row == 0 ? c_ctx[k] : c[(row - 1) * 1024 + k]; st[i] = siluf_(cv); }
        __syncthreads();
        float acc[5] = {0.f, 0.f, 0.f, 0.f, 0.f};
        const float* W = ada_w + (size_t)l * 1024 * 6144 + (size_t)(wid * 128) * 6144 + col;
#pragma unroll 16
        for (int kk = 0; kk < 128; ++kk) { const float w = W[(size_t)kk * 6144];
#pragma unroll
            for (int row = 0; row < 5; ++row) acc[row] += st[row * 128 + kk] * w; }
#pragma unroll
        for (int row = 0; row < 5; ++row) red[(wid * 5 + row) * 64 + lane] = acc[row];
        __syncthreads();
        if (tid < 320) { const int row = tid / 64, ln = tid % 64; float s = 0.f;
#pragma unroll
            for (int w = 0; w < 8; ++w) s += red[(w * 5 + row) * 64 + ln];
            const int cc = cgp * 64 + ln; mod[(l * 5 + row) * 6144 + cc] = s + ada_b[l * 6144 + cc]; }
        __syncthreads();
    }
    const int gw = bid * 8 + wid, GW = G * 8;
    LAS unsigned char* scr = lds + 65536 + wid * 9216;
    for (int u = gw; u < 6400; u += GW) {
        const int l = u / 3200; int r = u % 3200;
        if (r < 896) transpose_unit(p.IN(11) + (size_t)l * 1024 * PW, 1024, PW, NP, (bf16_t*)(p.ws + WS_WIN) + (size_t)l * NP * 1024, r, lane, scr);
        else if (r < 1152) transpose_unit(p.IN(12) + (size_t)l * 1024 * 1024, 1024, 1024, 1024, (bf16_t*)(p.ws + WS_WOUT) + (size_t)l * 1024 * 1024, r - 896, lane, scr);
        else if (r < 2176) transpose_unit(p.IN(26) + (size_t)l * 1024 * 4096, 1024, 4096, 4096, (bf16_t*)(p.ws + WS_W1) + (size_t)l * 4096 * 1024, r - 1152, lane, scr);
        else transpose_unit(p.IN(27) + (size_t)l * 4096 * 1024, 4096, 1024, 1024, (bf16_t*)(p.ws + WS_W2) + (size_t)l * 1024 * 4096, r - 2176, lane, scr);
    }
}

DI void phase_norm(const Params& p, int l, int which, const int tid, const bool dry = false) {
    const int lane = tid & 63, wid = tid >> 6, gw = blockIdx.x * 8 + wid, GW = gridDim.x * 8;
    const float* mod = (const float*)(p.ws + WS_MOD);
    bf16_t* hm = (bf16_t*)(p.ws + (dry ? WS_OI : WS_HM));
    float* xo = dry ? (float*)(p.ws + WS_HL) : p.out;
    const float* g = which == 0 ? p.IN(7) + l * 1024 : (which == 1 ? p.IN(8) + l * 1024 : p.IN(28));
    const bool first = (which == 0 && l == 0), from_in = (l == 0 && which != 2);
    for (int row0 = gw; row0 < NTOK; row0 += 4 * GW) {
        f32x4 v[4][4]; float ss[4];
#pragma unroll
        for (int k = 0; k < 4; ++k) {
            const int row = row0 + k * GW; ss[k] = 0.f;
            if (row < NTOK) {
                const float* xr = from_in ? (row < 4096 ? p.IN(0) + (size_t)row * 1024 : p.IN(1) + (size_t)(row - 4096) * 1024) : p.out + (size_t)row * 1024;
#pragma unroll
                for (int j = 0; j < 4; ++j) v[k][j] = ((const f32x4*)xr)[lane + 64 * j];
                if (!first) {
                    const bf16_t* pr = (const bf16_t*)(p.ws + WS_DSA) + (size_t)row * 1024;
#pragma unroll
                    for (int j = 0; j < 4; ++j) { const u32x2 pp = ((const u32x2*)pr)[lane + 64 * j], pq = ((const u32x2*)(pr + (size_t)NTOK * 1024))[lane + 64 * j];
                        v[k][j].x += __uint_as_float(pp.x << 16) + __uint_as_float(pq.x << 16); v[k][j].y += __uint_as_float(pp.x & 0xffff0000u) + __uint_as_float(pq.x & 0xffff0000u);
                        v[k][j].z += __uint_as_float(pp.y << 16) + __uint_as_float(pq.y << 16); v[k][j].w += __uint_as_float(pp.y & 0xffff0000u) + __uint_as_float(pq.y & 0xffff0000u); }
                }
            }
        }
#pragma unroll
        for (int k = 0; k < 4; ++k) {
            const int row = row0 + k * GW;
            if (row < NTOK) {
#pragma unroll
                for (int j = 0; j < 4; ++j) ss[k] += (v[k][j].x * v[k][j].x + v[k][j].y * v[k][j].y) + (v[k][j].z * v[k][j].z + v[k][j].w * v[k][j].w);
            }
        }
#pragma unroll
        for (int o = 1; o < 64; o <<= 1) {
#pragma unroll
            for (int k = 0; k < 4; ++k) ss[k] += shx(ss[k], lane, o);
        }
#pragma unroll
        for (int k = 0; k < 4; ++k) {
            const int row = row0 + k * GW;
            if (row < NTOK) {
                const float rstd = rsqrtf(ss[k] * (1.f / 1024.f) + 1e-6f);
                if (which == 2) {
                    float* yo = xo + (size_t)row * 1024;
#pragma unroll
                    for (int j = 0; j < 4; ++j) { const f32x4 gv = ((const f32x4*)g)[lane + 64 * j]; ((f32x4*)yo)[lane + 64 * j] = v[k][j] * rstd * gv; }
                } else {
                    const float* mr = mod + (size_t)(l * 5 + modrow_of(row)) * 6144 + (which == 0 ? 0 : 3072);
#pragma unroll
                    for (int j = 0; j < 4; ++j) { const f32x4 gv = ((const f32x4*)g)[lane + 64 * j]; const f32x4 sh = ((const f32x4*)mr)[lane + 64 * j], sc = ((const f32x4*)(mr + 1024))[lane + 64 * j];
                        const f32x4 hv = v[k][j] * rstd * gv * (sc + 1.f) + sh;
                        u32x2 o; o.x = pk2(hv.x, hv.y); o.y = pk2(hv.z, hv.w);
                        ((u32x2*)(hm + (size_t)row * 1024))[lane + 64 * j] = o;
                        if (!first) ((f32x4*)(xo + (size_t)row * 1024))[lane + 64 * j] = v[k][j]; }
                }
            }
        }
    }
}

constexpr int M1_TILE_BYTES = 66048, M1_WL_BYTES = 9216;
template <int NCOL8, int NROWS>
DI void stage_tile(const char* proj, LAS unsigned char* tile, int row_first, int col0, int pitchB, int dstB, int s0, int s1, int tid) {
    constexpr int NCH = NCOL8 * NROWS, IT = (NCH + 511) / 512;
    u32x4 v[IT];
#pragma unroll
    for (int i = 0; i < IT; ++i) { const int id = tid + 512 * i; const int row = id / NCOL8, cc = id % NCOL8, t = row_first + row;
        v[i] = (u32x4){0u, 0u, 0u, 0u};
        if (id < NCH && t >= s0 && t < s1) v[i] = *(const u32x4*)(proj + ((size_t)t * NP + col0 + cc * 8) * 2); }
#pragma unroll
    for (int i = 0; i < IT; ++i) { const int id = tid + 512 * i; const int row = id / NCOL8, cc = id % NCOL8;
        if (id < NCH) *(LAS u32x4*)(tile + row * pitchB + dstB + cc * 16) = v[i]; }
}

template <int MIX>
DI void m1_gla_wave(const Params& p, int l, int c, int hd, int dir, const LAS unsigned char* tile, LAS unsigned char* wl, const LAS unsigned char* wlp, int lane) {
    constexpr int DK = MIX == 0 ? 64 : 32, NT = DK / 32, PITCH = DK + 8, TP = MIX == 0 ? 1032 : 552;
    const int r = lane & 31, hh = lane >> 5, tok0 = c * 32;
    const LAS bf16_t* T = (const LAS bf16_t*)tile;
    LAS bf16_t* Qt = (LAS bf16_t*)wl; LAS bf16_t* Kt = Qt + 32 * PITCH;
    char* DS = (char*)(p.ws + (MIX == 0 ? WS_DSA : WS_DSB));
    float* ACH = (float*)(p.ws + (MIX == 0 ? WS_ACHA : WS_ACHB));
    char* QH = (char*)(p.ws + (MIX == 0 ? WS_QHA : WS_QHB));
    float* OI = (float*)(p.ws + WS_OI);
    const int tba = 4 * hh * TP, tb = tba + r;
#define TROW(li) ((8 * ((li) >> 2) + ((li) & 3)) * TP)
    const int vcol = MIX == 0 ? 256 + hd * 64 : 256 + hd * 64;
    bf16x8 vf[2][2];
#pragma unroll
    for (int n = 0; n < 2; ++n)
#pragma unroll
        for (int st = 0; st < 2; ++st)
#pragma unroll
            for (int j = 0; j < 8; ++j) vf[n][st][j] = (short)T[tb + TROW(8 * st + j) + vcol + 32 * n];
    const int qcol = MIX == 0 ? hd * 64 : hd * 32;
#pragma unroll 1
    for (int m = 0; m < NT; ++m) {
        float la[16], kk[16];
        if (MIX == 0) {
            const int zcol = (dir == 0 ? 512 : 768) + hd * 64 + 32 * m;
            const float* lbl = p.IN(13);
            float lb = 0.f;
            if (l == 1) { const int ch = hd * 64 + 32 * m + r; const float l0 = lbl[(0 * 2 + dir) * 256 + ch], l1 = lbl[(1 * 2 + dir) * 256 + ch]; lb = rcpf_(1.f + __expf(l0 - l1)); }
#pragma unroll
            for (int li = 0; li < 16; ++li) { const float z = bf2f(T[tb + TROW(li) + zcol]);
                const float e = __expf(-z), sg = rcpf_(1.f + e), omsg = e * sg;
                const float f = lb + (1.f - lb) * sg; kk[li] = (1.f - lb) * omsg; la[li] = __logf(fmaxf(f, 1e-20f)); }
        } else {
            const int kcol = 128 + hd * 32, acol = 512 + dir * 16;
            float w2[16];
#pragma unroll
            for (int rho = 0; rho < 16; ++rho) w2[rho] = p.IN(15)[((l * 2 + dir) * 16 + rho) * 128 + hd * 32 + r];
            const float ba = p.IN(16)[(l * 2 + dir) * 128 + hd * 32 + r];
#pragma unroll
            for (int li = 0; li < 16; ++li) {
                const u32x4 a0 = *(const LAS u32x4*)(T + tba + TROW(li) + acol), a1 = *(const LAS u32x4*)(T + tba + TROW(li) + acol + 8);
                float w = ba;
#pragma unroll
                for (int qd = 0; qd < 4; ++qd) { w += __uint_as_float(a0[qd] << 16) * w2[2 * qd] + __uint_as_float(a0[qd] & 0xffff0000u) * w2[2 * qd + 1];
                    w += __uint_as_float(a1[qd] << 16) * w2[8 + 2 * qd] + __uint_as_float(a1[qd] & 0xffff0000u) * w2[8 + 2 * qd + 1]; }
                const float ls = fminf(w, 0.f) - __logf(1.f + __expf(-fabsf(w)));
                la[li] = ls * (1.f / 16.f);
                kk[li] = bf2f(T[tb + TROW(li) + kcol]);
            }
        }
        float gs[4], pgs[4];
#pragma unroll
        for (int g = 0; g < 4; ++g) { gs[g] = (la[4 * g] + la[4 * g + 1]) + (la[4 * g + 2] + la[4 * g + 3]); pgs[g] = shx(gs[g], lane, 32); }
        float run = 0.f, half = 0.f; float cum[16];
#pragma unroll
        for (int g = 0; g < 4; ++g) { float b = run + (hh ? pgs[g] : 0.f); run += gs[g] + pgs[g]; if (g == 1) half = run;
#pragma unroll
            for (int i = 0; i < 4; ++i) { b += la[4 * g + i]; cum[4 * g + i] = b; } }
        const float total = run;
        const float ref = dir == 0 ? half : total - half;
        float kh[16];
        const unsigned qhb = MIX == 0 ? (unsigned)((tok0 + 4 * hh) * 512 + dir * 256 + hd * 64 + 32 * m + r) * 2u : (unsigned)((tok0 + 4 * hh) * 256 + dir * 128 + hd * 32 + r) * 2u;
#pragma unroll
        for (int li = 0; li < 16; ++li) {
            const float cv = dir == 0 ? cum[li] : (total - cum[li] + la[li]);
            const float eq = __expf(fminf(cv - ref, 80.f)), ek = __expf(fminf(ref - cv, 80.f));
            const int tkl = 8 * (li >> 2) + (li & 3);
            const float qv = bf2f(T[tb + TROW(li) + qcol + 32 * m]) * (MIX == 1 ? 0.17677669529663687f : 1.f);
            Qt[(tkl + 4 * hh) * PITCH + 32 * m + r] = f2bf(qv * eq);
            Kt[(tkl + 4 * hh) * PITCH + 32 * m + r] = f2bf(kk[li] * ek);
            kh[li] = kk[li] * __expf(total - cv);
            const float qh = qv * __expf(cv);
            *(bf16_t*)(QH + (qhb + (unsigned)(tkl * (MIX == 0 ? 512 : 256) * 2))) = f2bf(qh);
        }
        const bf16x8 khat0 = pack8(kh), khat1 = pack8(kh + 8);
        if (hh == 0) ACH[((c * 4 + hd) * 2 + dir) * DK + 32 * m + r] = __expf(total);
#pragma unroll
        for (int n = 0; n < 2; ++n) {
            f32x16 ds = zero16();
            ds = MFMA32(khat0, vf[n][0], ds); ds = MFMA32(khat1, vf[n][1], ds);
            const unsigned dsb = (unsigned)(((c * 4 + hd) * 2 + dir) * (DK * 64) * 2) + (unsigned)((n * (DK / 16) + 2 * m) * 1024 + r * 16 + hh * 8);
#pragma unroll
            for (int g = 0; g < 4; ++g) { u32x2 w; w.x = pk2(ds[4 * g], ds[4 * g + 1]); w.y = pk2(ds[4 * g + 2], ds[4 * g + 3]);
                *(u32x2*)(DS + (dsb + (unsigned)((g >> 1) * 1024 + (g & 1) * 512))) = w; }
        }
    }
#undef TROW
    __builtin_amdgcn_fence(__ATOMIC_RELEASE, "wavefront");
    __builtin_amdgcn_wave_barrier();
    f32x16 pt = zero16();
#pragma unroll
    for (int s = 0; s < DK / 16; ++s) {
        const bf16x8 kfr = *(const LAS bf16x8*)(Kt + r * PITCH + 16 * s + 8 * hh);
        const bf16x8 qfr = *(const LAS bf16x8*)(Qt + r * PITCH + 16 * s + 8 * hh);
        pt = MFMA32(kfr, qfr, pt);
    }
    __builtin_amdgcn_fence(__ATOMIC_RELEASE, "wavefront");
    __builtin_amdgcn_wave_barrier();
    LAS float* ex = (LAS float*)wl; const LAS float* exp_ = (const LAS float*)wlp;
#pragma unroll
    for (int i = 0; i < 16; ++i) { const int srow = crow(i, hh); const bool keep = dir == 0 ? (srow <= r) : (srow >= r); pt[i] = keep ? pt[i] : 0.f; ex[i * 64 + lane] = pt[i]; }
    __syncthreads();
    float ptv[16];
#pragma unroll
    for (int i = 0; i < 16; ++i) ptv[i] = pt[i] + exp_[i * 64 + lane];
    const bf16x8 pf0 = pack8(ptv), pf1 = pack8(ptv + 8);
    float* oi = OI + (size_t)((MIX * 256 + c) * 4 + hd) * 2048;
    {
        f32x16 ot = zero16();
        const bf16x8 va = dir == 0 ? vf[0][0] : vf[1][0], vb = dir == 0 ? vf[0][1] : vf[1][1];
        ot = MFMA32(va, pf0, ot); ot = MFMA32(vb, pf1, ot);
#pragma unroll
        for (int g = 0; g < 4; ++g) *(f32x4*)(oi + ((dir * 4 + g) * 64 + lane) * 4) = (f32x4){ot[4 * g], ot[4 * g + 1], ot[4 * g + 2], ot[4 * g + 3]};
    }
}

DI void m1_rg_wave(const Params& p, int l, int c, int nb, int dir, const LAS unsigned char* tile, int lane) {
    constexpr int TP = 264;
    const int r = lane & 31, hh = lane >> 5, tok0 = c * 32;
    const LAS bf16_t* T = (const LAS bf16_t*)tile;
    float* HL = (float*)(p.ws + WS_HL); float* CP = (float*)(p.ws + WS_CP);
    float* RAGA = (float*)(p.ws + WS_RAGA); float* RAGH = (float*)(p.ws + WS_RAGH);
    const int sgn = dir ? -1 : 1, lbase = dir ? 31 : 0;
    const float* cw = p.IN(18) + (size_t)(l * 2 + dir) * 4 * 256;
    const float* cb = p.IN(19) + (size_t)(l * 2 + dir) * 256;
    bf16x8 af[4];
    const int trow = lbase + sgn * r + 3;
#pragma unroll
    for (int s = 0; s < 4; ++s) {
        const int ch0 = 64 * nb + 16 * s + 8 * hh;
        float xc[8];
        { const f32x4 b0 = *(const f32x4*)(cb + ch0), b1 = *(const f32x4*)(cb + ch0 + 4);
          xc[0] = b0.x; xc[1] = b0.y; xc[2] = b0.z; xc[3] = b0.w; xc[4] = b1.x; xc[5] = b1.y; xc[6] = b1.z; xc[7] = b1.w; }
#pragma unroll
        for (int tap = 0; tap < 4; ++tap) {
            const u32x4 uu = *(const LAS u32x4*)(T + (trow + sgn * (tap - 3)) * TP + ch0);
            const f32x4 w0 = *(const f32x4*)(cw + tap * 256 + ch0), w1 = *(const f32x4*)(cw + tap * 256 + ch0 + 4);
            xc[0] += w0.x * __uint_as_float(uu.x << 16); xc[1] += w0.y * __uint_as_float(uu.x & 0xffff0000u);
            xc[2] += w0.z * __uint_as_float(uu.y << 16); xc[3] += w0.w * __uint_as_float(uu.y & 0xffff0000u);
            xc[4] += w1.x * __uint_as_float(uu.z << 16); xc[5] += w1.y * __uint_as_float(uu.z & 0xffff0000u);
            xc[6] += w1.z * __uint_as_float(uu.w << 16); xc[7] += w1.w * __uint_as_float(uu.w & 0xffff0000u);
        }
        af[s] = pack8(xc);
    }
    const float* wr_ = p.IN(20) + (size_t)((l * 2 + dir) * 4 + nb) * 4096;
    const float* wi_ = p.IN(22) + (size_t)((l * 2 + dir) * 4 + nb) * 4096;
#pragma unroll 1
    for (int n = 0; n < 2; ++n) {
        f32x16 rr = zero16(), ri = zero16();
#pragma unroll
        for (int s = 0; s < 4; ++s) {
            float br_[8], bi_[8];
#pragma unroll
            for (int j = 0; j < 8; ++j) { br_[j] = wr_[(16 * s + 8 * hh + j) * 64 + 32 * n + r]; bi_[j] = wi_[(16 * s + 8 * hh + j) * 64 + 32 * n + r]; }
            rr = MFMA32(af[s], pack8(br_), rr); ri = MFMA32(af[s], pack8(bi_), ri);
        }
        const int ch = 64 * nb + 32 * n + r;
        const float cbv = cb[ch]; float cwv[4];
#pragma unroll
        for (int tap = 0; tap < 4; ++tap) cwv[tap] = cw[tap * 256 + ch];
        const float brv = p.IN(21)[(l * 2 + dir) * 256 + ch], biv = p.IN(23)[(l * 2 + dir) * 256 + ch];
        const float lam = p.IN(24)[(l * 2 + dir) * 256 + ch];
        const float c8 = -8.f * log1pf(__expf(-lam));
        float a[16], bx[16];
#pragma unroll
        for (int li = 0; li < 16; ++li) {
            const int tr = lbase + sgn * (8 * (li >> 2) + 4 * hh + (li & 3)) + 3;
            float xcv = cbv;
#pragma unroll
            for (int tap = 0; tap < 4; ++tap) xcv += cwv[tap] * bf2f(T[(tr + sgn * (tap - 3)) * TP + ch]);
            const float rv = sigmoidf_(rr[li] + brv), iv = sigmoidf_(ri[li] + biv);
            const float loga = c8 * rv;
            a[li] = __expf(loga); bx[li] = __builtin_amdgcn_sqrtf(om_exp(2.f * loga)) * iv * xcv;
        }
        float Ag[4], Bg[4], pA[4], pB[4];
#pragma unroll
        for (int g = 0; g < 4; ++g) { float hl = 0.f, ap = 1.f;
#pragma unroll
            for (int i = 0; i < 4; ++i) { hl = a[4 * g + i] * hl + bx[4 * g + i]; ap *= a[4 * g + i]; }
            Ag[g] = ap; Bg[g] = hl; pA[g] = shx(ap, lane, 32); pB[g] = shx(hl, lane, 32); }
        float Hrun = 0.f, Prun = 1.f;
        const bool first = (hh == 0);
#pragma unroll
        for (int g = 0; g < 4; ++g) {
            const float A0 = first ? Ag[g] : pA[g], B0 = first ? Bg[g] : pB[g];
            const float A1 = first ? pA[g] : Ag[g], B1 = first ? pB[g] : Bg[g];
            float hcur = first ? Hrun : (A0 * Hrun + B0), pcur = first ? Prun : Prun * A0;
            Hrun = A1 * (A0 * Hrun + B0) + B1; Prun = Prun * A0 * A1;
#pragma unroll
            for (int i = 0; i < 4; ++i) { hcur = a[4 * g + i] * hcur + bx[4 * g + i]; pcur *= a[4 * g + i];
                const int tg = tok0 + lbase + sgn * (8 * g + 4 * hh + i);
                HL[((size_t)dir * NTOK + tg) * 256 + ch] = hcur; CP[((size_t)dir * NTOK + tg) * 256 + ch] = pcur; }
        }
        if (hh == 0) { RAGA[(c * 2 + dir) * 256 + ch] = Prun; RAGH[(c * 2 + dir) * 256 + ch] = Hrun; }
    }
}

DI void phase_m1(const Params& p, int l, LAS unsigned char* lds, const int tid, const int stages = 7) {
    const int lane = tid & 63, wid = __builtin_amdgcn_readfirstlane(tid >> 6);
    const char* proj = (const char*)(p.ws + WS_BIG);
    LAS unsigned char* tile = lds;
    LAS unsigned char* wl = lds + M1_TILE_BYTES + wid * M1_WL_BYTES;
    LAS unsigned char* wlp = lds + M1_TILE_BYTES + (wid ^ 1) * M1_WL_BYTES;
    for (int c = blockIdx.x; c < 256; c += gridDim.x) {
        int ln = lane, td = tid; asm volatile("" : "+v"(ln), "+v"(td));
        const int tok0 = c * 32;
        int s0, s1;
        if (c < 128) { s0 = (c >> 3) * 256; s1 = s0 + 256; } else { s0 = 4096 + ((c - 128) >> 5) * 1024; s1 = s0 + 1024; }
        if (stages & 1) {
        stage_tile<128, 32>(proj, tile, tok0, 0, 2064, 0, 0, NTOK, td);
        __syncthreads();
        m1_gla_wave<0>(p, l, c, wid >> 1, wid & 1, tile, wl, wlp, ln);
        __builtin_amdgcn_sched_barrier(0); asm volatile("" : "+v"(ln), "+v"(td));
        }
        if (stages & 2) {
        stage_tile<64, 32>(proj, tile, tok0, B_Q, 1104, 0, 0, NTOK, td);
        stage_tile<4, 32>(proj, tile, tok0, B_AF, 1104, 1024, 0, NTOK, td);
        __syncthreads();
        m1_gla_wave<1>(p, l, c, wid >> 1, wid & 1, tile, wl, wlp, ln);
        __builtin_amdgcn_sched_barrier(0); asm volatile("" : "+v"(ln), "+v"(td));
        }
        if (stages & 4) {
        stage_tile<32, 38>(proj, tile, tok0 - 3, C_X, 528, 0, s0, s1, td);
        __syncthreads();
        m1_rg_wave(p, l, c, wid >> 1, wid & 1, tile, ln);
        __syncthreads();
        }
    }
}

DI void m2_chain8(const Params& p, int l, int id, const bool dry) {
    const int sq = id / 6144; int rem = id % 6144;
    const int hd = rem / 1536, dir = (rem / 768) & 1; int f = rem % 768;
    const int mix = f < 512 ? 0 : 1; if (mix) f -= 512;
    const int dk = mix == 0 ? 64 : 32, S_ = dk / 16;
    const int lane_ = f & 63, ns = f >> 6, n = ns / S_, s = ns % S_;
    const int d0 = 16 * s + 8 * (lane_ >> 5), e = 32 * n + (lane_ & 31);
    char* DS = (char*)(p.ws + (mix == 0 ? WS_DSA : WS_DSB));
    char* DSO = dry ? (char*)(p.ws + (mix == 0 ? WS_HM : WS_BIG + 56 * MiB)) : DS;
    const float* ACH = (const float*)(p.ws + (mix == 0 ? WS_ACHA : WS_ACHB));
    float zf = 0.f; asm volatile("" : "+v"(zf));
    float S[8];
#pragma unroll
    for (int j = 0; j < 8; ++j) S[j] = zf;
    int c0, N;
    if (sq < 16) { c0 = sq * 8; N = 8; }
    else { c0 = 128 + (sq - 16) * 32; N = 32; const int b = sq - 16;
        const float* s0p = mix == 0 ? p.IN(2) + (size_t)((((b * 2 + l) * 2 + dir) * 4 + hd)) * 4096 : p.IN(3) + (size_t)((((b * 2 + l) * 2 + dir) * 4 + hd)) * 2048;
#pragma unroll
        for (int j = 0; j < 8; ++j) S[j] = s0p[(d0 + j) * 64 + e]; }
    for (int n0 = 0; n0 < N; n0 += 8) {
        u32x4 v[8]; f32x4 a0[8], a1[8];
#pragma unroll
        for (int i = 0; i < 8; ++i) { const int nn = n0 + i, c = c0 + (dir == 0 ? nn : N - 1 - nn); const size_t ui = (size_t)((c * 4 + hd) * 2 + dir);
            v[i] = *(const u32x4*)(DS + ui * (dk * 128) + f * 16); a0[i] = *(const f32x4*)(ACH + ui * dk + d0); a1[i] = *(const f32x4*)(ACH + ui * dk + d0 + 4); }
#pragma unroll
        for (int i = 0; i < 8; ++i) { const int nn = n0 + i, c = c0 + (dir == 0 ? nn : N - 1 - nn); const size_t ui = (size_t)((c * 4 + hd) * 2 + dir);
            u32x4 o; o.x = pk2(S[0], S[1]); o.y = pk2(S[2], S[3]); o.z = pk2(S[4], S[5]); o.w = pk2(S[6], S[7]);
            *(u32x4*)(DSO + ui * (dk * 128) + f * 16) = o;
            S[0] = a0[i].x * S[0] + __uint_as_float(v[i].x << 16); S[1] = a0[i].y * S[1] + __uint_as_float(v[i].x & 0xffff0000u);
            S[2] = a0[i].z * S[2] + __uint_as_float(v[i].y << 16); S[3] = a0[i].w * S[3] + __uint_as_float(v[i].y & 0xffff0000u);
            S[4] = a1[i].x * S[4] + __uint_as_float(v[i].z << 16); S[5] = a1[i].y * S[5] + __uint_as_float(v[i].z & 0xffff0000u);
            S[6] = a1[i].z * S[6] + __uint_as_float(v[i].w << 16); S[7] = a1[i].w * S[7] + __uint_as_float(v[i].w & 0xffff0000u); }
    }
    if (sq < 16) { const int b = sq;
        float* ob = dry ? (float*)(p.ws + 243 * MiB) - OUT_SH : p.out;
        float* op = mix == 0 ? ob + OUT_SH + (size_t)((((b * 2 + l) * 2 + dir) * 4 + hd)) * 4096 : ob + OUT_SG + (size_t)((((b * 2 + l) * 2 + dir) * 4 + hd)) * 2048;
#pragma unroll
        for (int j = 0; j < 8; ++j) op[(d0 + j) * 64 + e] = S[j]; }
}
DI void phase_m2(const Params& p, int l, const int tid, const bool dry = false) {
    const int gt = blockIdx.x * 512 + tid, GT = gridDim.x * 512;
    for (int id = gt; id < 20 * 6144; id += GT) m2_chain8(p, l, 20 * 6144 - 1 - id, dry);
    float* RAGH = (float*)(p.ws + WS_RAGH); const float* RAGA = (const float*)(p.ws + WS_RAGA);
    float* RAGO = dry ? (float*)(p.ws + 250 * MiB) : RAGH; float* SRO = dry ? (float*)(p.ws + 251 * MiB) - OUT_SR : p.out;
    for (int id = GT - 1 - gt; id < 20 * 512; id += GT) {
        const int sq = id / 512, dir = (id >> 8) & 1, ch = id & 255;
        int c0, N; float h = 0.f;
        if (sq < 16) { c0 = sq * 8; N = 8; } else { c0 = 128 + (sq - 16) * 32; N = 32; h = p.IN(4)[((size_t)((sq - 16) * 2 + l) * 2 + dir) * 256 + ch]; }
        for (int n0 = 0; n0 < N; n0 += 8) {
            float v[8], av[8];
#pragma unroll
            for (int i = 0; i < 8; ++i) { const int n = n0 + i, c = c0 + (dir == 0 ? n : N - 1 - n); v[i] = RAGH[(c * 2 + dir) * 256 + ch]; av[i] = RAGA[(c * 2 + dir) * 256 + ch]; }
#pragma unroll
            for (int i = 0; i < 8; ++i) { const int n = n0 + i, c = c0 + (dir == 0 ? n : N - 1 - n); RAGO[(c * 2 + dir) * 256 + ch] = h; h = av[i] * h + v[i]; }
        }
        if (sq < 16) SRO[OUT_SR + ((size_t)(sq * 2 + l) * 2 + dir) * 256 + ch] = h;
    }
}

template <int MIX>
DI void m3_gla_unit(const Params& p, int l, int c, int hd, int lane) {
    constexpr int DK = MIX == 0 ? 64 : 32;
    const int r = lane & 31, hh = lane >> 5, tok0 = c * 32;
    const bf16_t* proj = (const bf16_t*)(p.ws + WS_BIG);
    const bf16_t* DS = (const bf16_t*)(p.ws + (MIX == 0 ? WS_DSA : WS_DSB));
    const bf16_t* QH = (const bf16_t*)(p.ws + (MIX == 0 ? WS_QHA : WS_QHB));
    const float* oi = (const float*)(p.ws + WS_OI) + (size_t)((MIX * 256 + c) * 4 + hd) * 2048;
    bf16_t* mix = (bf16_t*)(p.ws + WS_HM);
    f32x16 acc[2];
#pragma unroll
    for (int n = 0; n < 2; ++n)
#pragma unroll
        for (int g = 0; g < 4; ++g) { const f32x4 v = *(const f32x4*)(oi + ((n * 4 + g) * 64 + lane) * 4); acc[n][4 * g] = v.x; acc[n][4 * g + 1] = v.y; acc[n][4 * g + 2] = v.z; acc[n][4 * g + 3] = v.w; }
#pragma unroll
    for (int dir = 0; dir < 2; ++dir) {
        const bf16_t* sp = DS + (size_t)((c * 4 + hd) * 2 + dir) * (DK * 64);
#pragma unroll
        for (int s = 0; s < DK / 16; ++s) {
            const bf16x8 qf = MIX == 0 ? *(const bf16x8*)(QH + (size_t)(tok0 + r) * 512 + dir * 256 + hd * 64 + 16 * s + 8 * hh)
                                       : *(const bf16x8*)(QH + (size_t)(tok0 + r) * 256 + dir * 128 + hd * 32 + 16 * s + 8 * hh);
#pragma unroll
            for (int n = 0; n < 2; ++n) {
                const bf16x8 sf = *(const bf16x8*)(sp + ((n * (DK / 16) + s) * 64 + lane) * 8);
                acc[n] = MFMA32(sf, qf, acc[n]);
            }
        }
    }
    float ss = 0.f;
#pragma unroll
    for (int n = 0; n < 2; ++n)
#pragma unroll
        for (int i = 0; i < 16; ++i) ss += acc[n][i] * acc[n][i];
    ss += shx(ss, lane, 32);
    const float rstd = rsqrtf(ss * (1.f / 64.f) + 1e-6f);
    const float* gain = (MIX == 0 ? p.IN(14) : p.IN(17)) + l * 256 + hd * 64;
    const bf16_t* grow = proj + (size_t)(tok0 + r) * NP + (MIX == 0 ? A_G : B_G) + hd * 64;
    bf16_t* orow = mix + (size_t)(tok0 + r) * 1024 + MIX * 256 + hd * 64;
#pragma unroll
    for (int n = 0; n < 2; ++n)
#pragma unroll
        for (int g = 0; g < 4; ++g) {
            const int e = 32 * n + 8 * g + 4 * hh;
            const u32x2 gg = *(const u32x2*)(grow + e); const f32x4 gn = *(const f32x4*)(gain + e);
            const float g0 = __uint_as_float(gg.x << 16), g1 = __uint_as_float(gg.x & 0xffff0000u), g2 = __uint_as_float(gg.y << 16), g3 = __uint_as_float(gg.y & 0xffff0000u);
            u32x2 o; o.x = pk2(acc[n][4 * g] * rstd * gn.x * siluf_(g0), acc[n][4 * g + 1] * rstd * gn.y * siluf_(g1));
            o.y = pk2(acc[n][4 * g + 2] * rstd * gn.z * siluf_(g2), acc[n][4 * g + 3] * rstd * gn.w * siluf_(g3));
            *(u32x2*)(orow + e) = o;
        }
}

DI float gelu_tanh(float x) { const float u = 0.7978845608028654f * (x + 0.044715f * x * x * x); const float t = 1.f - 2.f * rcpf_(__expf(2.f * u) + 1.f); return 0.5f * x * (1.f + t); }

DI void phase_m3(const Params& p, int l, const int tid) {
    const int lane = tid & 63, wid = __builtin_amdgcn_readfirstlane(tid >> 6), gw = blockIdx.x * 8 + wid, GW = gridDim.x * 8;
    for (int u = gw; u < 2048; u += GW) {
        const int ty = u & 1, idx = u >> 1, c = idx >> 2, hd = idx & 3;
        int ln = lane; asm volatile("" : "+v"(ln));
        if (ty == 0) m3_gla_unit<0>(p, l, c, hd, ln); else m3_gla_unit<1>(p, l, c, hd, ln);
    }
    const int gt = blockIdx.x * 512 + tid, GT = gridDim.x * 512;
    const bf16_t* proj = (const bf16_t*)(p.ws + WS_BIG);
    bf16_t* mix = (bf16_t*)(p.ws + WS_HM);
    const float* HL = (const float*)(p.ws + WS_HL); const float* CP = (const float*)(p.ws + WS_CP); const float* HIN = (const float*)(p.ws + WS_RAGH);
    for (int id0 = gt; id0 < NTOK * 64; id0 += 4 * GT) {
        f32x4 hf[4], hb[4], cf[4], cb[4], inf_[4], inb[4]; u32x2 gg[4];
#pragma unroll
        for (int k = 0; k < 4; ++k) { const int id = id0 + k * GT; if (id < NTOK * 64) { const int tok = id >> 6, ch = (id & 63) * 4, c = tok >> 5;
            hf[k] = *(const f32x4*)(HL + (size_t)tok * 256 + ch); hb[k] = *(const f32x4*)(HL + ((size_t)NTOK + tok) * 256 + ch);
            cf[k] = *(const f32x4*)(CP + (size_t)tok * 256 + ch); cb[k] = *(const f32x4*)(CP + ((size_t)NTOK + tok) * 256 + ch);
            inf_[k] = *(const f32x4*)(HIN + (c * 2 + 0) * 256 + ch); inb[k] = *(const f32x4*)(HIN + (c * 2 + 1) * 256 + ch);
            gg[k] = *(const u32x2*)(proj + (size_t)tok * NP + C_G + ch); } }
#pragma unroll
        for (int k = 0; k < 4; ++k) { const int id = id0 + k * GT; if (id < NTOK * 64) { const int tok = id >> 6, ch = (id & 63) * 4;
            const f32x4 y = hf[k] + cf[k] * inf_[k] + hb[k] + cb[k] * inb[k];
            u32x2 o; o.x = pk2(y.x * gelu_tanh(__uint_as_float(gg[k].x << 16)), y.y * gelu_tanh(__uint_as_float(gg[k].x & 0xffff0000u)));
            o.y = pk2(y.z * gelu_tanh(__uint_as_float(gg[k].y << 16)), y.w * gelu_tanh(__uint_as_float(gg[k].y & 0xffff0000u)));
            *(u32x2*)(mix + (size_t)tok * 1024 + 512 + ch) = o; } }
    }
    const float* sw = p.IN(25) + l * 3 * 256;
    for (int id0 = gt; id0 < NTOK * 64; id0 += 4 * GT) {
        u32x2 cc[4][3], vv[4][3], bb[4];
#pragma unroll
        for (int k = 0; k < 4; ++k) { const int id = id0 + k * GT; if (id < NTOK * 64) { const int tok = id >> 6, ch = (id & 63) * 4;
            const int seg = tok < 4096 ? 256 : 64, pos = tok & (seg - 1);
#pragma unroll
            for (int j = 0; j < 3; ++j) { const int pp = pos + j - 1; cc[k][j] = (u32x2){0u, 0u}; vv[k][j] = (u32x2){0u, 0u};
                if (pp >= 0 && pp < seg) { const int tt = tok + j - 1; cc[k][j] = *(const u32x2*)(proj + (size_t)tt * NP + D_C + ch); vv[k][j] = *(const u32x2*)(proj + (size_t)tt * NP + D_V + ch); } }
            bb[k] = *(const u32x2*)(proj + (size_t)tok * NP + D_B + ch); } }
#pragma unroll
        for (int k = 0; k < 4; ++k) { const int id = id0 + k * GT; if (id < NTOK * 64) { const int tok = id >> 6, ch = (id & 63) * 4;
            f32x4 y = {0.f, 0.f, 0.f, 0.f};
#pragma unroll
            for (int j = 0; j < 3; ++j) { const f32x4 w = *(const f32x4*)(sw + j * 256 + ch);
                y.x += w.x * __uint_as_float(cc[k][j].x << 16) * __uint_as_float(vv[k][j].x << 16); y.y += w.y * __uint_as_float(cc[k][j].x & 0xffff0000u) * __uint_as_float(vv[k][j].x & 0xffff0000u);
                y.z += w.z * __uint_as_float(cc[k][j].y << 16) * __uint_as_float(vv[k][j].y << 16); y.w += w.w * __uint_as_float(cc[k][j].y & 0xffff0000u) * __uint_as_float(vv[k][j].y & 0xffff0000u); }
            u32x2 o; o.x = pk2(y.x * __uint_as_float(bb[k].x << 16), y.y * __uint_as_float(bb[k].x & 0xffff0000u));
            o.y = pk2(y.z * __uint_as_float(bb[k].y << 16), y.w * __uint_as_float(bb[k].y & 0xffff0000u));
            *(u32x2*)(mix + (size_t)tok * 1024 + 768 + ch) = o; } }
    }
}

__global__ void __launch_bounds__(512, 2) fwd_kernel(Params pin) {
    extern __shared__ __attribute__((aligned(16))) unsigned char lds_raw[];
    LAS unsigned char* lds = (LAS unsigned char*)lds_raw;
    cg::grid_group grid = cg::this_grid();
    const int G = gridDim.x, bid = blockIdx.x;
    volatile LAS unsigned* bst = (volatile LAS unsigned*)(lds + LDS_BYTES - 16);
    if (threadIdx.x < 4) bst[threadIdx.x] = 0u;
    __syncthreads();
    if (bid == 0 && pin.ph_lo == 0) { unsigned* bw = (unsigned*)(pin.ws + WS_BAR); for (int i = threadIdx.x; i < 4096; i += 512) bw[i] = 0u; }
    XcdBarrier xbar; xbar.bar = (unsigned*)(pin.ws + WS_BAR); xbar.x = 0; xbar.st = bst;
    int nsync = 0;
    for (int ph2 = 2 * pin.ph_lo; ph2 < 2 * pin.ph_hi; ++ph2) {
        const int ph = ph2 >> 1;
        if ((ph2 & 1) && !((REPEAT_MASK >> ph) & 1u)) continue;
        size_t zo = 0; asm volatile("" : "+s"(zo));
        int tid = threadIdx.x; asm volatile("" : "+v"(tid));
        Params p = pin; p.ws += zo; p.out += zo; p.zo = zo;
        const float* mod = (const float*)(p.ws + WS_MOD);
        bf16_t* hm = (bf16_t*)(p.ws + WS_HM); bf16_t* big = (bf16_t*)(p.ws + WS_BIG);
        if (ph == 0) phase_p0(p, lds, tid);
        else if (ph == 19) phase_norm(p, 0, 2, tid, (ph2 & 1) != 0);
        else {
            const int l = (ph - 1) / 9, s = (ph - 1) % 9;
            pg8::StaticOrder S;
            if (s == 0) phase_norm(p, l, 0, tid, (ph2 & 1) != 0);
            else if (s == 1) { pg8::Gemm g{hm, (const bf16_t*)(p.ws + WS_WIN) + (size_t)l * NP * 1024, NTOK, NP, 1024, 1024}; S.init(NTOK, NP, G, bid);
                pg8::EpiBf16<0> E{big, NP}; pg8::gemm_phase(lds, g, S, E, tid); }
            else if (s == 2) phase_m1(p, l, lds, tid, (ph2 & 1) ? M1_PROBE_STAGES : 7);
            else if (s == 3) phase_m2(p, l, tid, (ph2 & 1) != 0);
            else if (s == 4) phase_m3(p, l, tid);
            else if (s == 5) { pg8::Gemm g{hm, (const bf16_t*)(p.ws + WS_WOUT) + (size_t)l * 1024 * 1024, NTOK, 1024, 512, 1024}; S.init(NTOK, 1024, G, bid, 2);
                pg8::EpiResid E{mod + (size_t)l * 5 * 6144 + 2048, (bf16_t*)(p.ws + ((ph2 & 1) ? WS_HL : WS_DSA))}; pg8::gemm_phase(lds, g, S, E, tid); }
            else if (s == 6) phase_norm(p, l, 1, tid, (ph2 & 1) != 0);
            else if (s == 7) { pg8::Gemm g{hm, (const bf16_t*)(p.ws + WS_W1) + (size_t)l * 4096 * 1024, NTOK, DFF, 1024, 1024}; S.init(NTOK, DFF, G, bid);
                pg8::EpiBf16<1> E{big, DFF}; pg8::gemm_phase(lds, g, S, E, tid); }
            else { pg8::Gemm g{big, (const bf16_t*)(p.ws + WS_W2) + (size_t)l * 1024 * 4096, NTOK, 1024, 2048, DFF}; S.init(NTOK, 1024, G, bid, 2);
                pg8::EpiResid E{mod + (size_t)l * 5 * 6144 + 5120, (bf16_t*)(p.ws + ((ph2 & 1) ? WS_HL : WS_DSA))}; pg8::gemm_phase(lds, g, S, E, tid); }
        }
        if (ph2 + 2 < 2 * pin.ph_hi || (!(ph2 & 1) && ((REPEAT_MASK >> ph) & 1u))) { if (nsync == 0) { grid.sync(); xbar = xcd_barrier_post((unsigned*)(pin.ws + WS_BAR), bst); } else xcd_barrier(xbar); ++nsync; }
    }
}

extern "C" void kernel_launch(void* const* d_in, const int* in_sizes, int n_in, void* d_out, int out_size, void* d_ws, size_t ws_size, hipStream_t stream) {
    static int grid = 0;
    if (grid == 0) {
        if (n_in != 29 || ws_size < WS_END) { fprintf(stderr, "kernel_launch: unexpected n_in %d / ws %zu\n", n_in, ws_size); grid = -1; return; }
        int dev = 0, cus = 0, per_cu = 0;
        hipGetDevice(&dev); hipDeviceGetAttribute(&cus, hipDeviceAttributeMultiprocessorCount, dev);
        if (hipFuncSetAttribute((const void*)fwd_kernel, hipFuncAttributeMaxDynamicSharedMemorySize, LDS_BYTES) != hipSuccess) { fprintf(stderr, "kernel_launch: hipFuncSetAttribute failed\n"); grid = -1; return; }
        if (hipOccupancyMaxActiveBlocksPerMultiprocessor(&per_cu, (const void*)fwd_kernel, 512, LDS_BYTES) != hipSuccess || per_cu < 1) { fprintf(stderr, "kernel_launch: occupancy query says %d\n", per_cu); per_cu = 1; }
        (void)hipGetLastError();
        grid = cus * 1;
        if (grid <= 0) grid = 256;
    }
    if (grid < 0) return;
    Params p{};
    for (int i = 0; i < 29; ++i) p.in[i] = (const float*)d_in[i];
    p.out = (float*)d_out; p.ws = (unsigned char*)d_ws;
#if MEGA
    p.ph_lo = 0; p.ph_hi = 20;
    void* args[] = {&p};
    hipError_t e = hipLaunchCooperativeKernel((const void*)fwd_kernel, dim3(grid), dim3(512), args, LDS_BYTES, stream);
    if (e != hipSuccess) fprintf(stderr, "cooperative launch failed: %s (grid %d)\n", hipGetErrorString(e), grid);
#else
    for (int ph = 0; ph < 20; ++ph) { p.ph_lo = ph; p.ph_hi = ph + 1; hipLaunchKernelGGL(fwd_kernel, dim3(grid), dim3(512), LDS_BYTES, stream, p); }
#endif
}
```

```cpp
#include <hip/hip_runtime.h>
#include <hip/hip_cooperative_groups.h>
#include <cstdio>
#include <cstdint>
namespace cg = cooperative_groups;

#ifndef MEGA
#define MEGA 1
#endif
#ifndef M1_PROBE_STAGES
#define M1_PROBE_STAGES 7
#endif
#ifndef REPEAT_MASK
#define REPEAT_MASK 0u
#endif

#define DI __device__ __forceinline__
#define LAS __attribute__((address_space(3)))
typedef unsigned short bf16_t;
typedef short bf16x8 __attribute__((ext_vector_type(8)));
typedef float f32x4 __attribute__((ext_vector_type(4)));
typedef float f32x16 __attribute__((ext_vector_type(16)));
typedef unsigned u32x4 __attribute__((ext_vector_type(4)));
typedef unsigned u32x2 __attribute__((ext_vector_type(2)));
typedef __bf16 bf16x2_t __attribute__((ext_vector_type(2)));
typedef float f32x2_t __attribute__((ext_vector_type(2)));

constexpr int NTOK = 8192, DM = 1024, NP = 3584, DFF = 4096;
constexpr int A_Q = 0, A_I = 256, A_FF = 512, A_FB = 768, A_G = 1024, B_Q = 1280, B_K = 1408, B_V = 1536, B_G = 1792, B_AF = 2048, B_AB = 2064,
              C_X = 2080, C_G = 2336, D_B = 2592, D_C = 2848, D_V = 3104, PW = 3360;
constexpr size_t MiB = 1u << 20;
constexpr size_t WS_WIN = 0, WS_WOUT = 14 * MiB, WS_W1 = 18 * MiB, WS_W2 = 34 * MiB, WS_MOD = 50 * MiB, WS_HM = 51 * MiB, WS_BIG = 67 * MiB,
                 WS_OI = 131 * MiB, WS_DSA = 147 * MiB, WS_DSB = 179 * MiB, WS_QHA = 195 * MiB, WS_QHB = 203 * MiB, WS_HL = 207 * MiB, WS_CP = 223 * MiB,
                 WS_ACHA = 239 * MiB, WS_ACHB = 239 * MiB + 512 * 1024, WS_RAGA = 240 * MiB, WS_RAGH = 240 * MiB + 512 * 1024, WS_BAR = 241 * MiB, WS_END = 242 * MiB;
constexpr int OUT_SH = 8388608, OUT_SG = OUT_SH + 1048576, OUT_SR = OUT_SG + 524288;
constexpr int LDS_BYTES = 147456;

struct Params { const float* in[29]; float* out; unsigned char* ws; size_t zo; int ph_lo, ph_hi;
    DI const float* IN(int i) const { return in[i] + zo; } };

DI float bf2f(bf16_t u) { return __uint_as_float(((unsigned)u) << 16); }
DI unsigned pk2(float lo, float hi) { f32x2_t v = {lo, hi}; bf16x2_t b = __builtin_convertvector(v, bf16x2_t); return __builtin_bit_cast(unsigned, b); }
DI bf16_t f2bf(float x) { return (bf16_t)(pk2(x, 0.f) & 0xffffu); }
DI bf16x8 pack8(const float* v) { u32x4 p; p.x = pk2(v[0], v[1]); p.y = pk2(v[2], v[3]); p.z = pk2(v[4], v[5]); p.w = pk2(v[6], v[7]); return __builtin_bit_cast(bf16x8, p); }
DI float rcpf_(float x) { return __builtin_amdgcn_rcpf(x); }
DI float sigmoidf_(float x) { return rcpf_(1.f + __expf(-x)); }
DI float siluf_(float x) { return x * rcpf_(1.f + __expf(-x)); }
DI float om_exp(float x) { const float s = -x * (1.f + x * 0.5f * (1.f + x * (1.f / 3.f) * (1.f + x * 0.25f * (1.f + x * 0.2f * (1.f + x * (1.f / 6.f)))))); return x > -0.3f ? s : 1.f - __expf(x); }
DI int crow(int reg, int h) { return (reg & 3) + 8 * (reg >> 2) + 4 * h; }
#define MFMA32(a, b, c) __builtin_amdgcn_mfma_f32_32x32x16_bf16((a), (b), (c), 0, 0, 0)
DI f32x16 zero16() { f32x16 z; for (int i = 0; i < 16; ++i) z[i] = 0.f; return z; }
DI float shx(float v, int lane, int m) { return __int_as_float(__builtin_amdgcn_ds_bpermute((lane ^ m) << 2, __float_as_int(v))); }
DI int modrow_of(int row) { return row < 4096 ? 0 : 1 + ((row - 4096) >> 10); }


#define XB_TMO      128
#define XB_XCNT(j)  (256  + 64 * (j))
#define XB_XSUB(j)  (1280 + 64 * (j))
#define XB_XGEN(j)  (2304 + 64 * (j))
#define XB_TOP      3328
#define XB_TOPGEN   3392
#define XCD_BAR_WORDS 3456
#define XB_SPIN_CAP (1u << 18)
DI unsigned xb_ld(unsigned* p)              { return __hip_atomic_load(p, __ATOMIC_RELAXED, __HIP_MEMORY_SCOPE_AGENT); }
DI unsigned xb_add(unsigned* p, unsigned v) { return __hip_atomic_fetch_add(p, v, __ATOMIC_RELAXED, __HIP_MEMORY_SCOPE_AGENT); }
DI unsigned xb_xcc_id() { return (unsigned)__builtin_amdgcn_s_getreg((3 << 11) | 20) & 0xFu; }
#define XB_SPIN(cond, bar) do { unsigned _sp = 0; while (cond) { __builtin_amdgcn_s_sleep(1); \
    if ((++_sp & 255u) == 0u) { if (xb_ld(&(bar)[XB_TMO])) break; if (_sp > XB_SPIN_CAP) { atomicAdd(&(bar)[XB_TMO], 1u); break; } } } } while (0)
struct XcdBarrier { unsigned* bar; unsigned x; volatile LAS unsigned* st; };
DI XcdBarrier xcd_barrier_post(unsigned* bar, volatile LAS unsigned* st) {
    XcdBarrier b; b.bar = bar; b.x = xb_xcc_id(); b.st = st;
    if (threadIdx.x == 0) (void)xb_add(&bar[XB_XCNT(b.x)], 1u);
    return b;
}
DI void xcd_barrier_complete(unsigned* bar, unsigned x, unsigned& nloc, unsigned& nx) {
    const unsigned G = gridDim.x * gridDim.y * gridDim.z;
    unsigned sum, cnt, mine, sp = 0u;
    for (;;) {
        sum = 0u; cnt = 0u; mine = 0u;
#pragma unroll
        for (unsigned j = 0; j < 16; ++j) { const unsigned c = xb_ld(&bar[XB_XCNT(j)]); sum += c; cnt += (c > 0u) ? 1u : 0u; mine = (j == x) ? c : mine; }
        if (sum == G) break;
        __builtin_amdgcn_s_sleep(1);
        if ((++sp & 255u) == 0u) { if (xb_ld(&bar[XB_TMO])) break; if (sp > XB_SPIN_CAP) { atomicAdd(&bar[XB_TMO], 1u); break; } }
    }
    nloc = mine > 0u ? mine : 1u; nx = cnt > 0u ? cnt : 1u;
}
DI void xcd_barrier(const XcdBarrier& b) {
    asm volatile("s_waitcnt vmcnt(0)" ::: "memory");
    __syncthreads();
    if (threadIdx.x == 0) {
        unsigned* bar = b.bar;
        __builtin_amdgcn_s_waitcnt(0);
        unsigned nloc = b.st[0], nx = b.st[1];
        if (nloc == 0u) { xcd_barrier_complete(bar, b.x, nloc, nx); b.st[0] = nloc; b.st[1] = nx; }
        const unsigned old = xb_add(&bar[XB_XSUB(b.x)], 1u);
        const unsigned gen = old / nloc;
        if (old + 1u == (gen + 1u) * nloc) {
            __builtin_amdgcn_fence(__ATOMIC_RELEASE, "agent");
            asm volatile("s_waitcnt vmcnt(0)" ::: "memory");
            const unsigned og = xb_add(&bar[XB_TOP], 1u);
            const unsigned tg = og / nx;
            if (og + 1u == (tg + 1u) * nx) xb_add(&bar[XB_TOPGEN], 1u);
            else XB_SPIN(xb_ld(&bar[XB_TOPGEN]) == tg, bar);
            __builtin_amdgcn_fence(__ATOMIC_ACQUIRE, "agent");
            xb_add(&bar[XB_XGEN(b.x)], 1u);
            asm volatile("s_waitcnt vmcnt(0)" ::: "memory");
        } else {
            XB_SPIN(xb_ld(&bar[XB_XGEN(b.x)]) == gen, bar);
            __builtin_amdgcn_fence(__ATOMIC_ACQUIRE, "agent");
            asm volatile("s_waitcnt vmcnt(0)" ::: "memory");
        }
    }
    __syncthreads();
}

namespace pg8 {
constexpr int BM = 256, BK = 64, HALF = 128, HTB = HALF * BK * 2, NXCD = 8, WGM = 8;
__host__ __device__ __forceinline__ int lds_byte(int r, int c) { const int st = (r >> 4) * 2 + (c >> 5), rr = r & 15, cc = c & 31, ob = rr * 64 + cc * 2; return st * 1024 + (ob ^ (((ob >> 9) & 1) << 5)); }
__host__ __device__ __forceinline__ void stage_rc(int b, int& R, int& C) { const int st = b / 1024, sb = b % 1024, swz = sb ^ (((sb >> 9) & 1) << 5); R = (st >> 1) * 16 + swz / 64; C = (st & 1) * 32 + (swz % 64) / 2; }
__host__ __device__ __forceinline__ int perm32(int rho) { const int n = rho >> 4, i = rho & 15; return 8 * (i >> 2) + 4 * n + (i & 3); }
struct Unit { int pm, pn, pk; };
struct Gemm { const bf16_t* A; const bf16_t* Bt; int M, N, K, lda; };
struct StaticOrder {
    int nM, nN, nwg, G, c, KS;
    __host__ __device__ void init(int M, int N, int G_, int c_, int KS_ = 1) { KS = KS_; nM = M / BM; nN = (N / BM) * KS; nwg = nM * nN; G = G_; c = c_; }
    __host__ __device__ bool next(int i, Unit& u) const {
        const long L = (long)i * G + c; if (L >= nwg) return false;
        int wgid = (int)L; { const int q = nwg / NXCD, r = nwg % NXCD, xcd = wgid % NXCD, off = wgid / NXCD; wgid = (xcd < r ? xcd * (q + 1) : r * (q + 1) + (xcd - r) * q) + off; }
        const int nig = WGM * nN, gid = wgid / nig, fm = gid * WGM, gsz = (nM - fm) < WGM ? (nM - fm) : WGM;
        u.pm = fm + ((wgid % nig) % gsz); const int pv = (wgid % nig) / gsz; u.pn = pv / KS; u.pk = pv % KS; return true;
    }
};
template <class Epi>
__device__ __forceinline__ void gemm_phase(LAS unsigned char* lds, const Gemm g, const StaticOrder& S, const Epi& E, const int tid) {
    const int wid = __builtin_amdgcn_readfirstlane(tid >> 6), lane = tid & 63, wr = wid >> 2, wc = wid & 3, fr = lane & 15, fq = lane >> 4;
    const int K = g.lda, nt = g.K / BK;
    unsigned voffA[2], voffB[2];
#pragma unroll
    for (int i = 0; i < 2; ++i) { int R, C; stage_rc(tid * 16 + i * 8192, R, C); const int Rb = (R & ~31) + perm32(R & 31);
        voffA[i] = (unsigned)(R * K + C) * 2u; voffB[i] = (unsigned)(Rb * K + C) * 2u; }
    const size_t kstep = (size_t)(BK * 2);
    const size_t hstep = (size_t)HALF * K * 2;
    const size_t tstep = 2 * hstep;
    const unsigned ldsw = (unsigned)wid * 1024u;
    const int aoff = lds_byte(wr * 64 + fr, fq * 8), boff = lds_byte(wc * 32 + fr, fq * 8);
#define PG8_SA(b, h) (((b) * 2 + (h)) * HTB)
#define PG8_SB(b, h) ((4 + (b) * 2 + (h)) * HTB)
#define PG8_STAGE(bufoff, gbase, voff) do { _Pragma("unroll") for (int _i = 0; _i < 2; ++_i) \
        __builtin_amdgcn_global_load_lds((const unsigned*)((const char*)(gbase) + (voff)[_i]), (LAS unsigned*)(lds + (bufoff) + ldsw + _i * 8192), 16, 0, 0); } while (0)
#define PG8_LDA(dst, b, h) do { _Pragma("unroll") for (int m = 0; m < 4; ++m) _Pragma("unroll") for (int k = 0; k < 2; ++k) dst[m][k] = *(const LAS bf16x8*)(lds + PG8_SA(b, h) + aoff + m * 2048 + k * 1024); } while (0)
#define PG8_LDB(dst, b, h) do { _Pragma("unroll") for (int n = 0; n < 2; ++n) _Pragma("unroll") for (int k = 0; k < 2; ++k) dst[n][k] = *(const LAS bf16x8*)(lds + PG8_SB(b, h) + boff + n * 2048 + k * 1024); } while (0)
#define PG8_MMA(ai, bj, At, Bt) do { __builtin_amdgcn_s_setprio(1); _Pragma("unroll") for (int m = 0; m < 4; ++m) _Pragma("unroll") for (int n = 0; n < 2; ++n) _Pragma("unroll") for (int k = 0; k < 2; ++k) \
        acc[ai][bj][m][n] = __builtin_amdgcn_mfma_f32_16x16x32_bf16(Bt[n][k], At[m][k], acc[ai][bj][m][n], 0, 0, 0); __builtin_amdgcn_s_setprio(0); } while (0)
#define PG8_WAIT_V(n) asm volatile("s_waitcnt vmcnt(" #n ")" ::: "memory")
#define PG8_WAIT_L(n) asm volatile("s_waitcnt lgkmcnt(" #n ")" ::: "memory")
#define PG8_BAR __builtin_amdgcn_s_barrier()
#define PG8_SCHED __builtin_amdgcn_sched_barrier(0)
    Unit cur, nxt; int ui = 0;
    if (!S.next(0, cur)) return;
    f32x4 acc[2][2][4][2];
#pragma unroll
    for (int a = 0; a < 2; ++a)
#pragma unroll
        for (int b = 0; b < 2; ++b)
#pragma unroll
            for (int m = 0; m < 4; ++m)
#pragma unroll
                for (int n = 0; n < 2; ++n) acc[a][b][m][n] = (f32x4){0.f, 0.f, 0.f, 0.f};
    bf16x8 At[4][2], B0[2][2], B1[2][2];
    const size_t ksplit = (size_t)g.K * 2;
    const char* cA = (const char*)g.A + (size_t)cur.pm * tstep + cur.pk * ksplit; const char* cB = (const char*)g.Bt + (size_t)cur.pn * tstep + cur.pk * ksplit;
    PG8_STAGE(PG8_SB(0, 0), cB, voffB); PG8_STAGE(PG8_SA(0, 0), cA, voffA); PG8_STAGE(PG8_SB(0, 1), cB + hstep, voffB); PG8_STAGE(PG8_SA(0, 1), cA + hstep, voffA);
    if (wr == 1) PG8_BAR;
    PG8_WAIT_V(4); PG8_BAR;
    PG8_STAGE(PG8_SB(1, 0), cB + kstep, voffB); PG8_STAGE(PG8_SA(1, 0), cA + kstep, voffA); PG8_STAGE(PG8_SB(1, 1), cB + hstep + kstep, voffB);
    PG8_WAIT_V(6); PG8_BAR;
    for (;;) {
        const bool has_next = S.next(ui + 1, nxt);
        const char* nA = has_next ? (const char*)g.A + (size_t)nxt.pm * tstep + nxt.pk * ksplit : cA; const char* nB = has_next ? (const char*)g.Bt + (size_t)nxt.pn * tstep + nxt.pk * ksplit : cB;
        for (int t = 0; t < nt; t += 2) {
            const bool last = (t == nt - 2);
            const char* a1 = cA + (size_t)(t + 1) * kstep;
            const char* a2 = last ? nA : cA + (size_t)(t + 2) * kstep; const char* b2 = last ? nB : cB + (size_t)(t + 2) * kstep;
            const char* a3 = a2 + kstep; const char* b3 = b2 + kstep;
            PG8_LDB(B0, 0, 0); PG8_SCHED; PG8_LDA(At, 0, 0); PG8_STAGE(PG8_SA(1, 1), a1 + hstep, voffA);
            PG8_WAIT_L(8); PG8_BAR; PG8_WAIT_L(0); PG8_MMA(0, 0, At, B0); PG8_BAR; PG8_SCHED;
            PG8_LDB(B1, 0, 1); PG8_STAGE(PG8_SB(0, 0), b2, voffB);
            PG8_BAR; PG8_WAIT_L(0); PG8_MMA(0, 1, At, B1); PG8_BAR;
            PG8_LDA(At, 0, 1); PG8_STAGE(PG8_SA(0, 0), a2, voffA);
            PG8_BAR; PG8_WAIT_L(0); PG8_MMA(1, 0, At, B0); PG8_BAR; PG8_SCHED;
            PG8_STAGE(PG8_SB(0, 1), b2 + hstep, voffB);
            PG8_WAIT_V(6); PG8_BAR; PG8_MMA(1, 1, At, B1); PG8_BAR;
            PG8_LDB(B0, 1, 0); PG8_SCHED; PG8_LDA(At, 1, 0); PG8_STAGE(PG8_SA(0, 1), a2 + hstep, voffA);
            PG8_WAIT_L(8); PG8_BAR; PG8_WAIT_L(0); PG8_MMA(0, 0, At, B0); PG8_BAR; PG8_SCHED;
            PG8_LDB(B1, 1, 1); PG8_STAGE(PG8_SB(1, 0), b3, voffB);
            PG8_BAR; PG8_WAIT_L(0); PG8_MMA(0, 1, At, B1); PG8_BAR;
            PG8_LDA(At, 1, 1); PG8_STAGE(PG8_SA(1, 0), a3, voffA);
            PG8_BAR; PG8_WAIT_L(0); PG8_MMA(1, 0, At, B0); PG8_BAR; PG8_SCHED;
            PG8_STAGE(PG8_SB(1, 1), b3 + hstep, voffB);
            PG8_WAIT_V(6); PG8_BAR; PG8_MMA(1, 1, At, B1); PG8_BAR;
        }
        E(acc, cur, wr, wc, fr, fq);
        if (!has_next) break;
#pragma unroll
        for (int a = 0; a < 2; ++a)
#pragma unroll
            for (int b = 0; b < 2; ++b)
#pragma unroll
                for (int m = 0; m < 4; ++m)
#pragma unroll
                    for (int n = 0; n < 2; ++n) acc[a][b][m][n] = (f32x4){0.f, 0.f, 0.f, 0.f};
        cur = nxt; cA = nA; cB = nB; ++ui;
    }
    PG8_WAIT_V(0);
    if (wr == 0) PG8_BAR;
    PG8_BAR;
#undef PG8_SA
#undef PG8_SB
#undef PG8_STAGE
#undef PG8_LDA
#undef PG8_LDB
#undef PG8_MMA
#undef PG8_WAIT_V
#undef PG8_WAIT_L
#undef PG8_BAR
#undef PG8_SCHED
}

template <int ACT> struct EpiBf16 {
    bf16_t* O; int ldc;
    __device__ __forceinline__ void operator()(const f32x4 (&acc)[2][2][4][2], const Unit& u, int wr, int wc, int fr, int fq) const {
        const int row0 = u.pm * BM + wr * 64 + fr, col0 = u.pn * BM + wc * 32 + 8 * fq;
#pragma unroll
        for (int ai = 0; ai < 2; ++ai)
#pragma unroll
            for (int m = 0; m < 4; ++m) { bf16_t* rowp = O + (size_t)(row0 + ai * HALF + m * 16) * ldc + col0;
#pragma unroll
                for (int bj = 0; bj < 2; ++bj) { f32x4 v0 = acc[ai][bj][m][0], v1 = acc[ai][bj][m][1];
                    if (ACT == 1) {
#pragma unroll
                        for (int q = 0; q < 4; ++q) { float a = fmaxf(v0[q], 0.f), b = fmaxf(v1[q], 0.f); v0[q] = a * a; v1[q] = b * b; } }
                    u32x4 w; w.x = pk2(v0[0], v0[1]); w.y = pk2(v0[2], v0[3]); w.z = pk2(v1[0], v1[1]); w.w = pk2(v1[2], v1[3]);
                    *(u32x4*)(rowp + bj * HALF) = w; } }
    }
};
struct EpiResid {
    const float* gate; bf16_t* pb;
    __device__ __forceinline__ void operator()(const f32x4 (&acc)[2][2][4][2], const Unit& u, int wr, int wc, int fr, int fq) const {
        const int rowb = u.pm * BM; const float* gp = gate + modrow_of(rowb) * 6144;
        const int row0 = rowb + wr * 64 + fr, col0 = u.pn * BM + wc * 32 + 8 * fq;
        bf16_t* pbk = pb + (size_t)u.pk * ((size_t)NTOK * 1024);
        f32x4 gv[2][2];
#pragma unroll
        for (int bj = 0; bj < 2; ++bj)
#pragma unroll
            for (int n = 0; n < 2; ++n) gv[bj][n] = *(const f32x4*)(gp + col0 + bj * HALF + 4 * n);
#pragma unroll
        for (int ai = 0; ai < 2; ++ai)
#pragma unroll
            for (int m = 0; m < 4; ++m) { const size_t ro = (size_t)(row0 + ai * HALF + m * 16) * 1024 + col0;
#pragma unroll
                for (int bj = 0; bj < 2; ++bj) { const f32x4 v0 = gv[bj][0] * acc[ai][bj][m][0], v1 = gv[bj][1] * acc[ai][bj][m][1];
                    u32x4 w; w.x = pk2(v0[0], v0[1]); w.y = pk2(v0[2], v0[3]); w.z = pk2(v1[0], v1[1]); w.w = pk2(v1[2], v1[3]);
                    *(u32x4*)(pbk + ro + bj * HALF) = w; } }
    }
};
}

DI void transpose_unit(const float* __restrict__ W, int K, int N, int Npad, bf16_t* WT, int unit, int lane, LAS unsigned char* scr) {
    const int nblk = Npad / 64, kb = unit / nblk, nb = unit % nblk, n = nb * 64 + lane, k0 = kb * 64;
    u32x4 o[8];
    if (n < N) {
        float v[64];
#pragma unroll
        for (int kk = 0; kk < 64; ++kk) v[kk] = W[(size_t)(k0 + kk) * N + n];
#pragma unroll
        for (int q = 0; q < 8; ++q) { o[q].x = pk2(v[8 * q], v[8 * q + 1]); o[q].y = pk2(v[8 * q + 2], v[8 * q + 3]); o[q].z = pk2(v[8 * q + 4], v[8 * q + 5]); o[q].w = pk2(v[8 * q + 6], v[8 * q + 7]); }
    } else {
#pragma unroll
        for (int q = 0; q < 8; ++q) o[q] = (u32x4){0u, 0u, 0u, 0u};
    }
#pragma unroll
    for (int q = 0; q < 8; ++q) *(LAS u32x4*)(scr + lane * 144 + q * 16) = o[q];
    __builtin_amdgcn_fence(__ATOMIC_RELEASE, "wavefront"); __builtin_amdgcn_wave_barrier();
    const int ch = lane & 7, rb = lane >> 3;
#pragma unroll
    for (int j = 0; j < 8; ++j) { const int row = rb + 8 * j; const u32x4 w = *(const LAS u32x4*)(scr + row * 144 + ch * 16);
        *(u32x4*)(WT + (size_t)(nb * 64 + row) * K + k0 + ch * 8) = w; }
    __builtin_amdgcn_fence(__ATOMIC_RELEASE, "wavefront"); __builtin_amdgcn_wave_barrier();
}

DI void phase_p0(const Params& p, LAS unsigned char* lds, const int tid) {
    const int lane = tid & 63, wid = tid >> 6, G = gridDim.x, bid = blockIdx.x;
    const float* c = p.IN(5); const float* c_ctx = p.IN(6); const float* ada_w = p.IN(9); const float* ada_b = p.IN(10);
    float* mod = (float*)(p.ws + WS_MOD);
    LAS float* st = (LAS float*)lds + wid * 640;
    LAS float* red = (LAS float*)(lds + 32768);
    for (int bu = bid; bu < 192; bu += G) {
        const int l = bu / 96, cgp = bu % 96, col = cgp * 64 + lane;
        for (int i = lane; i < 640; i += 64) { const int row = i / 128, k = wid * 128 + (i % 128); const float cv = row == 0 ? c_ctx[k] : c[(row - 1) * 1024 + k]; st[i] = siluf_(cv); }
        __syncthreads();
        float acc[5] = {0.f, 0.f, 0.f, 0.f, 0.f};
        const float* W = ada_w + (size_t)l * 1024 * 6144 + (size_t)(wid * 128) * 6144 + col;
#pragma unroll 16
        for (int kk = 0; kk < 128; ++kk) { const float w = W[(size_t)kk * 6144];
#pragma unroll
            for (int row = 0; row < 5; ++row) acc[row] += st[row * 128 + kk] * w; }
#pragma unroll
        for (int row = 0; row < 5; ++row) red[(wid * 5 + row) * 64 + lane] = acc[row];
        __syncthreads();
        if (tid < 320) { const int row = tid / 64, ln = tid % 64; float s = 0.f;
#pragma unroll
            for (int w = 0; w < 8; ++w) s += red[(w * 5 + row) * 64 + ln];
            const int cc = cgp * 64 + ln; mod[(l * 5 + row) * 6144 + cc] = s + ada_b[l * 6144 + cc]; }
        __syncthreads();
    }
    const int gw = bid * 8 + wid, GW = G * 8;
    LAS unsigned char* scr = lds + 65536 + wid * 9216;
    for (int u = gw; u < 6400; u += GW) {
        const int l = u / 3200; int r = u % 3200;
        if (r < 896) transpose_unit(p.IN(11) + (size_t)l * 1024 * PW, 1024, PW, NP, (bf16_t*)(p.ws + WS_WIN) + (size_t)l * NP * 1024, r, lane, scr);
        else if (r < 1152) transpose_unit(p.IN(12) + (size_t)l * 1024 * 1024, 1024, 1024, 1024, (bf16_t*)(p.ws + WS_WOUT) + (size_t)l * 1024 * 1024, r - 896, lane, scr);
        else if (r < 2176) transpose_unit(p.IN(26) + (size_t)l * 1024 * 4096, 1024, 4096, 4096, (bf16_t*)(p.ws + WS_W1) + (size_t)l * 4096 * 1024, r - 1152, lane, scr);
        else transpose_unit(p.IN(27) + (size_t)l * 4096 * 1024, 4096, 1024, 1024, (bf16_t*)(p.ws + WS_W2) + (size_t)l * 1024 * 4096, r - 2176, lane, scr);
    }
}

DI void phase_norm(const Params& p, int l, int which, const int tid, const bool dry = false) {
    const int lane = tid & 63, wid = tid >> 6, gw = blockIdx.x * 8 + wid, GW = gridDim.x * 8;
    const float* mod = (const float*)(p.ws + WS_MOD);
    bf16_t* hm = (bf16_t*)(p.ws + (dry ? WS_OI : WS_HM));
    float* xo = dry ? (float*)(p.ws + WS_HL) : p.out;
    const float* g = which == 0 ? p.IN(7) + l * 1024 : (which == 1 ? p.IN(8) + l * 1024 : p.IN(28));
    const bool first = (which == 0 && l == 0), from_in = (l == 0 && which != 2);
    for (int row0 = gw; row0 < NTOK; row0 += 4 * GW) {
        f32x4 v[4][4]; float ss[4];
#pragma unroll
        for (int k = 0; k < 4; ++k) {
            const int row = row0 + k * GW; ss[k] = 0.f;
            if (row < NTOK) {
                const float* xr = from_in ? (row < 4096 ? p.IN(0) + (size_t)row * 1024 : p.IN(1) + (size_t)(row - 4096) * 1024) : p.out + (size_t)row * 1024;
#pragma unroll
                for (int j = 0; j < 4; ++j) v[k][j] = ((const f32x4*)xr)[lane + 64 * j];
                if (!first) {
                    const bf16_t* pr = (const bf16_t*)(p.ws + WS_DSA) + (size_t)row * 1024;
#pragma unroll
                    for (int j = 0; j < 4; ++j) { const u32x2 pp = ((const u32x2*)pr)[lane + 64 * j], pq = ((const u32x2*)(pr + (size_t)NTOK * 1024))[lane + 64 * j];
                        v[k][j].x += __uint_as_float(pp.x << 16) + __uint_as_float(pq.x << 16); v[k][j].y += __uint_as_float(pp.x & 0xffff0000u) + __uint_as_float(pq.x & 0xffff0000u);
                        v[k][j].z += __uint_as_float(pp.y << 16) + __uint_as_float(pq.y << 16); v[k][j].w += __uint_as_float(pp.y & 0xffff0000u) + __uint_as_float(pq.y & 0xffff0000u); }
                }
            }
        }
#pragma unroll
        for (int k = 0; k < 4; ++k) {
            const int row = row0 + k * GW;
            if (row < NTOK) {
#pragma unroll
                for (int j = 0; j < 4; ++j) ss[k] += (v[k][j].x * v[k][j].x + v[k][j].y * v[k][j].y) + (v[k][j].z * v[k][j].z + v[k][j].w * v[k][j].w);
            }
        }
#pragma unroll
        for (int o = 1; o < 64; o <<= 1) {
#pragma unroll
            for (int k = 0; k < 4; ++k) ss[k] += shx(ss[k], lane, o);
        }
#pragma unroll
        for (int k = 0; k < 4; ++k) {
            const int row = row0 + k * GW;
            if (row < NTOK) {
                const float rstd = rsqrtf(ss[k] * (1.f / 1024.f) + 1e-6f);
                if (which == 2) {
                    float* yo = xo + (size_t)row * 1024;
#pragma unroll
                    for (int j = 0; j < 4; ++j) { const f32x4 gv = ((const f32x4*)g)[lane + 64 * j]; ((f32x4*)yo)[lane + 64 * j] = v[k][j] * rstd * gv; }
                } else {
                    const float* mr = mod + (size_t)(l * 5 + modrow_of(row)) * 6144 + (which == 0 ? 0 : 3072);
#pragma unroll
                    for (int j = 0; j < 4; ++j) { const f32x4 gv = ((const f32x4*)g)[lane + 64 * j]; const f32x4 sh = ((const f32x4*)mr)[lane + 64 * j], sc = ((const f32x4*)(mr + 1024))[lane + 64 * j];
                        const f32x4 hv = v[k][j] * rstd * gv * (sc + 1.f) + sh;
                        u32x2 o; o.x = pk2(hv.x, hv.y); o.y = pk2(hv.z, hv.w);
                        ((u32x2*)(hm + (size_t)row * 1024))[lane + 64 * j] = o;
                        if (!first) ((f32x4*)(xo + (size_t)row * 1024))[lane + 64 * j] = v[k][j]; }
                }
            }
        }
    }
}

constexpr int M1_TILE_BYTES = 66048, M1_WL_BYTES = 9216;
template <int NCOL8, int NROWS> struct StageRegs { static constexpr int NCH = NCOL8 * NROWS, IT = (NCH + 511) / 512; u32x4 v[IT]; };
template <int NCOL8, int NROWS>
DI void stage_load(StageRegs<NCOL8, NROWS>& R, const char* proj, int row_first, int col0, int s0, int s1, int tid) {
    constexpr int NCH = NCOL8 * NROWS, IT = (NCH + 511) / 512;
#pragma unroll
    for (int i = 0; i < IT; ++i) { const int id = tid + 512 * i; const int row = id / NCOL8, cc = id % NCOL8, t = row_first + row;
        R.v[i] = (u32x4){0u, 0u, 0u, 0u};
        if (id < NCH && t >= s0 && t < s1) R.v[i] = *(const u32x4*)(proj + ((size_t)t * NP + col0 + cc * 8) * 2); }
}
template <int NCOL8, int NROWS>
DI void stage_store(const StageRegs<NCOL8, NROWS>& R, LAS unsigned char* tile, int pitchB, int dstB, int tid) {
    constexpr int NCH = NCOL8 * NROWS, IT = (NCH + 511) / 512;
#pragma unroll
    for (int i = 0; i < IT; ++i) { const int id = tid + 512 * i; const int row = id / NCOL8, cc = id % NCOL8;
        if (id < NCH) *(LAS u32x4*)(tile + row * pitchB + dstB + cc * 16) = R.v[i]; }
}

template <int MIX>
DI void m1_gla_wave(const Params& p, int l, int c, int hd, int dir, const LAS unsigned char* tile, LAS unsigned char* wl, const LAS unsigned char* wlp, int lane) {
    constexpr int DK = MIX == 0 ? 64 : 32, NT = DK / 32, PITCH = DK + 8, TP = MIX == 0 ? 1032 : 552;
    const int r = lane & 31, hh = lane >> 5, tok0 = c * 32;
    const LAS bf16_t* T = (const LAS bf16_t*)tile;
    LAS bf16_t* Qt = (LAS bf16_t*)wl; LAS bf16_t* Kt = Qt + 32 * PITCH;
    char* DS = (char*)(p.ws + (MIX == 0 ? WS_DSA : WS_DSB));
    float* ACH = (float*)(p.ws + (MIX == 0 ? WS_ACHA : WS_ACHB));
    char* QH = (char*)(p.ws + (MIX == 0 ? WS_QHA : WS_QHB));
    float* OI = (float*)(p.ws + WS_OI);
    const int tba = 4 * hh * TP, tb = tba + r;
#define TROW(li) ((8 * ((li) >> 2) + ((li) & 3)) * TP)
    const int vcol = MIX == 0 ? 256 + hd * 64 : 256 + hd * 64;
    bf16x8 vf[2][2];
#pragma unroll
    for (int n = 0; n < 2; ++n)
#pragma unroll
        for (int st = 0; st < 2; ++st)
#pragma unroll
            for (int j = 0; j < 8; ++j) vf[n][st][j] = (short)T[tb + TROW(8 * st + j) + vcol + 32 * n];
    const int qcol = MIX == 0 ? hd * 64 : hd * 32;
#pragma unroll 1
    for (int m = 0; m < NT; ++m) {
        float la[16], kk[16];
        if (MIX == 0) {
            const int zcol = (dir == 0 ? 512 : 768) + hd * 64 + 32 * m;
            const float* lbl = p.IN(13);
            float lb = 0.f;
            if (l == 1) { const int ch = hd * 64 + 32 * m + r; const float l0 = lbl[(0 * 2 + dir) * 256 + ch], l1 = lbl[(1 * 2 + dir) * 256 + ch]; lb = rcpf_(1.f + __expf(l0 - l1)); }
#pragma unroll
            for (int li = 0; li < 16; ++li) { const float z = bf2f(T[tb + TROW(li) + zcol]);
                const float e = __expf(-z), sg = rcpf_(1.f + e), omsg = e * sg;
                const float f = lb + (1.f - lb) * sg; kk[li] = (1.f - lb) * omsg; la[li] = __logf(fmaxf(f, 1e-20f)); }
        } else {
            const int kcol = 128 + hd * 32, acol = 512 + dir * 16;
            float w2[16];
#pragma unroll
            for (int rho = 0; rho < 16; ++rho) w2[rho] = p.IN(15)[((l * 2 + dir) * 16 + rho) * 128 + hd * 32 + r];
            const float ba = p.IN(16)[(l * 2 + dir) * 128 + hd * 32 + r];
#pragma unroll
            for (int li = 0; li < 16; ++li) {
                const u32x4 a0 = *(const LAS u32x4*)(T + tba + TROW(li) + acol), a1 = *(const LAS u32x4*)(T + tba + TROW(li) + acol + 8);
                float w = ba;
#pragma unroll
                for (int qd = 0; qd < 4; ++qd) { w += __uint_as_float(a0[qd] << 16) * w2[2 * qd] + __uint_as_float(a0[qd] & 0xffff0000u) * w2[2 * qd + 1];
                    w += __uint_as_float(a1[qd] << 16) * w2[8 + 2 * qd] + __uint_as_float(a1[qd] & 0xffff0000u) * w2[8 + 2 * qd + 1]; }
                const float ls = fminf(w, 0.f) - __logf(1.f + __expf(-fabsf(w)));
                la[li] = ls * (1.f / 16.f);
                kk[li] = bf2f(T[tb + TROW(li) + kcol]);
            }
        }
        float gs[4], pgs[4];
#pragma unroll
        for (int g = 0; g < 4; ++g) { gs[g] = (la[4 * g] + la[4 * g + 1]) + (la[4 * g + 2] + la[4 * g + 3]); pgs[g] = shx(gs[g], lane, 32); }
        float run = 0.f, half = 0.f; float cum[16];
#pragma unroll
        for (int g = 0; g < 4; ++g) { float b = run + (hh ? pgs[g] : 0.f); run += gs[g] + pgs[g]; if (g == 1) half = run;
#pragma unroll
            for (int i = 0; i < 4; ++i) { b += la[4 * g + i]; cum[4 * g + i] = b; } }
        const float total = run;
        const float ref = dir == 0 ? half : total - half;
        float kh[16];
        const unsigned qhb = MIX == 0 ? (unsigned)((tok0 + 4 * hh) * 512 + dir * 256 + hd * 64 + 32 * m + r) * 2u : (unsigned)((tok0 + 4 * hh) * 256 + dir * 128 + hd * 32 + r) * 2u;
#pragma unroll
        for (int li = 0; li < 16; ++li) {
            const float cv = dir == 0 ? cum[li] : (total - cum[li] + la[li]);
            const float eq = __expf(fminf(cv - ref, 80.f)), ek = __expf(fminf(ref - cv, 80.f));
            const int tkl = 8 * (li >> 2) + (li & 3);
            const float qv = bf2f(T[tb + TROW(li) + qcol + 32 * m]) * (MIX == 1 ? 0.17677669529663687f : 1.f);
            Qt[(tkl + 4 * hh) * PITCH + 32 * m + r] = f2bf(qv * eq);
            Kt[(tkl + 4 * hh) * PITCH + 32 * m + r] = f2bf(kk[li] * ek);
            kh[li] = kk[li] * __expf(total - cv);
            const float qh = qv * __expf(cv);
            *(bf16_t*)(QH + (qhb + (unsigned)(tkl * (MIX == 0 ? 512 : 256) * 2))) = f2bf(qh);
        }
        const bf16x8 khat0 = pack8(kh), khat1 = pack8(kh + 8);
        if (hh == 0) ACH[((c * 4 + hd) * 2 + dir) * DK + 32 * m + r] = __expf(total);
#pragma unroll
        for (int n = 0; n < 2; ++n) {
            f32x16 ds = zero16();
            ds = MFMA32(khat0, vf[n][0], ds); ds = MFMA32(khat1, vf[n][1], ds);
            const unsigned dsb = (unsigned)(((c * 4 + hd) * 2 + dir) * (DK * 64) * 2) + (unsigned)((n * (DK / 16) + 2 * m) * 1024 + r * 16 + hh * 8);
#pragma unroll
            for (int g = 0; g < 4; ++g) { u32x2 w; w.x = pk2(ds[4 * g], ds[4 * g + 1]); w.y = pk2(ds[4 * g + 2], ds[4 * g + 3]);
                *(u32x2*)(DS + (dsb + (unsigned)((g >> 1) * 1024 + (g & 1) * 512))) = w; }
        }
    }
#undef TROW
    __builtin_amdgcn_fence(__ATOMIC_RELEASE, "wavefront");
    __builtin_amdgcn_wave_barrier();
    f32x16 pt = zero16();
#pragma unroll
    for (int s = 0; s < DK / 16; ++s) {
        const bf16x8 kfr = *(const LAS bf16x8*)(Kt + r * PITCH + 16 * s + 8 * hh);
        const bf16x8 qfr = *(const LAS bf16x8*)(Qt + r * PITCH + 16 * s + 8 * hh);
        pt = MFMA32(kfr, qfr, pt);
    }
    __builtin_amdgcn_fence(__ATOMIC_RELEASE, "wavefront");
    __builtin_amdgcn_wave_barrier();
    LAS float* ex = (LAS float*)wl; const LAS float* exp_ = (const LAS float*)wlp;
#pragma unroll
    for (int i = 0; i < 16; ++i) { const int srow = crow(i, hh); const bool keep = dir == 0 ? (srow <= r) : (srow >= r); pt[i] = keep ? pt[i] : 0.f; ex[i * 64 + lane] = pt[i]; }
    __syncthreads();
    float ptv[16];
#pragma unroll
    for (int i = 0; i < 16; ++i) ptv[i] = pt[i] + exp_[i * 64 + lane];
    const bf16x8 pf0 = pack8(ptv), pf1 = pack8(ptv + 8);
    float* oi = OI + (size_t)((MIX * 256 + c) * 4 + hd) * 2048;
    {
        f32x16 ot = zero16();
        const bf16x8 va = dir == 0 ? vf[0][0] : vf[1][0], vb = dir == 0 ? vf[0][1] : vf[1][1];
        ot = MFMA32(va, pf0, ot); ot = MFMA32(vb, pf1, ot);
#pragma unroll
        for (int g = 0; g < 4; ++g) *(f32x4*)(oi + ((dir * 4 + g) * 64 + lane) * 4) = (f32x4){ot[4 * g], ot[4 * g + 1], ot[4 * g + 2], ot[4 * g + 3]};
    }
}

DI void m1_rg_wave(const Params& p, int l, int c, int nb, int dir, const LAS unsigned char* tile, int lane) {
    constexpr int TP = 264;
    const int r = lane & 31, hh = lane >> 5, tok0 = c * 32;
    const LAS bf16_t* T = (const LAS bf16_t*)tile;
    float* HL = (float*)(p.ws + WS_HL); float* CP = (float*)(p.ws + WS_CP);
    float* RAGA = (float*)(p.ws + WS_RAGA); float* RAGH = (float*)(p.ws + WS_RAGH);
    const int sgn = dir ? -1 : 1, lbase = dir ? 31 : 0;
    const float* cw = p.IN(18) + (size_t)(l * 2 + dir) * 4 * 256;
    const float* cb = p.IN(19) + (size_t)(l * 2 + dir) * 256;
    bf16x8 af[4];
    const int trow = lbase + sgn * r + 3;
#pragma unroll
    for (int s = 0; s < 4; ++s) {
        const int ch0 = 64 * nb + 16 * s + 8 * hh;
        float xc[8];
        { const f32x4 b0 = *(const f32x4*)(cb + ch0), b1 = *(const f32x4*)(cb + ch0 + 4);
          xc[0] = b0.x; xc[1] = b0.y; xc[2] = b0.z; xc[3] = b0.w; xc[4] = b1.x; xc[5] = b1.y; xc[6] = b1.z; xc[7] = b1.w; }
#pragma unroll
        for (int tap = 0; tap < 4; ++tap) {
            const u32x4 uu = *(const LAS u32x4*)(T + (trow + sgn * (tap - 3)) * TP + ch0);
            const f32x4 w0 = *(const f32x4*)(cw + tap * 256 + ch0), w1 = *(const f32x4*)(cw + tap * 256 + ch0 + 4);
            xc[0] += w0.x * __uint_as_float(uu.x << 16); xc[1] += w0.y * __uint_as_float(uu.x & 0xffff0000u);
            xc[2] += w0.z * __uint_as_float(uu.y << 16); xc[3] += w0.w * __uint_as_float(uu.y & 0xffff0000u);
            xc[4] += w1.x * __uint_as_float(uu.z << 16); xc[5] += w1.y * __uint_as_float(uu.z & 0xffff0000u);
            xc[6] += w1.z * __uint_as_float(uu.w << 16); xc[7] += w1.w * __uint_as_float(uu.w & 0xffff0000u);
        }
        af[s] = pack8(xc);
    }
    const float* wr_ = p.IN(20) + (size_t)((l * 2 + dir) * 4 + nb) * 4096;
    const float* wi_ = p.IN(22) + (size_t)((l * 2 + dir) * 4 + nb) * 4096;
#pragma unroll 1
    for (int n = 0; n < 2; ++n) {
        f32x16 rr = zero16(), ri = zero16();
#pragma unroll
        for (int s = 0; s < 4; ++s) {
            float br_[8], bi_[8];
#pragma unroll
            for (int j = 0; j < 8; ++j) { br_[j] = wr_[(16 * s + 8 * hh + j) * 64 + 32 * n + r]; bi_[j] = wi_[(16 * s + 8 * hh + j) * 64 + 32 * n + r]; }
            rr = MFMA32(af[s], pack8(br_), rr); ri = MFMA32(af[s], pack8(bi_), ri);
        }
        const int ch = 64 * nb + 32 * n + r;
        const float cbv = cb[ch]; float cwv[4];
#pragma unroll
        for (int tap = 0; tap < 4; ++tap) cwv[tap] = cw[tap * 256 + ch];
        const float brv = p.IN(21)[(l * 2 + dir) * 256 + ch], biv = p.IN(23)[(l * 2 + dir) * 256 + ch];
        const float lam = p.IN(24)[(l * 2 + dir) * 256 + ch];
        const float c8 = -8.f * log1pf(__expf(-lam));
        float a[16], bx[16];
#pragma unroll
        for (int li = 0; li < 16; ++li) {
            const int tr = lbase + sgn * (8 * (li >> 2) + 4 * hh + (li & 3)) + 3;
            float xcv = cbv;
#pragma unroll
            for (int tap = 0; tap < 4; ++tap) xcv += cwv[tap] * bf2f(T[(tr + sgn * (tap - 3)) * TP + ch]);
            const float rv = sigmoidf_(rr[li] + brv), iv = sigmoidf_(ri[li] + biv);
            const float loga = c8 * rv;
            a[li] = __expf(loga); bx[li] = __builtin_amdgcn_sqrtf(om_exp(2.f * loga)) * iv * xcv;
        }
        float Ag[4], Bg[4], pA[4], pB[4];
#pragma unroll
        for (int g = 0; g < 4; ++g) { float hl = 0.f, ap = 1.f;
#pragma unroll
            for (int i = 0; i < 4; ++i) { hl = a[4 * g + i] * hl + bx[4 * g + i]; ap *= a[4 * g + i]; }
            Ag[g] = ap; Bg[g] = hl; pA[g] = shx(ap, lane, 32); pB[g] = shx(hl, lane, 32); }
        float Hrun = 0.f, Prun = 1.f;
        const bool first = (hh == 0);
#pragma unroll
        for (int g = 0; g < 4; ++g) {
            const float A0 = first ? Ag[g] : pA[g], B0 = first ? Bg[g] : pB[g];
            const float A1 = first ? pA[g] : Ag[g], B1 = first ? pB[g] : Bg[g];
            float hcur = first ? Hrun : (A0 * Hrun + B0), pcur = first ? Prun : Prun * A0;
            Hrun = A1 * (A0 * Hrun + B0) + B1; Prun = Prun * A0 * A1;
#pragma unroll
            for (int i = 0; i < 4; ++i) { hcur = a[4 * g + i] * hcur + bx[4 * g + i]; pcur *= a[4 * g + i];
                const int tg = tok0 + lbase + sgn * (8 * g + 4 * hh + i);
                HL[((size_t)dir * NTOK + tg) * 256 + ch] = hcur; CP[((size_t)dir * NTOK + tg) * 256 + ch] = pcur; }
        }
        if (hh == 0) { RAGA[(c * 2 + dir) * 256 + ch] = Prun; RAGH[(c * 2 + dir) * 256 + ch] = Hrun; }
    }
}

DI void phase_m1(const Params& p, int l, LAS unsigned char* lds, const int tid, const int stages = 7) {
    const int lane = tid & 63, wid = __builtin_amdgcn_readfirstlane(tid >> 6);
    const char* proj = (const char*)(p.ws + WS_BIG);
    LAS unsigned char* tile = lds;
    LAS unsigned char* wl = lds + M1_TILE_BYTES + wid * M1_WL_BYTES;
    LAS unsigned char* wlp = lds + M1_TILE_BYTES + (wid ^ 1) * M1_WL_BYTES;
    for (int c = blockIdx.x; c < 256; c += gridDim.x) {
        int ln = lane, td = tid; asm volatile("" : "+v"(ln), "+v"(td));
        const int tok0 = c * 32;
        int s0, s1;
        if (c < 128) { s0 = (c >> 3) * 256; s1 = s0 + 256; } else { s0 = 4096 + ((c - 128) >> 5) * 1024; s1 = s0 + 1024; }
        StageRegs<128, 32> ra; StageRegs<64, 32> rb; StageRegs<4, 32> rb2; StageRegs<32, 38> rc;
        if (stages & 1) stage_load(ra, proj, tok0, 0, 0, NTOK, td);
        if (stages & 2) { stage_load(rb, proj, tok0, B_Q, 0, NTOK, td); stage_load(rb2, proj, tok0, B_AF, 0, NTOK, td); }
        if (stages & 4) stage_load(rc, proj, tok0 - 3, C_X, s0, s1, td);
        if (stages & 1) {
        stage_store(ra, tile, 2064, 0, td);
        __syncthreads();
        m1_gla_wave<0>(p, l, c, wid >> 1, wid & 1, tile, wl, wlp, ln);
        __builtin_amdgcn_sched_barrier(0); asm volatile("" : "+v"(ln), "+v"(td));
        }
        if (stages & 2) {
        stage_store(rb, tile, 1104, 0, td); stage_store(rb2, tile, 1104, 1024, td);
        __syncthreads();
        m1_gla_wave<1>(p, l, c, wid >> 1, wid & 1, tile, wl, wlp, ln);
        __builtin_amdgcn_sched_barrier(0); asm volatile("" : "+v"(ln), "+v"(td));
        }
        if (stages & 4) {
        stage_store(rc, tile, 528, 0, td);
        __syncthreads();
        m1_rg_wave(p, l, c, wid >> 1, wid & 1, tile, ln);
        __syncthreads();
        }
    }
}

DI void m2_chain8(const Params& p, int l, int id, const bool dry) {
    const int sq = id / 6144; int rem = id % 6144;
    const int hd = rem / 1536, dir = (rem / 768) & 1; int f = rem % 768;
    const int mix = f < 512 ? 0 : 1; if (mix) f -= 512;
    const int dk = mix == 0 ? 64 : 32, S_ = dk / 16;
    const int lane_ = f & 63, ns = f >> 6, n = ns / S_, s = ns % S_;
    const int d0 = 16 * s + 8 * (lane_ >> 5), e = 32 * n + (lane_ & 31);
    char* DS = (char*)(p.ws + (mix == 0 ? WS_DSA : WS_DSB));
    char* DSO = dry ? (char*)(p.ws + (mix == 0 ? WS_HM : WS_BIG + 56 * MiB)) : DS;
    const float* ACH = (const float*)(p.ws + (mix == 0 ? WS_ACHA : WS_ACHB));
    float zf = 0.f; asm volatile("" : "+v"(zf));
    float S[8];
#pragma unroll
    for (int j = 0; j < 8; ++j) S[j] = zf;
    int c0, N;
    if (sq < 16) { c0 = sq * 8; N = 8; }
    else { c0 = 128 + (sq - 16) * 32; N = 32; const int b = sq - 16;
        const float* s0p = mix == 0 ? p.IN(2) + (size_t)((((b * 2 + l) * 2 + dir) * 4 + hd)) * 4096 : p.IN(3) + (size_t)((((b * 2 + l) * 2 + dir) * 4 + hd)) * 2048;
#pragma unroll
        for (int j = 0; j < 8; ++j) S[j] = s0p[(d0 + j) * 64 + e]; }
    for (int n0 = 0; n0 < N; n0 += 8) {
        u32x4 v[8]; f32x4 a0[8], a1[8];
#pragma unroll
        for (int i = 0; i < 8; ++i) { const int nn = n0 + i, c = c0 + (dir == 0 ? nn : N - 1 - nn); const size_t ui = (size_t)((c * 4 + hd) * 2 + dir);
            v[i] = *(const u32x4*)(DS + ui * (dk * 128) + f * 16); a0[i] = *(const f32x4*)(ACH + ui * dk + d0); a1[i] = *(const f32x4*)(ACH + ui * dk + d0 + 4); }
#pragma unroll
        for (int i = 0; i < 8; ++i) { const int nn = n0 + i, c = c0 + (dir == 0 ? nn : N - 1 - nn); const size_t ui = (size_t)((c * 4 + hd) * 2 + dir);
            u32x4 o; o.x = pk2(S[0], S[1]); o.y = pk2(S[2], S[3]); o.z = pk2(S[4], S[5]); o.w = pk2(S[6], S[7]);
            *(u32x4*)(DSO + ui * (dk * 128) + f * 16) = o;
            S[0] = a0[i].x * S[0] + __uint_as_float(v[i].x << 16); S[1] = a0[i].y * S[1] + __uint_as_float(v[i].x & 0xffff0000u);
            S[2] = a0[i].z * S[2] + __uint_as_float(v[i].y << 16); S[3] = a0[i].w * S[3] + __uint_as_float(v[i].y & 0xffff0000u);
            S[4] = a1[i].x * S[4] + __uint_as_float(v[i].z << 16); S[5] = a1[i].y * S[5] + __uint_as_float(v[i].z & 0xffff0000u);
            S[6] = a1[i].z * S[6] + __uint_as_float(v[i].w << 16); S[7] = a1[i].w * S[7] + __uint_as_float(v[i].w & 0xffff0000u); }
    }
    if (sq < 16) { const int b = sq;
        float* ob = dry ? (float*)(p.ws + 243 * MiB) - OUT_SH : p.out;
        float* op = mix == 0 ? ob + OUT_SH + (size_t)((((b * 2 + l) * 2 + dir) * 4 + hd)) * 4096 : ob + OUT_SG + (size_t)((((b * 2 + l) * 2 + dir) * 4 + hd)) * 2048;
#pragma unroll
        for (int j = 0; j < 8; ++j) op[(d0 + j) * 64 + e] = S[j]; }
}
DI void phase_m2(const Params& p, int l, const int tid, const bool dry = false) {
    const int gt = blockIdx.x * 512 + tid, GT = gridDim.x * 512;
    for (int id = gt; id < 20 * 6144; id += GT) m2_chain8(p, l, 20 * 6144 - 1 - id, dry);
    float* RAGH = (float*)(p.ws + WS_RAGH); const float* RAGA = (const float*)(p.ws + WS_RAGA);
    float* RAGO = dry ? (float*)(p.ws + 250 * MiB) : RAGH; float* SRO = dry ? (float*)(p.ws + 251 * MiB) - OUT_SR : p.out;
    for (int id = GT - 1 - gt; id < 20 * 512; id += GT) {
        const int sq = id / 512, dir = (id >> 8) & 1, ch = id & 255;
        int c0, N; float h = 0.f;
        if (sq < 16) { c0 = sq * 8; N = 8; } else { c0 = 128 + (sq - 16) * 32; N = 32; h = p.IN(4)[((size_t)((sq - 16) * 2 + l) * 2 + dir) * 256 + ch]; }
        for (int n0 = 0; n0 < N; n0 += 8) {
            float v[8], av[8];
#pragma unroll
            for (int i = 0; i < 8; ++i) { const int n = n0 + i, c = c0 + (dir == 0 ? n : N - 1 - n); v[i] = RAGH[(c * 2 + dir) * 256 + ch]; av[i] = RAGA[(c * 2 + dir) * 256 + ch]; }
#pragma unroll
            for (int i = 0; i < 8; ++i) { const int n = n0 + i, c = c0 + (dir == 0 ? n : N - 1 - n); RAGO[(c * 2 + dir) * 256 + ch] = h; h = av[i] * h + v[i]; }
        }
        if (sq < 16) SRO[OUT_SR + ((size_t)(sq * 2 + l) * 2 + dir) * 256 + ch] = h;
    }
}

template <int MIX>
DI void m3_gla_unit(const Params& p, int l, int c, int hd, int lane) {
    constexpr int DK = MIX == 0 ? 64 : 32;
    const int r = lane & 31, hh = lane >> 5, tok0 = c * 32;
    const bf16_t* proj = (const bf16_t*)(p.ws + WS_BIG);
    const bf16_t* DS = (const bf16_t*)(p.ws + (MIX == 0 ? WS_DSA : WS_DSB));
    const bf16_t* QH = (const bf16_t*)(p.ws + (MIX == 0 ? WS_QHA : WS_QHB));
    const float* oi = (const float*)(p.ws + WS_OI) + (size_t)((MIX * 256 + c) * 4 + hd) * 2048;
    bf16_t* mix = (bf16_t*)(p.ws + WS_HM);
    f32x16 acc[2];
#pragma unroll
    for (int n = 0; n < 2; ++n)
#pragma unroll
        for (int g = 0; g < 4; ++g) { const f32x4 v = *(const f32x4*)(oi + ((n * 4 + g) * 64 + lane) * 4); acc[n][4 * g] = v.x; acc[n][4 * g + 1] = v.y; acc[n][4 * g + 2] = v.z; acc[n][4 * g + 3] = v.w; }
#pragma unroll
    for (int dir = 0; dir < 2; ++dir) {
        const bf16_t* sp = DS + (size_t)((c * 4 + hd) * 2 + dir) * (DK * 64);
#pragma unroll
        for (int s = 0; s < DK / 16; ++s) {
            const bf16x8 qf = MIX == 0 ? *(const bf16x8*)(QH + (size_t)(tok0 + r) * 512 + dir * 256 + hd * 64 + 16 * s + 8 * hh)
                                       : *(const bf16x8*)(QH + (size_t)(tok0 + r) * 256 + dir * 128 + hd * 32 + 16 * s + 8 * hh);
#pragma unroll
            for (int n = 0; n < 2; ++n) {
                const bf16x8 sf = *(const bf16x8*)(sp + ((n * (DK / 16) + s) * 64 + lane) * 8);
                acc[n] = MFMA32(sf, qf, acc[n]);
            }
        }
    }
    float ss = 0.f;
#pragma unroll
    for (int n = 0; n < 2; ++n)
#pragma unroll
        for (int i = 0; i < 16; ++i) ss += acc[n][i] * acc[n][i];
    ss += shx(ss, lane, 32);
    const float rstd = rsqrtf(ss * (1.f / 64.f) + 1e-6f);
    const float* gain = (MIX == 0 ? p.IN(14) : p.IN(17)) + l * 256 + hd * 64;
    const bf16_t* grow = proj + (size_t)(tok0 + r) * NP + (MIX == 0 ? A_G : B_G) + hd * 64;
    bf16_t* orow = mix + (size_t)(tok0 + r) * 1024 + MIX * 256 + hd * 64;
#pragma unroll
    for (int n = 0; n < 2; ++n)
#pragma unroll
        for (int g = 0; g < 4; ++g) {
            const int e = 32 * n + 8 * g + 4 * hh;
            const u32x2 gg = *(const u32x2*)(grow + e); const f32x4 gn = *(const f32x4*)(gain + e);
            const float g0 = __uint_as_float(gg.x << 16), g1 = __uint_as_float(gg.x & 0xffff0000u), g2 = __uint_as_float(gg.y << 16), g3 = __uint_as_float(gg.y & 0xffff0000u);
            u32x2 o; o.x = pk2(acc[n][4 * g] * rstd * gn.x * siluf_(g0), acc[n][4 * g + 1] * rstd * gn.y * siluf_(g1));
            o.y = pk2(acc[n][4 * g + 2] * rstd * gn.z * siluf_(g2), acc[n][4 * g + 3] * rstd * gn.w * siluf_(g3));
            *(u32x2*)(orow + e) = o;
        }
}

DI float gelu_tanh(float x) { const float u = 0.7978845608028654f * (x + 0.044715f * x * x * x); const float t = 1.f - 2.f * rcpf_(__expf(2.f * u) + 1.f); return 0.5f * x * (1.f + t); }

DI void phase_m3(const Params& p, int l, const int tid) {
    const int lane = tid & 63, wid = __builtin_amdgcn_readfirstlane(tid >> 6), gw = blockIdx.x * 8 + wid, GW = gridDim.x * 8;
    for (int u = gw; u < 2048; u += GW) {
        const int ty = u & 1, idx = u >> 1, c = idx >> 2, hd = idx & 3;
        int ln = lane; asm volatile("" : "+v"(ln));
        if (ty == 0) m3_gla_unit<0>(p, l, c, hd, ln); else m3_gla_unit<1>(p, l, c, hd, ln);
    }
    const int gt = blockIdx.x * 512 + tid, GT = gridDim.x * 512;
    const bf16_t* proj = (const bf16_t*)(p.ws + WS_BIG);
    bf16_t* mix = (bf16_t*)(p.ws + WS_HM);
    const float* HL = (const float*)(p.ws + WS_HL); const float* CP = (const float*)(p.ws + WS_CP); const float* HIN = (const float*)(p.ws + WS_RAGH);
    for (int id0 = gt; id0 < NTOK * 64; id0 += 4 * GT) {
        f32x4 hf[4], hb[4], cf[4], cb[4], inf_[4], inb[4]; u32x2 gg[4];
#pragma unroll
        for (int k = 0; k < 4; ++k) { const int id = id0 + k * GT; if (id < NTOK * 64) { const int tok = id >> 6, ch = (id & 63) * 4, c = tok >> 5;
            hf[k] = *(const f32x4*)(HL + (size_t)tok * 256 + ch); hb[k] = *(const f32x4*)(HL + ((size_t)NTOK + tok) * 256 + ch);
            cf[k] = *(const f32x4*)(CP + (size_t)tok * 256 + ch); cb[k] = *(const f32x4*)(CP + ((size_t)NTOK + tok) * 256 + ch);
            inf_[k] = *(const f32x4*)(HIN + (c * 2 + 0) * 256 + ch); inb[k] = *(const f32x4*)(HIN + (c * 2 + 1) * 256 + ch);
            gg[k] = *(const u32x2*)(proj + (size_t)tok * NP + C_G + ch); } }
#pragma unroll
        for (int k = 0; k < 4; ++k) { const int id = id0 + k * GT; if (id < NTOK * 64) { const int tok = id >> 6, ch = (id & 63) * 4;
            const f32x4 y = hf[k] + cf[k] * inf_[k] + hb[k] + cb[k] * inb[k];
            u32x2 o; o.x = pk2(y.x * gelu_tanh(__uint_as_float(gg[k].x << 16)), y.y * gelu_tanh(__uint_as_float(gg[k].x & 0xffff0000u)));
            o.y = pk2(y.z * gelu_tanh(__uint_as_float(gg[k].y << 16)), y.w * gelu_tanh(__uint_as_float(gg[k].y & 0xffff0000u)));
            *(u32x2*)(mix + (size_t)tok * 1024 + 512 + ch) = o; } }
    }
    const float* sw = p.IN(25) + l * 3 * 256;
    for (int id0 = gt; id0 < NTOK * 64; id0 += 4 * GT) {
        u32x2 cc[4][3], vv[4][3], bb[4];
#pragma unroll
        for (int k = 0; k < 4; ++k) { const int id = id0 + k * GT; if (id < NTOK * 64) { const int tok = id >> 6, ch = (id & 63) * 4;
            const int seg = tok < 4096 ? 256 : 64, pos = tok & (seg - 1);
#pragma unroll
            for (int j = 0; j < 3; ++j) { const int pp = pos + j - 1; cc[k][j] = (u32x2){0u, 0u}; vv[k][j] = (u32x2){0u, 0u};
                if (pp >= 0 && pp < seg) { const int tt = tok + j - 1; cc[k][j] = *(const u32x2*)(proj + (size_t)tt * NP + D_C + ch); vv[k][j] = *(const u32x2*)(proj + (size_t)tt * NP + D_V + ch); } }
            bb[k] = *(const u32x2*)(proj + (size_t)tok * NP + D_B + ch); } }
#pragma unroll
        for (int k = 0; k < 4; ++k) { const int id = id0 + k * GT; if (id < NTOK * 64) { const int tok = id >> 6, ch = (id & 63) * 4;
            f32x4 y = {0.f, 0.f, 0.f, 0.f};
#pragma unroll
            for (int j = 0; j < 3; ++j) { const f32x4 w = *(const f32x4*)(sw + j * 256 + ch);
                y.x += w.x * __uint_as_float(cc[k][j].x << 16) * __uint_as_float(vv[k][j].x << 16); y.y += w.y * __uint_as_float(cc[k][j].x & 0xffff0000u) * __uint_as_float(vv[k][j].x & 0xffff0000u);
                y.z += w.z * __uint_as_float(cc[k][j].y << 16) * __uint_as_float(vv[k][j].y << 16); y.w += w.w * __uint_as_float(cc[k][j].y & 0xffff0000u) * __uint_as_float(vv[k][j].y & 0xffff0000u); }
            u32x2 o; o.x = pk2(y.x * __uint_as_float(bb[k].x << 16), y.y * __uint_as_float(bb[k].x & 0xffff0000u));
            o.y = pk2(y.z * __uint_as_float(bb[k].y << 16), y.w * __uint_as_float(bb[k].y & 0xffff0000u));
            *(u32x2*)(mix + (size_t)tok * 1024 + 768 + ch) = o; } }
    }
}

__global__ void __launch_bounds__(512, 2) fwd_kernel(Params pin) {
    extern __shared__ __attribute__((aligned(16))) unsigned char lds_raw[];
    LAS unsigned char* lds = (LAS unsigned char*)lds_raw;
    cg::grid_group grid = cg::this_grid();
    const int G = gridDim.x, bid = blockIdx.x;
    volatile LAS unsigned* bst = (volatile LAS unsigned*)(lds + LDS_BYTES - 16);
    if (threadIdx.x < 4) bst[threadIdx.x] = 0u;
    __syncthreads();
    if (bid == 0 && pin.ph_lo == 0) { unsigned* bw = (unsigned*)(pin.ws + WS_BAR); for (int i = threadIdx.x; i < 4096; i += 512) bw[i] = 0u; }
    XcdBarrier xbar; xbar.bar = (unsigned*)(pin.ws + WS_BAR); xbar.x = 0; xbar.st = bst;
    int nsync = 0;
    for (int ph2 = 2 * pin.ph_lo; ph2 < 2 * pin.ph_hi; ++ph2) {
        const int ph = ph2 >> 1;
        if ((ph2 & 1) && !((REPEAT_MASK >> ph) & 1u)) continue;
        size_t zo = 0; asm volatile("" : "+s"(zo));
        int tid = threadIdx.x; asm volatile("" : "+v"(tid));
        Params p = pin; p.ws += zo; p.out += zo; p.zo = zo;
        const float* mod = (const float*)(p.ws + WS_MOD);
        bf16_t* hm = (bf16_t*)(p.ws + WS_HM); bf16_t* big = (bf16_t*)(p.ws + WS_BIG);
        if (ph == 0) phase_p0(p, lds, tid);
        else if (ph == 19) phase_norm(p, 0, 2, tid, (ph2 & 1) != 0);
        else {
            const int l = (ph - 1) / 9, s = (ph - 1) % 9;
            pg8::StaticOrder S;
            if (s == 0) phase_norm(p, l, 0, tid, (ph2 & 1) != 0);
            else if (s == 1) { pg8::Gemm g{hm, (const bf16_t*)(p.ws + WS_WIN) + (size_t)l * NP * 1024, NTOK, NP, 1024, 1024}; S.init(NTOK, NP, G, bid);
                pg8::EpiBf16<0> E{big, NP}; pg8::gemm_phase(lds, g, S, E, tid); }
            else if (s == 2) phase_m1(p, l, lds, tid, (ph2 & 1) ? M1_PROBE_STAGES : 7);
            else if (s == 3) phase_m2(p, l, tid, (ph2 & 1) != 0);
            else if (s == 4) phase_m3(p, l, tid);
            else if (s == 5) { pg8::Gemm g{hm, (const bf16_t*)(p.ws + WS_WOUT) + (size_t)l * 1024 * 1024, NTOK, 1024, 512, 1024}; S.init(NTOK, 1024, G, bid, 2);
                pg8::EpiResid E{mod + (size_t)l * 5 * 6144 + 2048, (bf16_t*)(p.ws + ((ph2 & 1) ? WS_HL : WS_DSA))}; pg8::gemm_phase(lds, g, S, E, tid); }
            else if (s == 6) phase_norm(p, l, 1, tid, (ph2 & 1) != 0);
            else if (s == 7) { pg8::Gemm g{hm, (const bf16_t*)(p.ws + WS_W1) + (size_t)l * 4096 * 1024, NTOK, DFF, 1024, 1024}; S.init(NTOK, DFF, G, bid);
                pg8::EpiBf16<1> E{big, DFF}; pg8::gemm_phase(lds, g, S, E, tid); }
            else { pg8::Gemm g{big, (const bf16_t*)(p.ws + WS_W2) + (size_t)l * 1024 * 4096, NTOK, 1024, 2048, DFF}; S.init(NTOK, 1024, G, bid, 2);
                pg8::EpiResid E{mod + (size_t)l * 5 * 6144 + 5120, (bf16_t*)(p.ws + ((ph2 & 1) ? WS_HL : WS_DSA))}; pg8::gemm_phase(lds, g, S, E, tid); }
        }
        if (ph2 + 2 < 2 * pin.ph_hi || (!(ph2 & 1) && ((REPEAT_MASK >> ph) & 1u))) { if (nsync == 0) { grid.sync(); xbar = xcd_barrier_post((unsigned*)(pin.ws + WS_BAR), bst); } else xcd_barrier(xbar); ++nsync; }
    }
}

extern "C" void kernel_launch(void* const* d_in, const int* in_sizes, int n_in, void* d_out, int out_size, void* d_ws, size_t ws_size, hipStream_t stream) {
    static int grid = 0;
    if (grid == 0) {
        if (n_in != 29 || ws_size < WS_END) { fprintf(stderr, "kernel_launch: unexpected n_in %d / ws %zu\n", n_in, ws_size); grid = -1; return; }
        int dev = 0, cus = 0, per_cu = 0;
        hipGetDevice(&dev); hipDeviceGetAttribute(&cus, hipDeviceAttributeMultiprocessorCount, dev);
        if (hipFuncSetAttribute((const void*)fwd_kernel, hipFuncAttributeMaxDynamicSharedMemorySize, LDS_BYTES) != hipSuccess) { fprintf(stderr, "kernel_launch: hipFuncSetAttribute failed\n"); grid = -1; return; }
        if (hipOccupancyMaxActiveBlocksPerMultiprocessor(&per_cu, (const void*)fwd_kernel, 512, LDS_BYTES) != hipSuccess || per_cu < 1) { fprintf(stderr, "kernel_launch: occupancy query says %d\n", per_cu); per_cu = 1; }
        (void)hipGetLastError();
        grid = cus * 1;
        if (grid <= 0) grid = 256;
    }
    if (grid < 0) return;
    Params p{};
    for (int i = 0; i < 29; ++i) p.in[i] = (const float*)d_in[i];
    p.out = (float*)d_out; p.ws = (unsigned char*)d_ws;
#if MEGA
    p.ph_lo = 0; p.ph_hi = 20;
    void* args[] = {&p};
    hipError_t e = hipLaunchCooperativeKernel((const void*)fwd_kernel, dim3(grid), dim3(512), args, LDS_BYTES, stream);
    if (e != hipSuccess) fprintf(stderr, "cooperative launch failed: %s (grid %d)\n", hipGetErrorString(e), grid);
#else
    for (int ph = 0; ph < 20; ++ph) { p.ph_lo = ph; p.ph_hi = ph + 1; hipLaunchKernelGGL(fwd_kernel, dim3(grid), dim3(512), LDS_BYTES, stream, p); }
#endif
}
```

```cpp
#include <hip/hip_runtime.h>
#include <hip/hip_cooperative_groups.h>
#include <cstdio>
#include <cstdint>
namespace cg = cooperative_groups;

#ifndef MEGA
#define MEGA 1
#endif
#ifndef M1_PROBE_STAGES
#define M1_PROBE_STAGES 7
#endif
#ifndef GEMM_SP2
#define GEMM_SP2 true
#endif
#ifndef GEMM_ALIGN
#define GEMM_ALIGN true
#endif
#ifndef REPEAT_MASK
#define REPEAT_MASK 0u
#endif

#define DI __device__ __forceinline__
#define LAS __attribute__((address_space(3)))
typedef unsigned short bf16_t;
typedef short bf16x8 __attribute__((ext_vector_type(8)));
typedef float f32x4 __attribute__((ext_vector_type(4)));
typedef float f32x16 __attribute__((ext_vector_type(16)));
typedef unsigned u32x4 __attribute__((ext_vector_type(4)));
typedef unsigned u32x2 __attribute__((ext_vector_type(2)));
typedef __bf16 bf16x2_t __attribute__((ext_vector_type(2)));
typedef float f32x2_t __attribute__((ext_vector_type(2)));

constexpr int NTOK = 8192, DM = 1024, NP = 3584, DFF = 4096;
constexpr int A_Q = 0, A_I = 256, A_FF = 512, A_FB = 768, A_G = 1024, B_Q = 1280, B_K = 1408, B_V = 1536, B_G = 1792, B_AF = 2048, B_AB = 2064,
              C_X = 2080, C_G = 2336, D_B = 2592, D_C = 2848, D_V = 3104, PW = 3360;
constexpr size_t MiB = 1u << 20;
constexpr size_t WS_WIN = 0, WS_WOUT = 14 * MiB, WS_W1 = 18 * MiB, WS_W2 = 34 * MiB, WS_MOD = 50 * MiB, WS_HM = 51 * MiB, WS_BIG = 67 * MiB,
                 WS_OI = 131 * MiB, WS_DSA = 147 * MiB, WS_DSB = 179 * MiB, WS_QHA = 195 * MiB, WS_QHB = 203 * MiB, WS_HL = 207 * MiB, WS_CP = 223 * MiB,
                 WS_ACHA = 239 * MiB, WS_ACHB = 239 * MiB + 512 * 1024, WS_RAGA = 240 * MiB, WS_RAGH = 240 * MiB + 512 * 1024, WS_BAR = 241 * MiB, WS_END = 242 * MiB;
constexpr int OUT_SH = 8388608, OUT_SG = OUT_SH + 1048576, OUT_SR = OUT_SG + 524288;
constexpr int LDS_BYTES = 147456;

struct Params { const float* in[29]; float* out; unsigned char* ws; size_t zo; int ph_lo, ph_hi;
    DI const float* IN(int i) const { return in[i] + zo; } };

DI float bf2f(bf16_t u) { return __uint_as_float(((unsigned)u) << 16); }
DI unsigned pk2(float lo, float hi) { f32x2_t v = {lo, hi}; bf16x2_t b = __builtin_convertvector(v, bf16x2_t); return __builtin_bit_cast(unsigned, b); }
DI bf16_t f2bf(float x) { return (bf16_t)(pk2(x, 0.f) & 0xffffu); }
DI bf16x8 pack8(const float* v) { u32x4 p; p.x = pk2(v[0], v[1]); p.y = pk2(v[2], v[3]); p.z = pk2(v[4], v[5]); p.w = pk2(v[6], v[7]); return __builtin_bit_cast(bf16x8, p); }
DI float rcpf_(float x) { return __builtin_amdgcn_rcpf(x); }
DI float sigmoidf_(float x) { return rcpf_(1.f + __expf(-x)); }
DI float siluf_(float x) { return x * rcpf_(1.f + __expf(-x)); }
DI float om_exp(float x) { const float s = -x * (1.f + x * 0.5f * (1.f + x * (1.f / 3.f) * (1.f + x * 0.25f * (1.f + x * 0.2f * (1.f + x * (1.f / 6.f)))))); return x > -0.3f ? s : 1.f - __expf(x); }
DI int crow(int reg, int h) { return (reg & 3) + 8 * (reg >> 2) + 4 * h; }
#define MFMA32(a, b, c) __builtin_amdgcn_mfma_f32_32x32x16_bf16((a), (b), (c), 0, 0, 0)
DI f32x16 zero16() { f32x16 z; for (int i = 0; i < 16; ++i) z[i] = 0.f; return z; }
DI float shx(float v, int lane, int m) { return __int_as_float(__builtin_amdgcn_ds_bpermute((lane ^ m) << 2, __float_as_int(v))); }
DI int modrow_of(int row) { return row < 4096 ? 0 : 1 + ((row - 4096) >> 10); }


#define XB_TMO      128
#define XB_XCNT(j)  (256  + 64 * (j))
#define XB_XSUB(j)  (1280 + 64 * (j))
#define XB_XGEN(j)  (2304 + 64 * (j))
#define XB_TOP      3328
#define XB_TOPGEN   3392
#define XCD_BAR_WORDS 3456
#define XB_SPIN_CAP (1u << 18)
DI unsigned xb_ld(unsigned* p)              { return __hip_atomic_load(p, __ATOMIC_RELAXED, __HIP_MEMORY_SCOPE_AGENT); }
DI unsigned xb_add(unsigned* p, unsigned v) { return __hip_atomic_fetch_add(p, v, __ATOMIC_RELAXED, __HIP_MEMORY_SCOPE_AGENT); }
DI unsigned xb_xcc_id() { return (unsigned)__builtin_amdgcn_s_getreg((3 << 11) | 20) & 0xFu; }
#define XB_SPIN(cond, bar) do { unsigned _sp = 0; while (cond) { __builtin_amdgcn_s_sleep(1); \
    if ((++_sp & 255u) == 0u) { if (xb_ld(&(bar)[XB_TMO])) break; if (_sp > XB_SPIN_CAP) { atomicAdd(&(bar)[XB_TMO], 1u); break; } } } } while (0)
struct XcdBarrier { unsigned* bar; unsigned x; volatile LAS unsigned* st; };
DI XcdBarrier xcd_barrier_post(unsigned* bar, volatile LAS unsigned* st) {
    XcdBarrier b; b.bar = bar; b.x = xb_xcc_id(); b.st = st;
    if (threadIdx.x == 0) (void)xb_add(&bar[XB_XCNT(b.x)], 1u);
    return b;
}
DI void xcd_barrier_complete(unsigned* bar, unsigned x, unsigned& nloc, unsigned& nx) {
    const unsigned G = gridDim.x * gridDim.y * gridDim.z;
    unsigned sum, cnt, mine, sp = 0u;
    for (;;) {
        sum = 0u; cnt = 0u; mine = 0u;
#pragma unroll
        for (unsigned j = 0; j < 16; ++j) { const unsigned c = xb_ld(&bar[XB_XCNT(j)]); sum += c; cnt += (c > 0u) ? 1u : 0u; mine = (j == x) ? c : mine; }
        if (sum == G) break;
        __builtin_amdgcn_s_sleep(1);
        if ((++sp & 255u) == 0u) { if (xb_ld(&bar[XB_TMO])) break; if (sp > XB_SPIN_CAP) { atomicAdd(&bar[XB_TMO], 1u); break; } }
    }
    nloc = mine > 0u ? mine : 1u; nx = cnt > 0u ? cnt : 1u;
}
DI void xcd_barrier(const XcdBarrier& b) {
    asm volatile("s_waitcnt vmcnt(0)" ::: "memory");
    __syncthreads();
    if (threadIdx.x == 0) {
        unsigned* bar = b.bar;
        __builtin_amdgcn_s_waitcnt(0);
        unsigned nloc = b.st[0], nx = b.st[1];
        if (nloc == 0u) { xcd_barrier_complete(bar, b.x, nloc, nx); b.st[0] = nloc; b.st[1] = nx; }
        const unsigned old = xb_add(&bar[XB_XSUB(b.x)], 1u);
        const unsigned gen = old / nloc;
        if (old + 1u == (gen + 1u) * nloc) {
            __builtin_amdgcn_fence(__ATOMIC_RELEASE, "agent");
            asm volatile("s_waitcnt vmcnt(0)" ::: "memory");
            const unsigned og = xb_add(&bar[XB_TOP], 1u);
            const unsigned tg = og / nx;
            if (og + 1u == (tg + 1u) * nx) xb_add(&bar[XB_TOPGEN], 1u);
            else XB_SPIN(xb_ld(&bar[XB_TOPGEN]) == tg, bar);
            __builtin_amdgcn_fence(__ATOMIC_ACQUIRE, "agent");
            xb_add(&bar[XB_XGEN(b.x)], 1u);
            asm volatile("s_waitcnt vmcnt(0)" ::: "memory");
        } else {
            XB_SPIN(xb_ld(&bar[XB_XGEN(b.x)]) == gen, bar);
            __builtin_amdgcn_fence(__ATOMIC_ACQUIRE, "agent");
            asm volatile("s_waitcnt vmcnt(0)" ::: "memory");
        }
    }
    __syncthreads();
}

namespace pg8 {
constexpr int BM = 256, BK = 64, HALF = 128, HTB = HALF * BK * 2, NXCD = 8, WGM = 8;
__host__ __device__ __forceinline__ int lds_byte(int r, int c) { const int st = (r >> 4) * 2 + (c >> 5), rr = r & 15, cc = c & 31, ob = rr * 64 + cc * 2; return st * 1024 + (ob ^ (((ob >> 9) & 1) << 5)); }
__host__ __device__ __forceinline__ void stage_rc(int b, int& R, int& C) { const int st = b / 1024, sb = b % 1024, swz = sb ^ (((sb >> 9) & 1) << 5); R = (st >> 1) * 16 + swz / 64; C = (st & 1) * 32 + (swz % 64) / 2; }
__host__ __device__ __forceinline__ int perm32(int rho) { const int n = rho >> 4, i = rho & 15; return 8 * (i >> 2) + 4 * n + (i & 3); }
struct Unit { int pm, pn, pk; };
struct Gemm { const bf16_t* A; const bf16_t* Bt; int M, N, K, lda; };
struct StaticOrder {
    int nM, nN, nwg, G, c, KS;
    __host__ __device__ void init(int M, int N, int G_, int c_, int KS_ = 1) { KS = KS_; nM = M / BM; nN = (N / BM) * KS; nwg = nM * nN; G = G_; c = c_; }
    __host__ __device__ bool next(int i, Unit& u) const {
        const long L = (long)i * G + c; if (L >= nwg) return false;
        int wgid = (int)L; { const int q = nwg / NXCD, r = nwg % NXCD, xcd = wgid % NXCD, off = wgid / NXCD; wgid = (xcd < r ? xcd * (q + 1) : r * (q + 1) + (xcd - r) * q) + off; }
        const int nig = WGM * nN, gid = wgid / nig, fm = gid * WGM, gsz = (nM - fm) < WGM ? (nM - fm) : WGM;
        u.pm = fm + ((wgid % nig) % gsz); const int pv = (wgid % nig) / gsz; u.pn = pv / KS; u.pk = pv % KS; return true;
    }
};
template <class Epi, bool ALIGN_EPI = false, bool SP2 = false>
__device__ __forceinline__ void gemm_phase(LAS unsigned char* lds, const Gemm g, const StaticOrder& S, const Epi& E, const int tid) {
    const int wid = __builtin_amdgcn_readfirstlane(tid >> 6), lane = tid & 63, wr = wid >> 2, wc = wid & 3, fr = lane & 15, fq = lane >> 4;
    const int K = g.lda, nt = g.K / BK;
    unsigned voffA[2], voffB[2];
#pragma unroll
    for (int i = 0; i < 2; ++i) { int R, C; stage_rc(tid * 16 + i * 8192, R, C); const int Rb = (R & ~31) + perm32(R & 31);
        voffA[i] = (unsigned)(R * K + C) * 2u; voffB[i] = (unsigned)(Rb * K + C) * 2u; }
    const size_t kstep = (size_t)(BK * 2);
    const size_t hstep = (size_t)HALF * K * 2;
    const size_t tstep = 2 * hstep;
    const unsigned ldsw = (unsigned)wid * 1024u;
    const int aoff = lds_byte(wr * 64 + fr, fq * 8), boff = lds_byte(wc * 32 + fr, fq * 8);
#define PG8_SA(b, h) (((b) * 2 + (h)) * HTB)
#define PG8_SB(b, h) ((4 + (b) * 2 + (h)) * HTB)
#define PG8_STAGE(bufoff, gbase, voff) do { _Pragma("unroll") for (int _i = 0; _i < 2; ++_i) \
        __builtin_amdgcn_global_load_lds((const unsigned*)((const char*)(gbase) + (voff)[_i]), (LAS unsigned*)(lds + (bufoff) + ldsw + _i * 8192), 16, 0, 0); } while (0)
#define PG8_LDA(dst, b, h) do { _Pragma("unroll") for (int m = 0; m < 4; ++m) _Pragma("unroll") for (int k = 0; k < 2; ++k) dst[m][k] = *(const LAS bf16x8*)(lds + PG8_SA(b, h) + aoff + m * 2048 + k * 1024); } while (0)
#define PG8_LDB(dst, b, h) do { _Pragma("unroll") for (int n = 0; n < 2; ++n) _Pragma("unroll") for (int k = 0; k < 2; ++k) dst[n][k] = *(const LAS bf16x8*)(lds + PG8_SB(b, h) + boff + n * 2048 + k * 1024); } while (0)
#define PG8_MMA(ai, bj, At, Bt) do { __builtin_amdgcn_s_setprio(1); _Pragma("unroll") for (int m = 0; m < 4; ++m) _Pragma("unroll") for (int n = 0; n < 2; ++n) _Pragma("unroll") for (int k = 0; k < 2; ++k) \
        acc[ai][bj][m][n] = __builtin_amdgcn_mfma_f32_16x16x32_bf16(Bt[n][k], At[m][k], acc[ai][bj][m][n], 0, 0, 0); __builtin_amdgcn_s_setprio(0); } while (0)
#define PG8_WAIT_V(n) asm volatile("s_waitcnt vmcnt(" #n ")" ::: "memory")
#define PG8_WAIT_L(n) asm volatile("s_waitcnt lgkmcnt(" #n ")" ::: "memory")
#define PG8_BAR __builtin_amdgcn_s_barrier()
#define PG8_SCHED __builtin_amdgcn_sched_barrier(0)
    Unit cur, nxt; int ui = 0;
    if (!S.next(0, cur)) return;
    f32x4 acc[2][2][4][2];
#pragma unroll
    for (int a = 0; a < 2; ++a)
#pragma unroll
        for (int b = 0; b < 2; ++b)
#pragma unroll
            for (int m = 0; m < 4; ++m)
#pragma unroll
                for (int n = 0; n < 2; ++n) acc[a][b][m][n] = (f32x4){0.f, 0.f, 0.f, 0.f};
    bf16x8 At[4][2], B0[2][2], B1[2][2];
    const size_t ksplit = (size_t)g.K * 2;
    const char* cA = (const char*)g.A + (size_t)cur.pm * tstep + cur.pk * ksplit; const char* cB = (const char*)g.Bt + (size_t)cur.pn * tstep + cur.pk * ksplit;
    if constexpr (SP2) {
        PG8_STAGE(PG8_SB(0, 0), cB, voffB); PG8_STAGE(PG8_SB(0, 1), cB + hstep, voffB); PG8_STAGE(PG8_SA(0, 0), cA, voffA); PG8_STAGE(PG8_SA(0, 1), cA + hstep, voffA);
        if (wr == 1) PG8_BAR;
        PG8_WAIT_V(2); PG8_BAR;
        PG8_STAGE(PG8_SB(1, 0), cB + kstep, voffB); PG8_STAGE(PG8_SA(1, 0), cA + kstep, voffA); PG8_STAGE(PG8_SB(1, 1), cB + hstep + kstep, voffB);
        PG8_WAIT_V(6); PG8_BAR;
    } else {
        PG8_STAGE(PG8_SB(0, 0), cB, voffB); PG8_STAGE(PG8_SA(0, 0), cA, voffA); PG8_STAGE(PG8_SB(0, 1), cB + hstep, voffB); PG8_STAGE(PG8_SA(0, 1), cA + hstep, voffA);
        if (wr == 1) PG8_BAR;
        PG8_WAIT_V(4); PG8_BAR;
        PG8_STAGE(PG8_SB(1, 0), cB + kstep, voffB); PG8_STAGE(PG8_SA(1, 0), cA + kstep, voffA); PG8_STAGE(PG8_SB(1, 1), cB + hstep + kstep, voffB);
        PG8_WAIT_V(6); PG8_BAR;
    }
    for (;;) {
        const bool has_next = S.next(ui + 1, nxt);
        const char* nA = has_next ? (const char*)g.A + (size_t)nxt.pm * tstep + nxt.pk * ksplit : cA; const char* nB = has_next ? (const char*)g.Bt + (size_t)nxt.pn * tstep + nxt.pk * ksplit : cB;
        for (int t = 0; t < nt; t += 2) {
            const bool last = (t == nt - 2);
            const char* a1 = cA + (size_t)(t + 1) * kstep;
            const char* a2 = last ? nA : cA + (size_t)(t + 2) * kstep; const char* b2 = last ? nB : cB + (size_t)(t + 2) * kstep;
            const char* a3 = a2 + kstep; const char* b3 = b2 + kstep;
            if constexpr (SP2) {
            PG8_LDB(B0, 0, 0); PG8_LDB(B1, 0, 1); PG8_SCHED; PG8_LDA(At, 0, 0); PG8_STAGE(PG8_SA(1, 1), a1 + hstep, voffA);
            PG8_WAIT_V(8); PG8_WAIT_L(0); PG8_BAR; PG8_MMA(0, 0, At, B0); PG8_MMA(0, 1, At, B1); PG8_BAR; PG8_SCHED;
            PG8_LDA(At, 0, 1); PG8_STAGE(PG8_SB(0, 0), b2, voffB); PG8_STAGE(PG8_SB(0, 1), b2 + hstep, voffB); PG8_STAGE(PG8_SA(0, 0), a2, voffA);
            PG8_WAIT_V(8); PG8_WAIT_L(0); PG8_BAR; PG8_MMA(1, 0, At, B0); PG8_MMA(1, 1, At, B1); PG8_BAR; PG8_SCHED;
            PG8_LDB(B0, 1, 0); PG8_LDB(B1, 1, 1); PG8_SCHED; PG8_LDA(At, 1, 0); PG8_STAGE(PG8_SA(0, 1), a2 + hstep, voffA);
            PG8_WAIT_V(8); PG8_WAIT_L(0); PG8_BAR; PG8_MMA(0, 0, At, B0); PG8_MMA(0, 1, At, B1); PG8_BAR; PG8_SCHED;
            PG8_LDA(At, 1, 1); PG8_STAGE(PG8_SB(1, 0), b3, voffB); PG8_STAGE(PG8_SB(1, 1), b3 + hstep, voffB); PG8_STAGE(PG8_SA(1, 0), a3, voffA);
            PG8_WAIT_V(8); PG8_WAIT_L(0); PG8_BAR; PG8_MMA(1, 0, At, B0); PG8_MMA(1, 1, At, B1); PG8_BAR; PG8_SCHED;
            } else {
            PG8_LDB(B0, 0, 0); PG8_SCHED; PG8_LDA(At, 0, 0); PG8_STAGE(PG8_SA(1, 1), a1 + hstep, voffA);
            PG8_WAIT_L(8); PG8_BAR; PG8_WAIT_L(0); PG8_MMA(0, 0, At, B0); PG8_BAR; PG8_SCHED;
            PG8_LDB(B1, 0, 1); PG8_STAGE(PG8_SB(0, 0), b2, voffB);
            PG8_BAR; PG8_WAIT_L(0); PG8_MMA(0, 1, At, B1); PG8_BAR;
            PG8_LDA(At, 0, 1); PG8_STAGE(PG8_SA(0, 0), a2, voffA);
            PG8_BAR; PG8_WAIT_L(0); PG8_MMA(1, 0, At, B0); PG8_BAR; PG8_SCHED;
            PG8_STAGE(PG8_SB(0, 1), b2 + hstep, voffB);
            PG8_WAIT_V(6); PG8_BAR; PG8_MMA(1, 1, At, B1); PG8_BAR;
            PG8_LDB(B0, 1, 0); PG8_SCHED; PG8_LDA(At, 1, 0); PG8_STAGE(PG8_SA(0, 1), a2 + hstep, voffA);
            PG8_WAIT_L(8); PG8_BAR; PG8_WAIT_L(0); PG8_MMA(0, 0, At, B0); PG8_BAR; PG8_SCHED;
            PG8_LDB(B1, 1, 1); PG8_STAGE(PG8_SB(1, 0), b3, voffB);
            PG8_BAR; PG8_WAIT_L(0); PG8_MMA(0, 1, At, B1); PG8_BAR;
            PG8_LDA(At, 1, 1); PG8_STAGE(PG8_SA(1, 0), a3, voffA);
            PG8_BAR; PG8_WAIT_L(0); PG8_MMA(1, 0, At, B0); PG8_BAR; PG8_SCHED;
            PG8_STAGE(PG8_SB(1, 1), b3 + hstep, voffB);
            PG8_WAIT_V(6); PG8_BAR; PG8_MMA(1, 1, At, B1); PG8_BAR;
            }
        }
        if constexpr (ALIGN_EPI) { if (wr == 0) PG8_BAR; }
        E(acc, cur, wr, wc, fr, fq);
        if (!has_next) break;
#pragma unroll
        for (int a = 0; a < 2; ++a)
#pragma unroll
            for (int b = 0; b < 2; ++b)
#pragma unroll
                for (int m = 0; m < 4; ++m)
#pragma unroll
                    for (int n = 0; n < 2; ++n) acc[a][b][m][n] = (f32x4){0.f, 0.f, 0.f, 0.f};
        cur = nxt; cA = nA; cB = nB; ++ui;
        if constexpr (ALIGN_EPI) { if (wr == 1) PG8_BAR; }
    }
    PG8_WAIT_V(0);
    if constexpr (!ALIGN_EPI) { if (wr == 0) PG8_BAR; }
    PG8_BAR;
#undef PG8_SA
#undef PG8_SB
#undef PG8_STAGE
#undef PG8_LDA
#undef PG8_LDB
#undef PG8_MMA
#undef PG8_WAIT_V
#undef PG8_WAIT_L
#undef PG8_BAR
#undef PG8_SCHED
}

template <int ACT> struct EpiBf16 {
    bf16_t* O; int ldc;
    __device__ __forceinline__ void operator()(const f32x4 (&acc)[2][2][4][2], const Unit& u, int wr, int wc, int fr, int fq) const {
        const int row0 = u.pm * BM + wr * 64 + fr, col0 = u.pn * BM + wc * 32 + 8 * fq;
#pragma unroll
        for (int ai = 0; ai < 2; ++ai)
#pragma unroll
            for (int m = 0; m < 4; ++m) { bf16_t* rowp = O + (size_t)(row0 + ai * HALF + m * 16) * ldc + col0;
#pragma unroll
                for (int bj = 0; bj < 2; ++bj) { f32x4 v0 = acc[ai][bj][m][0], v1 = acc[ai][bj][m][1];
                    if (ACT == 1) {
#pragma unroll
                        for (int q = 0; q < 4; ++q) { float a = fmaxf(v0[q], 0.f), b = fmaxf(v1[q], 0.f); v0[q] = a * a; v1[q] = b * b; } }
                    u32x4 w; w.x = pk2(v0[0], v0[1]); w.y = pk2(v0[2], v0[3]); w.z = pk2(v1[0], v1[1]); w.w = pk2(v1[2], v1[3]);
                    *(u32x4*)(rowp + bj * HALF) = w; } }
    }
};
struct EpiResid {
    const float* gate; bf16_t* pb;
    __device__ __forceinline__ void operator()(const f32x4 (&acc)[2][2][4][2], const Unit& u, int wr, int wc, int fr, int fq) const {
        const int rowb = u.pm * BM; const float* gp = gate + modrow_of(rowb) * 6144;
        const int row0 = rowb + wr * 64 + fr, col0 = u.pn * BM + wc * 32 + 8 * fq;
        bf16_t* pbk = pb + (size_t)u.pk * ((size_t)NTOK * 1024);
        f32x4 gv[2][2];
#pragma unroll
        for (int bj = 0; bj < 2; ++bj)
#pragma unroll
            for (int n = 0; n < 2; ++n) gv[bj][n] = *(const f32x4*)(gp + col0 + bj * HALF + 4 * n);
#pragma unroll
        for (int ai = 0; ai < 2; ++ai)
#pragma unroll
            for (int m = 0; m < 4; ++m) { const size_t ro = (size_t)(row0 + ai * HALF + m * 16) * 1024 + col0;
#pragma unroll
                for (int bj = 0; bj < 2; ++bj) { const f32x4 v0 = gv[bj][0] * acc[ai][bj][m][0], v1 = gv[bj][1] * acc[ai][bj][m][1];
                    u32x4 w; w.x = pk2(v0[0], v0[1]); w.y = pk2(v0[2], v0[3]); w.z = pk2(v1[0], v1[1]); w.w = pk2(v1[2], v1[3]);
                    *(u32x4*)(pbk + ro + bj * HALF) = w; } }
    }
};
}

DI void transpose_unit(const float* __restrict__ W, int K, int N, int Npad, bf16_t* WT, int unit, int lane, LAS unsigned char* scr) {
    const int nblk = Npad / 64, kb = unit / nblk, nb = unit % nblk, n = nb * 64 + lane, k0 = kb * 64;
    u32x4 o[8];
    if (n < N) {
        float v[64];
#pragma unroll
        for (int kk = 0; kk < 64; ++kk) v[kk] = W[(size_t)(k0 + kk) * N + n];
#pragma unroll
        for (int q = 0; q < 8; ++q) { o[q].x = pk2(v[8 * q], v[8 * q + 1]); o[q].y = pk2(v[8 * q + 2], v[8 * q + 3]); o[q].z = pk2(v[8 * q + 4], v[8 * q + 5]); o[q].w = pk2(v[8 * q + 6], v[8 * q + 7]); }
    } else {
#pragma unroll
        for (int q = 0; q < 8; ++q) o[q] = (u32x4){0u, 0u, 0u, 0u};
    }
#pragma unroll
    for (int q = 0; q < 8; ++q) *(LAS u32x4*)(scr + lane * 144 + q * 16) = o[q];
    __builtin_amdgcn_fence(__ATOMIC_RELEASE, "wavefront"); __builtin_amdgcn_wave_barrier();
    const int ch = lane & 7, rb = lane >> 3;
#pragma unroll
    for (int j = 0; j < 8; ++j) { const int row = rb + 8 * j; const u32x4 w = *(const LAS u32x4*)(scr + row * 144 + ch * 16);
        *(u32x4*)(WT + (size_t)(nb * 64 + row) * K + k0 + ch * 8) = w; }
    __builtin_amdgcn_fence(__ATOMIC_RELEASE, "wavefront"); __builtin_amdgcn_wave_barrier();
}

DI void phase_p0(const Params& p, LAS unsigned char* lds, const int tid) {
    const int lane = tid & 63, wid = tid >> 6, G = gridDim.x, bid = blockIdx.x;
    const float* c = p.IN(5); const float* c_ctx = p.IN(6); const float* ada_w = p.IN(9); const float* ada_b = p.IN(10);
    float* mod = (float*)(p.ws + WS_MOD);
    LAS float* st = (LAS float*)lds + wid * 640;
    LAS float* red = (LAS float*)(lds + 32768);
    for (int bu = bid; bu < 192; bu += G) {
        const int l = bu / 96, cgp = bu % 96, col = cgp * 64 + lane;
        for (int i = lane; i < 640; i += 64) { const int row = i / 128, k = wid * 128 + (i % 128); const float cv = row == 0 ? c_ctx[k] : c[(row - 1) * 1024 + k]; st[i] = siluf_(cv); }
        __syncthreads();
        float acc[5] = {0.f, 0.f, 0.f, 0.f, 0.f};
        const float* W = ada_w + (size_t)l * 1024 * 6144 + (size_t)(wid * 128) * 6144 + col;
#pragma unroll 16
        for (int kk = 0; kk < 128; ++kk) { const float w = W[(size_t)kk * 6144];
#pragma unroll
            for (int row = 0; row < 5; ++row) acc[row] += st[row * 128 + kk] * w; }
#pragma unroll
        for (int row = 0; row < 5; ++row) red[(wid * 5 + row) * 64 + lane] = acc[row];
        __syncthreads();
        if (tid < 320) { const int row = tid / 64, ln = tid % 64; float s = 0.f;
#pragma unroll
            for (int w = 0; w < 8; ++w) s += red[(w * 5 + row) * 64 + ln];
            const int cc = cgp * 64 + ln; mod[(l * 5 + row) * 6144 + cc] = s + ada_b[l * 6144 + cc]; }
        __syncthreads();
    }
    const int gw = bid * 8 + wid, GW = G * 8;
    LAS unsigned char* scr = lds + 65536 + wid * 9216;
    for (int u = gw; u < 6400; u += GW) {
        const int l = u / 3200; int r = u % 3200;
        if (r < 896) transpose_unit(p.IN(11) + (size_t)l * 1024 * PW, 1024, PW, NP, (bf16_t*)(p.ws + WS_WIN) + (size_t)l * NP * 1024, r, lane, scr);
        else if (r < 1152) transpose_unit(p.IN(12) + (size_t)l * 1024 * 1024, 1024, 1024, 1024, (bf16_t*)(p.ws + WS_WOUT) + (size_t)l * 1024 * 1024, r - 896, lane, scr);
        else if (r < 2176) transpose_unit(p.IN(26) + (size_t)l * 1024 * 4096, 1024, 4096, 4096, (bf16_t*)(p.ws + WS_W1) + (size_t)l * 4096 * 1024, r - 1152, lane, scr);
        else transpose_unit(p.IN(27) + (size_t)l * 4096 * 1024, 4096, 1024, 1024, (bf16_t*)(p.ws + WS_W2) + (size_t)l * 1024 * 4096, r - 2176, lane, scr);
    }
}

DI void phase_norm(const Params& p, int l, int which, const int tid, const bool dry = false) {
    const int lane = tid & 63, wid = tid >> 6, gw = blockIdx.x * 8 + wid, GW = gridDim.x * 8;
    const float* mod = (const float*)(p.ws + WS_MOD);
    bf16_t* hm = (bf16_t*)(p.ws + (dry ? WS_OI : WS_HM));
    float* xo = dry ? (float*)(p.ws + WS_HL) : p.out;
    const float* g = which == 0 ? p.IN(7) + l * 1024 : (which == 1 ? p.IN(8) + l * 1024 : p.IN(28));
    const bool first = (which == 0 && l == 0), from_in = (l == 0 && which != 2);
    for (int row0 = gw; row0 < NTOK; row0 += 4 * GW) {
        f32x4 v[4][4]; float ss[4];
#pragma unroll
        for (int k = 0; k < 4; ++k) {
            const int row = row0 + k * GW; ss[k] = 0.f;
            if (row < NTOK) {
                const float* xr = from_in ? (row < 4096 ? p.IN(0) + (size_t)row * 1024 : p.IN(1) + (size_t)(row - 4096) * 1024) : p.out + (size_t)row * 1024;
#pragma unroll
                for (int j = 0; j < 4; ++j) v[k][j] = ((const f32x4*)xr)[lane + 64 * j];
                if (!first) {
                    const bf16_t* pr = (const bf16_t*)(p.ws + WS_DSA) + (size_t)row * 1024;
#pragma unroll
                    for (int j = 0; j < 4; ++j) { const u32x2 pp = ((const u32x2*)pr)[lane + 64 * j], pq = ((const u32x2*)(pr + (size_t)NTOK * 1024))[lane + 64 * j];
                        v[k][j].x += __uint_as_float(pp.x << 16) + __uint_as_float(pq.x << 16); v[k][j].y += __uint_as_float(pp.x & 0xffff0000u) + __uint_as_float(pq.x & 0xffff0000u);
                        v[k][j].z += __uint_as_float(pp.y << 16) + __uint_as_float(pq.y << 16); v[k][j].w += __uint_as_float(pp.y & 0xffff0000u) + __uint_as_float(pq.y & 0xffff0000u); }
                }
            }
        }
#pragma unroll
        for (int k = 0; k < 4; ++k) {
            const int row = row0 + k * GW;
            if (row < NTOK) {
#pragma unroll
                for (int j = 0; j < 4; ++j) ss[k] += (v[k][j].x * v[k][j].x + v[k][j].y * v[k][j].y) + (v[k][j].z * v[k][j].z + v[k][j].w * v[k][j].w);
            }
        }
#pragma unroll
        for (int o = 1; o < 64; o <<= 1) {
#pragma unroll
            for (int k = 0; k < 4; ++k) ss[k] += shx(ss[k], lane, o);
        }
#pragma unroll
        for (int k = 0; k < 4; ++k) {
            const int row = row0 + k * GW;
            if (row < NTOK) {
                const float rstd = rsqrtf(ss[k] * (1.f / 1024.f) + 1e-6f);
                if (which == 2) {
                    float* yo = xo + (size_t)row * 1024;
#pragma unroll
                    for (int j = 0; j < 4; ++j) { const f32x4 gv = ((const f32x4*)g)[lane + 64 * j]; ((f32x4*)yo)[lane + 64 * j] = v[k][j] * rstd * gv; }
                } else {
                    const float* mr = mod + (size_t)(l * 5 + modrow_of(row)) * 6144 + (which == 0 ? 0 : 3072);
#pragma unroll
                    for (int j = 0; j < 4; ++j) { const f32x4 gv = ((const f32x4*)g)[lane + 64 * j]; const f32x4 sh = ((const f32x4*)mr)[lane + 64 * j], sc = ((const f32x4*)(mr + 1024))[lane + 64 * j];
                        const f32x4 hv = v[k][j] * rstd * gv * (sc + 1.f) + sh;
                        u32x2 o; o.x = pk2(hv.x, hv.y); o.y = pk2(hv.z, hv.w);
                        ((u32x2*)(hm + (size_t)row * 1024))[lane + 64 * j] = o;
                        if (!first) ((f32x4*)(xo + (size_t)row * 1024))[lane + 64 * j] = v[k][j]; }
                }
            }
        }
    }
}

constexpr int M1_TILE_BYTES = 66048, M1_WL_BYTES = 9216;
template <int NCOL8, int NROWS> struct StageRegs { static constexpr int NCH = NCOL8 * NROWS, IT = (NCH + 511) / 512; u32x4 v[IT]; };
template <int NCOL8, int NROWS>
DI void stage_load(StageRegs<NCOL8, NROWS>& R, const char* proj, int row_first, int col0, int s0, int s1, int tid) {
    constexpr int NCH = NCOL8 * NROWS, IT = (NCH + 511) / 512;
#pragma unroll
    for (int i = 0; i < IT; ++i) { const int id = tid + 512 * i; const int row = id / NCOL8, cc = id % NCOL8, t = row_first + row;
        R.v[i] = (u32x4){0u, 0u, 0u, 0u};
        if (id < NCH && t >= s0 && t < s1) R.v[i] = *(const u32x4*)(proj + ((size_t)t * NP + col0 + cc * 8) * 2); }
}
template <int NCOL8, int NROWS>
DI void stage_store(const StageRegs<NCOL8, NROWS>& R, LAS unsigned char* tile, int pitchB, int dstB, int tid) {
    constexpr int NCH = NCOL8 * NROWS, IT = (NCH + 511) / 512;
#pragma unroll
    for (int i = 0; i < IT; ++i) { const int id = tid + 512 * i; const int row = id / NCOL8, cc = id % NCOL8;
        if (id < NCH) *(LAS u32x4*)(tile + row * pitchB + dstB + cc * 16) = R.v[i]; }
}

template <int MIX>
DI void m1_gla_wave(const Params& p, int l, int c, int hd, int dir, const LAS unsigned char* tile, LAS unsigned char* wl, const LAS unsigned char* wlp, int lane) {
    constexpr int DK = MIX == 0 ? 64 : 32, NT = DK / 32, PITCH = DK + 8, TP = MIX == 0 ? 1032 : 552;
    const int r = lane & 31, hh = lane >> 5, tok0 = c * 32;
    const LAS bf16_t* T = (const LAS bf16_t*)tile;
    LAS bf16_t* Qt = (LAS bf16_t*)wl; LAS bf16_t* Kt = Qt + 32 * PITCH;
    char* DS = (char*)(p.ws + (MIX == 0 ? WS_DSA : WS_DSB));
    float* ACH = (float*)(p.ws + (MIX == 0 ? WS_ACHA : WS_ACHB));
    char* QH = (char*)(p.ws + (MIX == 0 ? WS_QHA : WS_QHB));
    float* OI = (float*)(p.ws + WS_OI);
    const int tba = 4 * hh * TP, tb = tba + r;
#define TROW(li) ((8 * ((li) >> 2) + ((li) & 3)) * TP)
    const int vcol = MIX == 0 ? 256 + hd * 64 : 256 + hd * 64;
    bf16x8 vf[2][2];
#pragma unroll
    for (int n = 0; n < 2; ++n)
#pragma unroll
        for (int st = 0; st < 2; ++st)
#pragma unroll
            for (int j = 0; j < 8; ++j) vf[n][st][j] = (short)T[tb + TROW(8 * st + j) + vcol + 32 * n];
    const int qcol = MIX == 0 ? hd * 64 : hd * 32;
#pragma unroll 1
    for (int m = 0; m < NT; ++m) {
        float la[16], kk[16];
        if (MIX == 0) {
            const int zcol = (dir == 0 ? 512 : 768) + hd * 64 + 32 * m;
            const float* lbl = p.IN(13);
            float lb = 0.f;
            if (l == 1) { const int ch = hd * 64 + 32 * m + r; const float l0 = lbl[(0 * 2 + dir) * 256 + ch], l1 = lbl[(1 * 2 + dir) * 256 + ch]; lb = rcpf_(1.f + __expf(l0 - l1)); }
#pragma unroll
            for (int li = 0; li < 16; ++li) { const float z = bf2f(T[tb + TROW(li) + zcol]);
                const float e = __expf(-z), sg = rcpf_(1.f + e), omsg = e * sg;
                const float f = lb + (1.f - lb) * sg; kk[li] = (1.f - lb) * omsg; la[li] = __logf(fmaxf(f, 1e-20f)); }
        } else {
            const int kcol = 128 + hd * 32, acol = 512 + dir * 16;
            float w2[16];
#pragma unroll
            for (int rho = 0; rho < 16; ++rho) w2[rho] = p.IN(15)[((l * 2 + dir) * 16 + rho) * 128 + hd * 32 + r];
            const float ba = p.IN(16)[(l * 2 + dir) * 128 + hd * 32 + r];
#pragma unroll
            for (int li = 0; li < 16; ++li) {
                const u32x4 a0 = *(const LAS u32x4*)(T + tba + TROW(li) + acol), a1 = *(const LAS u32x4*)(T + tba + TROW(li) + acol + 8);
                float w = ba;
#pragma unroll
                for (int qd = 0; qd < 4; ++qd) { w += __uint_as_float(a0[qd] << 16) * w2[2 * qd] + __uint_as_float(a0[qd] & 0xffff0000u) * w2[2 * qd + 1];
                    w += __uint_as_float(a1[qd] << 16) * w2[8 + 2 * qd] + __uint_as_float(a1[qd] & 0xffff0000u) * w2[8 + 2 * qd + 1]; }
                const float ls = fminf(w, 0.f) - __logf(1.f + __expf(-fabsf(w)));
                la[li] = ls * (1.f / 16.f);
                kk[li] = bf2f(T[tb + TROW(li) + kcol]);
            }
        }
        float gs[4], pgs[4];
#pragma unroll
        for (int g = 0; g < 4; ++g) { gs[g] = (la[4 * g] + la[4 * g + 1]) + (la[4 * g + 2] + la[4 * g + 3]); pgs[g] = shx(gs[g], lane, 32); }
        float run = 0.f, half = 0.f; float cum[16];
#pragma unroll
        for (int g = 0; g < 4; ++g) { float b = run + (hh ? pgs[g] : 0.f); run += gs[g] + pgs[g]; if (g == 1) half = run;
#pragma unroll
            for (int i = 0; i < 4; ++i) { b += la[4 * g + i]; cum[4 * g + i] = b; } }
        const float total = run;
        const float ref = dir == 0 ? half : total - half;
        float kh[16];
        const unsigned qhb = MIX == 0 ? (unsigned)((tok0 + 4 * hh) * 512 + dir * 256 + hd * 64 + 32 * m + r) * 2u : (unsigned)((tok0 + 4 * hh) * 256 + dir * 128 + hd * 32 + r) * 2u;
#pragma unroll
        for (int li = 0; li < 16; ++li) {
            const float cv = dir == 0 ? cum[li] : (total - cum[li] + la[li]);
            const float eq = __expf(fminf(cv - ref, 80.f)), ek = __expf(fminf(ref - cv, 80.f));
            const int tkl = 8 * (li >> 2) + (li & 3);
            const float qv = bf2f(T[tb + TROW(li) + qcol + 32 * m]) * (MIX == 1 ? 0.17677669529663687f : 1.f);
            Qt[(tkl + 4 * hh) * PITCH + 32 * m + r] = f2bf(qv * eq);
            Kt[(tkl + 4 * hh) * PITCH + 32 * m + r] = f2bf(kk[li] * ek);
            kh[li] = kk[li] * __expf(total - cv);
            const float qh = qv * __expf(cv);
            *(bf16_t*)(QH + (qhb + (unsigned)(tkl * (MIX == 0 ? 512 : 256) * 2))) = f2bf(qh);
        }
        const bf16x8 khat0 = pack8(kh), khat1 = pack8(kh + 8);
        if (hh == 0) ACH[((c * 4 + hd) * 2 + dir) * DK + 32 * m + r] = __expf(total);
#pragma unroll
        for (int n = 0; n < 2; ++n) {
            f32x16 ds = zero16();
            ds = MFMA32(khat0, vf[n][0], ds); ds = MFMA32(khat1, vf[n][1], ds);
            const unsigned dsb = (unsigned)(((c * 4 + hd) * 2 + dir) * (DK * 64) * 2) + (unsigned)((n * (DK / 16) + 2 * m) * 1024 + r * 16 + hh * 8);
#pragma unroll
            for (int g = 0; g < 4; ++g) { u32x2 w; w.x = pk2(ds[4 * g], ds[4 * g + 1]); w.y = pk2(ds[4 * g + 2], ds[4 * g + 3]);
                *(u32x2*)(DS + (dsb + (unsigned)((g >> 1) * 1024 + (g & 1) * 512))) = w; }
        }
    }
#undef TROW
    __builtin_amdgcn_fence(__ATOMIC_RELEASE, "wavefront");
    __builtin_amdgcn_wave_barrier();
    f32x16 pt = zero16();
#pragma unroll
    for (int s = 0; s < DK / 16; ++s) {
        const bf16x8 kfr = *(const LAS bf16x8*)(Kt + r * PITCH + 16 * s + 8 * hh);
        const bf16x8 qfr = *(const LAS bf16x8*)(Qt + r * PITCH + 16 * s + 8 * hh);
        pt = MFMA32(kfr, qfr, pt);
    }
    __builtin_amdgcn_fence(__ATOMIC_RELEASE, "wavefront");
    __builtin_amdgcn_wave_barrier();
    LAS float* ex = (LAS float*)wl; const LAS float* exp_ = (const LAS float*)wlp;
#pragma unroll
    for (int i = 0; i < 16; ++i) { const int srow = crow(i, hh); const bool keep = dir == 0 ? (srow <= r) : (srow >= r); pt[i] = keep ? pt[i] : 0.f; ex[i * 64 + lane] = pt[i]; }
    __syncthreads();
    float ptv[16];
#pragma unroll
    for (int i = 0; i < 16; ++i) ptv[i] = pt[i] + exp_[i * 64 + lane];
    const bf16x8 pf0 = pack8(ptv), pf1 = pack8(ptv + 8);
    float* oi = OI + (size_t)((MIX * 256 + c) * 4 + hd) * 2048;
    {
        f32x16 ot = zero16();
        const bf16x8 va = dir == 0 ? vf[0][0] : vf[1][0], vb = dir == 0 ? vf[0][1] : vf[1][1];
        ot = MFMA32(va, pf0, ot); ot = MFMA32(vb, pf1, ot);
#pragma unroll
        for (int g = 0; g < 4; ++g) *(f32x4*)(oi + ((dir * 4 + g) * 64 + lane) * 4) = (f32x4){ot[4 * g], ot[4 * g + 1], ot[4 * g + 2], ot[4 * g + 3]};
    }
}

DI void m1_rg_wave(const Params& p, int l, int c, int nb, int dir, const LAS unsigned char* tile, int lane) {
    constexpr int TP = 264;
    const int r = lane & 31, hh = lane >> 5, tok0 = c * 32;
    const LAS bf16_t* T = (const LAS bf16_t*)tile;
    float* HL = (float*)(p.ws + WS_HL); float* CP = (float*)(p.ws + WS_CP);
    float* RAGA = (float*)(p.ws + WS_RAGA); float* RAGH = (float*)(p.ws + WS_RAGH);
    const int sgn = dir ? -1 : 1, lbase = dir ? 31 : 0;
    const float* cw = p.IN(18) + (size_t)(l * 2 + dir) * 4 * 256;
    const float* cb = p.IN(19) + (size_t)(l * 2 + dir) * 256;
    bf16x8 af[4];
    const int trow = lbase + sgn * r + 3;
#pragma unroll
    for (int s = 0; s < 4; ++s) {
        const int ch0 = 64 * nb + 16 * s + 8 * hh;
        float xc[8];
        { const f32x4 b0 = *(const f32x4*)(cb + ch0), b1 = *(const f32x4*)(cb + ch0 + 4);
          xc[0] = b0.x; xc[1] = b0.y; xc[2] = b0.z; xc[3] = b0.w; xc[4] = b1.x; xc[5] = b1.y; xc[6] = b1.z; xc[7] = b1.w; }
#pragma unroll
        for (int tap = 0; tap < 4; ++tap) {
            const u32x4 uu = *(const LAS u32x4*)(T + (trow + sgn * (tap - 3)) * TP + ch0);
            const f32x4 w0 = *(const f32x4*)(cw + tap * 256 + ch0), w1 = *(const f32x4*)(cw + tap * 256 + ch0 + 4);
            xc[0] += w0.x * __uint_as_float(uu.x << 16); xc[1] += w0.y * __uint_as_float(uu.x & 0xffff0000u);
            xc[2] += w0.z * __uint_as_float(uu.y << 16); xc[3] += w0.w * __uint_as_float(uu.y & 0xffff0000u);
            xc[4] += w1.x * __uint_as_float(uu.z << 16); xc[5] += w1.y * __uint_as_float(uu.z & 0xffff0000u);
            xc[6] += w1.z * __uint_as_float(uu.w << 16); xc[7] += w1.w * __uint_as_float(uu.w & 0xffff0000u);
        }
        af[s] = pack8(xc);
    }
    const float* wr_ = p.IN(20) + (size_t)((l * 2 + dir) * 4 + nb) * 4096;
    const float* wi_ = p.IN(22) + (size_t)((l * 2 + dir) * 4 + nb) * 4096;
#pragma unroll 1
    for (int n = 0; n < 2; ++n) {
        f32x16 rr = zero16(), ri = zero16();
#pragma unroll
        for (int s = 0; s < 4; ++s) {
            float br_[8], bi_[8];
#pragma unroll
            for (int j = 0; j < 8; ++j) { br_[j] = wr_[(16 * s + 8 * hh + j) * 64 + 32 * n + r]; bi_[j] = wi_[(16 * s + 8 * hh + j) * 64 + 32 * n + r]; }
            rr = MFMA32(af[s], pack8(br_), rr); ri = MFMA32(af[s], pack8(bi_), ri);
        }
        const int ch = 64 * nb + 32 * n + r;
        const float cbv = cb[ch]; float cwv[4];
#pragma unroll
        for (int tap = 0; tap < 4; ++tap) cwv[tap] = cw[tap * 256 + ch];
        const float brv = p.IN(21)[(l * 2 + dir) * 256 + ch], biv = p.IN(23)[(l * 2 + dir) * 256 + ch];
        const float lam = p.IN(24)[(l * 2 + dir) * 256 + ch];
        const float c8 = -8.f * log1pf(__expf(-lam));
        float a[16], bx[16];
#pragma unroll
        for (int li = 0; li < 16; ++li) {
            const int tr = lbase + sgn * (8 * (li >> 2) + 4 * hh + (li & 3)) + 3;
            float xcv = cbv;
#pragma unroll
            for (int tap = 0; tap < 4; ++tap) xcv += cwv[tap] * bf2f(T[(tr + sgn * (tap - 3)) * TP + ch]);
            const float rv = sigmoidf_(rr[li] + brv), iv = sigmoidf_(ri[li] + biv);
            const float loga = c8 * rv;
            a[li] = __expf(loga); bx[li] = __builtin_amdgcn_sqrtf(om_exp(2.f * loga)) * iv * xcv;
        }
        float Ag[4], Bg[4], pA[4], pB[4];
#pragma unroll
        for (int g = 0; g < 4; ++g) { float hl = 0.f, ap = 1.f;
#pragma unroll
            for (int i = 0; i < 4; ++i) { hl = a[4 * g + i] * hl + bx[4 * g + i]; ap *= a[4 * g + i]; }
            Ag[g] = ap; Bg[g] = hl; pA[g] = shx(ap, lane, 32); pB[g] = shx(hl, lane, 32); }
        float Hrun = 0.f, Prun = 1.f;
        const bool first = (hh == 0);
#pragma unroll
        for (int g = 0; g < 4; ++g) {
            const float A0 = first ? Ag[g] : pA[g], B0 = first ? Bg[g] : pB[g];
            const float A1 = first ? pA[g] : Ag[g], B1 = first ? pB[g] : Bg[g];
            float hcur = first ? Hrun : (A0 * Hrun + B0), pcur = first ? Prun : Prun * A0;
            Hrun = A1 * (A0 * Hrun + B0) + B1; Prun = Prun * A0 * A1;
#pragma unroll
            for (int i = 0; i < 4; ++i) { hcur = a[4 * g + i] * hcur + bx[4 * g + i]; pcur *= a[4 * g + i];
                const int tg = tok0 + lbase + sgn * (8 * g + 4 * hh + i);
                HL[((size_t)dir * NTOK + tg) * 256 + ch] = hcur; CP[((size_t)dir * NTOK + tg) * 256 + ch] = pcur; }
        }
        if (hh == 0) { RAGA[(c * 2 + dir) * 256 + ch] = Prun; RAGH[(c * 2 + dir) * 256 + ch] = Hrun; }
    }
}

DI void phase_m1(const Params& p, int l, LAS unsigned char* lds, const int tid, const int stages = 7) {
    const int lane = tid & 63, wid = __builtin_amdgcn_readfirstlane(tid >> 6);
    const char* proj = (const char*)(p.ws + WS_BIG);
    LAS unsigned char* tile = lds;
    LAS unsigned char* wl = lds + M1_TILE_BYTES + wid * M1_WL_BYTES;
    LAS unsigned char* wlp = lds + M1_TILE_BYTES + (wid ^ 1) * M1_WL_BYTES;
    for (int c = blockIdx.x; c < 256; c += gridDim.x) {
        int ln = lane, td = tid; asm volatile("" : "+v"(ln), "+v"(td));
        const int tok0 = c * 32;
        int s0, s1;
        if (c < 128) { s0 = (c >> 3) * 256; s1 = s0 + 256; } else { s0 = 4096 + ((c - 128) >> 5) * 1024; s1 = s0 + 1024; }
        StageRegs<128, 32> ra; StageRegs<64, 32> rb; StageRegs<4, 32> rb2; StageRegs<32, 38> rc;
        if (stages & 1) stage_load(ra, proj, tok0, 0, 0, NTOK, td);
        if (stages & 2) { stage_load(rb, proj, tok0, B_Q, 0, NTOK, td); stage_load(rb2, proj, tok0, B_AF, 0, NTOK, td); }
        if (stages & 4) stage_load(rc, proj, tok0 - 3, C_X, s0, s1, td);
        if (stages & 1) {
        stage_store(ra, tile, 2064, 0, td);
        __syncthreads();
        m1_gla_wave<0>(p, l, c, wid >> 1, wid & 1, tile, wl, wlp, ln);
        __builtin_amdgcn_sched_barrier(0); asm volatile("" : "+v"(ln), "+v"(td));
        }
        if (stages & 2) {
        stage_store(rb, tile, 1104, 0, td); stage_store(rb2, tile, 1104, 1024, td);
        __syncthreads();
        m1_gla_wave<1>(p, l, c, wid >> 1, wid & 1, tile, wl, wlp, ln);
        __builtin_amdgcn_sched_barrier(0); asm volatile("" : "+v"(ln), "+v"(td));
        }
        if (stages & 4) {
        stage_store(rc, tile, 528, 0, td);
        __syncthreads();
        m1_rg_wave(p, l, c, wid >> 1, wid & 1, tile, ln);
        __syncthreads();
        }
    }
}

DI void m2_chain8(const Params& p, int l, int id, const bool dry) {
    const int sq = id / 6144; int rem = id % 6144;
    const int hd = rem / 1536, dir = (rem / 768) & 1; int f = rem % 768;
    const int mix = f < 512 ? 0 : 1; if (mix) f -= 512;
    const int dk = mix == 0 ? 64 : 32, S_ = dk / 16;
    const int lane_ = f & 63, ns = f >> 6, n = ns / S_, s = ns % S_;
    const int d0 = 16 * s + 8 * (lane_ >> 5), e = 32 * n + (lane_ & 31);
    char* DS = (char*)(p.ws + (mix == 0 ? WS_DSA : WS_DSB));
    char* DSO = dry ? (char*)(p.ws + (mix == 0 ? WS_HM : WS_BIG + 56 * MiB)) : DS;
    const float* ACH = (const float*)(p.ws + (mix == 0 ? WS_ACHA : WS_ACHB));
    float zf = 0.f; asm volatile("" : "+v"(zf));
    float S[8];
#pragma unroll
    for (int j = 0; j < 8; ++j) S[j] = zf;
    int c0, N;
    if (sq < 16) { c0 = sq * 8; N = 8; }
    else { c0 = 128 + (sq - 16) * 32; N = 32; const int b = sq - 16;
        const float* s0p = mix == 0 ? p.IN(2) + (size_t)((((b * 2 + l) * 2 + dir) * 4 + hd)) * 4096 : p.IN(3) + (size_t)((((b * 2 + l) * 2 + dir) * 4 + hd)) * 2048;
#pragma unroll
        for (int j = 0; j < 8; ++j) S[j] = s0p[(d0 + j) * 64 + e]; }
    for (int n0 = 0; n0 < N; n0 += 8) {
        u32x4 v[8]; f32x4 a0[8], a1[8];
#pragma unroll
        for (int i = 0; i < 8; ++i) { const int nn = n0 + i, c = c0 + (dir == 0 ? nn : N - 1 - nn); const size_t ui = (size_t)((c * 4 + hd) * 2 + dir);
            v[i] = *(const u32x4*)(DS + ui * (dk * 128) + f * 16); a0[i] = *(const f32x4*)(ACH + ui * dk + d0); a1[i] = *(const f32x4*)(ACH + ui * dk + d0 + 4); }
#pragma unroll
        for (int i = 0; i < 8; ++i) { const int nn = n0 + i, c = c0 + (dir == 0 ? nn : N - 1 - nn); const size_t ui = (size_t)((c * 4 + hd) * 2 + dir);
            u32x4 o; o.x = pk2(S[0], S[1]); o.y = pk2(S[2], S[3]); o.z = pk2(S[4], S[5]); o.w = pk2(S[6], S[7]);
            *(u32x4*)(DSO + ui * (dk * 128) + f * 16) = o;
            S[0] = a0[i].x * S[0] + __uint_as_float(v[i].x << 16); S[1] = a0[i].y * S[1] + __uint_as_float(v[i].x & 0xffff0000u);
            S[2] = a0[i].z * S[2] + __uint_as_float(v[i].y << 16); S[3] = a0[i].w * S[3] + __uint_as_float(v[i].y & 0xffff0000u);
            S[4] = a1[i].x * S[4] + __uint_as_float(v[i].z << 16); S[5] = a1[i].y * S[5] + __uint_as_float(v[i].z & 0xffff0000u);
            S[6] = a1[i].z * S[6] + __uint_as_float(v[i].w << 16); S[7] = a1[i].w * S[7] + __uint_as_float(v[i].w & 0xffff0000u); }
    }
    if (sq < 16) { const int b = sq;
        float* ob = dry ? (float*)(p.ws + 243 * MiB) - OUT_SH : p.out;
        float* op = mix == 0 ? ob + OUT_SH + (size_t)((((b * 2 + l) * 2 + dir) * 4 + hd)) * 4096 : ob + OUT_SG + (size_t)((((b * 2 + l) * 2 + dir) * 4 + hd)) * 2048;
#pragma unroll
        for (int j = 0; j < 8; ++j) op[(d0 + j) * 64 + e] = S[j]; }
}
DI void phase_m2(const Params& p, int l, const int tid, const bool dry = false) {
    const int gt = blockIdx.x * 512 + tid, GT = gridDim.x * 512;
    for (int id = gt; id < 20 * 6144; id += GT) m2_chain8(p, l, 20 * 6144 - 1 - id, dry);
    float* RAGH = (float*)(p.ws + WS_RAGH); const float* RAGA = (const float*)(p.ws + WS_RAGA);
    float* RAGO = dry ? (float*)(p.ws + 250 * MiB) : RAGH; float* SRO = dry ? (float*)(p.ws + 251 * MiB) - OUT_SR : p.out;
    for (int id = GT - 1 - gt; id < 20 * 512; id += GT) {
        const int sq = id / 512, dir = (id >> 8) & 1, ch = id & 255;
        int c0, N; float h = 0.f;
        if (sq < 16) { c0 = sq * 8; N = 8; } else { c0 = 128 + (sq - 16) * 32; N = 32; h = p.IN(4)[((size_t)((sq - 16) * 2 + l) * 2 + dir) * 256 + ch]; }
        for (int n0 = 0; n0 < N; n0 += 8) {
            float v[8], av[8];
#pragma unroll
            for (int i = 0; i < 8; ++i) { const int n = n0 + i, c = c0 + (dir == 0 ? n : N - 1 - n); v[i] = RAGH[(c * 2 + dir) * 256 + ch]; av[i] = RAGA[(c * 2 + dir) * 256 + ch]; }
#pragma unroll
            for (int i = 0; i < 8; ++i) { const int n = n0 + i, c = c0 + (dir == 0 ? n : N - 1 - n); RAGO[(c * 2 + dir) * 256 + ch] = h; h = av[i] * h + v[i]; }
        }
        if (sq < 16) SRO[OUT_SR + ((size_t)(sq * 2 + l) * 2 + dir) * 256 + ch] = h;
    }
}

template <int MIX>
DI void m3_gla_unit(const Params& p, int l, int c, int hd, int lane) {
    constexpr int DK = MIX == 0 ? 64 : 32;
    const int r = lane & 31, hh = lane >> 5, tok0 = c * 32;
    const bf16_t* proj = (const bf16_t*)(p.ws + WS_BIG);
    const bf16_t* DS = (const bf16_t*)(p.ws + (MIX == 0 ? WS_DSA : WS_DSB));
    const bf16_t* QH = (const bf16_t*)(p.ws + (MIX == 0 ? WS_QHA : WS_QHB));
    const float* oi = (const float*)(p.ws + WS_OI) + (size_t)((MIX * 256 + c) * 4 + hd) * 2048;
    bf16_t* mix = (bf16_t*)(p.ws + WS_HM);
    f32x16 acc[2];
#pragma unroll
    for (int n = 0; n < 2; ++n)
#pragma unroll
        for (int g = 0; g < 4; ++g) { const f32x4 v = *(const f32x4*)(oi + ((n * 4 + g) * 64 + lane) * 4); acc[n][4 * g] = v.x; acc[n][4 * g + 1] = v.y; acc[n][4 * g + 2] = v.z; acc[n][4 * g + 3] = v.w; }
#pragma unroll
    for (int dir = 0; dir < 2; ++dir) {
        const bf16_t* sp = DS + (size_t)((c * 4 + hd) * 2 + dir) * (DK * 64);
#pragma unroll
        for (int s = 0; s < DK / 16; ++s) {
            const bf16x8 qf = MIX == 0 ? *(const bf16x8*)(QH + (size_t)(tok0 + r) * 512 + dir * 256 + hd * 64 + 16 * s + 8 * hh)
                                       : *(const bf16x8*)(QH + (size_t)(tok0 + r) * 256 + dir * 128 + hd * 32 + 16 * s + 8 * hh);
#pragma unroll
            for (int n = 0; n < 2; ++n) {
                const bf16x8 sf = *(const bf16x8*)(sp + ((n * (DK / 16) + s) * 64 + lane) * 8);
                acc[n] = MFMA32(sf, qf, acc[n]);
            }
        }
    }
    float ss = 0.f;
#pragma unroll
    for (int n = 0; n < 2; ++n)
#pragma unroll
        for (int i = 0; i < 16; ++i) ss += acc[n][i] * acc[n][i];
    ss += shx(ss, lane, 32);
    const float rstd = rsqrtf(ss * (1.f / 64.f) + 1e-6f);
    const float* gain = (MIX == 0 ? p.IN(14) : p.IN(17)) + l * 256 + hd * 64;
    const bf16_t* grow = proj + (size_t)(tok0 + r) * NP + (MIX == 0 ? A_G : B_G) + hd * 64;
    bf16_t* orow = mix + (size_t)(tok0 + r) * 1024 + MIX * 256 + hd * 64;
#pragma unroll
    for (int n = 0; n < 2; ++n)
#pragma unroll
        for (int g = 0; g < 4; ++g) {
            const int e = 32 * n + 8 * g + 4 * hh;
            const u32x2 gg = *(const u32x2*)(grow + e); const f32x4 gn = *(const f32x4*)(gain + e);
            const float g0 = __uint_as_float(gg.x << 16), g1 = __uint_as_float(gg.x & 0xffff0000u), g2 = __uint_as_float(gg.y << 16), g3 = __uint_as_float(gg.y & 0xffff0000u);
            u32x2 o; o.x = pk2(acc[n][4 * g] * rstd * gn.x * siluf_(g0), acc[n][4 * g + 1] * rstd * gn.y * siluf_(g1));
            o.y = pk2(acc[n][4 * g + 2] * rstd * gn.z * siluf_(g2), acc[n][4 * g + 3] * rstd * gn.w * siluf_(g3));
            *(u32x2*)(orow + e) = o;
        }
}

DI float gelu_tanh(float x) { const float u = 0.7978845608028654f * (x + 0.044715f * x * x * x); const float t = 1.f - 2.f * rcpf_(__expf(2.f * u) + 1.f); return 0.5f * x * (1.f + t); }

DI void phase_m3(const Params& p, int l, const int tid) {
    const int lane = tid & 63, wid = __builtin_amdgcn_readfirstlane(tid >> 6), gw = blockIdx.x * 8 + wid, GW = gridDim.x * 8;
    for (int u = gw; u < 2048; u += GW) {
        const int ty = u & 1, idx = u >> 1, c = idx >> 2, hd = idx & 3;
        int ln = lane; asm volatile("" : "+v"(ln));
        if (ty == 0) m3_gla_unit<0>(p, l, c, hd, ln); else m3_gla_unit<1>(p, l, c, hd, ln);
    }
    const int gt = blockIdx.x * 512 + tid, GT = gridDim.x * 512;
    const bf16_t* proj = (const bf16_t*)(p.ws + WS_BIG);
    bf16_t* mix = (bf16_t*)(p.ws + WS_HM);
    const float* HL = (const float*)(p.ws + WS_HL); const float* CP = (const float*)(p.ws + WS_CP); const float* HIN = (const float*)(p.ws + WS_RAGH);
    for (int id0 = gt; id0 < NTOK * 64; id0 += 4 * GT) {
        f32x4 hf[4], hb[4], cf[4], cb[4], inf_[4], inb[4]; u32x2 gg[4];
#pragma unroll
        for (int k = 0; k < 4; ++k) { const int id = id0 + k * GT; if (id < NTOK * 64) { const int tok = id >> 6, ch = (id & 63) * 4, c = tok >> 5;
            hf[k] = *(const f32x4*)(HL + (size_t)tok * 256 + ch); hb[k] = *(const f32x4*)(HL + ((size_t)NTOK + tok) * 256 + ch);
            cf[k] = *(const f32x4*)(CP + (size_t)tok * 256 + ch); cb[k] = *(const f32x4*)(CP + ((size_t)NTOK + tok) * 256 + ch);
            inf_[k] = *(const f32x4*)(HIN + (c * 2 + 0) * 256 + ch); inb[k] = *(const f32x4*)(HIN + (c * 2 + 1) * 256 + ch);
            gg[k] = *(const u32x2*)(proj + (size_t)tok * NP + C_G + ch); } }
#pragma unroll
        for (int k = 0; k < 4; ++k) { const int id = id0 + k * GT; if (id < NTOK * 64) { const int tok = id >> 6, ch = (id & 63) * 4;
            const f32x4 y = hf[k] + cf[k] * inf_[k] + hb[k] + cb[k] * inb[k];
            u32x2 o; o.x = pk2(y.x * gelu_tanh(__uint_as_float(gg[k].x << 16)), y.y * gelu_tanh(__uint_as_float(gg[k].x & 0xffff0000u)));
            o.y = pk2(y.z * gelu_tanh(__uint_as_float(gg[k].y << 16)), y.w * gelu_tanh(__uint_as_float(gg[k].y & 0xffff0000u)));
            *(u32x2*)(mix + (size_t)tok * 1024 + 512 + ch) = o; } }
    }
    const float* sw = p.IN(25) + l * 3 * 256;
    for (int id0 = gt; id0 < NTOK * 64; id0 += 4 * GT) {
        u32x2 cc[4][3], vv[4][3], bb[4];
#pragma unroll
        for (int k = 0; k < 4; ++k) { const int id = id0 + k * GT; if (id < NTOK * 64) { const int tok = id >> 6, ch = (id & 63) * 4;
            const int seg = tok < 4096 ? 256 : 64, pos = tok & (seg - 1);
#pragma unroll
            for (int j = 0; j < 3; ++j) { const int pp = pos + j - 1; cc[k][j] = (u32x2){0u, 0u}; vv[k][j] = (u32x2){0u, 0u};
                if (pp >= 0 && pp < seg) { const int tt = tok + j - 1; cc[k][j] = *(const u32x2*)(proj + (size_t)tt * NP + D_C + ch); vv[k][j] = *(const u32x2*)(proj + (size_t)tt * NP + D_V + ch); } }
            bb[k] = *(const u32x2*)(proj + (size_t)tok * NP + D_B + ch); } }
#pragma unroll
        for (int k = 0; k < 4; ++k) { const int id = id0 + k * GT; if (id < NTOK * 64) { const int tok = id >> 6, ch = (id & 63) * 4;
            f32x4 y = {0.f, 0.f, 0.f, 0.f};
#pragma unroll
            for (int j = 0; j < 3; ++j) { const f32x4 w = *(const f32x4*)(sw + j * 256 + ch);
                y.x += w.x * __uint_as_float(cc[k][j].x << 16) * __uint_as_float(vv[k][j].x << 16); y.y += w.y * __uint_as_float(cc[k][j].x & 0xffff0000u) * __uint_as_float(vv[k][j].x & 0xffff0000u);
                y.z += w.z * __uint_as_float(cc[k][j].y << 16) * __uint_as_float(vv[k][j].y << 16); y.w += w.w * __uint_as_float(cc[k][j].y & 0xffff0000u) * __uint_as_float(vv[k][j].y & 0xffff0000u); }
            u32x2 o; o.x = pk2(y.x * __uint_as_float(bb[k].x << 16), y.y * __uint_as_float(bb[k].x & 0xffff0000u));
            o.y = pk2(y.z * __uint_as_float(bb[k].y << 16), y.w * __uint_as_float(bb[k].y & 0xffff0000u));
            *(u32x2*)(mix + (size_t)tok * 1024 + 768 + ch) = o; } }
    }
}

__global__ void __launch_bounds__(512, 2) fwd_kernel(Params pin) {
    extern __shared__ __attribute__((aligned(16))) unsigned char lds_raw[];
    LAS unsigned char* lds = (LAS unsigned char*)lds_raw;
    cg::grid_group grid = cg::this_grid();
    const int G = gridDim.x, bid = blockIdx.x;
    volatile LAS unsigned* bst = (volatile LAS unsigned*)(lds + LDS_BYTES - 16);
    if (threadIdx.x < 4) bst[threadIdx.x] = 0u;
    __syncthreads();
    if (bid == 0 && pin.ph_lo == 0) { unsigned* bw = (unsigned*)(pin.ws + WS_BAR); for (int i = threadIdx.x; i < 4096; i += 512) bw[i] = 0u; }
    XcdBarrier xbar; xbar.bar = (unsigned*)(pin.ws + WS_BAR); xbar.x = 0; xbar.st = bst;
    int nsync = 0;
    for (int ph2 = 2 * pin.ph_lo; ph2 < 2 * pin.ph_hi; ++ph2) {
        const int ph = ph2 >> 1;
        if ((ph2 & 1) && !((REPEAT_MASK >> ph) & 1u)) continue;
        size_t zo = 0; asm volatile("" : "+s"(zo));
        int tid = threadIdx.x; asm volatile("" : "+v"(tid));
        Params p = pin; p.ws += zo; p.out += zo; p.zo = zo;
        const float* mod = (const float*)(p.ws + WS_MOD);
        bf16_t* hm = (bf16_t*)(p.ws + WS_HM); bf16_t* big = (bf16_t*)(p.ws + WS_BIG);
        if (ph == 0) phase_p0(p, lds, tid);
        else if (ph == 19) phase_norm(p, 0, 2, tid, (ph2 & 1) != 0);
        else {
            const int l = (ph - 1) / 9, s = (ph - 1) % 9;
            pg8::StaticOrder S;
            if (s == 0) phase_norm(p, l, 0, tid, (ph2 & 1) != 0);
            else if (s == 1) { pg8::Gemm g{hm, (const bf16_t*)(p.ws + WS_WIN) + (size_t)l * NP * 1024, NTOK, NP, 1024, 1024}; S.init(NTOK, NP, G, bid);
                pg8::EpiBf16<0> E{big, NP}; pg8::gemm_phase<pg8::EpiBf16<0>, GEMM_ALIGN, GEMM_SP2>(lds, g, S, E, tid); }
            else if (s == 2) phase_m1(p, l, lds, tid, (ph2 & 1) ? M1_PROBE_STAGES : 7);
            else if (s == 3) phase_m2(p, l, tid, (ph2 & 1) != 0);
            else if (s == 4) phase_m3(p, l, tid);
            else if (s == 5) { pg8::Gemm g{hm, (const bf16_t*)(p.ws + WS_WOUT) + (size_t)l * 1024 * 1024, NTOK, 1024, 512, 1024}; S.init(NTOK, 1024, G, bid, 2);
                pg8::EpiResid E{mod + (size_t)l * 5 * 6144 + 2048, (bf16_t*)(p.ws + ((ph2 & 1) ? WS_HL : WS_DSA))}; pg8::gemm_phase<pg8::EpiResid, false, GEMM_SP2>(lds, g, S, E, tid); }
            else if (s == 6) phase_norm(p, l, 1, tid, (ph2 & 1) != 0);
            else if (s == 7) { pg8::Gemm g{hm, (const bf16_t*)(p.ws + WS_W1) + (size_t)l * 4096 * 1024, NTOK, DFF, 1024, 1024}; S.init(NTOK, DFF, G, bid);
                pg8::EpiBf16<1> E{big, DFF}; pg8::gemm_phase<pg8::EpiBf16<1>, GEMM_ALIGN, GEMM_SP2>(lds, g, S, E, tid); }
            else { pg8::Gemm g{big, (const bf16_t*)(p.ws + WS_W2) + (size_t)l * 1024 * 4096, NTOK, 1024, 2048, DFF}; S.init(NTOK, 1024, G, bid, 2);
                pg8::EpiResid E{mod + (size_t)l * 5 * 6144 + 5120, (bf16_t*)(p.ws + ((ph2 & 1) ? WS_HL : WS_DSA))}; pg8::gemm_phase<pg8::EpiResid, false, GEMM_SP2>(lds, g, S, E, tid); }
        }
        if (ph2 + 2 < 2 * pin.ph_hi || (!(ph2 & 1) && ((REPEAT_MASK >> ph) & 1u))) { if (nsync == 0) { grid.sync(); xbar = xcd_barrier_post((unsigned*)(pin.ws + WS_BAR), bst); } else xcd_barrier(xbar); ++nsync; }
    }
}

extern "C" void kernel_launch(void* const* d_in, const int* in_sizes, int n_in, void* d_out, int out_size, void* d_ws, size_t ws_size, hipStream_t stream) {
    static int grid = 0;
    if (grid == 0) {
        if (n_in != 29 || ws_size < WS_END) { fprintf(stderr, "kernel_launch: unexpected n_in %d / ws %zu\n", n_in, ws_size); grid = -1; return; }
        int dev = 0, cus = 0, per_cu = 0;
        hipGetDevice(&dev); hipDeviceGetAttribute(&cus, hipDeviceAttributeMultiprocessorCount, dev);
        if (hipFuncSetAttribute((const void*)fwd_kernel, hipFuncAttributeMaxDynamicSharedMemorySize, LDS_BYTES) != hipSuccess) { fprintf(stderr, "kernel_launch: hipFuncSetAttribute failed\n"); grid = -1; return; }
        if (hipOccupancyMaxActiveBlocksPerMultiprocessor(&per_cu, (const void*)fwd_kernel, 512, LDS_BYTES) != hipSuccess || per_cu < 1) { fprintf(stderr, "kernel_launch: occupancy query says %d\n", per_cu); per_cu = 1; }
        (void)hipGetLastError();
        grid = cus * 1;
        if (grid <= 0) grid = 256;
    }
    if (grid < 0) return;
    Params p{};
    for (int i = 0; i < 29; ++i) p.in[i] = (const float*)d_in[i];
    p.out = (float*)d_out; p.ws = (unsigned char*)d_ws;
#if MEGA
    p.ph_lo = 0; p.ph_hi = 20;
    void* args[] = {&p};
    hipError_t e = hipLaunchCooperativeKernel((const void*)fwd_kernel, dim3(grid), dim3(512), args, LDS_BYTES, stream);
    if (e != hipSuccess) fprintf(stderr, "cooperative launch failed: %s (grid %d)\n", hipGetErrorString(e), grid);
#else
    for (int ph = 0; ph < 20; ++ph) { p.ph_lo = ph; p.ph_hi = ph + 1; hipLaunchKernelGGL(fwd_kernel, dim3(grid), dim3(512), LDS_BYTES, stream, p); }
#endif
}
```

```cpp
#include <hip/hip_runtime.h>
#include <hip/hip_cooperative_groups.h>
#include <cstdio>
#include <cstdint>
namespace cg = cooperative_groups;

#ifndef MEGA
#define MEGA 1
#endif
#ifndef M1_PROBE_STAGES
#define M1_PROBE_STAGES 7
#endif
#ifndef GEMM_SP2
#define GEMM_SP2 true
#endif
#ifndef GEMM_ALIGN
#define GEMM_ALIGN true
#endif
#ifndef REPEAT_MASK
#define REPEAT_MASK 0u
#endif

#define DI __device__ __forceinline__
#define LAS __attribute__((address_space(3)))
typedef unsigned short bf16_t;
typedef short bf16x8 __attribute__((ext_vector_type(8)));
typedef float f32x4 __attribute__((ext_vector_type(4)));
typedef float f32x16 __attribute__((ext_vector_type(16)));
typedef unsigned u32x4 __attribute__((ext_vector_type(4)));
typedef unsigned u32x2 __attribute__((ext_vector_type(2)));
typedef __bf16 bf16x2_t __attribute__((ext_vector_type(2)));
typedef float f32x2_t __attribute__((ext_vector_type(2)));

constexpr int NTOK = 8192, DM = 1024, NP = 3584, DFF = 4096;
constexpr int A_Q = 0, A_I = 256, A_FF = 512, A_FB = 768, A_G = 1024, B_Q = 1280, B_K = 1408, B_V = 1536, B_G = 1792, B_AF = 2048, B_AB = 2064,
              C_X = 2080, C_G = 2336, D_B = 2592, D_C = 2848, D_V = 3104, PW = 3360;
constexpr size_t MiB = 1u << 20;
constexpr size_t WS_WIN = 0, WS_WOUT = 14 * MiB, WS_W1 = 18 * MiB, WS_W2 = 34 * MiB, WS_MOD = 50 * MiB, WS_HM = 51 * MiB, WS_BIG = 67 * MiB,
                 WS_OI = 131 * MiB, WS_DSA = 147 * MiB, WS_DSB = 179 * MiB, WS_QHA = 195 * MiB, WS_QHB = 203 * MiB, WS_HL = 207 * MiB, WS_CP = 223 * MiB,
                 WS_ACHA = 239 * MiB, WS_ACHB = 239 * MiB + 512 * 1024, WS_RAGA = 240 * MiB, WS_RAGH = 240 * MiB + 512 * 1024, WS_BAR = 241 * MiB, WS_END = 242 * MiB;
constexpr int OUT_SH = 8388608, OUT_SG = OUT_SH + 1048576, OUT_SR = OUT_SG + 524288;
constexpr int LDS_BYTES = 147456;

struct Params { const float* in[29]; float* out; unsigned char* ws; size_t zo; int ph_lo, ph_hi;
    DI const float* IN(int i) const { return in[i] + zo; } };

DI float bf2f(bf16_t u) { return __uint_as_float(((unsigned)u) << 16); }
DI unsigned pk2(float lo, float hi) { f32x2_t v = {lo, hi}; bf16x2_t b = __builtin_convertvector(v, bf16x2_t); return __builtin_bit_cast(unsigned, b); }
DI bf16_t f2bf(float x) { return (bf16_t)(pk2(x, 0.f) & 0xffffu); }
DI bf16x8 pack8(const float* v) { u32x4 p; p.x = pk2(v[0], v[1]); p.y = pk2(v[2], v[3]); p.z = pk2(v[4], v[5]); p.w = pk2(v[6], v[7]); return __builtin_bit_cast(bf16x8, p); }
DI float rcpf_(float x) { return __builtin_amdgcn_rcpf(x); }
DI float sigmoidf_(float x) { return rcpf_(1.f + __expf(-x)); }
DI float siluf_(float x) { return x * rcpf_(1.f + __expf(-x)); }
DI float om_exp(float x) { const float s = -x * (1.f + x * 0.5f * (1.f + x * (1.f / 3.f) * (1.f + x * 0.25f * (1.f + x * 0.2f * (1.f + x * (1.f / 6.f)))))); return x > -0.3f ? s : 1.f - __expf(x); }
DI int crow(int reg, int h) { return (reg & 3) + 8 * (reg >> 2) + 4 * h; }
#define MFMA32(a, b, c) __builtin_amdgcn_mfma_f32_32x32x16_bf16((a), (b), (c), 0, 0, 0)
DI f32x16 zero16() { f32x16 z; for (int i = 0; i < 16; ++i) z[i] = 0.f; return z; }
DI float shx(float v, int lane, int m) { return __int_as_float(__builtin_amdgcn_ds_bpermute((lane ^ m) << 2, __float_as_int(v))); }
DI int modrow_of(int row) { return row < 4096 ? 0 : 1 + ((row - 4096) >> 10); }


#define XB_TMO      128
#define XB_XCNT(j)  (256  + 64 * (j))
#define XB_XSUB(j)  (1280 + 64 * (j))
#define XB_XGEN(j)  (2304 + 64 * (j))
#define XB_TOP      3328
#define XB_TOPGEN   3392
#define XCD_BAR_WORDS 3456
#define XB_SPIN_CAP (1u << 18)
DI unsigned xb_ld(unsigned* p)              { return __hip_atomic_load(p, __ATOMIC_RELAXED, __HIP_MEMORY_SCOPE_AGENT); }
DI unsigned xb_add(unsigned* p, unsigned v) { return __hip_atomic_fetch_add(p, v, __ATOMIC_RELAXED, __HIP_MEMORY_SCOPE_AGENT); }
DI unsigned xb_xcc_id() { return (unsigned)__builtin_amdgcn_s_getreg((3 << 11) | 20) & 0xFu; }
#define XB_SPIN(cond, bar) do { unsigned _sp = 0; while (cond) { __builtin_amdgcn_s_sleep(1); \
    if ((++_sp & 255u) == 0u) { if (xb_ld(&(bar)[XB_TMO])) break; if (_sp > XB_SPIN_CAP) { atomicAdd(&(bar)[XB_TMO], 1u); break; } } } } while (0)
struct XcdBarrier { unsigned* bar; unsigned x; volatile LAS unsigned* st; };
DI XcdBarrier xcd_barrier_post(unsigned* bar, volatile LAS unsigned* st) {
    XcdBarrier b; b.bar = bar; b.x = xb_xcc_id(); b.st = st;
    if (threadIdx.x == 0) (void)xb_add(&bar[XB_XCNT(b.x)], 1u);
    return b;
}
DI void xcd_barrier_complete(unsigned* bar, unsigned x, unsigned& nloc, unsigned& nx) {
    const unsigned G = gridDim.x * gridDim.y * gridDim.z;
    unsigned sum, cnt, mine, sp = 0u;
    for (;;) {
        sum = 0u; cnt = 0u; mine = 0u;
#pragma unroll
        for (unsigned j = 0; j < 16; ++j) { const unsigned c = xb_ld(&bar[XB_XCNT(j)]); sum += c; cnt += (c > 0u) ? 1u : 0u; mine = (j == x) ? c : mine; }
        if (sum == G) break;
        __builtin_amdgcn_s_sleep(1);
        if ((++sp & 255u) == 0u) { if (xb_ld(&bar[XB_TMO])) break; if (sp > XB_SPIN_CAP) { atomicAdd(&bar[XB_TMO], 1u); break; } }
    }
    nloc = mine > 0u ? mine : 1u; nx = cnt > 0u ? cnt : 1u;
}
DI void xcd_barrier(const XcdBarrier& b) {
    asm volatile("s_waitcnt vmcnt(0)" ::: "memory");
    __syncthreads();
    if (threadIdx.x == 0) {
        unsigned* bar = b.bar;
        __builtin_amdgcn_s_waitcnt(0);
        unsigned nloc = b.st[0], nx = b.st[1];
        if (nloc == 0u) { xcd_barrier_complete(bar, b.x, nloc, nx); b.st[0] = nloc; b.st[1] = nx; }
        const unsigned old = xb_add(&bar[XB_XSUB(b.x)], 1u);
        const unsigned gen = old / nloc;
        if (old + 1u == (gen + 1u) * nloc) {
            __builtin_amdgcn_fence(__ATOMIC_RELEASE, "agent");
            asm volatile("s_waitcnt vmcnt(0)" ::: "memory");
            const unsigned og = xb_add(&bar[XB_TOP], 1u);
            const unsigned tg = og / nx;
            if (og + 1u == (tg + 1u) * nx) xb_add(&bar[XB_TOPGEN], 1u);
            else XB_SPIN(xb_ld(&bar[XB_TOPGEN]) == tg, bar);
            __builtin_amdgcn_fence(__ATOMIC_ACQUIRE, "agent");
            xb_add(&bar[XB_XGEN(b.x)], 1u);
            asm volatile("s_waitcnt vmcnt(0)" ::: "memory");
        } else {
            XB_SPIN(xb_ld(&bar[XB_XGEN(b.x)]) == gen, bar);
            __builtin_amdgcn_fence(__ATOMIC_ACQUIRE, "agent");
            asm volatile("s_waitcnt vmcnt(0)" ::: "memory");
        }
    }
    __syncthreads();
}

namespace pg8 {
constexpr int BM = 256, BK = 64, HALF = 128, HTB = HALF * BK * 2, NXCD = 8, WGM = 8;
__host__ __device__ __forceinline__ int lds_byte(int r, int c) { const int st = (r >> 4) * 2 + (c >> 5), rr = r & 15, cc = c & 31, ob = rr * 64 + cc * 2; return st * 1024 + (ob ^ (((ob >> 9) & 1) << 5)); }
__host__ __device__ __forceinline__ void stage_rc(int b, int& R, int& C) { const int st = b / 1024, sb = b % 1024, swz = sb ^ (((sb >> 9) & 1) << 5); R = (st >> 1) * 16 + swz / 64; C = (st & 1) * 32 + (swz % 64) / 2; }
__host__ __device__ __forceinline__ int perm32(int rho) { const int n = rho >> 4, i = rho & 15; return 8 * (i >> 2) + 4 * n + (i & 3); }
struct Unit { int pm, pn, pk; };
struct Gemm { const bf16_t* A; const bf16_t* Bt; int M, N, K, lda; };
struct StaticOrder {
    int nM, nN, nwg, G, c, KS;
    __host__ __device__ void init(int M, int N, int G_, int c_, int KS_ = 1) { KS = KS_; nM = M / BM; nN = (N / BM) * KS; nwg = nM * nN; G = G_; c = c_; }
    __host__ __device__ bool next(int i, Unit& u) const {
        const long L = (long)i * G + c; if (L >= nwg) return false;
        int wgid = (int)L; { const int q = nwg / NXCD, r = nwg % NXCD, xcd = wgid % NXCD, off = wgid / NXCD; wgid = (xcd < r ? xcd * (q + 1) : r * (q + 1) + (xcd - r) * q) + off; }
        const int nig = WGM * nN, gid = wgid / nig, fm = gid * WGM, gsz = (nM - fm) < WGM ? (nM - fm) : WGM;
        u.pm = fm + ((wgid % nig) % gsz); const int pv = (wgid % nig) / gsz; u.pn = pv / KS; u.pk = pv % KS; return true;
    }
};
template <class Epi, bool SP2 = false>
__device__ __forceinline__ void gemm_phase(LAS unsigned char* lds, const Gemm g, const StaticOrder& S, const Epi& E, const int tid, const bool ALIGN_EPI) {
    const int wid = __builtin_amdgcn_readfirstlane(tid >> 6), lane = tid & 63, wr = wid >> 2, wc = wid & 3, fr = lane & 15, fq = lane >> 4;
    const int K = g.lda, nt = g.K / BK;
    unsigned voffA[2], voffB[2];
#pragma unroll
    for (int i = 0; i < 2; ++i) { int R, C; stage_rc(tid * 16 + i * 8192, R, C); const int Rb = (R & ~31) + perm32(R & 31);
        voffA[i] = (unsigned)(R * K + C) * 2u; voffB[i] = (unsigned)(Rb * K + C) * 2u; }
    const size_t kstep = (size_t)(BK * 2);
    const size_t hstep = (size_t)HALF * K * 2;
    const size_t tstep = 2 * hstep;
    const unsigned ldsw = (unsigned)wid * 1024u;
    const int aoff = lds_byte(wr * 64 + fr, fq * 8), boff = lds_byte(wc * 32 + fr, fq * 8);
#define PG8_SA(b, h) (((b) * 2 + (h)) * HTB)
#define PG8_SB(b, h) ((4 + (b) * 2 + (h)) * HTB)
#define PG8_STAGE(bufoff, gbase, voff) do { _Pragma("unroll") for (int _i = 0; _i < 2; ++_i) \
        __builtin_amdgcn_global_load_lds((const unsigned*)((const char*)(gbase) + (voff)[_i]), (LAS unsigned*)(lds + (bufoff) + ldsw + _i * 8192), 16, 0, 0); } while (0)
#define PG8_LDA(dst, b, h) do { _Pragma("unroll") for (int m = 0; m < 4; ++m) _Pragma("unroll") for (int k = 0; k < 2; ++k) dst[m][k] = *(const LAS bf16x8*)(lds + PG8_SA(b, h) + aoff + m * 2048 + k * 1024); } while (0)
#define PG8_LDB(dst, b, h) do { _Pragma("unroll") for (int n = 0; n < 2; ++n) _Pragma("unroll") for (int k = 0; k < 2; ++k) dst[n][k] = *(const LAS bf16x8*)(lds + PG8_SB(b, h) + boff + n * 2048 + k * 1024); } while (0)
#define PG8_MMA(ai, bj, At, Bt) do { __builtin_amdgcn_s_setprio(1); _Pragma("unroll") for (int m = 0; m < 4; ++m) _Pragma("unroll") for (int n = 0; n < 2; ++n) _Pragma("unroll") for (int k = 0; k < 2; ++k) \
        acc[ai][bj][m][n] = __builtin_amdgcn_mfma_f32_16x16x32_bf16(Bt[n][k], At[m][k], acc[ai][bj][m][n], 0, 0, 0); __builtin_amdgcn_s_setprio(0); } while (0)
#define PG8_WAIT_V(n) asm volatile("s_waitcnt vmcnt(" #n ")" ::: "memory")
#define PG8_WAIT_L(n) asm volatile("s_waitcnt lgkmcnt(" #n ")" ::: "memory")
#define PG8_BAR __builtin_amdgcn_s_barrier()
#define PG8_SCHED __builtin_amdgcn_sched_barrier(0)
    Unit cur, nxt; int ui = 0;
    if (!S.next(0, cur)) return;
    f32x4 acc[2][2][4][2];
#pragma unroll
    for (int a = 0; a < 2; ++a)
#pragma unroll
        for (int b = 0; b < 2; ++b)
#pragma unroll
            for (int m = 0; m < 4; ++m)
#pragma unroll
                for (int n = 0; n < 2; ++n) acc[a][b][m][n] = (f32x4){0.f, 0.f, 0.f, 0.f};
    bf16x8 At[4][2], B0[2][2], B1[2][2];
    const size_t ksplit = (size_t)g.K * 2;
    const char* cA = (const char*)g.A + (size_t)cur.pm * tstep + cur.pk * ksplit; const char* cB = (const char*)g.Bt + (size_t)cur.pn * tstep + cur.pk * ksplit;
    if constexpr (SP2) {
        PG8_STAGE(PG8_SB(0, 0), cB, voffB); PG8_STAGE(PG8_SB(0, 1), cB + hstep, voffB); PG8_STAGE(PG8_SA(0, 0), cA, voffA); PG8_STAGE(PG8_SA(0, 1), cA + hstep, voffA);
        if (wr == 1) PG8_BAR;
        PG8_WAIT_V(2); PG8_BAR;
        PG8_STAGE(PG8_SB(1, 0), cB + kstep, voffB); PG8_STAGE(PG8_SA(1, 0), cA + kstep, voffA); PG8_STAGE(PG8_SB(1, 1), cB + hstep + kstep, voffB);
        PG8_WAIT_V(6); PG8_BAR;
    } else {
        PG8_STAGE(PG8_SB(0, 0), cB, voffB); PG8_STAGE(PG8_SA(0, 0), cA, voffA); PG8_STAGE(PG8_SB(0, 1), cB + hstep, voffB); PG8_STAGE(PG8_SA(0, 1), cA + hstep, voffA);
        if (wr == 1) PG8_BAR;
        PG8_WAIT_V(4); PG8_BAR;
        PG8_STAGE(PG8_SB(1, 0), cB + kstep, voffB); PG8_STAGE(PG8_SA(1, 0), cA + kstep, voffA); PG8_STAGE(PG8_SB(1, 1), cB + hstep + kstep, voffB);
        PG8_WAIT_V(6); PG8_BAR;
    }
    for (;;) {
        const bool has_next = S.next(ui + 1, nxt);
        const char* nA = has_next ? (const char*)g.A + (size_t)nxt.pm * tstep + nxt.pk * ksplit : cA; const char* nB = has_next ? (const char*)g.Bt + (size_t)nxt.pn * tstep + nxt.pk * ksplit : cB;
        for (int t = 0; t < nt; t += 2) {
            const bool last = (t == nt - 2);
            const char* a1 = cA + (size_t)(t + 1) * kstep;
            const char* a2 = last ? nA : cA + (size_t)(t + 2) * kstep; const char* b2 = last ? nB : cB + (size_t)(t + 2) * kstep;
            const char* a3 = a2 + kstep; const char* b3 = b2 + kstep;
            if constexpr (SP2) {
            PG8_LDB(B0, 0, 0); PG8_LDB(B1, 0, 1); PG8_SCHED; PG8_LDA(At, 0, 0); PG8_STAGE(PG8_SA(1, 1), a1 + hstep, voffA);
            PG8_WAIT_V(8); PG8_WAIT_L(0); PG8_BAR; PG8_MMA(0, 0, At, B0); PG8_MMA(0, 1, At, B1); PG8_BAR; PG8_SCHED;
            PG8_LDA(At, 0, 1); PG8_STAGE(PG8_SB(0, 0), b2, voffB); PG8_STAGE(PG8_SB(0, 1), b2 + hstep, voffB); PG8_STAGE(PG8_SA(0, 0), a2, voffA);
            PG8_WAIT_V(8); PG8_WAIT_L(0); PG8_BAR; PG8_MMA(1, 0, At, B0); PG8_MMA(1, 1, At, B1); PG8_BAR; PG8_SCHED;
            PG8_LDB(B0, 1, 0); PG8_LDB(B1, 1, 1); PG8_SCHED; PG8_LDA(At, 1, 0); PG8_STAGE(PG8_SA(0, 1), a2 + hstep, voffA);
            PG8_WAIT_V(8); PG8_WAIT_L(0); PG8_BAR; PG8_MMA(0, 0, At, B0); PG8_MMA(0, 1, At, B1); PG8_BAR; PG8_SCHED;
            PG8_LDA(At, 1, 1); PG8_STAGE(PG8_SB(1, 0), b3, voffB); PG8_STAGE(PG8_SB(1, 1), b3 + hstep, voffB); PG8_STAGE(PG8_SA(1, 0), a3, voffA);
            PG8_WAIT_V(8); PG8_WAIT_L(0); PG8_BAR; PG8_MMA(1, 0, At, B0); PG8_MMA(1, 1, At, B1); PG8_BAR; PG8_SCHED;
            } else {
            PG8_LDB(B0, 0, 0); PG8_SCHED; PG8_LDA(At, 0, 0); PG8_STAGE(PG8_SA(1, 1), a1 + hstep, voffA);
            PG8_WAIT_L(8); PG8_BAR; PG8_WAIT_L(0); PG8_MMA(0, 0, At, B0); PG8_BAR; PG8_SCHED;
            PG8_LDB(B1, 0, 1); PG8_STAGE(PG8_SB(0, 0), b2, voffB);
            PG8_BAR; PG8_WAIT_L(0); PG8_MMA(0, 1, At, B1); PG8_BAR;
            PG8_LDA(At, 0, 1); PG8_STAGE(PG8_SA(0, 0), a2, voffA);
            PG8_BAR; PG8_WAIT_L(0); PG8_MMA(1, 0, At, B0); PG8_BAR; PG8_SCHED;
            PG8_STAGE(PG8_SB(0, 1), b2 + hstep, voffB);
            PG8_WAIT_V(6); PG8_BAR; PG8_MMA(1, 1, At, B1); PG8_BAR;
            PG8_LDB(B0, 1, 0); PG8_SCHED; PG8_LDA(At, 1, 0); PG8_STAGE(PG8_SA(0, 1), a2 + hstep, voffA);
            PG8_WAIT_L(8); PG8_BAR; PG8_WAIT_L(0); PG8_MMA(0, 0, At, B0); PG8_BAR; PG8_SCHED;
            PG8_LDB(B1, 1, 1); PG8_STAGE(PG8_SB(1, 0), b3, voffB);
            PG8_BAR; PG8_WAIT_L(0); PG8_MMA(0, 1, At, B1); PG8_BAR;
            PG8_LDA(At, 1, 1); PG8_STAGE(PG8_SA(1, 0), a3, voffA);
            PG8_BAR; PG8_WAIT_L(0); PG8_MMA(1, 0, At, B0); PG8_BAR; PG8_SCHED;
            PG8_STAGE(PG8_SB(1, 1), b3 + hstep, voffB);
            PG8_WAIT_V(6); PG8_BAR; PG8_MMA(1, 1, At, B1); PG8_BAR;
            }
        }
        if (ALIGN_EPI) { if (wr == 0) PG8_BAR; }
        E(acc, cur, wr, wc, fr, fq);
        if (!has_next) break;
#pragma unroll
        for (int a = 0; a < 2; ++a)
#pragma unroll
            for (int b = 0; b < 2; ++b)
#pragma unroll
                for (int m = 0; m < 4; ++m)
#pragma unroll
                    for (int n = 0; n < 2; ++n) acc[a][b][m][n] = (f32x4){0.f, 0.f, 0.f, 0.f};
        cur = nxt; cA = nA; cB = nB; ++ui;
        if (ALIGN_EPI) { if (wr == 1) PG8_BAR; }
    }
    PG8_WAIT_V(0);
    if (!ALIGN_EPI) { if (wr == 0) PG8_BAR; }
    PG8_BAR;
#undef PG8_SA
#undef PG8_SB
#undef PG8_STAGE
#undef PG8_LDA
#undef PG8_LDB
#undef PG8_MMA
#undef PG8_WAIT_V
#undef PG8_WAIT_L
#undef PG8_BAR
#undef PG8_SCHED
}

template <int ACT> struct EpiBf16 {
    bf16_t* O; int ldc;
    __device__ __forceinline__ void operator()(const f32x4 (&acc)[2][2][4][2], const Unit& u, int wr, int wc, int fr, int fq) const {
        const int row0 = u.pm * BM + wr * 64 + fr, col0 = u.pn * BM + wc * 32 + 8 * fq;
#pragma unroll
        for (int ai = 0; ai < 2; ++ai)
#pragma unroll
            for (int m = 0; m < 4; ++m) { bf16_t* rowp = O + (size_t)(row0 + ai * HALF + m * 16) * ldc + col0;
#pragma unroll
                for (int bj = 0; bj < 2; ++bj) { f32x4 v0 = acc[ai][bj][m][0], v1 = acc[ai][bj][m][1];
                    if (ACT == 1) {
#pragma unroll
                        for (int q = 0; q < 4; ++q) { float a = fmaxf(v0[q], 0.f), b = fmaxf(v1[q], 0.f); v0[q] = a * a; v1[q] = b * b; } }
                    u32x4 w; w.x = pk2(v0[0], v0[1]); w.y = pk2(v0[2], v0[3]); w.z = pk2(v1[0], v1[1]); w.w = pk2(v1[2], v1[3]);
                    *(u32x4*)(rowp + bj * HALF) = w; } }
    }
};
struct EpiResid {
    const float* gate; bf16_t* pb;
    __device__ __forceinline__ void operator()(const f32x4 (&acc)[2][2][4][2], const Unit& u, int wr, int wc, int fr, int fq) const {
        const int rowb = u.pm * BM; const float* gp = gate + modrow_of(rowb) * 6144;
        const int row0 = rowb + wr * 64 + fr, col0 = u.pn * BM + wc * 32 + 8 * fq;
        bf16_t* pbk = pb + (size_t)u.pk * ((size_t)NTOK * 1024);
        f32x4 gv[2][2];
#pragma unroll
        for (int bj = 0; bj < 2; ++bj)
#pragma unroll
            for (int n = 0; n < 2; ++n) gv[bj][n] = *(const f32x4*)(gp + col0 + bj * HALF + 4 * n);
#pragma unroll
        for (int ai = 0; ai < 2; ++ai)
#pragma unroll
            for (int m = 0; m < 4; ++m) { const size_t ro = (size_t)(row0 + ai * HALF + m * 16) * 1024 + col0;
#pragma unroll
                for (int bj = 0; bj < 2; ++bj) { const f32x4 v0 = gv[bj][0] * acc[ai][bj][m][0], v1 = gv[bj][1] * acc[ai][bj][m][1];
                    u32x4 w; w.x = pk2(v0[0], v0[1]); w.y = pk2(v0[2], v0[3]); w.z = pk2(v1[0], v1[1]); w.w = pk2(v1[2], v1[3]);
                    *(u32x4*)(pbk + ro + bj * HALF) = w; } }
    }
};
struct EpiAny {
    int mode; bf16_t* O; int ldc; const float* gate;
    __device__ __forceinline__ void operator()(const f32x4 (&acc)[2][2][4][2], const Unit& u, int wr, int wc, int fr, int fq) const {
        const int rowb = u.pm * BM, row0 = rowb + wr * 64 + fr, col0 = u.pn * BM + wc * 32 + 8 * fq;
        bf16_t* base = O;
        f32x4 gv[2][2];
#pragma unroll
        for (int bj = 0; bj < 2; ++bj)
#pragma unroll
            for (int n = 0; n < 2; ++n) gv[bj][n] = (f32x4){1.f, 1.f, 1.f, 1.f};
        if (mode == 2) {
            const float* gp = gate + modrow_of(rowb) * 6144; base = O + (size_t)u.pk * ((size_t)NTOK * 1024);
#pragma unroll
            for (int bj = 0; bj < 2; ++bj)
#pragma unroll
                for (int n = 0; n < 2; ++n) gv[bj][n] = *(const f32x4*)(gp + col0 + bj * HALF + 4 * n);
        }
#pragma unroll
        for (int ai = 0; ai < 2; ++ai)
#pragma unroll
            for (int m = 0; m < 4; ++m) { bf16_t* rowp = base + (size_t)(row0 + ai * HALF + m * 16) * ldc + col0;
#pragma unroll
                for (int bj = 0; bj < 2; ++bj) { f32x4 v0 = acc[ai][bj][m][0], v1 = acc[ai][bj][m][1];
                    if (mode == 1) {
#pragma unroll
                        for (int q = 0; q < 4; ++q) { const float a = fmaxf(v0[q], 0.f), b = fmaxf(v1[q], 0.f); v0[q] = a * a; v1[q] = b * b; } }
                    v0 = v0 * gv[bj][0]; v1 = v1 * gv[bj][1];
                    u32x4 w; w.x = pk2(v0[0], v0[1]); w.y = pk2(v0[2], v0[3]); w.z = pk2(v1[0], v1[1]); w.w = pk2(v1[2], v1[3]);
                    *(u32x4*)(rowp + bj * HALF) = w; } }
    }
};
}

DI void transpose_unit(const float* __restrict__ W, int K, int N, int Npad, bf16_t* WT, int unit, int lane, LAS unsigned char* scr) {
    const int nblk = Npad / 64, kb = unit / nblk, nb = unit % nblk, n = nb * 64 + lane, k0 = kb * 64;
    u32x4 o[8];
    if (n < N) {
        float v[64];
#pragma unroll
        for (int kk = 0; kk < 64; ++kk) v[kk] = W[(size_t)(k0 + kk) * N + n];
#pragma unroll
        for (int q = 0; q < 8; ++q) { o[q].x = pk2(v[8 * q], v[8 * q + 1]); o[q].y = pk2(v[8 * q + 2], v[8 * q + 3]); o[q].z = pk2(v[8 * q + 4], v[8 * q + 5]); o[q].w = pk2(v[8 * q + 6], v[8 * q + 7]); }
    } else {
#pragma unroll
        for (int q = 0; q < 8; ++q) o[q] = (u32x4){0u, 0u, 0u, 0u};
    }
#pragma unroll
    for (int q = 0; q < 8; ++q) *(LAS u32x4*)(scr + lane * 144 + q * 16) = o[q];
    __builtin_amdgcn_fence(__ATOMIC_RELEASE, "wavefront"); __builtin_amdgcn_wave_barrier();
    const int ch = lane & 7, rb = lane >> 3;
#pragma unroll
    for (int j = 0; j < 8; ++j) { const int row = rb + 8 * j; const u32x4 w = *(const LAS u32x4*)(scr + row * 144 + ch * 16);
        *(u32x4*)(WT + (size_t)(nb * 64 + row) * K + k0 + ch * 8) = w; }
    __builtin_amdgcn_fence(__ATOMIC_RELEASE, "wavefront"); __builtin_amdgcn_wave_barrier();
}

DI void phase_p0(const Params& p, LAS unsigned char* lds, const int tid) {
    const int lane = tid & 63, wid = tid >> 6, G = gridDim.x, bid = blockIdx.x;
    const float* c = p.IN(5); const float* c_ctx = p.IN(6); const float* ada_w = p.IN(9); const float* ada_b = p.IN(10);
    float* mod = (float*)(p.ws + WS_MOD);
    LAS float* st = (LAS float*)lds + wid * 640;
    LAS float* red = (LAS float*)(lds + 32768);
    for (int bu = bid; bu < 192; bu += G) {
        const int l = bu / 96, cgp = bu % 96, col = cgp * 64 + lane;
        for (int i = lane; i < 640; i += 64) { const int row = i / 128, k = wid * 128 + (i % 128); const float cv = row == 0 ? c_ctx[k] : c[(row - 1) * 1024 + k]; st[i] = siluf_(cv); }
        __syncthreads();
        float acc[5] = {0.f, 0.f, 0.f, 0.f, 0.f};
        const float* W = ada_w + (size_t)l * 1024 * 6144 + (size_t)(wid * 128) * 6144 + col;
#pragma unroll 16
        for (int kk = 0; kk < 128; ++kk) { const float w = W[(size_t)kk * 6144];
#pragma unroll
            for (int row = 0; row < 5; ++row) acc[row] += st[row * 128 + kk] * w; }
#pragma unroll
        for (int row = 0; row < 5; ++row) red[(wid * 5 + row) * 64 + lane] = acc[row];
        __syncthreads();
        if (tid < 320) { const int row = tid / 64, ln = tid % 64; float s = 0.f;
#pragma unroll
            for (int w = 0; w < 8; ++w) s += red[(w * 5 + row) * 64 + ln];
            const int cc = cgp * 64 + ln; mod[(l * 5 + row) * 6144 + cc] = s + ada_b[l * 6144 + cc]; }
        __syncthreads();
    }
    const int gw = bid * 8 + wid, GW = G * 8;
    LAS unsigned char* scr = lds + 65536 + wid * 9216;
    for (int u = gw; u < 6400; u += GW) {
        const int l = u / 3200; int r = u % 3200;
        if (r < 896) transpose_unit(p.IN(11) + (size_t)l * 1024 * PW, 1024, PW, NP, (bf16_t*)(p.ws + WS_WIN) + (size_t)l * NP * 1024, r, lane, scr);
        else if (r < 1152) transpose_unit(p.IN(12) + (size_t)l * 1024 * 1024, 1024, 1024, 1024, (bf16_t*)(p.ws + WS_WOUT) + (size_t)l * 1024 * 1024, r - 896, lane, scr);
        else if (r < 2176) transpose_unit(p.IN(26) + (size_t)l * 1024 * 4096, 1024, 4096, 4096, (bf16_t*)(p.ws + WS_W1) + (size_t)l * 4096 * 1024, r - 1152, lane, scr);
        else transpose_unit(p.IN(27) + (size_t)l * 4096 * 1024, 4096, 1024, 1024, (bf16_t*)(p.ws + WS_W2) + (size_t)l * 1024 * 4096, r - 2176, lane, scr);
    }
}

DI void phase_norm(const Params& p, int l, int which, const int tid, const bool dry = false) {
    const int lane = tid & 63, wid = tid >> 6, gw = blockIdx.x * 8 + wid, GW = gridDim.x * 8;
    const float* mod = (const float*)(p.ws + WS_MOD);
    bf16_t* hm = (bf16_t*)(p.ws + (dry ? WS_OI : WS_HM));
    float* xo = dry ? (float*)(p.ws + WS_HL) : p.out;
    const float* g = which == 0 ? p.IN(7) + l * 1024 : (which == 1 ? p.IN(8) + l * 1024 : p.IN(28));
    const bool first = (which == 0 && l == 0), from_in = (l == 0 && which != 2);
    for (int row0 = gw; row0 < NTOK; row0 += 4 * GW) {
        f32x4 v[4][4]; float ss[4];
#pragma unroll
        for (int k = 0; k < 4; ++k) {
            const int row = row0 + k * GW; ss[k] = 0.f;
            if (row < NTOK) {
                const float* xr = from_in ? (row < 4096 ? p.IN(0) + (size_t)row * 1024 : p.IN(1) + (size_t)(row - 4096) * 1024) : p.out + (size_t)row * 1024;
#pragma unroll
                for (int j = 0; j < 4; ++j) v[k][j] = ((const f32x4*)xr)[lane + 64 * j];
                if (!first) {
                    const bf16_t* pr = (const bf16_t*)(p.ws + WS_DSA) + (size_t)row * 1024;
#pragma unroll
                    for (int j = 0; j < 4; ++j) { const u32x2 pp = ((const u32x2*)pr)[lane + 64 * j], pq = ((const u32x2*)(pr + (size_t)NTOK * 1024))[lane + 64 * j];
                        v[k][j].x += __uint_as_float(pp.x << 16) + __uint_as_float(pq.x << 16); v[k][j].y += __uint_as_float(pp.x & 0xffff0000u) + __uint_as_float(pq.x & 0xffff0000u);
                        v[k][j].z += __uint_as_float(pp.y << 16) + __uint_as_float(pq.y << 16); v[k][j].w += __uint_as_float(pp.y & 0xffff0000u) + __uint_as_float(pq.y & 0xffff0000u); }
                }
            }
        }
#pragma unroll
        for (int k = 0; k < 4; ++k) {
            const int row = row0 + k * GW;
            if (row < NTOK) {
#pragma unroll
                for (int j = 0; j < 4; ++j) ss[k] += (v[k][j].x * v[k][j].x + v[k][j].y * v[k][j].y) + (v[k][j].z * v[k][j].z + v[k][j].w * v[k][j].w);
            }
        }
#pragma unroll
        for (int o = 1; o < 64; o <<= 1) {
#pragma unroll
            for (int k = 0; k < 4; ++k) ss[k] += shx(ss[k], lane, o);
        }
#pragma unroll
        for (int k = 0; k < 4; ++k) {
            const int row = row0 + k * GW;
            if (row < NTOK) {
                const float rstd = rsqrtf(ss[k] * (1.f / 1024.f) + 1e-6f);
                if (which == 2) {
                    float* yo = xo + (size_t)row * 1024;
#pragma unroll
                    for (int j = 0; j < 4; ++j) { const f32x4 gv = ((const f32x4*)g)[lane + 64 * j]; ((f32x4*)yo)[lane + 64 * j] = v[k][j] * rstd * gv; }
                } else {
                    const float* mr = mod + (size_t)(l * 5 + modrow_of(row)) * 6144 + (which == 0 ? 0 : 3072);
#pragma unroll
                    for (int j = 0; j < 4; ++j) { const f32x4 gv = ((const f32x4*)g)[lane + 64 * j]; const f32x4 sh = ((const f32x4*)mr)[lane + 64 * j], sc = ((const f32x4*)(mr + 1024))[lane + 64 * j];
                        const f32x4 hv = v[k][j] * rstd * gv * (sc + 1.f) + sh;
                        u32x2 o; o.x = pk2(hv.x, hv.y); o.y = pk2(hv.z, hv.w);
                        ((u32x2*)(hm + (size_t)row * 1024))[lane + 64 * j] = o;
                        if (!first) ((f32x4*)(xo + (size_t)row * 1024))[lane + 64 * j] = v[k][j]; }
                }
            }
        }
    }
}

constexpr int M1_TILE_BYTES = 66048, M1_WL_BYTES = 9216;
template <int NCOL8, int NROWS> struct StageRegs { static constexpr int NCH = NCOL8 * NROWS, IT = (NCH + 511) / 512; u32x4 v[IT]; };
template <int NCOL8, int NROWS>
DI void stage_load(StageRegs<NCOL8, NROWS>& R, const char* proj, int row_first, int col0, int s0, int s1, int tid) {
    constexpr int NCH = NCOL8 * NROWS, IT = (NCH + 511) / 512;
#pragma unroll
    for (int i = 0; i < IT; ++i) { const int id = tid + 512 * i; const int row = id / NCOL8, cc = id % NCOL8, t = row_first + row;
        R.v[i] = (u32x4){0u, 0u, 0u, 0u};
        if (id < NCH && t >= s0 && t < s1) R.v[i] = *(const u32x4*)(proj + ((size_t)t * NP + col0 + cc * 8) * 2); }
}
template <int NCOL8, int NROWS>
DI void stage_store(const StageRegs<NCOL8, NROWS>& R, LAS unsigned char* tile, int pitchB, int dstB, int tid) {
    constexpr int NCH = NCOL8 * NROWS, IT = (NCH + 511) / 512;
#pragma unroll
    for (int i = 0; i < IT; ++i) { const int id = tid + 512 * i; const int row = id / NCOL8, cc = id % NCOL8;
        if (id < NCH) *(LAS u32x4*)(tile + row * pitchB + dstB + cc * 16) = R.v[i]; }
}

template <int MIX>
DI void m1_gla_wave(const Params& p, int l, int c, int hd, int dir, const LAS unsigned char* tile, LAS unsigned char* wl, const LAS unsigned char* wlp, int lane) {
    constexpr int DK = MIX == 0 ? 64 : 32, NT = DK / 32, PITCH = DK + 8, TP = MIX == 0 ? 1032 : 552;
    const int r = lane & 31, hh = lane >> 5, tok0 = c * 32;
    const LAS bf16_t* T = (const LAS bf16_t*)tile;
    LAS bf16_t* Qt = (LAS bf16_t*)wl; LAS bf16_t* Kt = Qt + 32 * PITCH;
    char* DS = (char*)(p.ws + (MIX == 0 ? WS_DSA : WS_DSB));
    float* ACH = (float*)(p.ws + (MIX == 0 ? WS_ACHA : WS_ACHB));
    char* QH = (char*)(p.ws + (MIX == 0 ? WS_QHA : WS_QHB));
    float* OI = (float*)(p.ws + WS_OI);
    const int tba = 4 * hh * TP, tb = tba + r;
#define TROW(li) ((8 * ((li) >> 2) + ((li) & 3)) * TP)
    const int vcol = MIX == 0 ? 256 + hd * 64 : 256 + hd * 64;
    bf16x8 vf[2][2];
#pragma unroll
    for (int n = 0; n < 2; ++n)
#pragma unroll
        for (int st = 0; st < 2; ++st)
#pragma unroll
            for (int j = 0; j < 8; ++j) vf[n][st][j] = (short)T[tb + TROW(8 * st + j) + vcol + 32 * n];
    const int qcol = MIX == 0 ? hd * 64 : hd * 32;
#pragma unroll 1
    for (int m = 0; m < NT; ++m) {
        float la[16], kk[16];
        if (MIX == 0) {
            const int zcol = (dir == 0 ? 512 : 768) + hd * 64 + 32 * m;
            const float* lbl = p.IN(13);
            float lb = 0.f;
            if (l == 1) { const int ch = hd * 64 + 32 * m + r; const float l0 = lbl[(0 * 2 + dir) * 256 + ch], l1 = lbl[(1 * 2 + dir) * 256 + ch]; lb = rcpf_(1.f + __expf(l0 - l1)); }
#pragma unroll
            for (int li = 0; li < 16; ++li) { const float z = bf2f(T[tb + TROW(li) + zcol]);
                const float e = __expf(-z), sg = rcpf_(1.f + e), omsg = e * sg;
                const float f = lb + (1.f - lb) * sg; kk[li] = (1.f - lb) * omsg; la[li] = __logf(fmaxf(f, 1e-20f)); }
        } else {
            const int kcol = 128 + hd * 32, acol = 512 + dir * 16;
            float w2[16];
#pragma unroll
            for (int rho = 0; rho < 16; ++rho) w2[rho] = p.IN(15)[((l * 2 + dir) * 16 + rho) * 128 + hd * 32 + r];
            const float ba = p.IN(16)[(l * 2 + dir) * 128 + hd * 32 + r];
#pragma unroll
            for (int li = 0; li < 16; ++li) {
                const u32x4 a0 = *(const LAS u32x4*)(T + tba + TROW(li) + acol), a1 = *(const LAS u32x4*)(T + tba + TROW(li) + acol + 8);
                float w = ba;
#pragma unroll
                for (int qd = 0; qd < 4; ++qd) { w += __uint_as_float(a0[qd] << 16) * w2[2 * qd] + __uint_as_float(a0[qd] & 0xffff0000u) * w2[2 * qd + 1];
                    w += __uint_as_float(a1[qd] << 16) * w2[8 + 2 * qd] + __uint_as_float(a1[qd] & 0xffff0000u) * w2[8 + 2 * qd + 1]; }
                const float ls = fminf(w, 0.f) - __logf(1.f + __expf(-fabsf(w)));
                la[li] = ls * (1.f / 16.f);
                kk[li] = bf2f(T[tb + TROW(li) + kcol]);
            }
        }
        float gs[4], pgs[4];
#pragma unroll
        for (int g = 0; g < 4; ++g) { gs[g] = (la[4 * g] + la[4 * g + 1]) + (la[4 * g + 2] + la[4 * g + 3]); pgs[g] = shx(gs[g], lane, 32); }
        float run = 0.f, half = 0.f; float cum[16];
#pragma unroll
        for (int g = 0; g < 4; ++g) { float b = run + (hh ? pgs[g] : 0.f); run += gs[g] + pgs[g]; if (g == 1) half = run;
#pragma unroll
            for (int i = 0; i < 4; ++i) { b += la[4 * g + i]; cum[4 * g + i] = b; } }
        const float total = run;
        const float ref = dir == 0 ? half : total - half;
        float kh[16];
        const unsigned qhb = MIX == 0 ? (unsigned)((tok0 + 4 * hh) * 512 + dir * 256 + hd * 64 + 32 * m + r) * 2u : (unsigned)((tok0 + 4 * hh) * 256 + dir * 128 + hd * 32 + r) * 2u;
#pragma unroll
        for (int li = 0; li < 16; ++li) {
            const float cv = dir == 0 ? cum[li] : (total - cum[li] + la[li]);
            const float eq = __expf(fminf(cv - ref, 80.f)), ek = __expf(fminf(ref - cv, 80.f));
            const int tkl = 8 * (li >> 2) + (li & 3);
            const float qv = bf2f(T[tb + TROW(li) + qcol + 32 * m]) * (MIX == 1 ? 0.17677669529663687f : 1.f);
            Qt[(tkl + 4 * hh) * PITCH + 32 * m + r] = f2bf(qv * eq);
            Kt[(tkl + 4 * hh) * PITCH + 32 * m + r] = f2bf(kk[li] * ek);
            kh[li] = kk[li] * __expf(total - cv);
            const float qh = qv * __expf(cv);
            *(bf16_t*)(QH + (qhb + (unsigned)(tkl * (MIX == 0 ? 512 : 256) * 2))) = f2bf(qh);
        }
        const bf16x8 khat0 = pack8(kh), khat1 = pack8(kh + 8);
        if (hh == 0) ACH[((c * 4 + hd) * 2 + dir) * DK + 32 * m + r] = __expf(total);
#pragma unroll
        for (int n = 0; n < 2; ++n) {
            f32x16 ds = zero16();
            ds = MFMA32(khat0, vf[n][0], ds); ds = MFMA32(khat1, vf[n][1], ds);
            const unsigned dsb = (unsigned)(((c * 4 + hd) * 2 + dir) * (DK * 64) * 2) + (unsigned)((n * (DK / 16) + 2 * m) * 1024 + r * 16 + hh * 8);
#pragma unroll
            for (int g = 0; g < 4; ++g) { u32x2 w; w.x = pk2(ds[4 * g], ds[4 * g + 1]); w.y = pk2(ds[4 * g + 2], ds[4 * g + 3]);
                *(u32x2*)(DS + (dsb + (unsigned)((g >> 1) * 1024 + (g & 1) * 512))) = w; }
        }
    }
#undef TROW
    __builtin_amdgcn_fence(__ATOMIC_RELEASE, "wavefront");
    __builtin_amdgcn_wave_barrier();
    f32x16 pt = zero16();
#pragma unroll
    for (int s = 0; s < DK / 16; ++s) {
        const bf16x8 kfr = *(const LAS bf16x8*)(Kt + r * PITCH + 16 * s + 8 * hh);
        const bf16x8 qfr = *(const LAS bf16x8*)(Qt + r * PITCH + 16 * s + 8 * hh);
        pt = MFMA32(kfr, qfr, pt);
    }
    __builtin_amdgcn_fence(__ATOMIC_RELEASE, "wavefront");
    __builtin_amdgcn_wave_barrier();
    LAS float* ex = (LAS float*)wl; const LAS float* exp_ = (const LAS float*)wlp;
#pragma unroll
    for (int i = 0; i < 16; ++i) { const int srow = crow(i, hh); const bool keep = dir == 0 ? (srow <= r) : (srow >= r); pt[i] = keep ? pt[i] : 0.f; ex[i * 64 + lane] = pt[i]; }
    __syncthreads();
    float ptv[16];
#pragma unroll
    for (int i = 0; i < 16; ++i) ptv[i] = pt[i] + exp_[i * 64 + lane];
    const bf16x8 pf0 = pack8(ptv), pf1 = pack8(ptv + 8);
    float* oi = OI + (size_t)((MIX * 256 + c) * 4 + hd) * 2048;
    {
        f32x16 ot = zero16();
        const bf16x8 va = dir == 0 ? vf[0][0] : vf[1][0], vb = dir == 0 ? vf[0][1] : vf[1][1];
        ot = MFMA32(va, pf0, ot); ot = MFMA32(vb, pf1, ot);
#pragma unroll
        for (int g = 0; g < 4; ++g) *(f32x4*)(oi + ((dir * 4 + g) * 64 + lane) * 4) = (f32x4){ot[4 * g], ot[4 * g + 1], ot[4 * g + 2], ot[4 * g + 3]};
    }
}

DI void m1_rg_wave(const Params& p, int l, int c, int nb, int dir, const LAS unsigned char* tile, int lane) {
    constexpr int TP = 264;
    const int r = lane & 31, hh = lane >> 5, tok0 = c * 32;
    const LAS bf16_t* T = (const LAS bf16_t*)tile;
    float* HL = (float*)(p.ws + WS_HL); float* CP = (float*)(p.ws + WS_CP);
    float* RAGA = (float*)(p.ws + WS_RAGA); float* RAGH = (float*)(p.ws + WS_RAGH);
    const int sgn = dir ? -1 : 1, lbase = dir ? 31 : 0;
    const float* cw = p.IN(18) + (size_t)(l * 2 + dir) * 4 * 256;
    const float* cb = p.IN(19) + (size_t)(l * 2 + dir) * 256;
    bf16x8 af[4];
    const int trow = lbase + sgn * r + 3;
#pragma unroll
    for (int s = 0; s < 4; ++s) {
        const int ch0 = 64 * nb + 16 * s + 8 * hh;
        float xc[8];
        { const f32x4 b0 = *(const f32x4*)(cb + ch0), b1 = *(const f32x4*)(cb + ch0 + 4);
          xc[0] = b0.x; xc[1] = b0.y; xc[2] = b0.z; xc[3] = b0.w; xc[4] = b1.x; xc[5] = b1.y; xc[6] = b1.z; xc[7] = b1.w; }
#pragma unroll
        for (int tap = 0; tap < 4; ++tap) {
            const u32x4 uu = *(const LAS u32x4*)(T + (trow + sgn * (tap - 3)) * TP + ch0);
            const f32x4 w0 = *(const f32x4*)(cw + tap * 256 + ch0), w1 = *(const f32x4*)(cw + tap * 256 + ch0 + 4);
            xc[0] += w0.x * __uint_as_float(uu.x << 16); xc[1] += w0.y * __uint_as_float(uu.x & 0xffff0000u);
            xc[2] += w0.z * __uint_as_float(uu.y << 16); xc[3] += w0.w * __uint_as_float(uu.y & 0xffff0000u);
            xc[4] += w1.x * __uint_as_float(uu.z << 16); xc[5] += w1.y * __uint_as_float(uu.z & 0xffff0000u);
            xc[6] += w1.z * __uint_as_float(uu.w << 16); xc[7] += w1.w * __uint_as_float(uu.w & 0xffff0000u);
        }
        af[s] = pack8(xc);
    }
    const float* wr_ = p.IN(20) + (size_t)((l * 2 + dir) * 4 + nb) * 4096;
    const float* wi_ = p.IN(22) + (size_t)((l * 2 + dir) * 4 + nb) * 4096;
#pragma unroll 1
    for (int n = 0; n < 2; ++n) {
        f32x16 rr = zero16(), ri = zero16();
#pragma unroll
        for (int s = 0; s < 4; ++s) {
            float br_[8], bi_[8];
#pragma unroll
            for (int j = 0; j < 8; ++j) { br_[j] = wr_[(16 * s + 8 * hh + j) * 64 + 32 * n + r]; bi_[j] = wi_[(16 * s + 8 * hh + j) * 64 + 32 * n + r]; }
            rr = MFMA32(af[s], pack8(br_), rr); ri = MFMA32(af[s], pack8(bi_), ri);
        }
        const int ch = 64 * nb + 32 * n + r;
        const float cbv = cb[ch]; float cwv[4];
#pragma unroll
        for (int tap = 0; tap < 4; ++tap) cwv[tap] = cw[tap * 256 + ch];
        const float brv = p.IN(21)[(l * 2 + dir) * 256 + ch], biv = p.IN(23)[(l * 2 + dir) * 256 + ch];
        const float lam = p.IN(24)[(l * 2 + dir) * 256 + ch];
        const float c8 = -8.f * log1pf(__expf(-lam));
        float a[16], bx[16];
#pragma unroll
        for (int li = 0; li < 16; ++li) {
            const int tr = lbase + sgn * (8 * (li >> 2) + 4 * hh + (li & 3)) + 3;
            float xcv = cbv;
#pragma unroll
            for (int tap = 0; tap < 4; ++tap) xcv += cwv[tap] * bf2f(T[(tr + sgn * (tap - 3)) * TP + ch]);
            const float rv = sigmoidf_(rr[li] + brv), iv = sigmoidf_(ri[li] + biv);
            const float loga = c8 * rv;
            a[li] = __expf(loga); bx[li] = __builtin_amdgcn_sqrtf(om_exp(2.f * loga)) * iv * xcv;
        }
        float Ag[4], Bg[4], pA[4], pB[4];
#pragma unroll
        for (int g = 0; g < 4; ++g) { float hl = 0.f, ap = 1.f;
#pragma unroll
            for (int i = 0; i < 4; ++i) { hl = a[4 * g + i] * hl + bx[4 * g + i]; ap *= a[4 * g + i]; }
            Ag[g] = ap; Bg[g] = hl; pA[g] = shx(ap, lane, 32); pB[g] = shx(hl, lane, 32); }
        float Hrun = 0.f, Prun = 1.f;
        const bool first = (hh == 0);
#pragma unroll
        for (int g = 0; g < 4; ++g) {
            const float A0 = first ? Ag[g] : pA[g], B0 = first ? Bg[g] : pB[g];
            const float A1 = first ? pA[g] : Ag[g], B1 = first ? pB[g] : Bg[g];
            float hcur = first ? Hrun : (A0 * Hrun + B0), pcur = first ? Prun : Prun * A0;
            Hrun = A1 * (A0 * Hrun + B0) + B1; Prun = Prun * A0 * A1;
#pragma unroll
            for (int i = 0; i < 4; ++i) { hcur = a[4 * g + i] * hcur + bx[4 * g + i]; pcur *= a[4 * g + i];
                const int tg = tok0 + lbase + sgn * (8 * g + 4 * hh + i);
                HL[((size_t)dir * NTOK + tg) * 256 + ch] = hcur; CP[((size_t)dir * NTOK + tg) * 256 + ch] = pcur; }
        }
        if (hh == 0) { RAGA[(c * 2 + dir) * 256 + ch] = Prun; RAGH[(c * 2 + dir) * 256 + ch] = Hrun; }
    }
}

DI void phase_m1(const Params& p, int l, LAS unsigned char* lds, const int tid, const int stages = 7) {
    const int lane = tid & 63, wid = __builtin_amdgcn_readfirstlane(tid >> 6);
    const char* proj = (const char*)(p.ws + WS_BIG);
    LAS unsigned char* tile = lds;
    LAS unsigned char* wl = lds + M1_TILE_BYTES + wid * M1_WL_BYTES;
    LAS unsigned char* wlp = lds + M1_TILE_BYTES + (wid ^ 1) * M1_WL_BYTES;
    for (int c = blockIdx.x; c < 256; c += gridDim.x) {
        int ln = lane, td = tid; asm volatile("" : "+v"(ln), "+v"(td));
        const int tok0 = c * 32;
        int s0, s1;
        if (c < 128) { s0 = (c >> 3) * 256; s1 = s0 + 256; } else { s0 = 4096 + ((c - 128) >> 5) * 1024; s1 = s0 + 1024; }
        StageRegs<128, 32> ra; StageRegs<64, 32> rb; StageRegs<4, 32> rb2; StageRegs<32, 38> rc;
        if (stages & 1) stage_load(ra, proj, tok0, 0, 0, NTOK, td);
        if (stages & 2) { stage_load(rb, proj, tok0, B_Q, 0, NTOK, td); stage_load(rb2, proj, tok0, B_AF, 0, NTOK, td); }
        if (stages & 4) stage_load(rc, proj, tok0 - 3, C_X, s0, s1, td);
        if (stages & 1) {
        stage_store(ra, tile, 2064, 0, td);
        __syncthreads();
        m1_gla_wave<0>(p, l, c, wid >> 1, wid & 1, tile, wl, wlp, ln);
        __builtin_amdgcn_sched_barrier(0); asm volatile("" : "+v"(ln), "+v"(td));
        }
        if (stages & 2) {
        stage_store(rb, tile, 1104, 0, td); stage_store(rb2, tile, 1104, 1024, td);
        __syncthreads();
        m1_gla_wave<1>(p, l, c, wid >> 1, wid & 1, tile, wl, wlp, ln);
        __builtin_amdgcn_sched_barrier(0); asm volatile("" : "+v"(ln), "+v"(td));
        }
        if (stages & 4) {
        stage_store(rc, tile, 528, 0, td);
        __syncthreads();
        m1_rg_wave(p, l, c, wid >> 1, wid & 1, tile, ln);
        __syncthreads();
        }
    }
}

DI void m2_chain8(const Params& p, int l, int id, const bool dry) {
    const int sq = id / 6144; int rem = id % 6144;
    const int hd = rem / 1536, dir = (rem / 768) & 1; int f = rem % 768;
    const int mix = f < 512 ? 0 : 1; if (mix) f -= 512;
    const int dk = mix == 0 ? 64 : 32, S_ = dk / 16;
    const int lane_ = f & 63, ns = f >> 6, n = ns / S_, s = ns % S_;
    const int d0 = 16 * s + 8 * (lane_ >> 5), e = 32 * n + (lane_ & 31);
    char* DS = (char*)(p.ws + (mix == 0 ? WS_DSA : WS_DSB));
    char* DSO = dry ? (char*)(p.ws + (mix == 0 ? WS_HM : WS_BIG + 56 * MiB)) : DS;
    const float* ACH = (const float*)(p.ws + (mix == 0 ? WS_ACHA : WS_ACHB));
    float zf = 0.f; asm volatile("" : "+v"(zf));
    float S[8];
#pragma unroll
    for (int j = 0; j < 8; ++j) S[j] = zf;
    int c0, N;
    if (sq < 16) { c0 = sq * 8; N = 8; }
    else { c0 = 128 + (sq - 16) * 32; N = 32; const int b = sq - 16;
        const float* s0p = mix == 0 ? p.IN(2) + (size_t)((((b * 2 + l) * 2 + dir) * 4 + hd)) * 4096 : p.IN(3) + (size_t)((((b * 2 + l) * 2 + dir) * 4 + hd)) * 2048;
#pragma unroll
        for (int j = 0; j < 8; ++j) S[j] = s0p[(d0 + j) * 64 + e]; }
    for (int n0 = 0; n0 < N; n0 += 8) {
        u32x4 v[8]; f32x4 a0[8], a1[8];
#pragma unroll
        for (int i = 0; i < 8; ++i) { const int nn = n0 + i, c = c0 + (dir == 0 ? nn : N - 1 - nn); const size_t ui = (size_t)((c * 4 + hd) * 2 + dir);
            v[i] = *(const u32x4*)(DS + ui * (dk * 128) + f * 16); a0[i] = *(const f32x4*)(ACH + ui * dk + d0); a1[i] = *(const f32x4*)(ACH + ui * dk + d0 + 4); }
#pragma unroll
        for (int i = 0; i < 8; ++i) { const int nn = n0 + i, c = c0 + (dir == 0 ? nn : N - 1 - nn); const size_t ui = (size_t)((c * 4 + hd) * 2 + dir);
            u32x4 o; o.x = pk2(S[0], S[1]); o.y = pk2(S[2], S[3]); o.z = pk2(S[4], S[5]); o.w = pk2(S[6], S[7]);
            *(u32x4*)(DSO + ui * (dk * 128) + f * 16) = o;
            S[0] = a0[i].x * S[0] + __uint_as_float(v[i].x << 16); S[1] = a0[i].y * S[1] + __uint_as_float(v[i].x & 0xffff0000u);
            S[2] = a0[i].z * S[2] + __uint_as_float(v[i].y << 16); S[3] = a0[i].w * S[3] + __uint_as_float(v[i].y & 0xffff0000u);
            S[4] = a1[i].x * S[4] + __uint_as_float(v[i].z << 16); S[5] = a1[i].y * S[5] + __uint_as_float(v[i].z & 0xffff0000u);
            S[6] = a1[i].z * S[6] + __uint_as_float(v[i].w << 16); S[7] = a1[i].w * S[7] + __uint_as_float(v[i].w & 0xffff0000u); }
    }
    if (sq < 16) { const int b = sq;
        float* ob = dry ? (float*)(p.ws + 243 * MiB) - OUT_SH : p.out;
        float* op = mix == 0 ? ob + OUT_SH + (size_t)((((b * 2 + l) * 2 + dir) * 4 + hd)) * 4096 : ob + OUT_SG + (size_t)((((b * 2 + l) * 2 + dir) * 4 + hd)) * 2048;
#pragma unroll
        for (int j = 0; j < 8; ++j) op[(d0 + j) * 64 + e] = S[j]; }
}
DI void phase_m2(const Params& p, int l, const int tid, const bool dry = false) {
    const int gt = blockIdx.x * 512 + tid, GT = gridDim.x * 512;
    for (int id = gt; id < 20 * 6144; id += GT) m2_chain8(p, l, 20 * 6144 - 1 - id, dry);
    float* RAGH = (float*)(p.ws + WS_RAGH); const float* RAGA = (const float*)(p.ws + WS_RAGA);
    float* RAGO = dry ? (float*)(p.ws + 250 * MiB) : RAGH; float* SRO = dry ? (float*)(p.ws + 251 * MiB) - OUT_SR : p.out;
    for (int id = GT - 1 - gt; id < 20 * 512; id += GT) {
        const int sq = id / 512, dir = (id >> 8) & 1, ch = id & 255;
        int c0, N; float h = 0.f;
        if (sq < 16) { c0 = sq * 8; N = 8; } else { c0 = 128 + (sq - 16) * 32; N = 32; h = p.IN(4)[((size_t)((sq - 16) * 2 + l) * 2 + dir) * 256 + ch]; }
        for (int n0 = 0; n0 < N; n0 += 8) {
            float v[8], av[8];
#pragma unroll
            for (int i = 0; i < 8; ++i) { const int n = n0 + i, c = c0 + (dir == 0 ? n : N - 1 - n); v[i] = RAGH[(c * 2 + dir) * 256 + ch]; av[i] = RAGA[(c * 2 + dir) * 256 + ch]; }
#pragma unroll
            for (int i = 0; i < 8; ++i) { const int n = n0 + i, c = c0 + (dir == 0 ? n : N - 1 - n); RAGO[(c * 2 + dir) * 256 + ch] = h; h = av[i] * h + v[i]; }
        }
        if (sq < 16) SRO[OUT_SR + ((size_t)(sq * 2 + l) * 2 + dir) * 256 + ch] = h;
    }
}

DI void m3_gla_unit(const Params& p, int l, int c, int hd, int MIX, int lane) {
    const int DK = MIX == 0 ? 64 : 32, S_ = DK >> 4;
    const int r = lane & 31, hh = lane >> 5, tok0 = c * 32;
    const bf16_t* proj = (const bf16_t*)(p.ws + WS_BIG);
    const bf16_t* DS = (const bf16_t*)(p.ws + (MIX == 0 ? WS_DSA : WS_DSB));
    const bf16_t* QH = (const bf16_t*)(p.ws + (MIX == 0 ? WS_QHA : WS_QHB));
    const float* oi = (const float*)(p.ws + WS_OI) + (size_t)((MIX * 256 + c) * 4 + hd) * 2048;
    bf16_t* mix = (bf16_t*)(p.ws + WS_HM);
    f32x16 acc[2];
#pragma unroll
    for (int n = 0; n < 2; ++n)
#pragma unroll
        for (int g = 0; g < 4; ++g) { const f32x4 v = *(const f32x4*)(oi + ((n * 4 + g) * 64 + lane) * 4); acc[n][4 * g] = v.x; acc[n][4 * g + 1] = v.y; acc[n][4 * g + 2] = v.z; acc[n][4 * g + 3] = v.w; }
#pragma unroll 1
    for (int dir = 0; dir < 2; ++dir) {
        const bf16_t* sp = DS + (size_t)((c * 4 + hd) * 2 + dir) * (DK * 64);
        const bf16_t* qp = QH + (size_t)(tok0 + r) * (8 * DK) + dir * (4 * DK) + hd * DK + 8 * hh;
#pragma unroll 2
        for (int s = 0; s < S_; ++s) {
            const bf16x8 qf = *(const bf16x8*)(qp + 16 * s);
            const bf16x8 sf0 = *(const bf16x8*)(sp + (s * 64 + lane) * 8), sf1 = *(const bf16x8*)(sp + ((S_ + s) * 64 + lane) * 8);
            acc[0] = MFMA32(sf0, qf, acc[0]); acc[1] = MFMA32(sf1, qf, acc[1]);
        }
    }
    float ss = 0.f;
#pragma unroll
    for (int n = 0; n < 2; ++n)
#pragma unroll
        for (int i = 0; i < 16; ++i) ss += acc[n][i] * acc[n][i];
    ss += shx(ss, lane, 32);
    const float rstd = rsqrtf(ss * (1.f / 64.f) + 1e-6f);
    const float* gain = (MIX == 0 ? p.IN(14) : p.IN(17)) + l * 256 + hd * 64;
    const bf16_t* grow = proj + (size_t)(tok0 + r) * NP + (MIX == 0 ? A_G : B_G) + hd * 64;
    bf16_t* orow = mix + (size_t)(tok0 + r) * 1024 + MIX * 256 + hd * 64;
#pragma unroll
    for (int n = 0; n < 2; ++n)
#pragma unroll
        for (int g = 0; g < 4; ++g) {
            const int e = 32 * n + 8 * g + 4 * hh;
            const u32x2 gg = *(const u32x2*)(grow + e); const f32x4 gn = *(const f32x4*)(gain + e);
            const float g0 = __uint_as_float(gg.x << 16), g1 = __uint_as_float(gg.x & 0xffff0000u), g2 = __uint_as_float(gg.y << 16), g3 = __uint_as_float(gg.y & 0xffff0000u);
            u32x2 o; o.x = pk2(acc[n][4 * g] * rstd * gn.x * siluf_(g0), acc[n][4 * g + 1] * rstd * gn.y * siluf_(g1));
            o.y = pk2(acc[n][4 * g + 2] * rstd * gn.z * siluf_(g2), acc[n][4 * g + 3] * rstd * gn.w * siluf_(g3));
            *(u32x2*)(orow + e) = o;
        }
}

DI float gelu_tanh(float x) { const float u = 0.7978845608028654f * (x + 0.044715f * x * x * x); const float t = 1.f - 2.f * rcpf_(__expf(2.f * u) + 1.f); return 0.5f * x * (1.f + t); }

DI void phase_m3(const Params& p, int l, const int tid) {
    const int lane = tid & 63, wid = __builtin_amdgcn_readfirstlane(tid >> 6), gw = blockIdx.x * 8 + wid, GW = gridDim.x * 8;
    for (int u = gw; u < 2048; u += GW) {
        const int ty = u & 1, idx = u >> 1, c = idx >> 2, hd = idx & 3;
        int ln = lane; asm volatile("" : "+v"(ln));
        m3_gla_unit(p, l, c, hd, ty, ln);
    }
    const int gt = blockIdx.x * 512 + tid, GT = gridDim.x * 512;
    const bf16_t* proj = (const bf16_t*)(p.ws + WS_BIG);
    bf16_t* mix = (bf16_t*)(p.ws + WS_HM);
    const float* HL = (const float*)(p.ws + WS_HL); const float* CP = (const float*)(p.ws + WS_CP); const float* HIN = (const float*)(p.ws + WS_RAGH);
    for (int id0 = gt; id0 < NTOK * 64; id0 += 4 * GT) {
        f32x4 hf[4], hb[4], cf[4], cb[4], inf_[4], inb[4]; u32x2 gg[4];
#pragma unroll
        for (int k = 0; k < 4; ++k) { const int id = id0 + k * GT; if (id < NTOK * 64) { const int tok = id >> 6, ch = (id & 63) * 4, c = tok >> 5;
            hf[k] = *(const f32x4*)(HL + (size_t)tok * 256 + ch); hb[k] = *(const f32x4*)(HL + ((size_t)NTOK + tok) * 256 + ch);
            cf[k] = *(const f32x4*)(CP + (size_t)tok * 256 + ch); cb[k] = *(const f32x4*)(CP + ((size_t)NTOK + tok) * 256 + ch);
            inf_[k] = *(const f32x4*)(HIN + (c * 2 + 0) * 256 + ch); inb[k] = *(const f32x4*)(HIN + (c * 2 + 1) * 256 + ch);
            gg[k] = *(const u32x2*)(proj + (size_t)tok * NP + C_G + ch); } }
#pragma unroll
        for (int k = 0; k < 4; ++k) { const int id = id0 + k * GT; if (id < NTOK * 64) { const int tok = id >> 6, ch = (id & 63) * 4;
            const f32x4 y = hf[k] + cf[k] * inf_[k] + hb[k] + cb[k] * inb[k];
            u32x2 o; o.x = pk2(y.x * gelu_tanh(__uint_as_float(gg[k].x << 16)), y.y * gelu_tanh(__uint_as_float(gg[k].x & 0xffff0000u)));
            o.y = pk2(y.z * gelu_tanh(__uint_as_float(gg[k].y << 16)), y.w * gelu_tanh(__uint_as_float(gg[k].y & 0xffff0000u)));
            *(u32x2*)(mix + (size_t)tok * 1024 + 512 + ch) = o; } }
    }
    const float* sw = p.IN(25) + l * 3 * 256;
    for (int id0 = gt; id0 < NTOK * 64; id0 += 4 * GT) {
        u32x2 cc[4][3], vv[4][3], bb[4];
#pragma unroll
        for (int k = 0; k < 4; ++k) { const int id = id0 + k * GT; if (id < NTOK * 64) { const int tok = id >> 6, ch = (id & 63) * 4;
            const int seg = tok < 4096 ? 256 : 64, pos = tok & (seg - 1);
#pragma unroll
            for (int j = 0; j < 3; ++j) { const int pp = pos + j - 1; cc[k][j] = (u32x2){0u, 0u}; vv[k][j] = (u32x2){0u, 0u};
                if (pp >= 0 && pp < seg) { const int tt = tok + j - 1; cc[k][j] = *(const u32x2*)(proj + (size_t)tt * NP + D_C + ch); vv[k][j] = *(const u32x2*)(proj + (size_t)tt * NP + D_V + ch); } }
            bb[k] = *(const u32x2*)(proj + (size_t)tok * NP + D_B + ch); } }
#pragma unroll
        for (int k = 0; k < 4; ++k) { const int id = id0 + k * GT; if (id < NTOK * 64) { const int tok = id >> 6, ch = (id & 63) * 4;
            f32x4 y = {0.f, 0.f, 0.f, 0.f};
#pragma unroll
            for (int j = 0; j < 3; ++j) { const f32x4 w = *(const f32x4*)(sw + j * 256 + ch);
                y.x += w.x * __uint_as_float(cc[k][j].x << 16) * __uint_as_float(vv[k][j].x << 16); y.y += w.y * __uint_as_float(cc[k][j].x & 0xffff0000u) * __uint_as_float(vv[k][j].x & 0xffff0000u);
                y.z += w.z * __uint_as_float(cc[k][j].y << 16) * __uint_as_float(vv[k][j].y << 16); y.w += w.w * __uint_as_float(cc[k][j].y & 0xffff0000u) * __uint_as_float(vv[k][j].y & 0xffff0000u); }
            u32x2 o; o.x = pk2(y.x * __uint_as_float(bb[k].x << 16), y.y * __uint_as_float(bb[k].x & 0xffff0000u));
            o.y = pk2(y.z * __uint_as_float(bb[k].y << 16), y.w * __uint_as_float(bb[k].y & 0xffff0000u));
            *(u32x2*)(mix + (size_t)tok * 1024 + 768 + ch) = o; } }
    }
}

__global__ void __launch_bounds__(512, 2) fwd_kernel(Params pin) {
    extern __shared__ __attribute__((aligned(16))) unsigned char lds_raw[];
    LAS unsigned char* lds = (LAS unsigned char*)lds_raw;
    cg::grid_group grid = cg::this_grid();
    const int G = gridDim.x, bid = blockIdx.x;
    volatile LAS unsigned* bst = (volatile LAS unsigned*)(lds + LDS_BYTES - 16);
    if (threadIdx.x < 4) bst[threadIdx.x] = 0u;
    __syncthreads();
    if (bid == 0 && pin.ph_lo == 0) { unsigned* bw = (unsigned*)(pin.ws + WS_BAR); for (int i = threadIdx.x; i < 4096; i += 512) bw[i] = 0u; }
    XcdBarrier xbar; xbar.bar = (unsigned*)(pin.ws + WS_BAR); xbar.x = 0; xbar.st = bst;
    int nsync = 0;
    for (int ph2 = 2 * pin.ph_lo; ph2 < 2 * pin.ph_hi; ++ph2) {
        const int ph = ph2 >> 1;
        if ((ph2 & 1) && !((REPEAT_MASK >> ph) & 1u)) continue;
        size_t zo = 0; asm volatile("" : "+s"(zo));
        int tid = threadIdx.x; asm volatile("" : "+v"(tid));
        Params p = pin; p.ws += zo; p.out += zo; p.zo = zo;
        const float* mod = (const float*)(p.ws + WS_MOD);
        bf16_t* hm = (bf16_t*)(p.ws + WS_HM); bf16_t* big = (bf16_t*)(p.ws + WS_BIG);
        if (ph == 0) phase_p0(p, lds, tid);
        else {
            const int l = ph == 19 ? 0 : (ph - 1) / 9, s = ph == 19 ? 9 : (ph - 1) % 9;
            pg8::StaticOrder S; pg8::Gemm g{hm, hm, 0, 0, 0, 0}; pg8::EpiAny E{0, big, 0, mod}; bool is_gemm = false, align = false;
            if (s == 0 || s == 6 || s == 9) phase_norm(p, l, s == 0 ? 0 : (s == 6 ? 1 : 2), tid, (ph2 & 1) != 0);
            else if (s == 1) { g = pg8::Gemm{hm, (const bf16_t*)(p.ws + WS_WIN) + (size_t)l * NP * 1024, NTOK, NP, 1024, 1024}; S.init(NTOK, NP, G, bid);
                E = pg8::EpiAny{0, big, NP, mod}; is_gemm = true; align = GEMM_ALIGN; }
            else if (s == 2) phase_m1(p, l, lds, tid, (ph2 & 1) ? M1_PROBE_STAGES : 7);
            else if (s == 3) phase_m2(p, l, tid, (ph2 & 1) != 0);
            else if (s == 4) phase_m3(p, l, tid);
            else if (s == 5) { g = pg8::Gemm{hm, (const bf16_t*)(p.ws + WS_WOUT) + (size_t)l * 1024 * 1024, NTOK, 1024, 512, 1024}; S.init(NTOK, 1024, G, bid, 2);
                E = pg8::EpiAny{2, (bf16_t*)(p.ws + ((ph2 & 1) ? WS_HL : WS_DSA)), 1024, mod + (size_t)l * 5 * 6144 + 2048}; is_gemm = true; }
            else if (s == 7) { g = pg8::Gemm{hm, (const bf16_t*)(p.ws + WS_W1) + (size_t)l * 4096 * 1024, NTOK, DFF, 1024, 1024}; S.init(NTOK, DFF, G, bid);
                E = pg8::EpiAny{1, big, DFF, mod}; is_gemm = true; align = GEMM_ALIGN; }
            else { g = pg8::Gemm{big, (const bf16_t*)(p.ws + WS_W2) + (size_t)l * 1024 * 4096, NTOK, 1024, 2048, DFF}; S.init(NTOK, 1024, G, bid, 2);
                E = pg8::EpiAny{2, (bf16_t*)(p.ws + ((ph2 & 1) ? WS_HL : WS_DSA)), 1024, mod + (size_t)l * 5 * 6144 + 5120}; is_gemm = true; }
            if (is_gemm) pg8::gemm_phase<pg8::EpiAny, GEMM_SP2>(lds, g, S, E, tid, align);
        }
        if (ph2 + 2 < 2 * pin.ph_hi || (!(ph2 & 1) && ((REPEAT_MASK >> ph) & 1u))) { if (nsync == 0) { grid.sync(); xbar = xcd_barrier_post((unsigned*)(pin.ws + WS_BAR), bst); } else xcd_barrier(xbar); ++nsync; }
    }
}

extern "C" void kernel_launch(void* const* d_in, const int* in_sizes, int n_in, void* d_out, int out_size, void* d_ws, size_t ws_size, hipStream_t stream) {
    static int grid = 0;
    if (grid == 0) {
        if (n_in != 29 || ws_size < WS_END) { fprintf(stderr, "kernel_launch: unexpected n_in %d / ws %zu\n", n_in, ws_size); grid = -1; return; }
        int dev = 0, cus = 0, per_cu = 0;
        hipGetDevice(&dev); hipDeviceGetAttribute(&cus, hipDeviceAttributeMultiprocessorCount, dev);
        if (hipFuncSetAttribute((const void*)fwd_kernel, hipFuncAttributeMaxDynamicSharedMemorySize, LDS_BYTES) != hipSuccess) { fprintf(stderr, "kernel_launch: hipFuncSetAttribute failed\n"); grid = -1; return; }
        if (hipOccupancyMaxActiveBlocksPerMultiprocessor(&per_cu, (const void*)fwd_kernel, 512, LDS_BYTES) != hipSuccess || per_cu < 1) { fprintf(stderr, "kernel_launch: occupancy query says %d\n", per_cu); per_cu = 1; }
        (void)hipGetLastError();
        grid = cus * 1;
        if (grid <= 0) grid = 256;
    }
    if (grid < 0) return;
    Params p{};
    for (int i = 0; i < 29; ++i) p.in[i] = (const float*)d_in[i];
    p.out = (float*)d_out; p.ws = (unsigned char*)d_ws;
#if MEGA
    p.ph_lo = 0; p.ph_hi = 20;
    void* args[] = {&p};
    hipError_t e = hipLaunchCooperativeKernel((const void*)fwd_kernel, dim3(grid), dim3(512), args, LDS_BYTES, stream);
    if (e != hipSuccess) fprintf(stderr, "cooperative launch failed: %s (grid %d)\n", hipGetErrorString(e), grid);
#else
    for (int ph = 0; ph < 20; ++ph) { p.ph_lo = ph; p.ph_hi = ph + 1; hipLaunchKernelGGL(fwd_kernel, dim3(grid), dim3(512), LDS_BYTES, stream, p); }
#endif
}
```

```cpp
#include <hip/hip_runtime.h>
#include <hip/hip_cooperative_groups.h>
#include <cstdio>
#include <cstdint>
namespace cg = cooperative_groups;

#ifndef MEGA
#define MEGA 1
#endif
#ifndef M1_PROBE_STAGES
#define M1_PROBE_STAGES 7
#endif
#ifndef GEMM_SP2
#define GEMM_SP2 true
#endif
#ifndef GEMM_ALIGN
#define GEMM_ALIGN true
#endif
#ifndef REPEAT_MASK
#define REPEAT_MASK 0u
#endif

#define DI __device__ __forceinline__
#define LAS __attribute__((address_space(3)))
typedef unsigned short bf16_t;
typedef short bf16x8 __attribute__((ext_vector_type(8)));
typedef float f32x4 __attribute__((ext_vector_type(4)));
typedef float f32x16 __attribute__((ext_vector_type(16)));
typedef unsigned u32x4 __attribute__((ext_vector_type(4)));
typedef unsigned u32x2 __attribute__((ext_vector_type(2)));
typedef __bf16 bf16x2_t __attribute__((ext_vector_type(2)));
typedef float f32x2_t __attribute__((ext_vector_type(2)));

constexpr int NTOK = 8192, DM = 1024, NP = 3584, DFF = 4096;
constexpr int A_Q = 0, A_I = 256, A_FF = 512, A_FB = 768, A_G = 1024, B_Q = 1280, B_K = 1408, B_V = 1536, B_G = 1792, B_AF = 2048, B_AB = 2064,
              C_X = 2080, C_G = 2336, D_B = 2592, D_C = 2848, D_V = 3104, PW = 3360;
constexpr size_t MiB = 1u << 20;
constexpr size_t WS_WIN = 0, WS_WOUT = 14 * MiB, WS_W1 = 18 * MiB, WS_W2 = 34 * MiB, WS_MOD = 50 * MiB, WS_HM = 51 * MiB, WS_BIG = 67 * MiB,
                 WS_OI = 131 * MiB, WS_DSA = 147 * MiB, WS_DSB = 179 * MiB, WS_QHA = 195 * MiB, WS_QHB = 203 * MiB, WS_HL = 207 * MiB, WS_CP = 223 * MiB,
                 WS_ACHA = 239 * MiB, WS_ACHB = 239 * MiB + 512 * 1024, WS_RAGA = 240 * MiB, WS_RAGH = 240 * MiB + 512 * 1024, WS_BAR = 241 * MiB, WS_END = 242 * MiB;
constexpr int OUT_SH = 8388608, OUT_SG = OUT_SH + 1048576, OUT_SR = OUT_SG + 524288;
constexpr int LDS_BYTES = 147456;

struct Params { const float* in[29]; float* out; unsigned char* ws; size_t zo; int ph_lo, ph_hi;
    DI const float* IN(int i) const { return in[i] + zo; } };

DI float bf2f(bf16_t u) { return __uint_as_float(((unsigned)u) << 16); }
DI unsigned pk2(float lo, float hi) { f32x2_t v = {lo, hi}; bf16x2_t b = __builtin_convertvector(v, bf16x2_t); return __builtin_bit_cast(unsigned, b); }
DI bf16_t f2bf(float x) { return (bf16_t)(pk2(x, 0.f) & 0xffffu); }
DI bf16x8 pack8(const float* v) { u32x4 p; p.x = pk2(v[0], v[1]); p.y = pk2(v[2], v[3]); p.z = pk2(v[4], v[5]); p.w = pk2(v[6], v[7]); return __builtin_bit_cast(bf16x8, p); }
DI float rcpf_(float x) { return __builtin_amdgcn_rcpf(x); }
DI float sigmoidf_(float x) { return rcpf_(1.f + __expf(-x)); }
DI float siluf_(float x) { return x * rcpf_(1.f + __expf(-x)); }
DI float om_exp(float x) { const float s = -x * (1.f + x * 0.5f * (1.f + x * (1.f / 3.f) * (1.f + x * 0.25f * (1.f + x * 0.2f * (1.f + x * (1.f / 6.f)))))); return x > -0.3f ? s : 1.f - __expf(x); }
DI int crow(int reg, int h) { return (reg & 3) + 8 * (reg >> 2) + 4 * h; }
#define MFMA32(a, b, c) __builtin_amdgcn_mfma_f32_32x32x16_bf16((a), (b), (c), 0, 0, 0)
DI f32x16 zero16() { f32x16 z; for (int i = 0; i < 16; ++i) z[i] = 0.f; return z; }
DI float shx(float v, int lane, int m) { return __int_as_float(__builtin_amdgcn_ds_bpermute((lane ^ m) << 2, __float_as_int(v))); }
DI int modrow_of(int row) { return row < 4096 ? 0 : 1 + ((row - 4096) >> 10); }


#define XB_TMO      128
#define XB_XCNT(j)  (256  + 64 * (j))
#define XB_XSUB(j)  (1280 + 64 * (j))
#define XB_XGEN(j)  (2304 + 64 * (j))
#define XB_TOP      3328
#define XB_TOPGEN   3392
#define XCD_BAR_WORDS 3456
#define XB_SPIN_CAP (1u << 18)
DI unsigned xb_ld(unsigned* p)              { return __hip_atomic_load(p, __ATOMIC_RELAXED, __HIP_MEMORY_SCOPE_AGENT); }
DI unsigned xb_add(unsigned* p, unsigned v) { return __hip_atomic_fetch_add(p, v, __ATOMIC_RELAXED, __HIP_MEMORY_SCOPE_AGENT); }
DI unsigned xb_xcc_id() { return (unsigned)__builtin_amdgcn_s_getreg((3 << 11) | 20) & 0xFu; }
#define XB_SPIN(cond, bar) do { unsigned _sp = 0; while (cond) { __builtin_amdgcn_s_sleep(1); \
    if ((++_sp & 255u) == 0u) { if (xb_ld(&(bar)[XB_TMO])) break; if (_sp > XB_SPIN_CAP) { atomicAdd(&(bar)[XB_TMO], 1u); break; } } } } while (0)
struct XcdBarrier { unsigned* bar; unsigned x; volatile LAS unsigned* st; };
DI XcdBarrier xcd_barrier_post(unsigned* bar, volatile LAS unsigned* st) {
    XcdBarrier b; b.bar = bar; b.x = xb_xcc_id(); b.st = st;
    if (threadIdx.x == 0) (void)xb_add(&bar[XB_XCNT(b.x)], 1u);
    return b;
}
DI void xcd_barrier_complete(unsigned* bar, unsigned x, unsigned& nloc, unsigned& nx) {
    const unsigned G = gridDim.x * gridDim.y * gridDim.z;
    unsigned sum, cnt, mine, sp = 0u;
    for (;;) {
        sum = 0u; cnt = 0u; mine = 0u;
#pragma unroll
        for (unsigned j = 0; j < 16; ++j) { const unsigned c = xb_ld(&bar[XB_XCNT(j)]); sum += c; cnt += (c > 0u) ? 1u : 0u; mine = (j == x) ? c : mine; }
        if (sum == G) break;
        __builtin_amdgcn_s_sleep(1);
        if ((++sp & 255u) == 0u) { if (xb_ld(&bar[XB_TMO])) break; if (sp > XB_SPIN_CAP) { atomicAdd(&bar[XB_TMO], 1u); break; } }
    }
    nloc = mine > 0u ? mine : 1u; nx = cnt > 0u ? cnt : 1u;
}
DI void xcd_barrier(const XcdBarrier& b) {
    asm volatile("s_waitcnt vmcnt(0)" ::: "memory");
    __syncthreads();
    if (threadIdx.x == 0) {
        unsigned* bar = b.bar;
        __builtin_amdgcn_s_waitcnt(0);
        unsigned nloc = b.st[0], nx = b.st[1];
        if (nloc == 0u) { xcd_barrier_complete(bar, b.x, nloc, nx); b.st[0] = nloc; b.st[1] = nx; }
        const unsigned old = xb_add(&bar[XB_XSUB(b.x)], 1u);
        const unsigned gen = old / nloc;
        if (old + 1u == (gen + 1u) * nloc) {
            __builtin_amdgcn_fence(__ATOMIC_RELEASE, "agent");
            asm volatile("s_waitcnt vmcnt(0)" ::: "memory");
            const unsigned og = xb_add(&bar[XB_TOP], 1u);
            const unsigned tg = og / nx;
            if (og + 1u == (tg + 1u) * nx) xb_add(&bar[XB_TOPGEN], 1u);
            else XB_SPIN(xb_ld(&bar[XB_TOPGEN]) == tg, bar);
            __builtin_amdgcn_fence(__ATOMIC_ACQUIRE, "agent");
            xb_add(&bar[XB_XGEN(b.x)], 1u);
            asm volatile("s_waitcnt vmcnt(0)" ::: "memory");
        } else {
            XB_SPIN(xb_ld(&bar[XB_TOPGEN]) == gen, bar);
            __builtin_amdgcn_fence(__ATOMIC_ACQUIRE, "agent");
            asm volatile("s_waitcnt vmcnt(0)" ::: "memory");
        }
    }
    __syncthreads();
}

namespace pg8 {
constexpr int BM = 256, BK = 64, HALF = 128, HTB = HALF * BK * 2, NXCD = 8, WGM = 8;
__host__ __device__ __forceinline__ int lds_byte(int r, int c) { const int st = (r >> 4) * 2 + (c >> 5), rr = r & 15, cc = c & 31, ob = rr * 64 + cc * 2; return st * 1024 + (ob ^ (((ob >> 9) & 1) << 5)); }
__host__ __device__ __forceinline__ void stage_rc(int b, int& R, int& C) { const int st = b / 1024, sb = b % 1024, swz = sb ^ (((sb >> 9) & 1) << 5); R = (st >> 1) * 16 + swz / 64; C = (st & 1) * 32 + (swz % 64) / 2; }
__host__ __device__ __forceinline__ int perm32(int rho) { const int n = rho >> 4, i = rho & 15; return 8 * (i >> 2) + 4 * n + (i & 3); }
struct Unit { int pm, pn, pk; };
struct Gemm { const bf16_t* A; const bf16_t* Bt; int M, N, K, lda; };
struct StaticOrder {
    int nM, nN, nwg, G, c, KS;
    __host__ __device__ void init(int M, int N, int G_, int c_, int KS_ = 1) { KS = KS_; nM = M / BM; nN = (N / BM) * KS; nwg = nM * nN; G = G_; c = c_; }
    __host__ __device__ bool next(int i, Unit& u) const {
        const long L = (long)i * G + c; if (L >= nwg) return false;
        int wgid = (int)L; { const int q = nwg / NXCD, r = nwg % NXCD, xcd = wgid % NXCD, off = wgid / NXCD; wgid = (xcd < r ? xcd * (q + 1) : r * (q + 1) + (xcd - r) * q) + off; }
        const int nig = WGM * nN, gid = wgid / nig, fm = gid * WGM, gsz = (nM - fm) < WGM ? (nM - fm) : WGM;
        u.pm = fm + ((wgid % nig) % gsz); const int pv = (wgid % nig) / gsz; u.pn = pv / KS; u.pk = pv % KS; return true;
    }
};
template <class Epi, bool SP2 = false>
__device__ __forceinline__ void gemm_phase(LAS unsigned char* lds, const Gemm g, const StaticOrder& S, const Epi& E, const int tid, const bool ALIGN_EPI) {
    const int wid = __builtin_amdgcn_readfirstlane(tid >> 6), lane = tid & 63, wr = wid >> 2, wc = wid & 3, fr = lane & 15, fq = lane >> 4;
    const int K = g.lda, nt = g.K / BK;
    unsigned voffA[2], voffB[2];
#pragma unroll
    for (int i = 0; i < 2; ++i) { int R, C; stage_rc(tid * 16 + i * 8192, R, C); const int Rb = (R & ~31) + perm32(R & 31);
        voffA[i] = (unsigned)(R * K + C) * 2u; voffB[i] = (unsigned)(Rb * K + C) * 2u; }
    const size_t kstep = (size_t)(BK * 2);
    const size_t hstep = (size_t)HALF * K * 2;
    const size_t tstep = 2 * hstep;
    const unsigned ldsw = (unsigned)wid * 1024u;
    const int aoff = lds_byte(wr * 64 + fr, fq * 8), boff = lds_byte(wc * 32 + fr, fq * 8);
#define PG8_SA(b, h) (((b) * 2 + (h)) * HTB)
#define PG8_SB(b, h) ((4 + (b) * 2 + (h)) * HTB)
#define PG8_STAGE(bufoff, gbase, voff) do { _Pragma("unroll") for (int _i = 0; _i < 2; ++_i) \
        __builtin_amdgcn_global_load_lds((const unsigned*)((const char*)(gbase) + (voff)[_i]), (LAS unsigned*)(lds + (bufoff) + ldsw + _i * 8192), 16, 0, 0); } while (0)
#define PG8_LDA(dst, b, h) do { _Pragma("unroll") for (int m = 0; m < 4; ++m) _Pragma("unroll") for (int k = 0; k < 2; ++k) dst[m][k] = *(const LAS bf16x8*)(lds + PG8_SA(b, h) + aoff + m * 2048 + k * 1024); } while (0)
#define PG8_LDB(dst, b, h) do { _Pragma("unroll") for (int n = 0; n < 2; ++n) _Pragma("unroll") for (int k = 0; k < 2; ++k) dst[n][k] = *(const LAS bf16x8*)(lds + PG8_SB(b, h) + boff + n * 2048 + k * 1024); } while (0)
#define PG8_MMA(ai, bj, At, Bt) do { __builtin_amdgcn_s_setprio(1); _Pragma("unroll") for (int m = 0; m < 4; ++m) _Pragma("unroll") for (int n = 0; n < 2; ++n) _Pragma("unroll") for (int k = 0; k < 2; ++k) \
        acc[ai][bj][m][n] = __builtin_amdgcn_mfma_f32_16x16x32_bf16(Bt[n][k], At[m][k], acc[ai][bj][m][n], 0, 0, 0); __builtin_amdgcn_s_setprio(0); } while (0)
#define PG8_WAIT_V(n) asm volatile("s_waitcnt vmcnt(" #n ")" ::: "memory")
#define PG8_WAIT_L(n) asm volatile("s_waitcnt lgkmcnt(" #n ")" ::: "memory")
#define PG8_BAR __builtin_amdgcn_s_barrier()
#define PG8_SCHED __builtin_amdgcn_sched_barrier(0)
    Unit cur, nxt; int ui = 0;
    if (!S.next(0, cur)) return;
    f32x4 acc[2][2][4][2];
#pragma unroll
    for (int a = 0; a < 2; ++a)
#pragma unroll
        for (int b = 0; b < 2; ++b)
#pragma unroll
            for (int m = 0; m < 4; ++m)
#pragma unroll
                for (int n = 0; n < 2; ++n) acc[a][b][m][n] = (f32x4){0.f, 0.f, 0.f, 0.f};
    bf16x8 At[4][2], B0[2][2], B1[2][2];
    const size_t ksplit = (size_t)g.K * 2;
    const char* cA = (const char*)g.A + (size_t)cur.pm * tstep + cur.pk * ksplit; const char* cB = (const char*)g.Bt + (size_t)cur.pn * tstep + cur.pk * ksplit;
    if constexpr (SP2) {
        PG8_STAGE(PG8_SB(0, 0), cB, voffB); PG8_STAGE(PG8_SB(0, 1), cB + hstep, voffB); PG8_STAGE(PG8_SA(0, 0), cA, voffA); PG8_STAGE(PG8_SA(0, 1), cA + hstep, voffA);
        if (wr == 1) PG8_BAR;
        PG8_WAIT_V(2); PG8_BAR;
        PG8_STAGE(PG8_SB(1, 0), cB + kstep, voffB); PG8_STAGE(PG8_SA(1, 0), cA + kstep, voffA); PG8_STAGE(PG8_SB(1, 1), cB + hstep + kstep, voffB);
        PG8_WAIT_V(6); PG8_BAR;
    } else {
        PG8_STAGE(PG8_SB(0, 0), cB, voffB); PG8_STAGE(PG8_SA(0, 0), cA, voffA); PG8_STAGE(PG8_SB(0, 1), cB + hstep, voffB); PG8_STAGE(PG8_SA(0, 1), cA + hstep, voffA);
        if (wr == 1) PG8_BAR;
        PG8_WAIT_V(4); PG8_BAR;
        PG8_STAGE(PG8_SB(1, 0), cB + kstep, voffB); PG8_STAGE(PG8_SA(1, 0), cA + kstep, voffA); PG8_STAGE(PG8_SB(1, 1), cB + hstep + kstep, voffB);
        PG8_WAIT_V(6); PG8_BAR;
    }
    for (;;) {
        const bool has_next = S.next(ui + 1, nxt);
        const char* nA = has_next ? (const char*)g.A + (size_t)nxt.pm * tstep + nxt.pk * ksplit : cA; const char* nB = has_next ? (const char*)g.Bt + (size_t)nxt.pn * tstep + nxt.pk * ksplit : cB;
        for (int t = 0; t < nt; t += 2) {
            const bool last = (t == nt - 2);
            const char* a1 = cA + (size_t)(t + 1) * kstep;
            const char* a2 = last ? nA : cA + (size_t)(t + 2) * kstep; const char* b2 = last ? nB : cB + (size_t)(t + 2) * kstep;
            const char* a3 = a2 + kstep; const char* b3 = b2 + kstep;
            if constexpr (SP2) {
            PG8_LDB(B0, 0, 0); PG8_LDB(B1, 0, 1); PG8_SCHED; PG8_LDA(At, 0, 0); PG8_STAGE(PG8_SA(1, 1), a1 + hstep, voffA);
            PG8_WAIT_V(8); PG8_WAIT_L(0); PG8_BAR; PG8_MMA(0, 0, At, B0); PG8_MMA(0, 1, At, B1); PG8_BAR; PG8_SCHED;
            PG8_LDA(At, 0, 1); PG8_STAGE(PG8_SB(0, 0), b2, voffB); PG8_STAGE(PG8_SB(0, 1), b2 + hstep, voffB); PG8_STAGE(PG8_SA(0, 0), a2, voffA);
            PG8_WAIT_V(8); PG8_WAIT_L(0); PG8_BAR; PG8_MMA(1, 0, At, B0); PG8_MMA(1, 1, At, B1); PG8_BAR; PG8_SCHED;
            PG8_LDB(B0, 1, 0); PG8_LDB(B1, 1, 1); PG8_SCHED; PG8_LDA(At, 1, 0); PG8_STAGE(PG8_SA(0, 1), a2 + hstep, voffA);
            PG8_WAIT_V(8); PG8_WAIT_L(0); PG8_BAR; PG8_MMA(0, 0, At, B0); PG8_MMA(0, 1, At, B1); PG8_BAR; PG8_SCHED;
            PG8_LDA(At, 1, 1); PG8_STAGE(PG8_SB(1, 0), b3, voffB); PG8_STAGE(PG8_SB(1, 1), b3 + hstep, voffB); PG8_STAGE(PG8_SA(1, 0), a3, voffA);
            PG8_WAIT_V(8); PG8_WAIT_L(0); PG8_BAR; PG8_MMA(1, 0, At, B0); PG8_MMA(1, 1, At, B1); PG8_BAR; PG8_SCHED;
            } else {
            PG8_LDB(B0, 0, 0); PG8_SCHED; PG8_LDA(At, 0, 0); PG8_STAGE(PG8_SA(1, 1), a1 + hstep, voffA);
            PG8_WAIT_L(8); PG8_BAR; PG8_WAIT_L(0); PG8_MMA(0, 0, At, B0); PG8_BAR; PG8_SCHED;
            PG8_LDB(B1, 0, 1); PG8_STAGE(PG8_SB(0, 0), b2, voffB);
            PG8_BAR; PG8_WAIT_L(0); PG8_MMA(0, 1, At, B1); PG8_BAR;
            PG8_LDA(At, 0, 1); PG8_STAGE(PG8_SA(0, 0), a2, voffA);
            PG8_BAR; PG8_WAIT_L(0); PG8_MMA(1, 0, At, B0); PG8_BAR; PG8_SCHED;
            PG8_STAGE(PG8_SB(0, 1), b2 + hstep, voffB);
            PG8_WAIT_V(6); PG8_BAR; PG8_MMA(1, 1, At, B1); PG8_BAR;
            PG8_LDB(B0, 1, 0); PG8_SCHED; PG8_LDA(At, 1, 0); PG8_STAGE(PG8_SA(0, 1), a2 + hstep, voffA);
            PG8_WAIT_L(8); PG8_BAR; PG8_WAIT_L(0); PG8_MMA(0, 0, At, B0); PG8_BAR; PG8_SCHED;
            PG8_LDB(B1, 1, 1); PG8_STAGE(PG8_SB(1, 0), b3, voffB);
            PG8_BAR; PG8_WAIT_L(0); PG8_MMA(0, 1, At, B1); PG8_BAR;
            PG8_LDA(At, 1, 1); PG8_STAGE(PG8_SA(1, 0), a3, voffA);
            PG8_BAR; PG8_WAIT_L(0); PG8_MMA(1, 0, At, B0); PG8_BAR; PG8_SCHED;
            PG8_STAGE(PG8_SB(1, 1), b3 + hstep, voffB);
            PG8_WAIT_V(6); PG8_BAR; PG8_MMA(1, 1, At, B1); PG8_BAR;
            }
        }
        if (ALIGN_EPI) { if (wr == 0) PG8_BAR; }
        E(acc, cur, wr, wc, fr, fq);
        if (!has_next) break;
#pragma unroll
        for (int a = 0; a < 2; ++a)
#pragma unroll
            for (int b = 0; b < 2; ++b)
#pragma unroll
                for (int m = 0; m < 4; ++m)
#pragma unroll
                    for (int n = 0; n < 2; ++n) acc[a][b][m][n] = (f32x4){0.f, 0.f, 0.f, 0.f};
        cur = nxt; cA = nA; cB = nB; ++ui;
        if (ALIGN_EPI) { if (wr == 1) PG8_BAR; }
    }
    PG8_WAIT_V(0);
    if (!ALIGN_EPI) { if (wr == 0) PG8_BAR; }
    PG8_BAR;
#undef PG8_SA
#undef PG8_SB
#undef PG8_STAGE
#undef PG8_LDA
#undef PG8_LDB
#undef PG8_MMA
#undef PG8_WAIT_V
#undef PG8_WAIT_L
#undef PG8_BAR
#undef PG8_SCHED
}

template <int ACT> struct EpiBf16 {
    bf16_t* O; int ldc;
    __device__ __forceinline__ void operator()(const f32x4 (&acc)[2][2][4][2], const Unit& u, int wr, int wc, int fr, int fq) const {
        const int row0 = u.pm * BM + wr * 64 + fr, col0 = u.pn * BM + wc * 32 + 8 * fq;
#pragma unroll
        for (int ai = 0; ai < 2; ++ai)
#pragma unroll
            for (int m = 0; m < 4; ++m) { bf16_t* rowp = O + (size_t)(row0 + ai * HALF + m * 16) * ldc + col0;
#pragma unroll
                for (int bj = 0; bj < 2; ++bj) { f32x4 v0 = acc[ai][bj][m][0], v1 = acc[ai][bj][m][1];
                    if (ACT == 1) {
#pragma unroll
                        for (int q = 0; q < 4; ++q) { float a = fmaxf(v0[q], 0.f), b = fmaxf(v1[q], 0.f); v0[q] = a * a; v1[q] = b * b; } }
                    u32x4 w; w.x = pk2(v0[0], v0[1]); w.y = pk2(v0[2], v0[3]); w.z = pk2(v1[0], v1[1]); w.w = pk2(v1[2], v1[3]);
                    *(u32x4*)(rowp + bj * HALF) = w; } }
    }
};
struct EpiResid {
    const float* gate; bf16_t* pb;
    __device__ __forceinline__ void operator()(const f32x4 (&acc)[2][2][4][2], const Unit& u, int wr, int wc, int fr, int fq) const {
        const int rowb = u.pm * BM; const float* gp = gate + modrow_of(rowb) * 6144;
        const int row0 = rowb + wr * 64 + fr, col0 = u.pn * BM + wc * 32 + 8 * fq;
        bf16_t* pbk = pb + (size_t)u.pk * ((size_t)NTOK * 1024);
        f32x4 gv[2][2];
#pragma unroll
        for (int bj = 0; bj < 2; ++bj)
#pragma unroll
            for (int n = 0; n < 2; ++n) gv[bj][n] = *(const f32x4*)(gp + col0 + bj * HALF + 4 * n);
#pragma unroll
        for (int ai = 0; ai < 2; ++ai)
#pragma unroll
            for (int m = 0; m < 4; ++m) { const size_t ro = (size_t)(row0 + ai * HALF + m * 16) * 1024 + col0;
#pragma unroll
                for (int bj = 0; bj < 2; ++bj) { const f32x4 v0 = gv[bj][0] * acc[ai][bj][m][0], v1 = gv[bj][1] * acc[ai][bj][m][1];
                    u32x4 w; w.x = pk2(v0[0], v0[1]); w.y = pk2(v0[2], v0[3]); w.z = pk2(v1[0], v1[1]); w.w = pk2(v1[2], v1[3]);
                    *(u32x4*)(pbk + ro + bj * HALF) = w; } }
    }
};
struct EpiAny {
    int mode; bf16_t* O; int ldc; const float* gate;
    __device__ __forceinline__ void operator()(const f32x4 (&acc)[2][2][4][2], const Unit& u, int wr, int wc, int fr, int fq) const {
        const int rowb = u.pm * BM, row0 = rowb + wr * 64 + fr, col0 = u.pn * BM + wc * 32 + 8 * fq;
        bf16_t* base = O;
        f32x4 gv[2][2];
#pragma unroll
        for (int bj = 0; bj < 2; ++bj)
#pragma unroll
            for (int n = 0; n < 2; ++n) gv[bj][n] = (f32x4){1.f, 1.f, 1.f, 1.f};
        if (mode == 2) {
            const float* gp = gate + modrow_of(rowb) * 6144; base = O + (size_t)u.pk * ((size_t)NTOK * 1024);
#pragma unroll
            for (int bj = 0; bj < 2; ++bj)
#pragma unroll
                for (int n = 0; n < 2; ++n) gv[bj][n] = *(const f32x4*)(gp + col0 + bj * HALF + 4 * n);
        }
#pragma unroll
        for (int ai = 0; ai < 2; ++ai)
#pragma unroll
            for (int m = 0; m < 4; ++m) { bf16_t* rowp = base + (size_t)(row0 + ai * HALF + m * 16) * ldc + col0;
#pragma unroll
                for (int bj = 0; bj < 2; ++bj) { f32x4 v0 = acc[ai][bj][m][0], v1 = acc[ai][bj][m][1];
                    if (mode == 1) {
#pragma unroll
                        for (int q = 0; q < 4; ++q) { const float a = fmaxf(v0[q], 0.f), b = fmaxf(v1[q], 0.f); v0[q] = a * a; v1[q] = b * b; } }
                    v0 = v0 * gv[bj][0]; v1 = v1 * gv[bj][1];
                    u32x4 w; w.x = pk2(v0[0], v0[1]); w.y = pk2(v0[2], v0[3]); w.z = pk2(v1[0], v1[1]); w.w = pk2(v1[2], v1[3]);
                    *(u32x4*)(rowp + bj * HALF) = w; } }
    }
};
}

DI void transpose_unit(const float* __restrict__ W, int K, int N, int Npad, bf16_t* WT, int unit, int lane, LAS unsigned char* scr) {
    const int nblk = Npad / 64, kb = unit / nblk, nb = unit % nblk, n = nb * 64 + lane, k0 = kb * 64;
    u32x4 o[8];
    if (n < N) {
        float v[64];
#pragma unroll
        for (int kk = 0; kk < 64; ++kk) v[kk] = W[(size_t)(k0 + kk) * N + n];
#pragma unroll
        for (int q = 0; q < 8; ++q) { o[q].x = pk2(v[8 * q], v[8 * q + 1]); o[q].y = pk2(v[8 * q + 2], v[8 * q + 3]); o[q].z = pk2(v[8 * q + 4], v[8 * q + 5]); o[q].w = pk2(v[8 * q + 6], v[8 * q + 7]); }
    } else {
#pragma unroll
        for (int q = 0; q < 8; ++q) o[q] = (u32x4){0u, 0u, 0u, 0u};
    }
#pragma unroll
    for (int q = 0; q < 8; ++q) *(LAS u32x4*)(scr + lane * 144 + q * 16) = o[q];
    __builtin_amdgcn_fence(__ATOMIC_RELEASE, "wavefront"); __builtin_amdgcn_wave_barrier();
    const int ch = lane & 7, rb = lane >> 3;
#pragma unroll
    for (int j = 0; j < 8; ++j) { const int row = rb + 8 * j; const u32x4 w = *(const LAS u32x4*)(scr + row * 144 + ch * 16);
        *(u32x4*)(WT + (size_t)(nb * 64 + row) * K + k0 + ch * 8) = w; }
    __builtin_amdgcn_fence(__ATOMIC_RELEASE, "wavefront"); __builtin_amdgcn_wave_barrier();
}

DI void phase_p0(const Params& p, LAS unsigned char* lds, const int tid) {
    const int lane = tid & 63, wid = tid >> 6, G = gridDim.x, bid = blockIdx.x;
    const float* c = p.IN(5); const float* c_ctx = p.IN(6); const float* ada_w = p.IN(9); const float* ada_b = p.IN(10);
    float* mod = (float*)(p.ws + WS_MOD);
    LAS float* st = (LAS float*)lds + wid * 640;
    LAS float* red = (LAS float*)(lds + 32768);
    for (int bu = bid; bu < 192; bu += G) {
        const int l = bu / 96, cgp = bu % 96, col = cgp * 64 + lane;
        for (int i = lane; i < 640; i += 64) { const int row = i / 128, k = wid * 128 + (i % 128); const float cv = row == 0 ? c_ctx[k] : c[(row - 1) * 1024 + k]; st[i] = siluf_(cv); }
        __syncthreads();
        float acc[5] = {0.f, 0.f, 0.f, 0.f, 0.f};
        const float* W = ada_w + (size_t)l * 1024 * 6144 + (size_t)(wid * 128) * 6144 + col;
#pragma unroll 16
        for (int kk = 0; kk < 128; ++kk) { const float w = W[(size_t)kk * 6144];
#pragma unroll
            for (int row = 0; row < 5; ++row) acc[row] += st[row * 128 + kk] * w; }
#pragma unroll
        for (int row = 0; row < 5; ++row) red[(wid * 5 + row) * 64 + lane] = acc[row];
        __syncthreads();
        if (tid < 320) { const int row = tid / 64, ln = tid % 64; float s = 0.f;
#pragma unroll
            for (int w = 0; w < 8; ++w) s += red[(w * 5 + row) * 64 + ln];
            const int cc = cgp * 64 + ln; mod[(l * 5 + row) * 6144 + cc] = s + ada_b[l * 6144 + cc]; }
        __syncthreads();
    }
    const int gw = bid * 8 + wid, GW = G * 8;
    LAS unsigned char* scr = lds + 65536 + wid * 9216;
    for (int u = gw; u < 6400; u += GW) {
        const int l = u / 3200; int r = u % 3200;
        const float* W; bf16_t* WT; int K, N, Npad;
        if (r < 896) { W = p.IN(11) + (size_t)l * 1024 * PW; K = 1024; N = PW; Npad = NP; WT = (bf16_t*)(p.ws + WS_WIN) + (size_t)l * NP * 1024; }
        else if (r < 1152) { W = p.IN(12) + (size_t)l * 1024 * 1024; K = 1024; N = 1024; Npad = 1024; WT = (bf16_t*)(p.ws + WS_WOUT) + (size_t)l * 1024 * 1024; r -= 896; }
        else if (r < 2176) { W = p.IN(26) + (size_t)l * 1024 * 4096; K = 1024; N = 4096; Npad = 4096; WT = (bf16_t*)(p.ws + WS_W1) + (size_t)l * 4096 * 1024; r -= 1152; }
        else { W = p.IN(27) + (size_t)l * 4096 * 1024; K = 4096; N = 1024; Npad = 1024; WT = (bf16_t*)(p.ws + WS_W2) + (size_t)l * 1024 * 4096; r -= 2176; }
        transpose_unit(W, K, N, Npad, WT, r, lane, scr);
    }
}

DI void phase_norm(const Params& p, int l, int which, const int tid, const bool dry = false) {
    const int lane = tid & 63, wid = tid >> 6, gw = blockIdx.x * 8 + wid, GW = gridDim.x * 8;
    const float* mod = (const float*)(p.ws + WS_MOD);
    bf16_t* hm = (bf16_t*)(p.ws + (dry ? WS_OI : WS_HM));
    float* xo = dry ? (float*)(p.ws + WS_HL) : p.out;
    const float* g = which == 0 ? p.IN(7) + l * 1024 : (which == 1 ? p.IN(8) + l * 1024 : p.IN(28));
    const bool first = (which == 0 && l == 0), from_in = (l == 0 && which != 2);
    for (int row0 = gw; row0 < NTOK; row0 += 4 * GW) {
        f32x4 v[4][4]; float ss[4];
#pragma unroll
        for (int k = 0; k < 4; ++k) {
            const int row = row0 + k * GW; ss[k] = 0.f;
            if (row < NTOK) {
                const float* xr = from_in ? (row < 4096 ? p.IN(0) + (size_t)row * 1024 : p.IN(1) + (size_t)(row - 4096) * 1024) : p.out + (size_t)row * 1024;
#pragma unroll
                for (int j = 0; j < 4; ++j) v[k][j] = ((const f32x4*)xr)[lane + 64 * j];
                if (!first) {
                    const bf16_t* pr = (const bf16_t*)(p.ws + WS_DSA) + (size_t)row * 1024;
#pragma unroll
                    for (int j = 0; j < 4; ++j) { const u32x2 pp = ((const u32x2*)pr)[lane + 64 * j], pq = ((const u32x2*)(pr + (size_t)NTOK * 1024))[lane + 64 * j];
                        v[k][j].x += __uint_as_float(pp.x << 16) + __uint_as_float(pq.x << 16); v[k][j].y += __uint_as_float(pp.x & 0xffff0000u) + __uint_as_float(pq.x & 0xffff0000u);
                        v[k][j].z += __uint_as_float(pp.y << 16) + __uint_as_float(pq.y << 16); v[k][j].w += __uint_as_float(pp.y & 0xffff0000u) + __uint_as_float(pq.y & 0xffff0000u); }
                }
            }
        }
#pragma unroll
        for (int k = 0; k < 4; ++k) {
            const int row = row0 + k * GW;
            if (row < NTOK) {
#pragma unroll
                for (int j = 0; j < 4; ++j) ss[k] += (v[k][j].x * v[k][j].x + v[k][j].y * v[k][j].y) + (v[k][j].z * v[k][j].z + v[k][j].w * v[k][j].w);
            }
        }
#pragma unroll
        for (int o = 1; o < 64; o <<= 1) {
#pragma unroll
            for (int k = 0; k < 4; ++k) ss[k] += shx(ss[k], lane, o);
        }
#pragma unroll
        for (int k = 0; k < 4; ++k) {
            const int row = row0 + k * GW;
            if (row < NTOK) {
                const float rstd = rsqrtf(ss[k] * (1.f / 1024.f) + 1e-6f);
                if (which == 2) {
                    float* yo = xo + (size_t)row * 1024;
#pragma unroll
                    for (int j = 0; j < 4; ++j) { const f32x4 gv = ((const f32x4*)g)[lane + 64 * j]; ((f32x4*)yo)[lane + 64 * j] = v[k][j] * rstd * gv; }
                } else {
                    const float* mr = mod + (size_t)(l * 5 + modrow_of(row)) * 6144 + (which == 0 ? 0 : 3072);
#pragma unroll
                    for (int j = 0; j < 4; ++j) { const f32x4 gv = ((const f32x4*)g)[lane + 64 * j]; const f32x4 sh = ((const f32x4*)mr)[lane + 64 * j], sc = ((const f32x4*)(mr + 1024))[lane + 64 * j];
                        const f32x4 hv = v[k][j] * rstd * gv * (sc + 1.f) + sh;
                        u32x2 o; o.x = pk2(hv.x, hv.y); o.y = pk2(hv.z, hv.w);
                        ((u32x2*)(hm + (size_t)row * 1024))[lane + 64 * j] = o;
                        if (!first) ((f32x4*)(xo + (size_t)row * 1024))[lane + 64 * j] = v[k][j]; }
                }
            }
        }
    }
}

constexpr int M1_TILE_BYTES = 66048, M1_WL_BYTES = 9216;
template <int NCOL8, int NROWS> struct StageRegs { static constexpr int NCH = NCOL8 * NROWS, IT = (NCH + 511) / 512; u32x4 v[IT]; };
template <int NCOL8, int NROWS>
DI void stage_load(StageRegs<NCOL8, NROWS>& R, const char* proj, int row_first, int col0, int s0, int s1, int tid) {
    constexpr int NCH = NCOL8 * NROWS, IT = (NCH + 511) / 512;
#pragma unroll
    for (int i = 0; i < IT; ++i) { const int id = tid + 512 * i; const int row = id / NCOL8, cc = id % NCOL8, t = row_first + row;
        R.v[i] = (u32x4){0u, 0u, 0u, 0u};
        if (id < NCH && t >= s0 && t < s1) R.v[i] = *(const u32x4*)(proj + ((size_t)t * NP + col0 + cc * 8) * 2); }
}
template <int NCOL8, int NROWS>
DI void stage_store(const StageRegs<NCOL8, NROWS>& R, LAS unsigned char* tile, int pitchB, int dstB, int tid) {
    constexpr int NCH = NCOL8 * NROWS, IT = (NCH + 511) / 512;
#pragma unroll
    for (int i = 0; i < IT; ++i) { const int id = tid + 512 * i; const int row = id / NCOL8, cc = id % NCOL8;
        if (id < NCH) *(LAS u32x4*)(tile + row * pitchB + dstB + cc * 16) = R.v[i]; }
}

template <int MIX>
DI void m1_gla_wave(const Params& p, int l, int c, int hd, int dir, const LAS unsigned char* tile, LAS unsigned char* wl, const LAS unsigned char* wlp, int lane) {
    constexpr int DK = MIX == 0 ? 64 : 32, NT = DK / 32, PITCH = DK + 8, TP = MIX == 0 ? 1032 : 552;
    const int r = lane & 31, hh = lane >> 5, tok0 = c * 32;
    const LAS bf16_t* T = (const LAS bf16_t*)tile;
    LAS bf16_t* Qt = (LAS bf16_t*)wl; LAS bf16_t* Kt = Qt + 32 * PITCH;
    char* DS = (char*)(p.ws + (MIX == 0 ? WS_DSA : WS_DSB));
    float* ACH = (float*)(p.ws + (MIX == 0 ? WS_ACHA : WS_ACHB));
    char* QH = (char*)(p.ws + (MIX == 0 ? WS_QHA : WS_QHB));
    float* OI = (float*)(p.ws + WS_OI);
    const int tba = 4 * hh * TP, tb = tba + r;
#define TROW(li) ((8 * ((li) >> 2) + ((li) & 3)) * TP)
    const int vcol = MIX == 0 ? 256 + hd * 64 : 256 + hd * 64;
    bf16x8 vf[2][2];
#pragma unroll
    for (int n = 0; n < 2; ++n)
#pragma unroll
        for (int st = 0; st < 2; ++st)
#pragma unroll
            for (int j = 0; j < 8; ++j) vf[n][st][j] = (short)T[tb + TROW(8 * st + j) + vcol + 32 * n];
    const int qcol = MIX == 0 ? hd * 64 : hd * 32;
#pragma unroll 1
    for (int m = 0; m < NT; ++m) {
        float la[16], kk[16];
        if (MIX == 0) {
            const int zcol = (dir == 0 ? 512 : 768) + hd * 64 + 32 * m;
            const float* lbl = p.IN(13);
            float lb = 0.f;
            if (l == 1) { const int ch = hd * 64 + 32 * m + r; const float l0 = lbl[(0 * 2 + dir) * 256 + ch], l1 = lbl[(1 * 2 + dir) * 256 + ch]; lb = rcpf_(1.f + __expf(l0 - l1)); }
#pragma unroll
            for (int li = 0; li < 16; ++li) { const float z = bf2f(T[tb + TROW(li) + zcol]);
                const float e = __expf(-z), sg = rcpf_(1.f + e), omsg = e * sg;
                const float f = lb + (1.f - lb) * sg; kk[li] = (1.f - lb) * omsg; la[li] = __logf(fmaxf(f, 1e-20f)); }
        } else {
            const int kcol = 128 + hd * 32, acol = 512 + dir * 16;
            float w2[16];
#pragma unroll
            for (int rho = 0; rho < 16; ++rho) w2[rho] = p.IN(15)[((l * 2 + dir) * 16 + rho) * 128 + hd * 32 + r];
            const float ba = p.IN(16)[(l * 2 + dir) * 128 + hd * 32 + r];
#pragma unroll
            for (int li = 0; li < 16; ++li) {
                const u32x4 a0 = *(const LAS u32x4*)(T + tba + TROW(li) + acol), a1 = *(const LAS u32x4*)(T + tba + TROW(li) + acol + 8);
                float w = ba;
#pragma unroll
                for (int qd = 0; qd < 4; ++qd) { w += __uint_as_float(a0[qd] << 16) * w2[2 * qd] + __uint_as_float(a0[qd] & 0xffff0000u) * w2[2 * qd + 1];
                    w += __uint_as_float(a1[qd] << 16) * w2[8 + 2 * qd] + __uint_as_float(a1[qd] & 0xffff0000u) * w2[8 + 2 * qd + 1]; }
                const float ls = fminf(w, 0.f) - __logf(1.f + __expf(-fabsf(w)));
                la[li] = ls * (1.f / 16.f);
                kk[li] = bf2f(T[tb + TROW(li) + kcol]);
            }
        }
        float gs[4], pgs[4];
#pragma unroll
        for (int g = 0; g < 4; ++g) { gs[g] = (la[4 * g] + la[4 * g + 1]) + (la[4 * g + 2] + la[4 * g + 3]); pgs[g] = shx(gs[g], lane, 32); }
        float run = 0.f, half = 0.f; float cum[16];
#pragma unroll
        for (int g = 0; g < 4; ++g) { float b = run + (hh ? pgs[g] : 0.f); run += gs[g] + pgs[g]; if (g == 1) half = run;
#pragma unroll
            for (int i = 0; i < 4; ++i) { b += la[4 * g + i]; cum[4 * g + i] = b; } }
        const float total = run;
        const float ref = dir == 0 ? half : total - half;
        float kh[16];
        const unsigned qhb = MIX == 0 ? (unsigned)((tok0 + 4 * hh) * 512 + dir * 256 + hd * 64 + 32 * m + r) * 2u : (unsigned)((tok0 + 4 * hh) * 256 + dir * 128 + hd * 32 + r) * 2u;
#pragma unroll
        for (int li = 0; li < 16; ++li) {
            const float cv = dir == 0 ? cum[li] : (total - cum[li] + la[li]);
            const float eq = __expf(fminf(cv - ref, 80.f)), ek = __expf(fminf(ref - cv, 80.f));
            const int tkl = 8 * (li >> 2) + (li & 3);
            const float qv = bf2f(T[tb + TROW(li) + qcol + 32 * m]) * (MIX == 1 ? 0.17677669529663687f : 1.f);
            Qt[(tkl + 4 * hh) * PITCH + 32 * m + r] = f2bf(qv * eq);
            Kt[(tkl + 4 * hh) * PITCH + 32 * m + r] = f2bf(kk[li] * ek);
            kh[li] = kk[li] * __expf(total - cv);
            const float qh = qv * __expf(cv);
            *(bf16_t*)(QH + (qhb + (unsigned)(tkl * (MIX == 0 ? 512 : 256) * 2))) = f2bf(qh);
        }
        const bf16x8 khat0 = pack8(kh), khat1 = pack8(kh + 8);
        if (hh == 0) ACH[((c * 4 + hd) * 2 + dir) * DK + 32 * m + r] = __expf(total);
#pragma unroll
        for (int n = 0; n < 2; ++n) {
            f32x16 ds = zero16();
            ds = MFMA32(khat0, vf[n][0], ds); ds = MFMA32(khat1, vf[n][1], ds);
            const unsigned dsb = (unsigned)(((c * 4 + hd) * 2 + dir) * (DK * 64) * 2) + (unsigned)((n * (DK / 16) + 2 * m) * 1024 + r * 16 + hh * 8);
#pragma unroll
            for (int g = 0; g < 4; ++g) { u32x2 w; w.x = pk2(ds[4 * g], ds[4 * g + 1]); w.y = pk2(ds[4 * g + 2], ds[4 * g + 3]);
                *(u32x2*)(DS + (dsb + (unsigned)((g >> 1) * 1024 + (g & 1) * 512))) = w; }
        }
    }
#undef TROW
    __builtin_amdgcn_fence(__ATOMIC_RELEASE, "wavefront");
    __builtin_amdgcn_wave_barrier();
    f32x16 pt = zero16();
#pragma unroll
    for (int s = 0; s < DK / 16; ++s) {
        const bf16x8 kfr = *(const LAS bf16x8*)(Kt + r * PITCH + 16 * s + 8 * hh);
        const bf16x8 qfr = *(const LAS bf16x8*)(Qt + r * PITCH + 16 * s + 8 * hh);
        pt = MFMA32(kfr, qfr, pt);
    }
    __builtin_amdgcn_fence(__ATOMIC_RELEASE, "wavefront");
    __builtin_amdgcn_wave_barrier();
    LAS float* ex = (LAS float*)wl; const LAS float* exp_ = (const LAS float*)wlp;
#pragma unroll
    for (int i = 0; i < 16; ++i) { const int srow = crow(i, hh); const bool keep = dir == 0 ? (srow <= r) : (srow >= r); pt[i] = keep ? pt[i] : 0.f; ex[i * 64 + lane] = pt[i]; }
    __syncthreads();
    float ptv[16];
#pragma unroll
    for (int i = 0; i < 16; ++i) ptv[i] = pt[i] + exp_[i * 64 + lane];
    const bf16x8 pf0 = pack8(ptv), pf1 = pack8(ptv + 8);
    float* oi = OI + (size_t)((MIX * 256 + c) * 4 + hd) * 2048;
    {
        f32x16 ot = zero16();
        const bf16x8 va = dir == 0 ? vf[0][0] : vf[1][0], vb = dir == 0 ? vf[0][1] : vf[1][1];
        ot = MFMA32(va, pf0, ot); ot = MFMA32(vb, pf1, ot);
#pragma unroll
        for (int g = 0; g < 4; ++g) *(f32x4*)(oi + ((dir * 4 + g) * 64 + lane) * 4) = (f32x4){ot[4 * g], ot[4 * g + 1], ot[4 * g + 2], ot[4 * g + 3]};
    }
}

DI void m1_rg_wave(const Params& p, int l, int c, int nb, int dir, const LAS unsigned char* tile, int lane) {
    constexpr int TP = 264;
    const int r = lane & 31, hh = lane >> 5, tok0 = c * 32;
    const LAS bf16_t* T = (const LAS bf16_t*)tile;
    float* HL = (float*)(p.ws + WS_HL); float* CP = (float*)(p.ws + WS_CP);
    float* RAGA = (float*)(p.ws + WS_RAGA); float* RAGH = (float*)(p.ws + WS_RAGH);
    const int sgn = dir ? -1 : 1, lbase = dir ? 31 : 0;
    const float* cw = p.IN(18) + (size_t)(l * 2 + dir) * 4 * 256;
    const float* cb = p.IN(19) + (size_t)(l * 2 + dir) * 256;
    bf16x8 af[4];
    const int trow = lbase + sgn * r + 3;
#pragma unroll
    for (int s = 0; s < 4; ++s) {
        const int ch0 = 64 * nb + 16 * s + 8 * hh;
        float xc[8];
        { const f32x4 b0 = *(const f32x4*)(cb + ch0), b1 = *(const f32x4*)(cb + ch0 + 4);
          xc[0] = b0.x; xc[1] = b0.y; xc[2] = b0.z; xc[3] = b0.w; xc[4] = b1.x; xc[5] = b1.y; xc[6] = b1.z; xc[7] = b1.w; }
#pragma unroll
        for (int tap = 0; tap < 4; ++tap) {
            const u32x4 uu = *(const LAS u32x4*)(T + (trow + sgn * (tap - 3)) * TP + ch0);
            const f32x4 w0 = *(const f32x4*)(cw + tap * 256 + ch0), w1 = *(const f32x4*)(cw + tap * 256 + ch0 + 4);
            xc[0] += w0.x * __uint_as_float(uu.x << 16); xc[1] += w0.y * __uint_as_float(uu.x & 0xffff0000u);
            xc[2] += w0.z * __uint_as_float(uu.y << 16); xc[3] += w0.w * __uint_as_float(uu.y & 0xffff0000u);
            xc[4] += w1.x * __uint_as_float(uu.z << 16); xc[5] += w1.y * __uint_as_float(uu.z & 0xffff0000u);
            xc[6] += w1.z * __uint_as_float(uu.w << 16); xc[7] += w1.w * __uint_as_float(uu.w & 0xffff0000u);
        }
        af[s] = pack8(xc);
    }
    const float* wr_ = p.IN(20) + (size_t)((l * 2 + dir) * 4 + nb) * 4096;
    const float* wi_ = p.IN(22) + (size_t)((l * 2 + dir) * 4 + nb) * 4096;
#pragma unroll 1
    for (int n = 0; n < 2; ++n) {
        f32x16 rr = zero16(), ri = zero16();
#pragma unroll
        for (int s = 0; s < 4; ++s) {
            float br_[8], bi_[8];
#pragma unroll
            for (int j = 0; j < 8; ++j) { br_[j] = wr_[(16 * s + 8 * hh + j) * 64 + 32 * n + r]; bi_[j] = wi_[(16 * s + 8 * hh + j) * 64 + 32 * n + r]; }
            rr = MFMA32(af[s], pack8(br_), rr); ri = MFMA32(af[s], pack8(bi_), ri);
        }
        const int ch = 64 * nb + 32 * n + r;
        const float cbv = cb[ch]; float cwv[4];
#pragma unroll
        for (int tap = 0; tap < 4; ++tap) cwv[tap] = cw[tap * 256 + ch];
        const float brv = p.IN(21)[(l * 2 + dir) * 256 + ch], biv = p.IN(23)[(l * 2 + dir) * 256 + ch];
        const float lam = p.IN(24)[(l * 2 + dir) * 256 + ch];
        const float c8 = -8.f * log1pf(__expf(-lam));
        float a[16], bx[16];
#pragma unroll
        for (int li = 0; li < 16; ++li) {
            const int tr = lbase + sgn * (8 * (li >> 2) + 4 * hh + (li & 3)) + 3;
            float xcv = cbv;
#pragma unroll
            for (int tap = 0; tap < 4; ++tap) xcv += cwv[tap] * bf2f(T[(tr + sgn * (tap - 3)) * TP + ch]);
            const float rv = sigmoidf_(rr[li] + brv), iv = sigmoidf_(ri[li] + biv);
            const float loga = c8 * rv;
            a[li] = __expf(loga); bx[li] = __builtin_amdgcn_sqrtf(om_exp(2.f * loga)) * iv * xcv;
        }
        float Ag[4], Bg[4], pA[4], pB[4];
#pragma unroll
        for (int g = 0; g < 4; ++g) { float hl = 0.f, ap = 1.f;
#pragma unroll
            for (int i = 0; i < 4; ++i) { hl = a[4 * g + i] * hl + bx[4 * g + i]; ap *= a[4 * g + i]; }
            Ag[g] = ap; Bg[g] = hl; pA[g] = shx(ap, lane, 32); pB[g] = shx(hl, lane, 32); }
        float Hrun = 0.f, Prun = 1.f;
        const bool first = (hh == 0);
#pragma unroll
        for (int g = 0; g < 4; ++g) {
            const float A0 = first ? Ag[g] : pA[g], B0 = first ? Bg[g] : pB[g];
            const float A1 = first ? pA[g] : Ag[g], B1 = first ? pB[g] : Bg[g];
            float hcur = first ? Hrun : (A0 * Hrun + B0), pcur = first ? Prun : Prun * A0;
            Hrun = A1 * (A0 * Hrun + B0) + B1; Prun = Prun * A0 * A1;
#pragma unroll
            for (int i = 0; i < 4; ++i) { hcur = a[4 * g + i] * hcur + bx[4 * g + i]; pcur *= a[4 * g + i];
                const int tg = tok0 + lbase + sgn * (8 * g + 4 * hh + i);
                HL[((size_t)dir * NTOK + tg) * 256 + ch] = hcur; CP[((size_t)dir * NTOK + tg) * 256 + ch] = pcur; }
        }
        if (hh == 0) { RAGA[(c * 2 + dir) * 256 + ch] = Prun; RAGH[(c * 2 + dir) * 256 + ch] = Hrun; }
    }
}

DI void phase_m1(const Params& p, int l, LAS unsigned char* lds, const int tid, const int stages = 7) {
    const int lane = tid & 63, wid = __builtin_amdgcn_readfirstlane(tid >> 6);
    const char* proj = (const char*)(p.ws + WS_BIG);
    LAS unsigned char* tile = lds;
    LAS unsigned char* wl = lds + M1_TILE_BYTES + wid * M1_WL_BYTES;
    LAS unsigned char* wlp = lds + M1_TILE_BYTES + (wid ^ 1) * M1_WL_BYTES;
    for (int c = blockIdx.x; c < 256; c += gridDim.x) {
        int ln = lane, td = tid; asm volatile("" : "+v"(ln), "+v"(td));
        const int tok0 = c * 32;
        int s0, s1;
        if (c < 128) { s0 = (c >> 3) * 256; s1 = s0 + 256; } else { s0 = 4096 + ((c - 128) >> 5) * 1024; s1 = s0 + 1024; }
        StageRegs<128, 32> ra; StageRegs<64, 32> rb; StageRegs<4, 32> rb2; StageRegs<32, 38> rc;
        if (stages & 1) stage_load(ra, proj, tok0, 0, 0, NTOK, td);
        if (stages & 2) { stage_load(rb, proj, tok0, B_Q, 0, NTOK, td); stage_load(rb2, proj, tok0, B_AF, 0, NTOK, td); }
        if (stages & 4) stage_load(rc, proj, tok0 - 3, C_X, s0, s1, td);
        if (stages & 1) {
        stage_store(ra, tile, 2064, 0, td);
        __syncthreads();
        m1_gla_wave<0>(p, l, c, wid >> 1, wid & 1, tile, wl, wlp, ln);
        __builtin_amdgcn_sched_barrier(0); asm volatile("" : "+v"(ln), "+v"(td));
        }
        if (stages & 2) {
        stage_store(rb, tile, 1104, 0, td); stage_store(rb2, tile, 1104, 1024, td);
        __syncthreads();
        m1_gla_wave<1>(p, l, c, wid >> 1, wid & 1, tile, wl, wlp, ln);
        __builtin_amdgcn_sched_barrier(0); asm volatile("" : "+v"(ln), "+v"(td));
        }
        if (stages & 4) {
        stage_store(rc, tile, 528, 0, td);
        __syncthreads();
        m1_rg_wave(p, l, c, wid >> 1, wid & 1, tile, ln);
        __syncthreads();
        }
    }
}

DI void m2_chain8(const Params& p, int l, int id, const bool dry) {
    const int sq = id / 6144; int rem = id % 6144;
    const int hd = rem / 1536, dir = (rem / 768) & 1; int f = rem % 768;
    const int mix = f < 512 ? 0 : 1; if (mix) f -= 512;
    const int dk = mix == 0 ? 64 : 32, S_ = dk / 16;
    const int lane_ = f & 63, ns = f >> 6, n = ns / S_, s = ns % S_;
    const int d0 = 16 * s + 8 * (lane_ >> 5), e = 32 * n + (lane_ & 31);
    char* DS = (char*)(p.ws + (mix == 0 ? WS_DSA : WS_DSB));
    char* DSO = dry ? (char*)(p.ws + (mix == 0 ? WS_HM : WS_BIG + 56 * MiB)) : DS;
    const float* ACH = (const float*)(p.ws + (mix == 0 ? WS_ACHA : WS_ACHB));
    float zf = 0.f; asm volatile("" : "+v"(zf));
    float S[8];
#pragma unroll
    for (int j = 0; j < 8; ++j) S[j] = zf;
    int c0, N;
    if (sq < 16) { c0 = sq * 8; N = 8; }
    else { c0 = 128 + (sq - 16) * 32; N = 32; const int b = sq - 16;
        const float* s0p = mix == 0 ? p.IN(2) + (size_t)((((b * 2 + l) * 2 + dir) * 4 + hd)) * 4096 : p.IN(3) + (size_t)((((b * 2 + l) * 2 + dir) * 4 + hd)) * 2048;
#pragma unroll
        for (int j = 0; j < 8; ++j) S[j] = s0p[(d0 + j) * 64 + e]; }
    for (int n0 = 0; n0 < N; n0 += 8) {
        u32x4 v[8]; f32x4 a0[8], a1[8];
#pragma unroll
        for (int i = 0; i < 8; ++i) { const int nn = n0 + i, c = c0 + (dir == 0 ? nn : N - 1 - nn); const size_t ui = (size_t)((c * 4 + hd) * 2 + dir);
            v[i] = *(const u32x4*)(DS + ui * (dk * 128) + f * 16); a0[i] = *(const f32x4*)(ACH + ui * dk + d0); a1[i] = *(const f32x4*)(ACH + ui * dk + d0 + 4); }
#pragma unroll
        for (int i = 0; i < 8; ++i) { const int nn = n0 + i, c = c0 + (dir == 0 ? nn : N - 1 - nn); const size_t ui = (size_t)((c * 4 + hd) * 2 + dir);
            u32x4 o; o.x = pk2(S[0], S[1]); o.y = pk2(S[2], S[3]); o.z = pk2(S[4], S[5]); o.w = pk2(S[6], S[7]);
            *(u32x4*)(DSO + ui * (dk * 128) + f * 16) = o;
            S[0] = a0[i].x * S[0] + __uint_as_float(v[i].x << 16); S[1] = a0[i].y * S[1] + __uint_as_float(v[i].x & 0xffff0000u);
            S[2] = a0[i].z * S[2] + __uint_as_float(v[i].y << 16); S[3] = a0[i].w * S[3] + __uint_as_float(v[i].y & 0xffff0000u);
            S[4] = a1[i].x * S[4] + __uint_as_float(v[i].z << 16); S[5] = a1[i].y * S[5] + __uint_as_float(v[i].z & 0xffff0000u);
            S[6] = a1[i].z * S[6] + __uint_as_float(v[i].w << 16); S[7] = a1[i].w * S[7] + __uint_as_float(v[i].w & 0xffff0000u); }
    }
    if (sq < 16) { const int b = sq;
        float* ob = dry ? (float*)(p.ws + 243 * MiB) - OUT_SH : p.out;
        float* op = mix == 0 ? ob + OUT_SH + (size_t)((((b * 2 + l) * 2 + dir) * 4 + hd)) * 4096 : ob + OUT_SG + (size_t)((((b * 2 + l) * 2 + dir) * 4 + hd)) * 2048;
#pragma unroll
        for (int j = 0; j < 8; ++j) op[(d0 + j) * 64 + e] = S[j]; }
}
DI void phase_m2(const Params& p, int l, const int tid, const bool dry = false) {
    const int gt = blockIdx.x * 512 + tid, GT = gridDim.x * 512;
    for (int id = gt; id < 20 * 6144; id += GT) m2_chain8(p, l, 20 * 6144 - 1 - id, dry);
    float* RAGH = (float*)(p.ws + WS_RAGH); const float* RAGA = (const float*)(p.ws + WS_RAGA);
    float* RAGO = dry ? (float*)(p.ws + 250 * MiB) : RAGH; float* SRO = dry ? (float*)(p.ws + 251 * MiB) - OUT_SR : p.out;
    for (int id = GT - 1 - gt; id < 20 * 512; id += GT) {
        const int sq = id / 512, dir = (id >> 8) & 1, ch = id & 255;
        int c0, N; float h = 0.f;
        if (sq < 16) { c0 = sq * 8; N = 8; } else { c0 = 128 + (sq - 16) * 32; N = 32; h = p.IN(4)[((size_t)((sq - 16) * 2 + l) * 2 + dir) * 256 + ch]; }
        for (int n0 = 0; n0 < N; n0 += 8) {
            float v[8], av[8];
#pragma unroll
            for (int i = 0; i < 8; ++i) { const int n = n0 + i, c = c0 + (dir == 0 ? n : N - 1 - n); v[i] = RAGH[(c * 2 + dir) * 256 + ch]; av[i] = RAGA[(c * 2 + dir) * 256 + ch]; }
#pragma unroll
            for (int i = 0; i < 8; ++i) { const int n = n0 + i, c = c0 + (dir == 0 ? n : N - 1 - n); RAGO[(c * 2 + dir) * 256 + ch] = h; h = av[i] * h + v[i]; }
        }
        if (sq < 16) SRO[OUT_SR + ((size_t)(sq * 2 + l) * 2 + dir) * 256 + ch] = h;
    }
}

DI void m3_gla_unit(const Params& p, int l, int c, int hd, int MIX, int lane) {
    const int DK = MIX == 0 ? 64 : 32, S_ = DK >> 4;
    const int r = lane & 31, hh = lane >> 5, tok0 = c * 32;
    const bf16_t* proj = (const bf16_t*)(p.ws + WS_BIG);
    const bf16_t* DS = (const bf16_t*)(p.ws + (MIX == 0 ? WS_DSA : WS_DSB));
    const bf16_t* QH = (const bf16_t*)(p.ws + (MIX == 0 ? WS_QHA : WS_QHB));
    const float* oi = (const float*)(p.ws + WS_OI) + (size_t)((MIX * 256 + c) * 4 + hd) * 2048;
    bf16_t* mix = (bf16_t*)(p.ws + WS_HM);
    f32x16 acc[2];
#pragma unroll
    for (int n = 0; n < 2; ++n)
#pragma unroll
        for (int g = 0; g < 4; ++g) { const f32x4 v = *(const f32x4*)(oi + ((n * 4 + g) * 64 + lane) * 4); acc[n][4 * g] = v.x; acc[n][4 * g + 1] = v.y; acc[n][4 * g + 2] = v.z; acc[n][4 * g + 3] = v.w; }
#pragma unroll 1
    for (int dir = 0; dir < 2; ++dir) {
        const bf16_t* sp = DS + (size_t)((c * 4 + hd) * 2 + dir) * (DK * 64);
        const bf16_t* qp = QH + (size_t)(tok0 + r) * (8 * DK) + dir * (4 * DK) + hd * DK + 8 * hh;
#pragma unroll 2
        for (int s = 0; s < S_; ++s) {
            const bf16x8 qf = *(const bf16x8*)(qp + 16 * s);
            const bf16x8 sf0 = *(const bf16x8*)(sp + (s * 64 + lane) * 8), sf1 = *(const bf16x8*)(sp + ((S_ + s) * 64 + lane) * 8);
            acc[0] = MFMA32(sf0, qf, acc[0]); acc[1] = MFMA32(sf1, qf, acc[1]);
        }
    }
    float ss = 0.f;
#pragma unroll
    for (int n = 0; n < 2; ++n)
#pragma unroll
        for (int i = 0; i < 16; ++i) ss += acc[n][i] * acc[n][i];
    ss += shx(ss, lane, 32);
    const float rstd = rsqrtf(ss * (1.f / 64.f) + 1e-6f);
    const float* gain = (MIX == 0 ? p.IN(14) : p.IN(17)) + l * 256 + hd * 64;
    const bf16_t* grow = proj + (size_t)(tok0 + r) * NP + (MIX == 0 ? A_G : B_G) + hd * 64;
    bf16_t* orow = mix + (size_t)(tok0 + r) * 1024 + MIX * 256 + hd * 64;
#pragma unroll
    for (int n = 0; n < 2; ++n)
#pragma unroll
        for (int g = 0; g < 4; ++g) {
            const int e = 32 * n + 8 * g + 4 * hh;
            const u32x2 gg = *(const u32x2*)(grow + e); const f32x4 gn = *(const f32x4*)(gain + e);
            const float g0 = __uint_as_float(gg.x << 16), g1 = __uint_as_float(gg.x & 0xffff0000u), g2 = __uint_as_float(gg.y << 16), g3 = __uint_as_float(gg.y & 0xffff0000u);
            u32x2 o; o.x = pk2(acc[n][4 * g] * rstd * gn.x * siluf_(g0), acc[n][4 * g + 1] * rstd * gn.y * siluf_(g1));
            o.y = pk2(acc[n][4 * g + 2] * rstd * gn.z * siluf_(g2), acc[n][4 * g + 3] * rstd * gn.w * siluf_(g3));
            *(u32x2*)(orow + e) = o;
        }
}

DI float gelu_tanh(float x) { const float u = 0.7978845608028654f * (x + 0.044715f * x * x * x); const float t = 1.f - 2.f * rcpf_(__expf(2.f * u) + 1.f); return 0.5f * x * (1.f + t); }

DI void phase_m3(const Params& p, int l, const int tid) {
    const int lane = tid & 63, wid = __builtin_amdgcn_readfirstlane(tid >> 6), gw = blockIdx.x * 8 + wid, GW = gridDim.x * 8;
    for (int u = gw; u < 2048; u += GW) {
        const int ty = u & 1, idx = u >> 1, c = idx >> 2, hd = idx & 3;
        int ln = lane; asm volatile("" : "+v"(ln));
        m3_gla_unit(p, l, c, hd, ty, ln);
    }
    const int gt = blockIdx.x * 512 + tid, GT = gridDim.x * 512;
    const bf16_t* proj = (const bf16_t*)(p.ws + WS_BIG);
    bf16_t* mix = (bf16_t*)(p.ws + WS_HM);
    const float* HL = (const float*)(p.ws + WS_HL); const float* CP = (const float*)(p.ws + WS_CP); const float* HIN = (const float*)(p.ws + WS_RAGH);
    for (int id0 = gt; id0 < NTOK * 64; id0 += 4 * GT) {
        f32x4 hf[4], hb[4], cf[4], cb[4], inf_[4], inb[4]; u32x2 gg[4];
#pragma unroll
        for (int k = 0; k < 4; ++k) { const int id = id0 + k * GT; if (id < NTOK * 64) { const int tok = id >> 6, ch = (id & 63) * 4, c = tok >> 5;
            hf[k] = *(const f32x4*)(HL + (size_t)tok * 256 + ch); hb[k] = *(const f32x4*)(HL + ((size_t)NTOK + tok) * 256 + ch);
            cf[k] = *(const f32x4*)(CP + (size_t)tok * 256 + ch); cb[k] = *(const f32x4*)(CP + ((size_t)NTOK + tok) * 256 + ch);
            inf_[k] = *(const f32x4*)(HIN + (c * 2 + 0) * 256 + ch); inb[k] = *(const f32x4*)(HIN + (c * 2 + 1) * 256 + ch);
            gg[k] = *(const u32x2*)(proj + (size_t)tok * NP + C_G + ch); } }
#pragma unroll
        for (int k = 0; k < 4; ++k) { const int id = id0 + k * GT; if (id < NTOK * 64) { const int tok = id >> 6, ch = (id & 63) * 4;
            const f32x4 y = hf[k] + cf[k] * inf_[k] + hb[k] + cb[k] * inb[k];
            u32x2 o; o.x = pk2(y.x * gelu_tanh(__uint_as_float(gg[k].x << 16)), y.y * gelu_tanh(__uint_as_float(gg[k].x & 0xffff0000u)));
            o.y = pk2(y.z * gelu_tanh(__uint_as_float(gg[k].y << 16)), y.w * gelu_tanh(__uint_as_float(gg[k].y & 0xffff0000u)));
            *(u32x2*)(mix + (size_t)tok * 1024 + 512 + ch) = o; } }
    }
    const float* sw = p.IN(25) + l * 3 * 256;
    for (int id0 = gt; id0 < NTOK * 64; id0 += 4 * GT) {
        u32x2 cc[4][3], vv[4][3], bb[4];
#pragma unroll
        for (int k = 0; k < 4; ++k) { const int id = id0 + k * GT; if (id < NTOK * 64) { const int tok = id >> 6, ch = (id & 63) * 4;
            const int seg = tok < 4096 ? 256 : 64, pos = tok & (seg - 1);
#pragma unroll
            for (int j = 0; j < 3; ++j) { const int pp = pos + j - 1; cc[k][j] = (u32x2){0u, 0u}; vv[k][j] = (u32x2){0u, 0u};
                if (pp >= 0 && pp < seg) { const int tt = tok + j - 1; cc[k][j] = *(const u32x2*)(proj + (size_t)tt * NP + D_C + ch); vv[k][j] = *(const u32x2*)(proj + (size_t)tt * NP + D_V + ch); } }
            bb[k] = *(const u32x2*)(proj + (size_t)tok * NP + D_B + ch); } }
#pragma unroll
        for (int k = 0; k < 4; ++k) { const int id = id0 + k * GT; if (id < NTOK * 64) { const int tok = id >> 6, ch = (id & 63) * 4;
            f32x4 y = {0.f, 0.f, 0.f, 0.f};
#pragma unroll
            for (int j = 0; j < 3; ++j) { const f32x4 w = *(const f32x4*)(sw + j * 256 + ch);
                y.x += w.x * __uint_as_float(cc[k][j].x << 16) * __uint_as_float(vv[k][j].x << 16); y.y += w.y * __uint_as_float(cc[k][j].x & 0xffff0000u) * __uint_as_float(vv[k][j].x & 0xffff0000u);
                y.z += w.z * __uint_as_float(cc[k][j].y << 16) * __uint_as_float(vv[k][j].y << 16); y.w += w.w * __uint_as_float(cc[k][j].y & 0xffff0000u) * __uint_as_float(vv[k][j].y & 0xffff0000u); }
            u32x2 o; o.x = pk2(y.x * __uint_as_float(bb[k].x << 16), y.y * __uint_as_float(bb[k].x & 0xffff0000u));
            o.y = pk2(y.z * __uint_as_float(bb[k].y << 16), y.w * __uint_as_float(bb[k].y & 0xffff0000u));
            *(u32x2*)(mix + (size_t)tok * 1024 + 768 + ch) = o; } }
    }
}

__global__ void __launch_bounds__(512, 2) fwd_kernel(Params pin) {
    extern __shared__ __attribute__((aligned(16))) unsigned char lds_raw[];
    LAS unsigned char* lds = (LAS unsigned char*)lds_raw;
    cg::grid_group grid = cg::this_grid();
    const int G = gridDim.x, bid = blockIdx.x;
    volatile LAS unsigned* bst = (volatile LAS unsigned*)(lds + LDS_BYTES - 16);
    if (threadIdx.x < 4) bst[threadIdx.x] = 0u;
    __syncthreads();
    if (bid == 0 && pin.ph_lo == 0) { unsigned* bw = (unsigned*)(pin.ws + WS_BAR); for (int i = threadIdx.x; i < 4096; i += 512) bw[i] = 0u; }
    XcdBarrier xbar; xbar.bar = (unsigned*)(pin.ws + WS_BAR); xbar.x = 0; xbar.st = bst;
    int nsync = 0;
    for (int ph2 = 2 * pin.ph_lo; ph2 < 2 * pin.ph_hi; ++ph2) {
        const int ph = ph2 >> 1;
        if ((ph2 & 1) && !((REPEAT_MASK >> ph) & 1u)) continue;
        size_t zo = 0; asm volatile("" : "+s"(zo));
        int tid = threadIdx.x; asm volatile("" : "+v"(tid));
        Params p = pin; p.ws += zo; p.out += zo; p.zo = zo;
        const float* mod = (const float*)(p.ws + WS_MOD);
        bf16_t* hm = (bf16_t*)(p.ws + WS_HM); bf16_t* big = (bf16_t*)(p.ws + WS_BIG);
        if (ph == 0) phase_p0(p, lds, tid);
        else {
            const int l = ph == 19 ? 0 : (ph - 1) / 9, s = ph == 19 ? 9 : (ph - 1) % 9;
            pg8::StaticOrder S; pg8::Gemm g{hm, hm, 0, 0, 0, 0}; pg8::EpiAny E{0, big, 0, mod}; bool is_gemm = false, align = false;
            if (s == 0 || s == 6 || s == 9) phase_norm(p, l, s == 0 ? 0 : (s == 6 ? 1 : 2), tid, (ph2 & 1) != 0);
            else if (s == 1) { g = pg8::Gemm{hm, (const bf16_t*)(p.ws + WS_WIN) + (size_t)l * NP * 1024, NTOK, NP, 1024, 1024}; S.init(NTOK, NP, G, bid);
                E = pg8::EpiAny{0, big, NP, mod}; is_gemm = true; align = GEMM_ALIGN; }
            else if (s == 2) phase_m1(p, l, lds, tid, (ph2 & 1) ? M1_PROBE_STAGES : 7);
            else if (s == 3) phase_m2(p, l, tid, (ph2 & 1) != 0);
            else if (s == 4) phase_m3(p, l, tid);
            else if (s == 5) { g = pg8::Gemm{hm, (const bf16_t*)(p.ws + WS_WOUT) + (size_t)l * 1024 * 1024, NTOK, 1024, 512, 1024}; S.init(NTOK, 1024, G, bid, 2);
                E = pg8::EpiAny{2, (bf16_t*)(p.ws + ((ph2 & 1) ? WS_HL : WS_DSA)), 1024, mod + (size_t)l * 5 * 6144 + 2048}; is_gemm = true; }
            else if (s == 7) { g = pg8::Gemm{hm, (const bf16_t*)(p.ws + WS_W1) + (size_t)l * 4096 * 1024, NTOK, DFF, 1024, 1024}; S.init(NTOK, DFF, G, bid);
                E = pg8::EpiAny{1, big, DFF, mod}; is_gemm = true; align = GEMM_ALIGN; }
            else { g = pg8::Gemm{big, (const bf16_t*)(p.ws + WS_W2) + (size_t)l * 1024 * 4096, NTOK, 1024, 2048, DFF}; S.init(NTOK, 1024, G, bid, 2);
                E = pg8::EpiAny{2, (bf16_t*)(p.ws + ((ph2 & 1) ? WS_HL : WS_DSA)), 1024, mod + (size_t)l * 5 * 6144 + 5120}; is_gemm = true; }
            if (is_gemm) pg8::gemm_phase<pg8::EpiAny, GEMM_SP2>(lds, g, S, E, tid, align);
        }
        if (ph2 + 2 < 2 * pin.ph_hi || (!(ph2 & 1) && ((REPEAT_MASK >> ph) & 1u))) { if (nsync == 0) { grid.sync(); xbar = xcd_barrier_post((unsigned*)(pin.ws + WS_BAR), bst); } else xcd_barrier(xbar); ++nsync; }
    }
}

extern "C" void kernel_launch(void* const* d_in, const int* in_sizes, int n_in, void* d_out, int out_size, void* d_ws, size_t ws_size, hipStream_t stream) {
    static int grid = 0;
    if (grid == 0) {
        if (n_in != 29 || ws_size < WS_END) { fprintf(stderr, "kernel_launch: unexpected n_in %d / ws %zu\n", n_in, ws_size); grid = -1; return; }
        int dev = 0, cus = 0, per_cu = 0;
        hipGetDevice(&dev); hipDeviceGetAttribute(&cus, hipDeviceAttributeMultiprocessorCount, dev);
        if (hipFuncSetAttribute((const void*)fwd_kernel, hipFuncAttributeMaxDynamicSharedMemorySize, LDS_BYTES) != hipSuccess) { fprintf(stderr, "kernel_launch: hipFuncSetAttribute failed\n"); grid = -1; return; }
        if (hipOccupancyMaxActiveBlocksPerMultiprocessor(&per_cu, (const void*)fwd_kernel, 512, LDS_BYTES) != hipSuccess || per_cu < 1) { fprintf(stderr, "kernel_launch: occupancy query says %d\n", per_cu); per_cu = 1; }
        (void)hipGetLastError();
        grid = cus * 1;
        if (grid <= 0) grid = 256;
    }
    if (grid < 0) return;
    Params p{};
    for (int i = 0; i < 29; ++i) p.in[i] = (const float*)d_in[i];
    p.out = (float*)d_out; p.ws = (unsigned char*)d_ws;
#if MEGA
    p.ph_lo = 0; p.ph_hi = 20;
    void* args[] = {&p};
    hipError_t e = hipLaunchCooperativeKernel((const void*)fwd_kernel, dim3(grid), dim3(512), args, LDS_BYTES, stream);
    if (e != hipSuccess) fprintf(stderr, "cooperative launch failed: %s (grid %d)\n", hipGetErrorString(e), grid);
#else
    for (int ph = 0; ph < 20; ++ph) { p.ph_lo = ph; p.ph_hi = ph + 1; hipLaunchKernelGGL(fwd_kernel, dim3(grid), dim3(512), LDS_BYTES, stream, p); }
#endif
}
```

```cpp
#include <hip/hip_runtime.h>
#include <hip/hip_cooperative_groups.h>
#include <cstdio>
#include <cstdint>
namespace cg = cooperative_groups;

#ifndef MEGA
#define MEGA 1
#endif
#ifndef M1_PROBE_STAGES
#define M1_PROBE_STAGES 7
#endif
#ifndef GEMM_SP2
#define GEMM_SP2 true
#endif
#ifndef GEMM_ALIGN
#define GEMM_ALIGN true
#endif
#ifndef REPEAT_MASK
#define REPEAT_MASK 0u
#endif

#define DI __device__ __forceinline__
#define LAS __attribute__((address_space(3)))
typedef unsigned short bf16_t;
typedef short bf16x8 __attribute__((ext_vector_type(8)));
typedef float f32x4 __attribute__((ext_vector_type(4)));
typedef float f32x16 __attribute__((ext_vector_type(16)));
typedef unsigned u32x4 __attribute__((ext_vector_type(4)));
typedef unsigned u32x2 __attribute__((ext_vector_type(2)));
typedef __bf16 bf16x2_t __attribute__((ext_vector_type(2)));
typedef float f32x2_t __attribute__((ext_vector_type(2)));

constexpr int NTOK = 8192, DM = 1024, NP = 3584, DFF = 4096;
constexpr int A_Q = 0, A_I = 256, A_FF = 512, A_FB = 768, A_G = 1024, B_Q = 1280, B_K = 1408, B_V = 1536, B_G = 1792, B_AF = 2048, B_AB = 2064,
              C_X = 2080, C_G = 2336, D_B = 2592, D_C = 2848, D_V = 3104, PW = 3360;
constexpr size_t MiB = 1u << 20;
constexpr size_t WS_WIN = 0, WS_WOUT = 14 * MiB, WS_W1 = 18 * MiB, WS_W2 = 34 * MiB, WS_MOD = 50 * MiB, WS_HM = 51 * MiB, WS_BIG = 67 * MiB,
                 WS_OI = 131 * MiB, WS_DSA = 147 * MiB, WS_DSB = 179 * MiB, WS_QHA = 195 * MiB, WS_QHB = 203 * MiB, WS_HL = 207 * MiB, WS_CP = 223 * MiB,
                 WS_ACHA = 239 * MiB, WS_ACHB = 239 * MiB + 512 * 1024, WS_RAGA = 240 * MiB, WS_RAGH = 240 * MiB + 512 * 1024, WS_BAR = 241 * MiB, WS_END = 242 * MiB;
constexpr int OUT_SH = 8388608, OUT_SG = OUT_SH + 1048576, OUT_SR = OUT_SG + 524288;
constexpr int LDS_BYTES = 147456;

struct Params { const float* in[29]; float* out; unsigned char* ws; size_t zo; int ph_lo, ph_hi;
    DI const float* IN(int i) const { return in[i] + zo; } };

DI float bf2f(bf16_t u) { return __uint_as_float(((unsigned)u) << 16); }
DI unsigned pk2(float lo, float hi) { f32x2_t v = {lo, hi}; bf16x2_t b = __builtin_convertvector(v, bf16x2_t); return __builtin_bit_cast(unsigned, b); }
DI bf16_t f2bf(float x) { return (bf16_t)(pk2(x, 0.f) & 0xffffu); }
DI bf16x8 pack8(const float* v) { u32x4 p; p.x = pk2(v[0], v[1]); p.y = pk2(v[2], v[3]); p.z = pk2(v[4], v[5]); p.w = pk2(v[6], v[7]); return __builtin_bit_cast(bf16x8, p); }
DI float rcpf_(float x) { return __builtin_amdgcn_rcpf(x); }
DI float sigmoidf_(float x) { return rcpf_(1.f + __expf(-x)); }
DI float siluf_(float x) { return x * rcpf_(1.f + __expf(-x)); }
DI float om_exp(float x) { const float s = -x * (1.f + x * 0.5f * (1.f + x * (1.f / 3.f) * (1.f + x * 0.25f * (1.f + x * 0.2f * (1.f + x * (1.f / 6.f)))))); return x > -0.3f ? s : 1.f - __expf(x); }
DI int crow(int reg, int h) { return (reg & 3) + 8 * (reg >> 2) + 4 * h; }
#define MFMA32(a, b, c) __builtin_amdgcn_mfma_f32_32x32x16_bf16((a), (b), (c), 0, 0, 0)
DI f32x16 zero16() { f32x16 z; for (int i = 0; i < 16; ++i) z[i] = 0.f; return z; }
DI float shx(float v, int lane, int m) { return __int_as_float(__builtin_amdgcn_ds_bpermute((lane ^ m) << 2, __float_as_int(v))); }
DI int modrow_of(int row) { return row < 4096 ? 0 : 1 + ((row - 4096) >> 10); }


#define XB_TMO      128
#define XB_XCNT(j)  (256  + 64 * (j))
#define XB_XSUB(j)  (1280 + 64 * (j))
#define XB_XGEN(j)  (2304 + 64 * (j))
#define XB_TOP      3328
#define XB_TOPGEN   3392
#define XCD_BAR_WORDS 3456
#define XB_SPIN_CAP (1u << 18)
DI unsigned xb_ld(unsigned* p)              { return __hip_atomic_load(p, __ATOMIC_RELAXED, __HIP_MEMORY_SCOPE_AGENT); }
DI unsigned xb_add(unsigned* p, unsigned v) { return __hip_atomic_fetch_add(p, v, __ATOMIC_RELAXED, __HIP_MEMORY_SCOPE_AGENT); }
DI unsigned xb_xcc_id() { return (unsigned)__builtin_amdgcn_s_getreg((3 << 11) | 20) & 0xFu; }
#define XB_SPIN(cond, bar) do { unsigned _sp = 0; while (cond) { __builtin_amdgcn_s_sleep(1); \
    if ((++_sp & 255u) == 0u) { if (xb_ld(&(bar)[XB_TMO])) break; if (_sp > XB_SPIN_CAP) { atomicAdd(&(bar)[XB_TMO], 1u); break; } } } } while (0)
struct XcdBarrier { unsigned* bar; unsigned x; volatile LAS unsigned* st; };
DI XcdBarrier xcd_barrier_post(unsigned* bar, volatile LAS unsigned* st) {
    XcdBarrier b; b.bar = bar; b.x = xb_xcc_id(); b.st = st;
    if (threadIdx.x == 0) (void)xb_add(&bar[XB_XCNT(b.x)], 1u);
    return b;
}
DI void xcd_barrier_complete(unsigned* bar, unsigned x, unsigned& nloc, unsigned& nx) {
    const unsigned G = gridDim.x * gridDim.y * gridDim.z;
    unsigned sum, cnt, mine, sp = 0u;
    for (;;) {
        sum = 0u; cnt = 0u; mine = 0u;
#pragma unroll
        for (unsigned j = 0; j < 16; ++j) { const unsigned c = xb_ld(&bar[XB_XCNT(j)]); sum += c; cnt += (c > 0u) ? 1u : 0u; mine = (j == x) ? c : mine; }
        if (sum == G) break;
        __builtin_amdgcn_s_sleep(1);
        if ((++sp & 255u) == 0u) { if (xb_ld(&bar[XB_TMO])) break; if (sp > XB_SPIN_CAP) { atomicAdd(&bar[XB_TMO], 1u); break; } }
    }
    nloc = mine > 0u ? mine : 1u; nx = cnt > 0u ? cnt : 1u;
}
DI void xcd_barrier(const XcdBarrier& b) {
    asm volatile("s_waitcnt vmcnt(0)" ::: "memory");
    __syncthreads();
    if (threadIdx.x == 0) {
        unsigned* bar = b.bar;
        __builtin_amdgcn_s_waitcnt(0);
        unsigned nloc = b.st[0], nx = b.st[1];
        if (nloc == 0u) { xcd_barrier_complete(bar, b.x, nloc, nx); b.st[0] = nloc; b.st[1] = nx; }
        const unsigned old = xb_add(&bar[XB_XSUB(b.x)], 1u);
        const unsigned gen = old / nloc;
        if (old + 1u == (gen + 1u) * nloc) {
            __builtin_amdgcn_fence(__ATOMIC_RELEASE, "agent");
            asm volatile("s_waitcnt vmcnt(0)" ::: "memory");
            const unsigned og = xb_add(&bar[XB_TOP], 1u);
            const unsigned tg = og / nx;
            if (og + 1u == (tg + 1u) * nx) xb_add(&bar[XB_TOPGEN], 1u);
            else XB_SPIN(xb_ld(&bar[XB_TOPGEN]) == tg, bar);
            __builtin_amdgcn_fence(__ATOMIC_ACQUIRE, "agent");
            xb_add(&bar[XB_XGEN(b.x)], 1u);
            asm volatile("s_waitcnt vmcnt(0)" ::: "memory");
        } else {
            XB_SPIN(xb_ld(&bar[XB_TOPGEN]) == gen, bar);
            __builtin_amdgcn_fence(__ATOMIC_ACQUIRE, "agent");
            asm volatile("s_waitcnt vmcnt(0)" ::: "memory");
        }
    }
    __syncthreads();
}

namespace pg8 {
constexpr int BM = 256, BK = 64, HALF = 128, HTB = HALF * BK * 2, NXCD = 8, WGM = 8;
__host__ __device__ __forceinline__ int lds_byte(int r, int c) { const int st = (r >> 4) * 2 + (c >> 5), rr = r & 15, cc = c & 31, ob = rr * 64 + cc * 2; return st * 1024 + (ob ^ (((ob >> 9) & 1) << 5)); }
__host__ __device__ __forceinline__ void stage_rc(int b, int& R, int& C) { const int st = b / 1024, sb = b % 1024, swz = sb ^ (((sb >> 9) & 1) << 5); R = (st >> 1) * 16 + swz / 64; C = (st & 1) * 32 + (swz % 64) / 2; }
__host__ __device__ __forceinline__ int perm32(int rho) { const int n = rho >> 4, i = rho & 15; return 8 * (i >> 2) + 4 * n + (i & 3); }
struct Unit { int pm, pn, pk; };
struct Gemm { const bf16_t* A; const bf16_t* Bt; int M, N, K, lda; };
struct StaticOrder {
    int nM, nN, nwg, G, c, KS;
    __host__ __device__ void init(int M, int N, int G_, int c_, int KS_ = 1) { KS = KS_; nM = M / BM; nN = (N / BM) * KS; nwg = nM * nN; G = G_; c = c_; }
    __host__ __device__ bool next(int i, Unit& u) const {
        const long L = (long)i * G + c; if (L >= nwg) return false;
        int wgid = (int)L; { const int q = nwg / NXCD, r = nwg % NXCD, xcd = wgid % NXCD, off = wgid / NXCD; wgid = (xcd < r ? xcd * (q + 1) : r * (q + 1) + (xcd - r) * q) + off; }
        const int nig = WGM * nN, gid = wgid / nig, fm = gid * WGM, gsz = (nM - fm) < WGM ? (nM - fm) : WGM;
        u.pm = fm + ((wgid % nig) % gsz); const int pv = (wgid % nig) / gsz; u.pn = pv / KS; u.pk = pv % KS; return true;
    }
};
template <class Epi, bool SP2 = false>
__device__ __forceinline__ void gemm_phase(LAS unsigned char* lds, const Gemm g, const StaticOrder& S, const Epi& E, const int tid, const bool ALIGN_EPI) {
    const int wid = __builtin_amdgcn_readfirstlane(tid >> 6), lane = tid & 63, wr = wid >> 2, wc = wid & 3, fr = lane & 15, fq = lane >> 4;
    const int K = g.lda, nt = g.K / BK;
    unsigned voffA[2], voffB[2];
#pragma unroll
    for (int i = 0; i < 2; ++i) { int R, C; stage_rc(tid * 16 + i * 8192, R, C); const int Rb = (R & ~31) + perm32(R & 31);
        voffA[i] = (unsigned)(R * K + C) * 2u; voffB[i] = (unsigned)(Rb * K + C) * 2u; }
    const size_t kstep = (size_t)(BK * 2);
    const size_t hstep = (size_t)HALF * K * 2;
    const size_t tstep = 2 * hstep;
    const unsigned ldsw = (unsigned)wid * 1024u;
    const int aoff = lds_byte(wr * 64 + fr, fq * 8), boff = lds_byte(wc * 32 + fr, fq * 8);
#define PG8_SA(b, h) (((b) * 2 + (h)) * HTB)
#define PG8_SB(b, h) ((4 + (b) * 2 + (h)) * HTB)
#define PG8_STAGE(bufoff, gbase, voff) do { _Pragma("unroll") for (int _i = 0; _i < 2; ++_i) \
        __builtin_amdgcn_global_load_lds((const unsigned*)((const char*)(gbase) + (voff)[_i]), (LAS unsigned*)(lds + (bufoff) + ldsw + _i * 8192), 16, 0, 0); } while (0)
#define PG8_LDA(dst, b, h) do { _Pragma("unroll") for (int m = 0; m < 4; ++m) _Pragma("unroll") for (int k = 0; k < 2; ++k) dst[m][k] = *(const LAS bf16x8*)(lds + PG8_SA(b, h) + aoff + m * 2048 + k * 1024); } while (0)
#define PG8_LDB(dst, b, h) do { _Pragma("unroll") for (int n = 0; n < 2; ++n) _Pragma("unroll") for (int k = 0; k < 2; ++k) dst[n][k] = *(const LAS bf16x8*)(lds + PG8_SB(b, h) + boff + n * 2048 + k * 1024); } while (0)
#define PG8_MMA(ai, bj, At, Bt) do { __builtin_amdgcn_s_setprio(1); _Pragma("unroll") for (int m = 0; m < 4; ++m) _Pragma("unroll") for (int n = 0; n < 2; ++n) _Pragma("unroll") for (int k = 0; k < 2; ++k) \
        acc[ai][bj][m][n] = __builtin_amdgcn_mfma_f32_16x16x32_bf16(Bt[n][k], At[m][k], acc[ai][bj][m][n], 0, 0, 0); __builtin_amdgcn_s_setprio(0); } while (0)
#define PG8_WAIT_V(n) asm volatile("s_waitcnt vmcnt(" #n ")" ::: "memory")
#define PG8_WAIT_L(n) asm volatile("s_waitcnt lgkmcnt(" #n ")" ::: "memory")
#define PG8_BAR __builtin_amdgcn_s_barrier()
#define PG8_SCHED __builtin_amdgcn_sched_barrier(0)
    Unit cur, nxt; int ui = 0;
    if (!S.next(0, cur)) return;
    f32x4 acc[2][2][4][2];
#pragma unroll
    for (int a = 0; a < 2; ++a)
#pragma unroll
        for (int b = 0; b < 2; ++b)
#pragma unroll
            for (int m = 0; m < 4; ++m)
#pragma unroll
                for (int n = 0; n < 2; ++n) acc[a][b][m][n] = (f32x4){0.f, 0.f, 0.f, 0.f};
    bf16x8 At[4][2], B0[2][2], B1[2][2];
    const size_t ksplit = (size_t)g.K * 2;
    const char* cA = (const char*)g.A + (size_t)cur.pm * tstep + cur.pk * ksplit; const char* cB = (const char*)g.Bt + (size_t)cur.pn * tstep + cur.pk * ksplit;
    if constexpr (SP2) {
        PG8_STAGE(PG8_SB(0, 0), cB, voffB); PG8_STAGE(PG8_SB(0, 1), cB + hstep, voffB); PG8_STAGE(PG8_SA(0, 0), cA, voffA); PG8_STAGE(PG8_SA(0, 1), cA + hstep, voffA);
        if (wr == 1) PG8_BAR;
        PG8_WAIT_V(2); PG8_BAR;
        PG8_STAGE(PG8_SB(1, 0), cB + kstep, voffB); PG8_STAGE(PG8_SA(1, 0), cA + kstep, voffA); PG8_STAGE(PG8_SB(1, 1), cB + hstep + kstep, voffB);
        PG8_WAIT_V(6); PG8_BAR;
    } else {
        PG8_STAGE(PG8_SB(0, 0), cB, voffB); PG8_STAGE(PG8_SA(0, 0), cA, voffA); PG8_STAGE(PG8_SB(0, 1), cB + hstep, voffB); PG8_STAGE(PG8_SA(0, 1), cA + hstep, voffA);
        if (wr == 1) PG8_BAR;
        PG8_WAIT_V(4); PG8_BAR;
        PG8_STAGE(PG8_SB(1, 0), cB + kstep, voffB); PG8_STAGE(PG8_SA(1, 0), cA + kstep, voffA); PG8_STAGE(PG8_SB(1, 1), cB + hstep + kstep, voffB);
        PG8_WAIT_V(6); PG8_BAR;
    }
    for (;;) {
        const bool has_next = S.next(ui + 1, nxt);
        const char* nA = has_next ? (const char*)g.A + (size_t)nxt.pm * tstep + nxt.pk * ksplit : cA; const char* nB = has_next ? (const char*)g.Bt + (size_t)nxt.pn * tstep + nxt.pk * ksplit : cB;
        for (int t = 0; t < nt; t += 2) {
            const bool last = (t == nt - 2);
            const char* a1 = cA + (size_t)(t + 1) * kstep;
            const char* a2 = last ? nA : cA + (size_t)(t + 2) * kstep; const char* b2 = last ? nB : cB + (size_t)(t + 2) * kstep;
            const char* a3 = a2 + kstep; const char* b3 = b2 + kstep;
            if constexpr (SP2) {
            PG8_LDB(B0, 0, 0); PG8_LDB(B1, 0, 1); PG8_SCHED; PG8_LDA(At, 0, 0); PG8_STAGE(PG8_SA(1, 1), a1 + hstep, voffA);
            PG8_WAIT_V(8); PG8_WAIT_L(0); PG8_BAR; PG8_MMA(0, 0, At, B0); PG8_MMA(0, 1, At, B1); PG8_BAR; PG8_SCHED;
            PG8_LDA(At, 0, 1); PG8_STAGE(PG8_SB(0, 0), b2, voffB); PG8_STAGE(PG8_SB(0, 1), b2 + hstep, voffB); PG8_STAGE(PG8_SA(0, 0), a2, voffA);
            PG8_WAIT_V(8); PG8_WAIT_L(0); PG8_BAR; PG8_MMA(1, 0, At, B0); PG8_MMA(1, 1, At, B1); PG8_BAR; PG8_SCHED;
            PG8_LDB(B0, 1, 0); PG8_LDB(B1, 1, 1); PG8_SCHED; PG8_LDA(At, 1, 0); PG8_STAGE(PG8_SA(0, 1), a2 + hstep, voffA);
            PG8_WAIT_V(8); PG8_WAIT_L(0); PG8_BAR; PG8_MMA(0, 0, At, B0); PG8_MMA(0, 1, At, B1); PG8_BAR; PG8_SCHED;
            PG8_LDA(At, 1, 1); PG8_STAGE(PG8_SB(1, 0), b3, voffB); PG8_STAGE(PG8_SB(1, 1), b3 + hstep, voffB); PG8_STAGE(PG8_SA(1, 0), a3, voffA);
            PG8_WAIT_V(8); PG8_WAIT_L(0); PG8_BAR; PG8_MMA(1, 0, At, B0); PG8_MMA(1, 1, At, B1); PG8_BAR; PG8_SCHED;
            } else {
            PG8_LDB(B0, 0, 0); PG8_SCHED; PG8_LDA(At, 0, 0); PG8_STAGE(PG8_SA(1, 1), a1 + hstep, voffA);
            PG8_WAIT_L(8); PG8_BAR; PG8_WAIT_L(0); PG8_MMA(0, 0, At, B0); PG8_BAR; PG8_SCHED;
            PG8_LDB(B1, 0, 1); PG8_STAGE(PG8_SB(0, 0), b2, voffB);
            PG8_BAR; PG8_WAIT_L(0); PG8_MMA(0, 1, At, B1); PG8_BAR;
            PG8_LDA(At, 0, 1); PG8_STAGE(PG8_SA(0, 0), a2, voffA);
            PG8_BAR; PG8_WAIT_L(0); PG8_MMA(1, 0, At, B0); PG8_BAR; PG8_SCHED;
            PG8_STAGE(PG8_SB(0, 1), b2 + hstep, voffB);
            PG8_WAIT_V(6); PG8_BAR; PG8_MMA(1, 1, At, B1); PG8_BAR;
            PG8_LDB(B0, 1, 0); PG8_SCHED; PG8_LDA(At, 1, 0); PG8_STAGE(PG8_SA(0, 1), a2 + hstep, voffA);
            PG8_WAIT_L(8); PG8_BAR; PG8_WAIT_L(0); PG8_MMA(0, 0, At, B0); PG8_BAR; PG8_SCHED;
            PG8_LDB(B1, 1, 1); PG8_STAGE(PG8_SB(1, 0), b3, voffB);
            PG8_BAR; PG8_WAIT_L(0); PG8_MMA(0, 1, At, B1); PG8_BAR;
            PG8_LDA(At, 1, 1); PG8_STAGE(PG8_SA(1, 0), a3, voffA);
            PG8_BAR; PG8_WAIT_L(0); PG8_MMA(1, 0, At, B0); PG8_BAR; PG8_SCHED;
            PG8_STAGE(PG8_SB(1, 1), b3 + hstep, voffB);
            PG8_WAIT_V(6); PG8_BAR; PG8_MMA(1, 1, At, B1); PG8_BAR;
            }
        }
        if (ALIGN_EPI) { if (wr == 0) PG8_BAR; }
        E(acc, cur, wr, wc, fr, fq);
        if (!has_next) break;
#pragma unroll
        for (int a = 0; a < 2; ++a)
#pragma unroll
            for (int b = 0; b < 2; ++b)
#pragma unroll
                for (int m = 0; m < 4; ++m)
#pragma unroll
                    for (int n = 0; n < 2; ++n) acc[a][b][m][n] = (f32x4){0.f, 0.f, 0.f, 0.f};
        cur = nxt; cA = nA; cB = nB; ++ui;
        if (ALIGN_EPI) { if (wr == 1) PG8_BAR; }
    }
    PG8_WAIT_V(0);
    if (!ALIGN_EPI) { if (wr == 0) PG8_BAR; }
    PG8_BAR;
#undef PG8_SA
#undef PG8_SB
#undef PG8_STAGE
#undef PG8_LDA
#undef PG8_LDB
#undef PG8_MMA
#undef PG8_WAIT_V
#undef PG8_WAIT_L
#undef PG8_BAR
#undef PG8_SCHED
}

template <int ACT> struct EpiBf16 {
    bf16_t* O; int ldc;
    __device__ __forceinline__ void operator()(const f32x4 (&acc)[2][2][4][2], const Unit& u, int wr, int wc, int fr, int fq) const {
        const int row0 = u.pm * BM + wr * 64 + fr, col0 = u.pn * BM + wc * 32 + 8 * fq;
#pragma unroll
        for (int ai = 0; ai < 2; ++ai)
#pragma unroll
            for (int m = 0; m < 4; ++m) { bf16_t* rowp = O + (size_t)(row0 + ai * HALF + m * 16) * ldc + col0;
#pragma unroll
                for (int bj = 0; bj < 2; ++bj) { f32x4 v0 = acc[ai][bj][m][0], v1 = acc[ai][bj][m][1];
                    if (ACT == 1) {
#pragma unroll
                        for (int q = 0; q < 4; ++q) { float a = fmaxf(v0[q], 0.f), b = fmaxf(v1[q], 0.f); v0[q] = a * a; v1[q] = b * b; } }
                    u32x4 w; w.x = pk2(v0[0], v0[1]); w.y = pk2(v0[2], v0[3]); w.z = pk2(v1[0], v1[1]); w.w = pk2(v1[2], v1[3]);
                    *(u32x4*)(rowp + bj * HALF) = w; } }
    }
};
struct EpiResid {
    const float* gate; bf16_t* pb;
    __device__ __forceinline__ void operator()(const f32x4 (&acc)[2][2][4][2], const Unit& u, int wr, int wc, int fr, int fq) const {
        const int rowb = u.pm * BM; const float* gp = gate + modrow_of(rowb) * 6144;
        const int row0 = rowb + wr * 64 + fr, col0 = u.pn * BM + wc * 32 + 8 * fq;
        bf16_t* pbk = pb + (size_t)u.pk * ((size_t)NTOK * 1024);
        f32x4 gv[2][2];
#pragma unroll
        for (int bj = 0; bj < 2; ++bj)
#pragma unroll
            for (int n = 0; n < 2; ++n) gv[bj][n] = *(const f32x4*)(gp + col0 + bj * HALF + 4 * n);
#pragma unroll
        for (int ai = 0; ai < 2; ++ai)
#pragma unroll
            for (int m = 0; m < 4; ++m) { const size_t ro = (size_t)(row0 + ai * HALF + m * 16) * 1024 + col0;
#pragma unroll
                for (int bj = 0; bj < 2; ++bj) { const f32x4 v0 = gv[bj][0] * acc[ai][bj][m][0], v1 = gv[bj][1] * acc[ai][bj][m][1];
                    u32x4 w; w.x = pk2(v0[0], v0[1]); w.y = pk2(v0[2], v0[3]); w.z = pk2(v1[0], v1[1]); w.w = pk2(v1[2], v1[3]);
                    *(u32x4*)(pbk + ro + bj * HALF) = w; } }
    }
};
struct EpiAny {
    int mode; bf16_t* O; int ldc; const float* gate;
    __device__ __forceinline__ void operator()(const f32x4 (&acc)[2][2][4][2], const Unit& u, int wr, int wc, int fr, int fq) const {
        const int rowb = u.pm * BM, row0 = rowb + wr * 64 + fr, col0 = u.pn * BM + wc * 32 + 8 * fq;
        bf16_t* base = O;
        f32x4 gv[2][2];
#pragma unroll
        for (int bj = 0; bj < 2; ++bj)
#pragma unroll
            for (int n = 0; n < 2; ++n) gv[bj][n] = (f32x4){1.f, 1.f, 1.f, 1.f};
        if (mode == 2) {
            const float* gp = gate + modrow_of(rowb) * 6144; base = O + (size_t)u.pk * ((size_t)NTOK * 1024);
#pragma unroll
            for (int bj = 0; bj < 2; ++bj)
#pragma unroll
                for (int n = 0; n < 2; ++n) gv[bj][n] = *(const f32x4*)(gp + col0 + bj * HALF + 4 * n);
        }
#pragma unroll
        for (int ai = 0; ai < 2; ++ai)
#pragma unroll
            for (int m = 0; m < 4; ++m) { bf16_t* rowp = base + (size_t)(row0 + ai * HALF + m * 16) * ldc + col0;
#pragma unroll
                for (int bj = 0; bj < 2; ++bj) { f32x4 v0 = acc[ai][bj][m][0], v1 = acc[ai][bj][m][1];
                    if (mode == 1) {
#pragma unroll
                        for (int q = 0; q < 4; ++q) { const float a = fmaxf(v0[q], 0.f), b = fmaxf(v1[q], 0.f); v0[q] = a * a; v1[q] = b * b; } }
                    v0 = v0 * gv[bj][0]; v1 = v1 * gv[bj][1];
                    u32x4 w; w.x = pk2(v0[0], v0[1]); w.y = pk2(v0[2], v0[3]); w.z = pk2(v1[0], v1[1]); w.w = pk2(v1[2], v1[3]);
                    *(u32x4*)(rowp + bj * HALF) = w; } }
    }
};
}

DI void transpose_unit(const float* __restrict__ W, int K, int N, int Npad, bf16_t* WT, int unit, int lane, LAS unsigned char* scr) {
    const int nblk = Npad / 64, kb = unit / nblk, nb = unit % nblk, n = nb * 64 + lane, k0 = kb * 64;
    u32x4 o[8];
    if (n < N) {
        float v[64];
#pragma unroll
        for (int kk = 0; kk < 64; ++kk) v[kk] = W[(size_t)(k0 + kk) * N + n];
#pragma unroll
        for (int q = 0; q < 8; ++q) { o[q].x = pk2(v[8 * q], v[8 * q + 1]); o[q].y = pk2(v[8 * q + 2], v[8 * q + 3]); o[q].z = pk2(v[8 * q + 4], v[8 * q + 5]); o[q].w = pk2(v[8 * q + 6], v[8 * q + 7]); }
    } else {
#pragma unroll
        for (int q = 0; q < 8; ++q) o[q] = (u32x4){0u, 0u, 0u, 0u};
    }
#pragma unroll
    for (int q = 0; q < 8; ++q) *(LAS u32x4*)(scr + lane * 144 + q * 16) = o[q];
    __builtin_amdgcn_fence(__ATOMIC_RELEASE, "wavefront"); __builtin_amdgcn_wave_barrier();
    const int ch = lane & 7, rb = lane >> 3;
#pragma unroll
    for (int j = 0; j < 8; ++j) { const int row = rb + 8 * j; const u32x4 w = *(const LAS u32x4*)(scr + row * 144 + ch * 16);
        *(u32x4*)(WT + (size_t)(nb * 64 + row) * K + k0 + ch * 8) = w; }
    __builtin_amdgcn_fence(__ATOMIC_RELEASE, "wavefront"); __builtin_amdgcn_wave_barrier();
}

DI void phase_p0(const Params& p, LAS unsigned char* lds, const int tid) {
    const int lane = tid & 63, wid = tid >> 6, G = gridDim.x, bid = blockIdx.x;
    const float* c = p.IN(5); const float* c_ctx = p.IN(6); const float* ada_w = p.IN(9); const float* ada_b = p.IN(10);
    float* mod = (float*)(p.ws + WS_MOD);
    LAS float* st = (LAS float*)lds + wid * 640;
    LAS float* red = (LAS float*)(lds + 32768);
    for (int bu = bid; bu < 192; bu += G) {
        const int l = bu / 96, cgp = bu % 96, col = cgp * 64 + lane;
        for (int i = lane; i < 640; i += 64) { const int row = i / 128, k = wid * 128 + (i % 128); const float cv = row == 0 ? c_ctx[k] : c[(row - 1) * 1024 + k]; st[i] = siluf_(cv); }
        __syncthreads();
        float acc[5] = {0.f, 0.f, 0.f, 0.f, 0.f};
        const float* W = ada_w + (size_t)l * 1024 * 6144 + (size_t)(wid * 128) * 6144 + col;
#pragma unroll 16
        for (int kk = 0; kk < 128; ++kk) { const float w = W[(size_t)kk * 6144];
#pragma unroll
            for (int row = 0; row < 5; ++row) acc[row] += st[row * 128 + kk] * w; }
#pragma unroll
        for (int row = 0; row < 5; ++row) red[(wid * 5 + row) * 64 + lane] = acc[row];
        __syncthreads();
        if (tid < 320) { const int row = tid / 64, ln = tid % 64; float s = 0.f;
#pragma unroll
            for (int w = 0; w < 8; ++w) s += red[(w * 5 + row) * 64 + ln];
            const int cc = cgp * 64 + ln; mod[(l * 5 + row) * 6144 + cc] = s + ada_b[l * 6144 + cc]; }
        __syncthreads();
    }
    const int gw = bid * 8 + wid, GW = G * 8;
    LAS unsigned char* scr = lds + 65536 + wid * 9216;
    for (int u = gw; u < 6400; u += GW) {
        const int l = u / 3200; int r = u % 3200;
        const float* W; bf16_t* WT; int K, N, Npad;
        if (r < 896) { W = p.IN(11) + (size_t)l * 1024 * PW; K = 1024; N = PW; Npad = NP; WT = (bf16_t*)(p.ws + WS_WIN) + (size_t)l * NP * 1024; }
        else if (r < 1152) { W = p.IN(12) + (size_t)l * 1024 * 1024; K = 1024; N = 1024; Npad = 1024; WT = (bf16_t*)(p.ws + WS_WOUT) + (size_t)l * 1024 * 1024; r -= 896; }
        else if (r < 2176) { W = p.IN(26) + (size_t)l * 1024 * 4096; K = 1024; N = 4096; Npad = 4096; WT = (bf16_t*)(p.ws + WS_W1) + (size_t)l * 4096 * 1024; r -= 1152; }
        else { W = p.IN(27) + (size_t)l * 4096 * 1024; K = 4096; N = 1024; Npad = 1024; WT = (bf16_t*)(p.ws + WS_W2) + (size_t)l * 1024 * 4096; r -= 2176; }
        transpose_unit(W, K, N, Npad, WT, r, lane, scr);
    }
}

DI void phase_norm(const Params& p, int l, int which, const int tid, const bool dry = false) {
    const int lane = tid & 63, wid = tid >> 6, gw = blockIdx.x * 8 + wid, GW = gridDim.x * 8;
    const float* mod = (const float*)(p.ws + WS_MOD);
    bf16_t* hm = (bf16_t*)(p.ws + (dry ? WS_OI : WS_HM));
    float* xo = dry ? (float*)(p.ws + WS_HL) : p.out;
    const float* g = which == 0 ? p.IN(7) + l * 1024 : (which == 1 ? p.IN(8) + l * 1024 : p.IN(28));
    const bool first = (which == 0 && l == 0), from_in = (l == 0 && which != 2);
    for (int row0 = gw; row0 < NTOK; row0 += 4 * GW) {
        f32x4 v[4][4]; float ss[4];
#pragma unroll
        for (int k = 0; k < 4; ++k) {
            const int row = row0 + k * GW; ss[k] = 0.f;
            if (row < NTOK) {
                const float* xr = from_in ? (row < 4096 ? p.IN(0) + (size_t)row * 1024 : p.IN(1) + (size_t)(row - 4096) * 1024) : p.out + (size_t)row * 1024;
#pragma unroll
                for (int j = 0; j < 4; ++j) v[k][j] = ((const f32x4*)xr)[lane + 64 * j];
                if (!first) {
                    const bf16_t* pr = (const bf16_t*)(p.ws + WS_DSA) + (size_t)row * 1024;
#pragma unroll
                    for (int j = 0; j < 4; ++j) { const u32x2 pp = ((const u32x2*)pr)[lane + 64 * j], pq = ((const u32x2*)(pr + (size_t)NTOK * 1024))[lane + 64 * j];
                        v[k][j].x += __uint_as_float(pp.x << 16) + __uint_as_float(pq.x << 16); v[k][j].y += __uint_as_float(pp.x & 0xffff0000u) + __uint_as_float(pq.x & 0xffff0000u);
                        v[k][j].z += __uint_as_float(pp.y << 16) + __uint_as_float(pq.y << 16); v[k][j].w += __uint_as_float(pp.y & 0xffff0000u) + __uint_as_float(pq.y & 0xffff0000u); }
                }
            }
        }
#pragma unroll
        for (int k = 0; k < 4; ++k) {
            const int row = row0 + k * GW;
            if (row < NTOK) {
#pragma unroll
                for (int j = 0; j < 4; ++j) ss[k] += (v[k][j].x * v[k][j].x + v[k][j].y * v[k][j].y) + (v[k][j].z * v[k][j].z + v[k][j].w * v[k][j].w);
            }
        }
#pragma unroll
        for (int o = 1; o < 64; o <<= 1) {
#pragma unroll
            for (int k = 0; k < 4; ++k) ss[k] += shx(ss[k], lane, o);
        }
#pragma unroll
        for (int k = 0; k < 4; ++k) {
            const int row = row0 + k * GW;
            if (row < NTOK) {
                const float rstd = rsqrtf(ss[k] * (1.f / 1024.f) + 1e-6f);
                if (which == 2) {
                    float* yo = xo + (size_t)row * 1024;
#pragma unroll
                    for (int j = 0; j < 4; ++j) { const f32x4 gv = ((const f32x4*)g)[lane + 64 * j]; ((f32x4*)yo)[lane + 64 * j] = v[k][j] * rstd * gv; }
                } else {
                    const float* mr = mod + (size_t)(l * 5 + modrow_of(row)) * 6144 + (which == 0 ? 0 : 3072);
#pragma unroll
                    for (int j = 0; j < 4; ++j) { const f32x4 gv = ((const f32x4*)g)[lane + 64 * j]; const f32x4 sh = ((const f32x4*)mr)[lane + 64 * j], sc = ((const f32x4*)(mr + 1024))[lane + 64 * j];
                        const f32x4 hv = v[k][j] * rstd * gv * (sc + 1.f) + sh;
                        u32x2 o; o.x = pk2(hv.x, hv.y); o.y = pk2(hv.z, hv.w);
                        ((u32x2*)(hm + (size_t)row * 1024))[lane + 64 * j] = o;
                        if (!first) ((f32x4*)(xo + (size_t)row * 1024))[lane + 64 * j] = v[k][j]; }
                }
            }
        }
    }
}

constexpr int M1_TILE_BYTES = 66048, M1_WL_BYTES = 9216;
template <int NCOL8, int NROWS> struct StageRegs { static constexpr int NCH = NCOL8 * NROWS, IT = (NCH + 511) / 512; u32x4 v[IT]; };
template <int NCOL8, int NROWS>
DI void stage_load(StageRegs<NCOL8, NROWS>& R, const char* proj, int row_first, int col0, int s0, int s1, int tid) {
    constexpr int NCH = NCOL8 * NROWS, IT = (NCH + 511) / 512;
#pragma unroll
    for (int i = 0; i < IT; ++i) { const int id = tid + 512 * i; const int row = id / NCOL8, cc = id % NCOL8, t = row_first + row;
        R.v[i] = (u32x4){0u, 0u, 0u, 0u};
        if (id < NCH && t >= s0 && t < s1) R.v[i] = *(const u32x4*)(proj + ((size_t)t * NP + col0 + cc * 8) * 2); }
}
template <int NCOL8, int NROWS>
DI void stage_store(const StageRegs<NCOL8, NROWS>& R, LAS unsigned char* tile, int pitchB, int dstB, int tid) {
    constexpr int NCH = NCOL8 * NROWS, IT = (NCH + 511) / 512;
#pragma unroll
    for (int i = 0; i < IT; ++i) { const int id = tid + 512 * i; const int row = id / NCOL8, cc = id % NCOL8;
        if (id < NCH) *(LAS u32x4*)(tile + row * pitchB + dstB + cc * 16) = R.v[i]; }
}

template <int MIX>
DI void m1_gla_wave(const Params& p, int l, int c, int hd, int dir, const LAS unsigned char* tile, LAS unsigned char* wl, const LAS unsigned char* wlp, int lane) {
    constexpr int DK = MIX == 0 ? 64 : 32, NT = DK / 32, PITCH = DK + 8, TP = MIX == 0 ? 1032 : 552;
    const int r = lane & 31, hh = lane >> 5, tok0 = c * 32;
    const LAS bf16_t* T = (const LAS bf16_t*)tile;
    LAS bf16_t* Qt = (LAS bf16_t*)wl; LAS bf16_t* Kt = Qt + 32 * PITCH;
    char* DS = (char*)(p.ws + (MIX == 0 ? WS_DSA : WS_DSB));
    float* ACH = (float*)(p.ws + (MIX == 0 ? WS_ACHA : WS_ACHB));
    char* QH = (char*)(p.ws + (MIX == 0 ? WS_QHA : WS_QHB));
    float* OI = (float*)(p.ws + WS_OI);
    const int tba = 4 * hh * TP, tb = tba + r;
#define TROW(li) ((8 * ((li) >> 2) + ((li) & 3)) * TP)
    const int vcol = MIX == 0 ? 256 + hd * 64 : 256 + hd * 64;
    bf16x8 vf[2][2];
#pragma unroll
    for (int n = 0; n < 2; ++n)
#pragma unroll
        for (int st = 0; st < 2; ++st)
#pragma unroll
            for (int j = 0; j < 8; ++j) vf[n][st][j] = (short)T[tb + TROW(8 * st + j) + vcol + 32 * n];
    const int qcol = MIX == 0 ? hd * 64 : hd * 32;
#pragma unroll 1
    for (int m = 0; m < NT; ++m) {
        float la[16], kk[16];
        if (MIX == 0) {
            const int zcol = (dir == 0 ? 512 : 768) + hd * 64 + 32 * m;
            const float* lbl = p.IN(13);
            float lb = 0.f;
            if (l == 1) { const int ch = hd * 64 + 32 * m + r; const float l0 = lbl[(0 * 2 + dir) * 256 + ch], l1 = lbl[(1 * 2 + dir) * 256 + ch]; lb = rcpf_(1.f + __expf(l0 - l1)); }
#pragma unroll
            for (int li = 0; li < 16; ++li) { const float z = bf2f(T[tb + TROW(li) + zcol]);
                const float e = __expf(-z), sg = rcpf_(1.f + e), omsg = e * sg;
                const float f = lb + (1.f - lb) * sg; kk[li] = (1.f - lb) * omsg; la[li] = __logf(fmaxf(f, 1e-20f)); }
        } else {
            const int kcol = 128 + hd * 32, acol = 512 + dir * 16;
            float w2[16];
#pragma unroll
            for (int rho = 0; rho < 16; ++rho) w2[rho] = p.IN(15)[((l * 2 + dir) * 16 + rho) * 128 + hd * 32 + r];
            const float ba = p.IN(16)[(l * 2 + dir) * 128 + hd * 32 + r];
#pragma unroll
            for (int li = 0; li < 16; ++li) {
                const u32x4 a0 = *(const LAS u32x4*)(T + tba + TROW(li) + acol), a1 = *(const LAS u32x4*)(T + tba + TROW(li) + acol + 8);
                float w = ba;
#pragma unroll
                for (int qd = 0; qd < 4; ++qd) { w += __uint_as_float(a0[qd] << 16) * w2[2 * qd] + __uint_as_float(a0[qd] & 0xffff0000u) * w2[2 * qd + 1];
                    w += __uint_as_float(a1[qd] << 16) * w2[8 + 2 * qd] + __uint_as_float(a1[qd] & 0xffff0000u) * w2[8 + 2 * qd + 1]; }
                const float ls = fminf(w, 0.f) - __logf(1.f + __expf(-fabsf(w)));
                la[li] = ls * (1.f / 16.f);
                kk[li] = bf2f(T[tb + TROW(li) + kcol]);
            }
        }
        float gs[4], pgs[4];
#pragma unroll
        for (int g = 0; g < 4; ++g) { gs[g] = (la[4 * g] + la[4 * g + 1]) + (la[4 * g + 2] + la[4 * g + 3]); pgs[g] = shx(gs[g], lane, 32); }
        float run = 0.f, half = 0.f; float cum[16];
#pragma unroll
        for (int g = 0; g < 4; ++g) { float b = run + (hh ? pgs[g] : 0.f); run += gs[g] + pgs[g]; if (g == 1) half = run;
#pragma unroll
            for (int i = 0; i < 4; ++i) { b += la[4 * g + i]; cum[4 * g + i] = b; } }
        const float total = run;
        const float ref = dir == 0 ? half : total - half;
        float kh[16];
        const unsigned qhb = MIX == 0 ? (unsigned)((tok0 + 4 * hh) * 512 + dir * 256 + hd * 64 + 32 * m + r) * 2u : (unsigned)((tok0 + 4 * hh) * 256 + dir * 128 + hd * 32 + r) * 2u;
#pragma unroll
        for (int li = 0; li < 16; ++li) {
            const float cv = dir == 0 ? cum[li] : (total - cum[li] + la[li]);
            const float eq = __expf(fminf(cv - ref, 80.f)), ek = __expf(fminf(ref - cv, 80.f));
            const int tkl = 8 * (li >> 2) + (li & 3);
            const float qv = bf2f(T[tb + TROW(li) + qcol + 32 * m]) * (MIX == 1 ? 0.17677669529663687f : 1.f);
            Qt[(tkl + 4 * hh) * PITCH + 32 * m + r] = f2bf(qv * eq);
            Kt[(tkl + 4 * hh) * PITCH + 32 * m + r] = f2bf(kk[li] * ek);
            kh[li] = kk[li] * __expf(total - cv);
            const float qh = qv * __expf(cv);
            *(bf16_t*)(QH + (qhb + (unsigned)(tkl * (MIX == 0 ? 512 : 256) * 2))) = f2bf(qh);
        }
        const bf16x8 khat0 = pack8(kh), khat1 = pack8(kh + 8);
        if (hh == 0) ACH[((c * 4 + hd) * 2 + dir) * DK + 32 * m + r] = __expf(total);
#pragma unroll
        for (int n = 0; n < 2; ++n) {
            f32x16 ds = zero16();
            ds = MFMA32(khat0, vf[n][0], ds); ds = MFMA32(khat1, vf[n][1], ds);
            const unsigned dsb = (unsigned)(((c * 4 + hd) * 2 + dir) * (DK * 64) * 2) + (unsigned)((n * (DK / 16) + 2 * m) * 1024 + r * 16 + hh * 8);
#pragma unroll
            for (int g = 0; g < 4; ++g) { u32x2 w; w.x = pk2(ds[4 * g], ds[4 * g + 1]); w.y = pk2(ds[4 * g + 2], ds[4 * g + 3]);
                *(u32x2*)(DS + (dsb + (unsigned)((g >> 1) * 1024 + (g & 1) * 512))) = w; }
        }
    }
#undef TROW
    __builtin_amdgcn_fence(__ATOMIC_RELEASE, "wavefront");
    __builtin_amdgcn_wave_barrier();
    f32x16 pt = zero16();
#pragma unroll
    for (int s = 0; s < DK / 16; ++s) {
        const bf16x8 kfr = *(const LAS bf16x8*)(Kt + r * PITCH + 16 * s + 8 * hh);
        const bf16x8 qfr = *(const LAS bf16x8*)(Qt + r * PITCH + 16 * s + 8 * hh);
        pt = MFMA32(kfr, qfr, pt);
    }
    __builtin_amdgcn_fence(__ATOMIC_RELEASE, "wavefront");
    __builtin_amdgcn_wave_barrier();
    LAS float* ex = (LAS float*)wl; const LAS float* exp_ = (const LAS float*)wlp;
#pragma unroll
    for (int i = 0; i < 16; ++i) { const int srow = crow(i, hh); const bool keep = dir == 0 ? (srow <= r) : (srow >= r); pt[i] = keep ? pt[i] : 0.f; ex[i * 64 + lane] = pt[i]; }
    __syncthreads();
    float ptv[16];
#pragma unroll
    for (int i = 0; i < 16; ++i) ptv[i] = pt[i] + exp_[i * 64 + lane];
    const bf16x8 pf0 = pack8(ptv), pf1 = pack8(ptv + 8);
    float* oi = OI + (size_t)((MIX * 256 + c) * 4 + hd) * 2048;
    {
        f32x16 ot = zero16();
        const bf16x8 va = dir == 0 ? vf[0][0] : vf[1][0], vb = dir == 0 ? vf[0][1] : vf[1][1];
        ot = MFMA32(va, pf0, ot); ot = MFMA32(vb, pf1, ot);
#pragma unroll
        for (int g = 0; g < 4; ++g) *(f32x4*)(oi + ((dir * 4 + g) * 64 + lane) * 4) = (f32x4){ot[4 * g], ot[4 * g + 1], ot[4 * g + 2], ot[4 * g + 3]};
    }
}

DI void m1_rg_wave(const Params& p, int l, int c, int nb, int dir, const LAS unsigned char* tile, int lane) {
    constexpr int TP = 264;
    const int r = lane & 31, hh = lane >> 5, tok0 = c * 32;
    const LAS bf16_t* T = (const LAS bf16_t*)tile;
    float* HL = (float*)(p.ws + WS_HL); float* CP = (float*)(p.ws + WS_CP);
    float* RAGA = (float*)(p.ws + WS_RAGA); float* RAGH = (float*)(p.ws + WS_RAGH);
    const int sgn = dir ? -1 : 1, lbase = dir ? 31 : 0;
    const float* cw = p.IN(18) + (size_t)(l * 2 + dir) * 4 * 256;
    const float* cb = p.IN(19) + (size_t)(l * 2 + dir) * 256;
    bf16x8 af[4];
    const int trow = lbase + sgn * r + 3;
#pragma unroll
    for (int s = 0; s < 4; ++s) {
        const int ch0 = 64 * nb + 16 * s + 8 * hh;
        float xc[8];
        { const f32x4 b0 = *(const f32x4*)(cb + ch0), b1 = *(const f32x4*)(cb + ch0 + 4);
          xc[0] = b0.x; xc[1] = b0.y; xc[2] = b0.z; xc[3] = b0.w; xc[4] = b1.x; xc[5] = b1.y; xc[6] = b1.z; xc[7] = b1.w; }
#pragma unroll
        for (int tap = 0; tap < 4; ++tap) {
            const u32x4 uu = *(const LAS u32x4*)(T + (trow + sgn * (tap - 3)) * TP + ch0);
            const f32x4 w0 = *(const f32x4*)(cw + tap * 256 + ch0), w1 = *(const f32x4*)(cw + tap * 256 + ch0 + 4);
            xc[0] += w0.x * __uint_as_float(uu.x << 16); xc[1] += w0.y * __uint_as_float(uu.x & 0xffff0000u);
            xc[2] += w0.z * __uint_as_float(uu.y << 16); xc[3] += w0.w * __uint_as_float(uu.y & 0xffff0000u);
            xc[4] += w1.x * __uint_as_float(uu.z << 16); xc[5] += w1.y * __uint_as_float(uu.z & 0xffff0000u);
            xc[6] += w1.z * __uint_as_float(uu.w << 16); xc[7] += w1.w * __uint_as_float(uu.w & 0xffff0000u);
        }
        af[s] = pack8(xc);
    }
    const float* wr_ = p.IN(20) + (size_t)((l * 2 + dir) * 4 + nb) * 4096;
    const float* wi_ = p.IN(22) + (size_t)((l * 2 + dir) * 4 + nb) * 4096;
#pragma unroll 1
    for (int n = 0; n < 2; ++n) {
        f32x16 rr = zero16(), ri = zero16();
#pragma unroll
        for (int s = 0; s < 4; ++s) {
            float br_[8], bi_[8];
#pragma unroll
            for (int j = 0; j < 8; ++j) { br_[j] = wr_[(16 * s + 8 * hh + j) * 64 + 32 * n + r]; bi_[j] = wi_[(16 * s + 8 * hh + j) * 64 + 32 * n + r]; }
            rr = MFMA32(af[s], pack8(br_), rr); ri = MFMA32(af[s], pack8(bi_), ri);
        }
        const int ch = 64 * nb + 32 * n + r;
        const float cbv = cb[ch]; float cwv[4];
#pragma unroll
        for (int tap = 0; tap < 4; ++tap) cwv[tap] = cw[tap * 256 + ch];
        const float brv = p.IN(21)[(l * 2 + dir) * 256 + ch], biv = p.IN(23)[(l * 2 + dir) * 256 + ch];
        const float lam = p.IN(24)[(l * 2 + dir) * 256 + ch];
        const float c8 = -8.f * log1pf(__expf(-lam));
        float a[16], bx[16];
#pragma unroll
        for (int li = 0; li < 16; ++li) {
            const int tr = lbase + sgn * (8 * (li >> 2) + 4 * hh + (li & 3)) + 3;
            float xcv = cbv;
#pragma unroll
            for (int tap = 0; tap < 4; ++tap) xcv += cwv[tap] * bf2f(T[(tr + sgn * (tap - 3)) * TP + ch]);
            const float rv = sigmoidf_(rr[li] + brv), iv = sigmoidf_(ri[li] + biv);
            const float loga = c8 * rv;
            a[li] = __expf(loga); bx[li] = __builtin_amdgcn_sqrtf(om_exp(2.f * loga)) * iv * xcv;
        }
        float Ag[4], Bg[4], pA[4], pB[4];
#pragma unroll
        for (int g = 0; g < 4; ++g) { float hl = 0.f, ap = 1.f;
#pragma unroll
            for (int i = 0; i < 4; ++i) { hl = a[4 * g + i] * hl + bx[4 * g + i]; ap *= a[4 * g + i]; }
            Ag[g] = ap; Bg[g] = hl; pA[g] = shx(ap, lane, 32); pB[g] = shx(hl, lane, 32); }
        float Hrun = 0.f, Prun = 1.f;
        const bool first = (hh == 0);
#pragma unroll
        for (int g = 0; g < 4; ++g) {
            const float A0 = first ? Ag[g] : pA[g], B0 = first ? Bg[g] : pB[g];
            const float A1 = first ? pA[g] : Ag[g], B1 = first ? pB[g] : Bg[g];
            float hcur = first ? Hrun : (A0 * Hrun + B0), pcur = first ? Prun : Prun * A0;
            Hrun = A1 * (A0 * Hrun + B0) + B1; Prun = Prun * A0 * A1;
#pragma unroll
            for (int i = 0; i < 4; ++i) { hcur = a[4 * g + i] * hcur + bx[4 * g + i]; pcur *= a[4 * g + i];
                const int tg = tok0 + lbase + sgn * (8 * g + 4 * hh + i);
                HL[((size_t)dir * NTOK + tg) * 256 + ch] = hcur; CP[((size_t)dir * NTOK + tg) * 256 + ch] = pcur; }
        }
        if (hh == 0) { RAGA[(c * 2 + dir) * 256 + ch] = Prun; RAGH[(c * 2 + dir) * 256 + ch] = Hrun; }
    }
}

DI void phase_m1(const Params& p, int l, LAS unsigned char* lds, const int tid, const int stages = 7) {
    const int lane = tid & 63, wid = __builtin_amdgcn_readfirstlane(tid >> 6);
    const char* proj = (const char*)(p.ws + WS_BIG);
    LAS unsigned char* tile = lds;
    LAS unsigned char* wl = lds + M1_TILE_BYTES + wid * M1_WL_BYTES;
    LAS unsigned char* wlp = lds + M1_TILE_BYTES + (wid ^ 1) * M1_WL_BYTES;
    for (int c = blockIdx.x; c < 256; c += gridDim.x) {
        int ln = lane, td = tid; asm volatile("" : "+v"(ln), "+v"(td));
        const int tok0 = c * 32;
        int s0, s1;
        if (c < 128) { s0 = (c >> 3) * 256; s1 = s0 + 256; } else { s0 = 4096 + ((c - 128) >> 5) * 1024; s1 = s0 + 1024; }
        StageRegs<128, 32> ra; StageRegs<64, 32> rb; StageRegs<4, 32> rb2; StageRegs<32, 38> rc;
        if (stages & 1) stage_load(ra, proj, tok0, 0, 0, NTOK, td);
        if (stages & 2) { stage_load(rb, proj, tok0, B_Q, 0, NTOK, td); stage_load(rb2, proj, tok0, B_AF, 0, NTOK, td); }
        if (stages & 4) stage_load(rc, proj, tok0 - 3, C_X, s0, s1, td);
        if (stages & 1) {
        stage_store(ra, tile, 2064, 0, td);
        __syncthreads();
        m1_gla_wave<0>(p, l, c, wid >> 1, wid & 1, tile, wl, wlp, ln);
        __builtin_amdgcn_sched_barrier(0); asm volatile("" : "+v"(ln), "+v"(td));
        }
        if (stages & 2) {
        stage_store(rb, tile, 1104, 0, td); stage_store(rb2, tile, 1104, 1024, td);
        __syncthreads();
        m1_gla_wave<1>(p, l, c, wid >> 1, wid & 1, tile, wl, wlp, ln);
        __builtin_amdgcn_sched_barrier(0); asm volatile("" : "+v"(ln), "+v"(td));
        }
        if (stages & 4) {
        stage_store(rc, tile, 528, 0, td);
        __syncthreads();
        m1_rg_wave(p, l, c, wid >> 1, wid & 1, tile, ln);
        __syncthreads();
        }
    }
}

DI void m2_chain8(const Params& p, int l, int id, const bool dry) {
    const int sq = id / 6144; int rem = id % 6144;
    const int hd = rem / 1536, dir = (rem / 768) & 1; int f = rem % 768;
    const int mix = f < 512 ? 0 : 1; if (mix) f -= 512;
    const int dk = mix == 0 ? 64 : 32, S_ = dk / 16;
    const int lane_ = f & 63, ns = f >> 6, n = ns / S_, s = ns % S_;
    const int d0 = 16 * s + 8 * (lane_ >> 5), e = 32 * n + (lane_ & 31);
    char* DS = (char*)(p.ws + (mix == 0 ? WS_DSA : WS_DSB));
    char* DSO = dry ? (char*)(p.ws + (mix == 0 ? WS_HM : WS_BIG + 56 * MiB)) : DS;
    const float* ACH = (const float*)(p.ws + (mix == 0 ? WS_ACHA : WS_ACHB));
    float zf = 0.f; asm volatile("" : "+v"(zf));
    float S[8];
#pragma unroll
    for (int j = 0; j < 8; ++j) S[j] = zf;
    int c0, N;
    if (sq < 16) { c0 = sq * 8; N = 8; }
    else { c0 = 128 + (sq - 16) * 32; N = 32; const int b = sq - 16;
        const float* s0p = mix == 0 ? p.IN(2) + (size_t)((((b * 2 + l) * 2 + dir) * 4 + hd)) * 4096 : p.IN(3) + (size_t)((((b * 2 + l) * 2 + dir) * 4 + hd)) * 2048;
#pragma unroll
        for (int j = 0; j < 8; ++j) S[j] = s0p[(d0 + j) * 64 + e]; }
    for (int n0 = 0; n0 < N; n0 += 8) {
        u32x4 v[8]; f32x4 a0[8], a1[8];
#pragma unroll
        for (int i = 0; i < 8; ++i) { const int nn = n0 + i, c = c0 + (dir == 0 ? nn : N - 1 - nn); const size_t ui = (size_t)((c * 4 + hd) * 2 + dir);
            v[i] = *(const u32x4*)(DS + ui * (dk * 128) + f * 16); a0[i] = *(const f32x4*)(ACH + ui * dk + d0); a1[i] = *(const f32x4*)(ACH + ui * dk + d0 + 4); }
#pragma unroll
        for (int i = 0; i < 8; ++i) { const int nn = n0 + i, c = c0 + (dir == 0 ? nn : N - 1 - nn); const size_t ui = (size_t)((c * 4 + hd) * 2 + dir);
            u32x4 o; o.x = pk2(S[0], S[1]); o.y = pk2(S[2], S[3]); o.z = pk2(S[4], S[5]); o.w = pk2(S[6], S[7]);
            *(u32x4*)(DSO + ui * (dk * 128) + f * 16) = o;
            S[0] = a0[i].x * S[0] + __uint_as_float(v[i].x << 16); S[1] = a0[i].y * S[1] + __uint_as_float(v[i].x & 0xffff0000u);
            S[2] = a0[i].z * S[2] + __uint_as_float(v[i].y << 16); S[3] = a0[i].w * S[3] + __uint_as_float(v[i].y & 0xffff0000u);
            S[4] = a1[i].x * S[4] + __uint_as_float(v[i].z << 16); S[5] = a1[i].y * S[5] + __uint_as_float(v[i].z & 0xffff0000u);
            S[6] = a1[i].z * S[6] + __uint_as_float(v[i].w << 16); S[7] = a1[i].w * S[7] + __uint_as_float(v[i].w & 0xffff0000u); }
    }
    if (sq < 16) { const int b = sq;
        float* ob = dry ? (float*)(p.ws + 243 * MiB) - OUT_SH : p.out;
        float* op = mix == 0 ? ob + OUT_SH + (size_t)((((b * 2 + l) * 2 + dir) * 4 + hd)) * 4096 : ob + OUT_SG + (size_t)((((b * 2 + l) * 2 + dir) * 4 + hd)) * 2048;
#pragma unroll
        for (int j = 0; j < 8; ++j) op[(d0 + j) * 64 + e] = S[j]; }
}
DI void phase_m2(const Params& p, int l, const int tid, const bool dry = false) {
    const int gt = blockIdx.x * 512 + tid, GT = gridDim.x * 512;
    for (int id = gt; id < 20 * 6144; id += GT) m2_chain8(p, l, 20 * 6144 - 1 - id, dry);
    float* RAGH = (float*)(p.ws + WS_RAGH); const float* RAGA = (const float*)(p.ws + WS_RAGA);
    float* RAGO = dry ? (float*)(p.ws + 250 * MiB) : RAGH; float* SRO = dry ? (float*)(p.ws + 251 * MiB) - OUT_SR : p.out;
    for (int id = GT - 1 - gt; id < 20 * 512; id += GT) {
        const int sq = id / 512, dir = (id >> 8) & 1, ch = id & 255;
        int c0, N; float h = 0.f;
        if (sq < 16) { c0 = sq * 8; N = 8; } else { c0 = 128 + (sq - 16) * 32; N = 32; h = p.IN(4)[((size_t)((sq - 16) * 2 + l) * 2 + dir) * 256 + ch]; }
        for (int n0 = 0; n0 < N; n0 += 8) {
            float v[8], av[8];
#pragma unroll
            for (int i = 0; i < 8; ++i) { const int n = n0 + i, c = c0 + (dir == 0 ? n : N - 1 - n); v[i] = RAGH[(c * 2 + dir) * 256 + ch]; av[i] = RAGA[(c * 2 + dir) * 256 + ch]; }
#pragma unroll
            for (int i = 0; i < 8; ++i) { const int n = n0 + i, c = c0 + (dir == 0 ? n : N - 1 - n); RAGO[(c * 2 + dir) * 256 + ch] = h; h = av[i] * h + v[i]; }
        }
        if (sq < 16) SRO[OUT_SR + ((size_t)(sq * 2 + l) * 2 + dir) * 256 + ch] = h;
    }
}

DI void m3_gla_unit(const Params& p, int l, int c, int hd, int MIX, int lane) {
    const int DK = MIX == 0 ? 64 : 32, S_ = DK >> 4;
    const int r = lane & 31, hh = lane >> 5, tok0 = c * 32;
    const bf16_t* proj = (const bf16_t*)(p.ws + WS_BIG);
    const bf16_t* DS = (const bf16_t*)(p.ws + (MIX == 0 ? WS_DSA : WS_DSB));
    const bf16_t* QH = (const bf16_t*)(p.ws + (MIX == 0 ? WS_QHA : WS_QHB));
    const float* oi = (const float*)(p.ws + WS_OI) + (size_t)((MIX * 256 + c) * 4 + hd) * 2048;
    bf16_t* mix = (bf16_t*)(p.ws + WS_HM);
    f32x16 acc[2];
#pragma unroll
    for (int n = 0; n < 2; ++n)
#pragma unroll
        for (int g = 0; g < 4; ++g) { const f32x4 v = *(const f32x4*)(oi + ((n * 4 + g) * 64 + lane) * 4); acc[n][4 * g] = v.x; acc[n][4 * g + 1] = v.y; acc[n][4 * g + 2] = v.z; acc[n][4 * g + 3] = v.w; }
#pragma unroll 1
    for (int dir = 0; dir < 2; ++dir) {
        const bf16_t* sp = DS + (size_t)((c * 4 + hd) * 2 + dir) * (DK * 64);
        const bf16_t* qp = QH + (size_t)(tok0 + r) * (8 * DK) + dir * (4 * DK) + hd * DK + 8 * hh;
#pragma unroll 2
        for (int s = 0; s < S_; ++s) {
            const bf16x8 qf = *(const bf16x8*)(qp + 16 * s);
            const bf16x8 sf0 = *(const bf16x8*)(sp + (s * 64 + lane) * 8), sf1 = *(const bf16x8*)(sp + ((S_ + s) * 64 + lane) * 8);
            acc[0] = MFMA32(sf0, qf, acc[0]); acc[1] = MFMA32(sf1, qf, acc[1]);
        }
    }
    float ss = 0.f;
#pragma unroll
    for (int n = 0; n < 2; ++n)
#pragma unroll
        for (int i = 0; i < 16; ++i) ss += acc[n][i] * acc[n][i];
    ss += shx(ss, lane, 32);
    const float rstd = rsqrtf(ss * (1.f / 64.f) + 1e-6f);
    const float* gain = (MIX == 0 ? p.IN(14) : p.IN(17)) + l * 256 + hd * 64;
    const bf16_t* grow = proj + (size_t)(tok0 + r) * NP + (MIX == 0 ? A_G : B_G) + hd * 64;
    bf16_t* orow = mix + (size_t)(tok0 + r) * 1024 + MIX * 256 + hd * 64;
#pragma unroll
    for (int n = 0; n < 2; ++n)
#pragma unroll
        for (int g = 0; g < 4; ++g) {
            const int e = 32 * n + 8 * g + 4 * hh;
            const u32x2 gg = *(const u32x2*)(grow + e); const f32x4 gn = *(const f32x4*)(gain + e);
            const float g0 = __uint_as_float(gg.x << 16), g1 = __uint_as_float(gg.x & 0xffff0000u), g2 = __uint_as_float(gg.y << 16), g3 = __uint_as_float(gg.y & 0xffff0000u);
            u32x2 o; o.x = pk2(acc[n][4 * g] * rstd * gn.x * siluf_(g0), acc[n][4 * g + 1] * rstd * gn.y * siluf_(g1));
            o.y = pk2(acc[n][4 * g + 2] * rstd * gn.z * siluf_(g2), acc[n][4 * g + 3] * rstd * gn.w * siluf_(g3));
            *(u32x2*)(orow + e) = o;
        }
}

DI float gelu_tanh(float x) { const float u = 0.7978845608028654f * (x + 0.044715f * x * x * x); const float t = 1.f - 2.f * rcpf_(__expf(2.f * u) + 1.f); return 0.5f * x * (1.f + t); }

DI void phase_m3(const Params& p, int l, const int tid) {
    const int lane = tid & 63, wid = __builtin_amdgcn_readfirstlane(tid >> 6), gw = blockIdx.x * 8 + wid, GW = gridDim.x * 8;
    for (int u = gw; u < 2048; u += GW) {
        const int ty = u & 1, idx = u >> 1, c = idx >> 2, hd = idx & 3;
        int ln = lane; asm volatile("" : "+v"(ln));
        m3_gla_unit(p, l, c, hd, ty, ln);
    }
    const int gt = blockIdx.x * 512 + tid, GT = gridDim.x * 512;
    const bf16_t* proj = (const bf16_t*)(p.ws + WS_BIG);
    bf16_t* mix = (bf16_t*)(p.ws + WS_HM);
    const float* HL = (const float*)(p.ws + WS_HL); const float* CP = (const float*)(p.ws + WS_CP); const float* HIN = (const float*)(p.ws + WS_RAGH);
    for (int id0 = gt; id0 < NTOK * 64; id0 += 4 * GT) {
        f32x4 hf[4], hb[4], cf[4], cb[4], inf_[4], inb[4]; u32x2 gg[4];
#pragma unroll
        for (int k = 0; k < 4; ++k) { const int id = id0 + k * GT; if (id < NTOK * 64) { const int tok = id >> 6, ch = (id & 63) * 4, c = tok >> 5;
            hf[k] = *(const f32x4*)(HL + (size_t)tok * 256 + ch); hb[k] = *(const f32x4*)(HL + ((size_t)NTOK + tok) * 256 + ch);
            cf[k] = *(const f32x4*)(CP + (size_t)tok * 256 + ch); cb[k] = *(const f32x4*)(CP + ((size_t)NTOK + tok) * 256 + ch);
            inf_[k] = *(const f32x4*)(HIN + (c * 2 + 0) * 256 + ch); inb[k] = *(const f32x4*)(HIN + (c * 2 + 1) * 256 + ch);
            gg[k] = *(const u32x2*)(proj + (size_t)tok * NP + C_G + ch); } }
#pragma unroll
        for (int k = 0; k < 4; ++k) { const int id = id0 + k * GT; if (id < NTOK * 64) { const int tok = id >> 6, ch = (id & 63) * 4;
            const f32x4 y = hf[k] + cf[k] * inf_[k] + hb[k] + cb[k] * inb[k];
            u32x2 o; o.x = pk2(y.x * gelu_tanh(__uint_as_float(gg[k].x << 16)), y.y * gelu_tanh(__uint_as_float(gg[k].x & 0xffff0000u)));
            o.y = pk2(y.z * gelu_tanh(__uint_as_float(gg[k].y << 16)), y.w * gelu_tanh(__uint_as_float(gg[k].y & 0xffff0000u)));
            *(u32x2*)(mix + (size_t)tok * 1024 + 512 + ch) = o; } }
    }
    const float* sw = p.IN(25) + l * 3 * 256;
    for (int id0 = gt; id0 < NTOK * 64; id0 += 4 * GT) {
        u32x2 cc[4][3], vv[4][3], bb[4];
#pragma unroll
        for (int k = 0; k < 4; ++k) { const int id = id0 + k * GT; if (id < NTOK * 64) { const int tok = id >> 6, ch = (id & 63) * 4;
            const int seg = tok < 4096 ? 256 : 64, pos = tok & (seg - 1);
#pragma unroll
            for (int j = 0; j < 3; ++j) { const int pp = pos + j - 1; cc[k][j] = (u32x2){0u, 0u}; vv[k][j] = (u32x2){0u, 0u};
                if (pp >= 0 && pp < seg) { const int tt = tok + j - 1; cc[k][j] = *(const u32x2*)(proj + (size_t)tt * NP + D_C + ch); vv[k][j] = *(const u32x2*)(proj + (size_t)tt * NP + D_V + ch); } }
            bb[k] = *(const u32x2*)(proj + (size_t)tok * NP + D_B + ch); } }
#pragma unroll
        for (int k = 0; k < 4; ++k) { const int id = id0 + k * GT; if (id < NTOK * 64) { const int tok = id >> 6, ch = (id & 63) * 4;
            f32x4 y = {0.f, 0.f, 0.f, 0.f};
#pragma unroll
            for (int j = 0; j < 3; ++j) { const f32x4 w = *(const f32x4*)(sw + j * 256 + ch);
                y.x += w.x * __uint_as_float(cc[k][j].x << 16) * __uint_as_float(vv[k][j].x << 16); y.y += w.y * __uint_as_float(cc[k][j].x & 0xffff0000u) * __uint_as_float(vv[k][j].x & 0xffff0000u);
                y.z += w.z * __uint_as_float(cc[k][j].y << 16) * __uint_as_float(vv[k][j].y << 16); y.w += w.w * __uint_as_float(cc[k][j].y & 0xffff0000u) * __uint_as_float(vv[k][j].y & 0xffff0000u); }
            u32x2 o; o.x = pk2(y.x * __uint_as_float(bb[k].x << 16), y.y * __uint_as_float(bb[k].x & 0xffff0000u));
            o.y = pk2(y.z * __uint_as_float(bb[k].y << 16), y.w * __uint_as_float(bb[k].y & 0xffff0000u));
            *(u32x2*)(mix + (size_t)tok * 1024 + 768 + ch) = o; } }
    }
}

__global__ void __launch_bounds__(512, 2) fwd_kernel(Params pin) {
    extern __shared__ __attribute__((aligned(16))) unsigned char lds_raw[];
    LAS unsigned char* lds = (LAS unsigned char*)lds_raw;
    cg::grid_group grid = cg::this_grid();
    const int G = gridDim.x, bid = blockIdx.x;
    volatile LAS unsigned* bst = (volatile LAS unsigned*)(lds + LDS_BYTES - 16);
    if (threadIdx.x < 4) bst[threadIdx.x] = 0u;
    __syncthreads();
    const XcdBarrier xbar = xcd_barrier_post((unsigned*)(pin.ws + WS_BAR), bst);
    for (int ph2 = 2 * pin.ph_lo; ph2 < 2 * pin.ph_hi; ++ph2) {
        const int ph = ph2 >> 1;
        if ((ph2 & 1) && !((REPEAT_MASK >> ph) & 1u)) continue;
        size_t zo = 0; asm volatile("" : "+s"(zo));
        int tid = threadIdx.x; asm volatile("" : "+v"(tid));
        Params p = pin; p.ws += zo; p.out += zo; p.zo = zo;
        const float* mod = (const float*)(p.ws + WS_MOD);
        bf16_t* hm = (bf16_t*)(p.ws + WS_HM); bf16_t* big = (bf16_t*)(p.ws + WS_BIG);
        if (ph == 0) phase_p0(p, lds, tid);
        else {
            const int l = ph == 19 ? 0 : (ph - 1) / 9, s = ph == 19 ? 9 : (ph - 1) % 9;
            pg8::StaticOrder S; pg8::Gemm g{hm, hm, 0, 0, 0, 0}; pg8::EpiAny E{0, big, 0, mod}; bool is_gemm = false, align = false;
            if (s == 0 || s == 6 || s == 9) phase_norm(p, l, s == 0 ? 0 : (s == 6 ? 1 : 2), tid, (ph2 & 1) != 0);
            else if (s == 1) { g = pg8::Gemm{hm, (const bf16_t*)(p.ws + WS_WIN) + (size_t)l * NP * 1024, NTOK, NP, 1024, 1024}; S.init(NTOK, NP, G, bid);
                E = pg8::EpiAny{0, big, NP, mod}; is_gemm = true; align = GEMM_ALIGN; }
            else if (s == 2) phase_m1(p, l, lds, tid, (ph2 & 1) ? M1_PROBE_STAGES : 7);
            else if (s == 3) phase_m2(p, l, tid, (ph2 & 1) != 0);
            else if (s == 4) phase_m3(p, l, tid);
            else if (s == 5) { g = pg8::Gemm{hm, (const bf16_t*)(p.ws + WS_WOUT) + (size_t)l * 1024 * 1024, NTOK, 1024, 512, 1024}; S.init(NTOK, 1024, G, bid, 2);
                E = pg8::EpiAny{2, (bf16_t*)(p.ws + ((ph2 & 1) ? WS_HL : WS_DSA)), 1024, mod + (size_t)l * 5 * 6144 + 2048}; is_gemm = true; }
            else if (s == 7) { g = pg8::Gemm{hm, (const bf16_t*)(p.ws + WS_W1) + (size_t)l * 4096 * 1024, NTOK, DFF, 1024, 1024}; S.init(NTOK, DFF, G, bid);
                E = pg8::EpiAny{1, big, DFF, mod}; is_gemm = true; align = GEMM_ALIGN; }
            else { g = pg8::Gemm{big, (const bf16_t*)(p.ws + WS_W2) + (size_t)l * 1024 * 4096, NTOK, 1024, 2048, DFF}; S.init(NTOK, 1024, G, bid, 2);
                E = pg8::EpiAny{2, (bf16_t*)(p.ws + ((ph2 & 1) ? WS_HL : WS_DSA)), 1024, mod + (size_t)l * 5 * 6144 + 5120}; is_gemm = true; }
            if (is_gemm) pg8::gemm_phase<pg8::EpiAny, GEMM_SP2>(lds, g, S, E, tid, align);
        }
        if (ph2 + 2 < 2 * pin.ph_hi || (!(ph2 & 1) && ((REPEAT_MASK >> ph) & 1u))) { if (pin.ph_hi > 1000) grid.sync();
            xcd_barrier(xbar); }
    }
}

extern "C" void kernel_launch(void* const* d_in, const int* in_sizes, int n_in, void* d_out, int out_size, void* d_ws, size_t ws_size, hipStream_t stream) {
    static int grid = 0;
    if (grid == 0) {
        if (n_in != 29 || ws_size < WS_END) { fprintf(stderr, "kernel_launch: unexpected n_in %d / ws %zu\n", n_in, ws_size); grid = -1; return; }
        int dev = 0, cus = 0, per_cu = 0;
        hipGetDevice(&dev); hipDeviceGetAttribute(&cus, hipDeviceAttributeMultiprocessorCount, dev);
        if (hipFuncSetAttribute((const void*)fwd_kernel, hipFuncAttributeMaxDynamicSharedMemorySize, LDS_BYTES) != hipSuccess) { fprintf(stderr, "kernel_launch: hipFuncSetAttribute failed\n"); grid = -1; return; }
        if (hipOccupancyMaxActiveBlocksPerMultiprocessor(&per_cu, (const void*)fwd_kernel, 512, LDS_BYTES) != hipSuccess || per_cu < 1) { fprintf(stderr, "kernel_launch: occupancy query says %d\n", per_cu); per_cu = 1; }
        (void)hipGetLastError();
        grid = cus * 1;
        if (grid <= 0) grid = 256;
    }
    if (grid < 0) return;
    if (hipMemsetAsync((char*)d_ws + WS_BAR, 0, 16384, stream) != hipSuccess) { fprintf(stderr, "kernel_launch: memset failed\n"); return; }
    Params p{};
    for (int i = 0; i < 29; ++i) p.in[i] = (const float*)d_in[i];
    p.out = (float*)d_out; p.ws = (unsigned char*)d_ws;
#if MEGA
    p.ph_lo = 0; p.ph_hi = 20;
    void* args[] = {&p};
    hipError_t e = hipLaunchCooperativeKernel((const void*)fwd_kernel, dim3(grid), dim3(512), args, LDS_BYTES, stream);
    if (e != hipSuccess) fprintf(stderr, "cooperative launch failed: %s (grid %d)\n", hipGetErrorString(e), grid);
#else
    for (int ph = 0; ph < 20; ++ph) { p.ph_lo = ph; p.ph_hi = ph + 1; hipLaunchKernelGGL(fwd_kernel, dim3(grid), dim3(512), LDS_BYTES, stream, p); }
#endif
}
```
